# Optimizing an MI355X kernel written in HIP

```python
import math
import jax, jax.numpy as jnp
from jax import lax
import numpy as np

D_MODEL = 1024
BATCH = 8
SEQ = 2048
DEPTH = 1

N_ATTN_HEADS = 8
ATTN_HEAD_DIM = 64
ATTN_V_DIM = 2 * ATTN_HEAD_DIM
ATTN_QK_WIDTH = N_ATTN_HEADS * 2 * ATTN_HEAD_DIM
ATTN_WIDTH = N_ATTN_HEADS * ATTN_V_DIM
Q_BLOCK = 128
CONV_WIDTH = D_MODEL
CONV_KERNEL = 3
PEER_HEADS = 8
PEER_N_KEYS = 128
PEER_N_EXPERTS = PEER_N_KEYS * PEER_N_KEYS
PEER_KEY_DIM = 256
PEER_HALF_DIM = PEER_KEY_DIM // 2
PEER_TOPK = 16
TOKEN_CHUNK = 128
RMS_EPS = 1e-6

IN_WIDTHS = (ATTN_QK_WIDTH, ATTN_QK_WIDTH, ATTN_WIDTH,
             CONV_WIDTH, CONV_WIDTH, CONV_WIDTH, D_MODEL, D_MODEL)
IN_WIDTH = sum(IN_WIDTHS)
IN_SPLITS = tuple(int(v) for v in np.cumsum(IN_WIDTHS)[:-1])

kernel_name = "hybrid_diffattn_shortconv_peer"


def rmsnorm(x, g):
    xf = x.astype(jnp.float32)
    r = lax.rsqrt(jnp.mean(xf * xf, axis=-1, keepdims=True) + RMS_EPS)
    return (xf * r).astype(x.dtype) * g


def diff_attention(q, k, v, lam):
    seq = q.shape[1]
    scale = ATTN_HEAD_DIM ** -0.5
    outs = []
    for blk in range(seq // Q_BLOCK):
        start = blk * Q_BLOCK
        end = start + Q_BLOCK
        qb, kb, vb = q[:, start:end], k[:, :end], v[:, :end]
        s = jnp.einsum('bqhmd,bkhmd->bhmqk', qb, kb).astype(jnp.float32) * scale
        q_pos = start + jnp.arange(Q_BLOCK)
        k_pos = jnp.arange(end)
        s = jnp.where(k_pos[None, :] <= q_pos[:, None], s, -jnp.inf)
        p = jax.nn.softmax(s, axis=-1)
        a = p[:, :, 0] - lam * p[:, :, 1]
        outs.append(jnp.einsum('bhqk,bkhe->bqhe', a.astype(vb.dtype), vb))
    return jnp.concatenate(outs, axis=1)


def causal_depthwise_conv(u, w):
    return lax.conv_general_dilated(
        u, w[:, None, :].astype(u.dtype), window_strides=(1,),
        padding=[(CONV_KERNEL - 1, 0)],
        dimension_numbers=('NWC', 'WIO', 'NWC'),
        feature_group_count=u.shape[-1])


def peer_ffn(xn, w_query, sub_keys, expert_u, expert_v):
    b, s, d = xn.shape
    t = b * s
    xf = xn.reshape(t, d)
    q = (xf @ w_query).reshape(t, PEER_HEADS, 2, PEER_HALF_DIM)
    half_scores = jnp.einsum('thmd,hmnd->thmn', q, sub_keys)
    top_s, top_i = lax.top_k(half_scores, PEER_TOPK)
    cand_s = (top_s[:, :, 0, :, None] + top_s[:, :, 1, None, :]).reshape(t, PEER_HEADS, PEER_TOPK * PEER_TOPK)
    cand_i = (top_i[:, :, 0, :, None] * PEER_N_KEYS + top_i[:, :, 1, None, :]).reshape(t, PEER_HEADS, PEER_TOPK * PEER_TOPK)
    sel_s, pos = lax.top_k(cand_s, PEER_TOPK)
    sel_i = jnp.take_along_axis(cand_i, pos, axis=-1)
    gates = jax.nn.softmax(sel_s.astype(jnp.float32), axis=-1).astype(xn.dtype)
    hk = PEER_HEADS * PEER_TOPK
    n_chunks = t // TOKEN_CHUNK

    def chunk_fn(args):
        xc, ic, gc = args
        u = expert_u[ic]
        a = jnp.einsum('cd,ced->ce', xc, u)
        hact = jax.nn.gelu(a, approximate=False) * gc
        return jnp.einsum('ce,ced->cd', hact, expert_v[ic])

    y = lax.map(chunk_fn, (xf.reshape(n_chunks, TOKEN_CHUNK, d),
                           sel_i.reshape(n_chunks, TOKEN_CHUNK, hk),
                           gates.reshape(n_chunks, TOKEN_CHUNK, hk)))
    return y.reshape(b, s, d)


def setup_inputs(seed: int = 0) -> dict:
    key = jax.random.key(seed)
    ks = jax.random.split(key, 16)
    f32 = jnp.float32

    def nrm(k, shape, scale):
        return jax.random.normal(k, shape, f32) * scale

    def gain(k, shape):
        return 1.0 + 0.01 * jax.random.normal(k, shape, f32)

    return {
        "x": nrm(ks[0], (BATCH, SEQ, D_MODEL), 1.0),
        "norm1_g": gain(ks[1], (DEPTH, D_MODEL)),
        "w_in": nrm(ks[2], (DEPTH, D_MODEL, IN_WIDTH), D_MODEL ** -0.5),
        "lambda_qk": nrm(ks[3], (DEPTH, 4, ATTN_HEAD_DIM), 0.1),
        "subln_g": gain(ks[4], (DEPTH, ATTN_V_DIM)),
        "conv_w": nrm(ks[5], (DEPTH, CONV_KERNEL, CONV_WIDTH), CONV_KERNEL ** -0.5),
        "w_attn_o": nrm(ks[6], (DEPTH, ATTN_WIDTH, D_MODEL), ATTN_WIDTH ** -0.5),
        "w_conv_o": nrm(ks[7], (DEPTH, CONV_WIDTH, D_MODEL), CONV_WIDTH ** -0.5),
        "w_out": nrm(ks[8], (DEPTH, D_MODEL, D_MODEL), D_MODEL ** -0.5),
        "norm2_g": gain(ks[9], (DEPTH, D_MODEL)),
        "w_query": nrm(ks[10], (DEPTH, D_MODEL, PEER_HEADS * PEER_KEY_DIM), D_MODEL ** -0.5),
        "sub_keys": nrm(ks[11], (DEPTH, PEER_HEADS, 2, PEER_N_KEYS, PEER_HALF_DIM), PEER_HALF_DIM ** -0.5),
        "expert_u": nrm(ks[12], (DEPTH, PEER_N_EXPERTS, D_MODEL), D_MODEL ** -0.5),
        "expert_v": nrm(ks[13], (DEPTH, PEER_N_EXPERTS, D_MODEL), D_MODEL ** -0.5),
        "final_g": gain(ks[14], (D_MODEL,)),
    }


def reference(x, norm1_g, w_in, lambda_qk, subln_g, conv_w, w_attn_o, w_conv_o,
              w_out, norm2_g, w_query, sub_keys, expert_u, expert_v, final_g):
    b, s, _ = x.shape
    h = x
    for l in range(DEPTH):
        lam_init = 0.8 - 0.6 * math.exp(-0.3 * l)
        lq = lambda_qk[l].astype(jnp.float32)
        lam = jnp.exp(jnp.sum(lq[0] * lq[1])) - jnp.exp(jnp.sum(lq[2] * lq[3])) + lam_init

        n = rmsnorm(h, norm1_g[l])
        proj = n @ w_in[l]
        q, k, v, cb, cc, cx, g_attn, g_conv = jnp.split(proj, IN_SPLITS, axis=-1)

        q = q.reshape(b, s, N_ATTN_HEADS, 2, ATTN_HEAD_DIM)
        k = k.reshape(b, s, N_ATTN_HEADS, 2, ATTN_HEAD_DIM)
        v = v.reshape(b, s, N_ATTN_HEADS, ATTN_V_DIM)
        o = diff_attention(q, k, v, lam)
        o = rmsnorm(o, subln_g[l]) * (1.0 - lam_init)
        y_attn = o.reshape(b, s, ATTN_WIDTH) @ w_attn_o[l]

        y_conv = (cb * causal_depthwise_conv(cc * cx, conv_w[l])) @ w_conv_o[l]

        merged = jax.nn.sigmoid(g_attn) * y_attn + jax.nn.sigmoid(g_conv) * y_conv
        h = h + merged @ w_out[l]

        h = h + peer_ffn(rmsnorm(h, norm2_g[l]), w_query[l], sub_keys[l], expert_u[l], expert_v[l])
    return rmsnorm(h, final_g)
```

```cpp
#include <hip/hip_runtime.h>
#include <hip/hip_cooperative_groups.h>
#include <cstdio>
#include <cstdint>
namespace cg = cooperative_groups;
namespace pg8 {
#define PG8_LAS __attribute__((address_space(3)))
typedef unsigned short bf16_t;
typedef short bf16x8 __attribute__((ext_vector_type(8)));
typedef float f32x4 __attribute__((ext_vector_type(4)));
typedef unsigned u32x4 __attribute__((ext_vector_type(4)));
constexpr int BM = 256, BK = 64, HALF = 128, HTB = HALF * BK * 2  , STAGE_BYTES = 8 * HTB, NXCD = 8, WGM = 8;

__host__ __device__ __forceinline__ int lds_byte(int r, int c) { const int st = (r >> 4) * 2 + (c >> 5), rr = r & 15, cc = c & 31, ob = rr * 64 + cc * 2; return st * 1024 + (ob ^ (((ob >> 9) & 1) << 5)); }
__host__ __device__ __forceinline__ void stage_rc(int b, int& R, int& C) { const int st = b / 1024, sb = b % 1024, swz = sb ^ (((sb >> 9) & 1) << 5); R = (st >> 1) * 16 + swz / 64; C = (st & 1) * 32 + (swz % 64) / 2; }
__host__ __device__ __forceinline__ int perm32(int rho) { const int n = rho >> 4, i = rho & 15; return 8 * (i >> 2) + 4 * n + (i & 3); }

struct Unit { int pm, pn, kh; };
struct Gemm { const bf16_t* A; const bf16_t* Bt; int M, N, K, lda, ldb; };
struct StaticOrder {
    int nM, nN, nwg, G, c;
    __host__ __device__ void init(int M, int N, int G_, int c_) { nM = M / BM; nN = N / BM; nwg = nM * nN; G = G_; c = c_; }
    __host__ __device__ bool next(int i, Unit& u) const {
        const long L = (long)i * G + c; if (L >= nwg) return false;
        int wgid = (int)L; { const int q = nwg / NXCD, r = nwg % NXCD, xcd = wgid % NXCD, off = wgid / NXCD; wgid = (xcd < r ? xcd * (q + 1) : r * (q + 1) + (xcd - r) * q) + off; }
        const int nig = WGM * nN, gid = wgid / nig, fm = gid * WGM, gsz = (nM - fm) < WGM ? (nM - fm) : WGM;
        u.pm = fm + ((wgid % nig) % gsz); u.pn = (wgid % nig) / gsz; u.kh = 0; return true;
    }
    __device__ __forceinline__ void a_ready(const Unit&) const {}
    __device__ __forceinline__ void done(const Unit&) const {}
};
struct SplitKOrder {
    StaticOrder base;
    __host__ __device__ bool next(int i, Unit& u) const { if (!base.next(i >> 1, u)) return false; u.kh = i & 1; return true; }
    __device__ __forceinline__ void a_ready(const Unit&) const {}
    __device__ __forceinline__ void done(const Unit&) const {}
};
__device__ __forceinline__ unsigned cvt_pk_bf16(float lo, float hi) { unsigned r; asm volatile("v_cvt_pk_bf16_f32 %0, %1, %2" : "=v"(r) : "v"(lo), "v"(hi)); return r; }
typedef float f32x2 __attribute__((ext_vector_type(2)));
typedef float f32x2 __attribute__((ext_vector_type(2)));
typedef unsigned u32x2 __attribute__((ext_vector_type(2)));
__device__ __forceinline__ void unpack8(const u32x4 w, float (&f)[8]) {
    f[0] = __builtin_bit_cast(float, w.x << 16); f[1] = __builtin_bit_cast(float, w.x & 0xffff0000u);
    f[2] = __builtin_bit_cast(float, w.y << 16); f[3] = __builtin_bit_cast(float, w.y & 0xffff0000u);
    f[4] = __builtin_bit_cast(float, w.z << 16); f[5] = __builtin_bit_cast(float, w.z & 0xffff0000u);
    f[6] = __builtin_bit_cast(float, w.w << 16); f[7] = __builtin_bit_cast(float, w.w & 0xffff0000u);
}
__device__ __forceinline__ u32x4 pack8(const f32x4 v0, const f32x4 v1) { u32x4 w; w.x = cvt_pk_bf16(v0[0], v0[1]); w.y = cvt_pk_bf16(v0[2], v0[3]); w.z = cvt_pk_bf16(v1[0], v1[1]); w.w = cvt_pk_bf16(v1[2], v1[3]); return w; }
struct EpiPlain {
    static constexpr bool PERM = true, AFTER_DRAIN = false, MID = false;
    bf16_t* O; int ldc;
    __device__ __forceinline__ void operator()(const f32x4 (&acc)[2][2][4][2], const Unit& u, int wr, int wc, int fr, int fq) const {
        const int row0 = u.pm * BM + wr * 64 + fr, col0 = u.pn * BM + wc * 32 + 8 * fq;
#pragma unroll
        for (int ai = 0; ai < 2; ++ai)
#pragma unroll
            for (int m = 0; m < 4; ++m) { bf16_t* rowp = O + (size_t)(row0 + ai * HALF + m * 16) * ldc + col0;
#pragma unroll
                for (int bj = 0; bj < 2; ++bj) *(u32x4*)(rowp + bj * HALF) = pack8(acc[ai][bj][m][0], acc[ai][bj][m][1]); }
    }
};
struct EpiQKVG {
    static constexpr bool PERM = true, AFTER_DRAIN = false, MID = false;
    bf16_t* QKV; bf16_t* GG; float c2;
    __device__ __forceinline__ void operator()(const f32x4 (&acc)[2][2][4][2], const Unit& u, int wr, int wc, int fr, int fq) const {
        int colt = u.pn * BM; bf16_t* base = QKV; int ldc = 3072; float sc = 1.f; bool sig = false;
        if (colt < 1024) sc = c2; else if (colt >= 3072) { base = GG; ldc = 2048; colt -= 3072; sig = true; }
        const int row0 = u.pm * BM + wr * 64 + fr, col0 = colt + wc * 32 + 8 * fq;
#pragma unroll
        for (int ai = 0; ai < 2; ++ai)
#pragma unroll
            for (int m = 0; m < 4; ++m) { bf16_t* rowp = base + (size_t)(row0 + ai * HALF + m * 16) * ldc + col0;
#pragma unroll
                for (int bj = 0; bj < 2; ++bj) { f32x4 v0 = acc[ai][bj][m][0], v1 = acc[ai][bj][m][1];
                    if (sig) {
#pragma unroll
                        for (int i = 0; i < 4; ++i) { v0[i] = __builtin_amdgcn_rcpf(1.f + __expf(-v0[i])); v1[i] = __builtin_amdgcn_rcpf(1.f + __expf(-v1[i])); }
                    } else { v0 = v0 * sc; v1 = v1 * sc; }
                    *(u32x4*)(rowp + bj * HALF) = pack8(v0, v1); } }
    }
};
struct EpiGateA {
    static constexpr bool PERM = true, AFTER_DRAIN = false, MID = false;
    const bf16_t* GG; float* TMP;
    __device__ __forceinline__ void operator()(const f32x4 (&acc)[2][2][4][2], const Unit& u, int wr, int wc, int fr, int fq) const {
        const int row0 = u.pm * BM + wr * 64 + fr, col0 = u.pn * BM + wc * 32 + 8 * fq;
#pragma unroll
        for (int ai = 0; ai < 2; ++ai)
#pragma unroll
            for (int m = 0; m < 4; ++m) { const size_t row = (size_t)(row0 + ai * HALF + m * 16);
#pragma unroll
                for (int bj = 0; bj < 2; ++bj) { const int col = col0 + bj * HALF; float g[8]; unpack8(*(const u32x4*)(GG + row * 2048 + col), g);
                    f32x4 v0 = acc[ai][bj][m][0], v1 = acc[ai][bj][m][1];
                    v0[0] *= g[0]; v0[1] *= g[1]; v0[2] *= g[2]; v0[3] *= g[3]; v1[0] *= g[4]; v1[1] *= g[5]; v1[2] *= g[6]; v1[3] *= g[7];
                    *(f32x4*)(TMP + row * 1024 + col) = v0; *(f32x4*)(TMP + row * 1024 + col + 4) = v1; } }
    }
};
struct EpiGateC {
    static constexpr bool PERM = true, AFTER_DRAIN = false, MID = false;
    const bf16_t* GG; const float* TMP; bf16_t* MG;
    __device__ __forceinline__ void operator()(const f32x4 (&acc)[2][2][4][2], const Unit& u, int wr, int wc, int fr, int fq) const {
        const int row0 = u.pm * BM + wr * 64 + fr, col0 = u.pn * BM + wc * 32 + 8 * fq;
#pragma unroll
        for (int ai = 0; ai < 2; ++ai)
#pragma unroll
            for (int m = 0; m < 4; ++m) { const size_t row = (size_t)(row0 + ai * HALF + m * 16);
#pragma unroll
                for (int bj = 0; bj < 2; ++bj) { const int col = col0 + bj * HALF; float g[8]; unpack8(*(const u32x4*)(GG + row * 2048 + 1024 + col), g);
                    const f32x4 t0 = *(const f32x4*)(TMP + row * 1024 + col), t1 = *(const f32x4*)(TMP + row * 1024 + col + 4);
                    f32x4 v0 = acc[ai][bj][m][0], v1 = acc[ai][bj][m][1];
                    v0[0] = t0[0] + v0[0] * g[0]; v0[1] = t0[1] + v0[1] * g[1]; v0[2] = t0[2] + v0[2] * g[2]; v0[3] = t0[3] + v0[3] * g[3];
                    v1[0] = t1[0] + v1[0] * g[4]; v1[1] = t1[1] + v1[1] * g[5]; v1[2] = t1[2] + v1[2] * g[6]; v1[3] = t1[3] + v1[3] * g[7];
                    *(u32x4*)(MG + row * 1024 + col) = pack8(v0, v1); } }
    }
};
struct EpiG1 {
    static constexpr bool PERM = true, AFTER_DRAIN = false, MID = false;
    bf16_t* QKV; bf16_t* GG; bf16_t* CB; bf16_t* PR; float c2;
    __device__ __forceinline__ void operator()(const f32x4 (&acc)[2][2][4][2], const Unit& u, int wr, int wc, int fr, int fq) const {
        int colt = u.pn * BM; const int row0 = u.pm * BM + wr * 64 + fr;
        if (colt >= 6144) {
            const int ch0 = (colt - 6144) / 2 + wc * 16 + 4 * fq;
#pragma unroll
            for (int ai = 0; ai < 2; ++ai)
#pragma unroll
                for (int m = 0; m < 4; ++m) { bf16_t* rowp = PR + (size_t)(row0 + ai * HALF + m * 16) * 1024 + ch0;
#pragma unroll
                    for (int bj = 0; bj < 2; ++bj) { const f32x4 v0 = acc[ai][bj][m][0], v1 = acc[ai][bj][m][1];
                        u32x2 w; w.x = cvt_pk_bf16(v0[0] * v0[1], v0[2] * v0[3]); w.y = cvt_pk_bf16(v1[0] * v1[1], v1[2] * v1[3]);
                        *(u32x2*)(rowp + bj * (HALF / 2)) = w; } }
            return;
        }
        bf16_t* base = QKV; int ldc = 3072; float sc = 1.f; bool sig = false;
        if (colt < 1024) sc = c2; else if (colt >= 5120) { base = CB; ldc = 2048; colt -= 5120; } else if (colt >= 3072) { base = GG; ldc = 2048; colt -= 3072; sig = true; }
        const int col0 = colt + wc * 32 + 8 * fq;
#pragma unroll
        for (int ai = 0; ai < 2; ++ai)
#pragma unroll
            for (int m = 0; m < 4; ++m) { bf16_t* rowp = base + (size_t)(row0 + ai * HALF + m * 16) * ldc + col0;
#pragma unroll
                for (int bj = 0; bj < 2; ++bj) { f32x4 v0 = acc[ai][bj][m][0], v1 = acc[ai][bj][m][1];
                    if (sig) {
#pragma unroll
                        for (int i = 0; i < 4; ++i) { v0[i] = __builtin_amdgcn_rcpf(1.f + __expf(-v0[i])); v1[i] = __builtin_amdgcn_rcpf(1.f + __expf(-v1[i])); }
                    } else { v0 = v0 * sc; v1 = v1 * sc; }
                    *(u32x4*)(rowp + bj * HALF) = pack8(v0, v1); } }
    }
};
struct EpiMerged {
    static constexpr bool PERM = true, AFTER_DRAIN = false, MID = true;
    const bf16_t* GG; bf16_t* MG;
    __device__ __forceinline__ void mid(f32x4 (&acc)[2][2][4][2], const Unit& u, int wr, int wc, int fr, int fq) const {
        const int row0 = u.pm * BM + wr * 64 + fr, col0 = u.pn * BM + wc * 32 + 8 * fq;
#pragma unroll
        for (int ai = 0; ai < 2; ++ai)
#pragma unroll
            for (int m = 0; m < 4; ++m) { const size_t row = (size_t)(row0 + ai * HALF + m * 16);
#pragma unroll
                for (int bj = 0; bj < 2; ++bj) { const int col = col0 + bj * HALF; float ga[8], gc[8];
                    unpack8(*(const u32x4*)(GG + row * 2048 + col), ga); unpack8(*(const u32x4*)(GG + row * 2048 + 1024 + col), gc);
#pragma unroll
                    for (int i = 0; i < 4; ++i) { acc[ai][bj][m][0][i] *= ga[i] * __builtin_amdgcn_rcpf(gc[i]); acc[ai][bj][m][1][i] *= ga[4 + i] * __builtin_amdgcn_rcpf(gc[4 + i]); }
                    asm volatile("" ::: "memory"); } }
    }
    __device__ __forceinline__ void operator()(const f32x4 (&acc)[2][2][4][2], const Unit& u, int wr, int wc, int fr, int fq) const {
        const int row0 = u.pm * BM + wr * 64 + fr, col0 = u.pn * BM + wc * 32 + 8 * fq;
#pragma unroll
        for (int ai = 0; ai < 2; ++ai)
#pragma unroll
            for (int m = 0; m < 4; ++m) { const size_t row = (size_t)(row0 + ai * HALF + m * 16);
#pragma unroll
                for (int bj = 0; bj < 2; ++bj) { const int col = col0 + bj * HALF; float gc[8]; unpack8(*(const u32x4*)(GG + row * 2048 + 1024 + col), gc);
                    f32x4 v0 = acc[ai][bj][m][0], v1 = acc[ai][bj][m][1];
#pragma unroll
                    for (int i = 0; i < 4; ++i) { v0[i] *= gc[i]; v1[i] *= gc[4 + i]; }
                    *(u32x4*)(MG + row * 1024 + col) = pack8(v0, v1); } }
    }
};
struct EpiResid {
    static constexpr bool PERM = true, AFTER_DRAIN = false, MID = false;
    const float* X; float* H2; bf16_t* H2B; float* SSQ;
    __device__ __forceinline__ void operator()(const f32x4 (&acc)[2][2][4][2], const Unit& u, int wr, int wc, int fr, int fq) const {
        const int row0 = u.pm * BM + wr * 64 + fr, col0 = u.pn * BM + wc * 32 + 8 * fq;
#pragma unroll
        for (int ai = 0; ai < 2; ++ai)
#pragma unroll
            for (int m = 0; m < 4; ++m) { const size_t row = (size_t)(row0 + ai * HALF + m * 16); float s = 0.f;
#pragma unroll
                for (int bj = 0; bj < 2; ++bj) { const size_t o = row * 1024 + col0 + bj * HALF;
                    const f32x4 v0 = acc[ai][bj][m][0] + *(const f32x4*)(X + o), v1 = acc[ai][bj][m][1] + *(const f32x4*)(X + o + 4);
                    *(f32x4*)(H2 + o) = v0; *(f32x4*)(H2 + o + 4) = v1; *(u32x4*)(H2B + o) = pack8(v0, v1);
                    s += (v0[0] * v0[0] + v0[1] * v0[1]) + (v0[2] * v0[2] + v0[3] * v0[3]) + (v1[0] * v1[0] + v1[1] * v1[1]) + (v1[2] * v1[2] + v1[3] * v1[3]); }
                s += __shfl_xor(s, 16); s += __shfl_xor(s, 32);
                if (fq == 0) SSQ[row * 16 + u.pn * 4 + wc] = s; }
    }
};
struct EpiRowScale {
    static constexpr bool PERM = true, AFTER_DRAIN = false, MID = false;
    const float* SSQ; bf16_t* O;
    __device__ __forceinline__ void operator()(const f32x4 (&acc)[2][2][4][2], const Unit& u, int wr, int wc, int fr, int fq) const {
        const int row0 = u.pm * BM + wr * 64 + fr, col0 = u.pn * BM + wc * 32 + 8 * fq;
#pragma unroll
        for (int ai = 0; ai < 2; ++ai)
#pragma unroll
            for (int m = 0; m < 4; ++m) { const size_t row = (size_t)(row0 + ai * HALF + m * 16);
                const f32x4* sp = (const f32x4*)(SSQ + row * 16); const f32x4 a = sp[0] + sp[1], b = sp[2] + sp[3], c = a + b;
                const float rs = rsqrtf(((c[0] + c[1]) + (c[2] + c[3])) * (1.f / 1024.f) + 1e-6f);
#pragma unroll
                for (int bj = 0; bj < 2; ++bj) *(u32x4*)(O + row * 2048 + col0 + bj * HALF) = pack8(acc[ai][bj][m][0] * rs, acc[ai][bj][m][1] * rs); }
    }
};
template <class Epi, class Sched, bool ALIGN_EPI = false, bool SP2 = false>
__device__ __forceinline__ void gemm_phase(PG8_LAS unsigned char* lds, const Gemm g, const Sched& S, const Epi& E) {
    const int tid = threadIdx.x, wid = __builtin_amdgcn_readfirstlane(tid >> 6), lane = tid & 63, wr = wid >> 2, wc = wid & 3, fr = lane & 15, fq = lane >> 4;
    const int K = g.K, nt = K / BK;
    unsigned voffA[2], voffB[2];
#pragma unroll
    for (int i = 0; i < 2; ++i) { int R, C; stage_rc(tid * 16 + i * 8192, R, C); const int Rb = Epi::PERM ? ((R & ~31) + perm32(R & 31)) : R;
        voffA[i] = (unsigned)(R * g.lda + C) * 2u; voffB[i] = (unsigned)(Rb * g.ldb + C) * 2u; }
    const size_t kstep = (size_t)(BK * 2);
    const size_t hstep = (size_t)HALF * g.ldb * 2;
    const size_t tstep = 2 * hstep;
    const size_t hstepA = (size_t)HALF * g.lda * 2, tstepA = 2 * hstepA;
    const unsigned ldsw = (unsigned)wid * 1024u;
    const int aoff = lds_byte(wr * 64 + fr, fq * 8), boff = lds_byte(wc * 32 + fr, fq * 8);
#define PG8_SA(b, h) (((b) * 2 + (h)) * HTB)
#define PG8_SB(b, h) ((4 + (b) * 2 + (h)) * HTB)
#define PG8_STAGE(bufoff, gbase, voff) do { _Pragma("unroll") for (int _i = 0; _i < 2; ++_i) \
        __builtin_amdgcn_global_load_lds((const unsigned*)((const char*)(gbase) + (voff)[_i]), (PG8_LAS unsigned*)(lds + (bufoff) + ldsw + _i * 8192), 16, 0, 0); } while (0)
#define PG8_LDA(dst, b, h) do { _Pragma("unroll") for (int m = 0; m < 4; ++m) _Pragma("unroll") for (int k = 0; k < 2; ++k) dst[m][k] = *(const PG8_LAS bf16x8*)(lds + PG8_SA(b, h) + aoff + m * 2048 + k * 1024); } while (0)
#define PG8_LDB(dst, b, h) do { _Pragma("unroll") for (int n = 0; n < 2; ++n) _Pragma("unroll") for (int k = 0; k < 2; ++k) dst[n][k] = *(const PG8_LAS bf16x8*)(lds + PG8_SB(b, h) + boff + n * 2048 + k * 1024); } while (0)
#define PG8_MMA(ai, bj, At, Bt) do { __builtin_amdgcn_s_setprio(1); _Pragma("unroll") for (int m = 0; m < 4; ++m) _Pragma("unroll") for (int n = 0; n < 2; ++n) _Pragma("unroll") for (int k = 0; k < 2; ++k) \
        acc[ai][bj][m][n] = __builtin_amdgcn_mfma_f32_16x16x32_bf16(Bt[n][k], At[m][k], acc[ai][bj][m][n], 0, 0, 0); __builtin_amdgcn_s_setprio(0); } while (0)
#define PG8_WAIT_V(n) asm volatile("s_waitcnt vmcnt(" #n ")" ::: "memory")
#define PG8_WAIT_L(n) asm volatile("s_waitcnt lgkmcnt(" #n ")" ::: "memory")
#define PG8_BAR __builtin_amdgcn_s_barrier()
#define PG8_SCHED __builtin_amdgcn_sched_barrier(0)
    Unit cur, nxt; int ui = 0;
    if (!S.next(0, cur)) return;
    f32x4 acc[2][2][4][2];
#pragma unroll
    for (int a = 0; a < 2; ++a)
#pragma unroll
        for (int b = 0; b < 2; ++b)
#pragma unroll
            for (int m = 0; m < 4; ++m)
#pragma unroll
                for (int n = 0; n < 2; ++n) acc[a][b][m][n] = (f32x4){0.f, 0.f, 0.f, 0.f};
    bf16x8 At[4][2], B0[2][2], B1[2][2];
    const char* cA = (const char*)g.A + (size_t)cur.pm * tstepA + (size_t)cur.kh * K * 2; const char* cB = (const char*)g.Bt + (size_t)cur.pn * tstep + (size_t)cur.kh * K * 2;
    S.a_ready(cur);
    if constexpr (SP2) {
        PG8_STAGE(PG8_SB(0, 0), cB, voffB); PG8_STAGE(PG8_SB(0, 1), cB + hstep, voffB); PG8_STAGE(PG8_SA(0, 0), cA, voffA); PG8_STAGE(PG8_SA(0, 1), cA + hstepA, voffA);
        if (wr == 1) PG8_BAR;
        PG8_WAIT_V(2); PG8_BAR;
        PG8_STAGE(PG8_SB(1, 0), cB + kstep, voffB); PG8_STAGE(PG8_SA(1, 0), cA + kstep, voffA); PG8_STAGE(PG8_SB(1, 1), cB + hstep + kstep, voffB);
        PG8_WAIT_V(6); PG8_BAR;
    } else {
        PG8_STAGE(PG8_SB(0, 0), cB, voffB); PG8_STAGE(PG8_SA(0, 0), cA, voffA); PG8_STAGE(PG8_SB(0, 1), cB + hstep, voffB); PG8_STAGE(PG8_SA(0, 1), cA + hstepA, voffA);
        if (wr == 1) PG8_BAR;
        PG8_WAIT_V(4); PG8_BAR;
        PG8_STAGE(PG8_SB(1, 0), cB + kstep, voffB); PG8_STAGE(PG8_SA(1, 0), cA + kstep, voffA); PG8_STAGE(PG8_SB(1, 1), cB + hstep + kstep, voffB);
        PG8_WAIT_V(6); PG8_BAR;
    }
    for (;;) {
        const bool has_next = S.next(ui + 1, nxt);
        const char* nA = has_next ? (const char*)g.A + (size_t)nxt.pm * tstepA + (size_t)nxt.kh * K * 2 : cA; const char* nB = has_next ? (const char*)g.Bt + (size_t)nxt.pn * tstep + (size_t)nxt.kh * K * 2 : cB;
        for (int t = 0; t < nt; t += 2) {
            const bool last = (t == nt - 2);
            const char* a1 = cA + (size_t)(t + 1) * kstep;
            const char* a2 = last ? nA : cA + (size_t)(t + 2) * kstep; const char* b2 = last ? nB : cB + (size_t)(t + 2) * kstep;
            const char* a3 = a2 + kstep; const char* b3 = b2 + kstep;
            if (last && has_next) S.a_ready(nxt);
            if constexpr (SP2) {
            PG8_LDB(B0, 0, 0); PG8_LDB(B1, 0, 1); PG8_SCHED; PG8_LDA(At, 0, 0); PG8_STAGE(PG8_SA(1, 1), a1 + hstepA, voffA);
            PG8_WAIT_V(8); PG8_WAIT_L(0); PG8_BAR; PG8_MMA(0, 0, At, B0); PG8_MMA(0, 1, At, B1); PG8_BAR; PG8_SCHED;
            PG8_LDA(At, 0, 1); PG8_STAGE(PG8_SB(0, 0), b2, voffB); PG8_STAGE(PG8_SB(0, 1), b2 + hstep, voffB); PG8_STAGE(PG8_SA(0, 0), a2, voffA);
            PG8_WAIT_V(8); PG8_WAIT_L(0); PG8_BAR; PG8_MMA(1, 0, At, B0); PG8_MMA(1, 1, At, B1); PG8_BAR; PG8_SCHED;
            PG8_LDB(B0, 1, 0); PG8_LDB(B1, 1, 1); PG8_SCHED; PG8_LDA(At, 1, 0); PG8_STAGE(PG8_SA(0, 1), a2 + hstepA, voffA);
            PG8_WAIT_V(8); PG8_WAIT_L(0); PG8_BAR; PG8_MMA(0, 0, At, B0); PG8_MMA(0, 1, At, B1); PG8_BAR; PG8_SCHED;
            PG8_LDA(At, 1, 1); PG8_STAGE(PG8_SB(1, 0), b3, voffB); PG8_STAGE(PG8_SB(1, 1), b3 + hstep, voffB); PG8_STAGE(PG8_SA(1, 0), a3, voffA);
            PG8_WAIT_V(8); PG8_WAIT_L(0); PG8_BAR; PG8_MMA(1, 0, At, B0); PG8_MMA(1, 1, At, B1); PG8_BAR; PG8_SCHED;
            } else {
            PG8_LDB(B0, 0, 0); PG8_SCHED; PG8_LDA(At, 0, 0); PG8_STAGE(PG8_SA(1, 1), a1 + hstepA, voffA);
            PG8_WAIT_L(8); PG8_BAR; PG8_WAIT_L(0); PG8_MMA(0, 0, At, B0); PG8_BAR; PG8_SCHED;
            PG8_LDB(B1, 0, 1); PG8_STAGE(PG8_SB(0, 0), b2, voffB);
            PG8_BAR; PG8_WAIT_L(0); PG8_MMA(0, 1, At, B1); PG8_BAR;
            PG8_LDA(At, 0, 1); PG8_STAGE(PG8_SA(0, 0), a2, voffA);
            PG8_BAR; PG8_WAIT_L(0); PG8_MMA(1, 0, At, B0); PG8_BAR; PG8_SCHED;
            PG8_STAGE(PG8_SB(0, 1), b2 + hstep, voffB);
            PG8_WAIT_V(6); PG8_BAR; PG8_MMA(1, 1, At, B1); PG8_BAR;
            PG8_LDB(B0, 1, 0); PG8_SCHED; PG8_LDA(At, 1, 0); PG8_STAGE(PG8_SA(0, 1), a2 + hstepA, voffA);
            PG8_WAIT_L(8); PG8_BAR; PG8_WAIT_L(0); PG8_MMA(0, 0, At, B0); PG8_BAR; PG8_SCHED;
            PG8_LDB(B1, 1, 1); PG8_STAGE(PG8_SB(1, 0), b3, voffB);
            PG8_BAR; PG8_WAIT_L(0); PG8_MMA(0, 1, At, B1); PG8_BAR;
            PG8_LDA(At, 1, 1); PG8_STAGE(PG8_SA(1, 0), a3, voffA);
            PG8_BAR; PG8_WAIT_L(0); PG8_MMA(1, 0, At, B0); PG8_BAR; PG8_SCHED;
            PG8_STAGE(PG8_SB(1, 1), b3 + hstep, voffB);
            PG8_WAIT_V(6); PG8_BAR; PG8_MMA(1, 1, At, B1); PG8_BAR;
            }
        }
        if constexpr (ALIGN_EPI) { if (wr == 0) PG8_BAR; }
        bool keep_acc = false;
        if constexpr (Epi::MID) { if (cur.kh == 0) { E.mid(acc, cur, wr, wc, fr, fq); keep_acc = true; } }
        if constexpr (!Epi::AFTER_DRAIN) { if (!keep_acc) { E(acc, cur, wr, wc, fr, fq); S.done(cur); } }
        if (!has_next) break;
        if (!keep_acc)
#pragma unroll
        for (int a = 0; a < 2; ++a)
#pragma unroll
            for (int b = 0; b < 2; ++b)
#pragma unroll
                for (int m = 0; m < 4; ++m)
#pragma unroll
                    for (int n = 0; n < 2; ++n) acc[a][b][m][n] = (f32x4){0.f, 0.f, 0.f, 0.f};
        cur = nxt; cA = nA; cB = nB; ++ui;
        if constexpr (ALIGN_EPI) { if (wr == 1) PG8_BAR; }
    }
    PG8_WAIT_V(0);
    if constexpr (!ALIGN_EPI) { if (wr == 0) PG8_BAR; }
    PG8_BAR;
    if constexpr (Epi::AFTER_DRAIN) { E.fused(acc, cur, wr, wc, fr, fq, lds, wid, lane); S.done(cur); }
#undef PG8_SA
#undef PG8_SB
#undef PG8_STAGE
#undef PG8_LDA
#undef PG8_LDB
#undef PG8_MMA
#undef PG8_WAIT_V
#undef PG8_WAIT_L
#undef PG8_BAR
#undef PG8_SCHED
}
}
#define LAS __attribute__((address_space(3)))
typedef unsigned short bf16;
typedef short bf16x8 __attribute__((ext_vector_type(8)));
typedef short s16x4 __attribute__((ext_vector_type(4)));
typedef float f32x4 __attribute__((ext_vector_type(4)));
typedef float f32x16 __attribute__((ext_vector_type(16)));
typedef unsigned u32x4 __attribute__((ext_vector_type(4)));
typedef unsigned u32x2 __attribute__((ext_vector_type(2)));
typedef float f32x2_t __attribute__((ext_vector_type(2))); typedef __bf16 bf16x2_t __attribute__((ext_vector_type(2)));

constexpr int T = 16384, DM = 1024, SEQ = 2048;
constexpr int NWAVES = 8, NTHR = 512;
constexpr int LDS_BYTES = 147456;
constexpr float EPS = 1e-6f;
constexpr float ESCALE = 64.f;
constexpr float C2 = 0.125f * 1.4426950408889634f;
constexpr size_t MiB = 1u << 20;
constexpr size_t WS_WIN = 0, WS_WAC = 16 * MiB, WS_WOUT = 20 * MiB, WS_WQ = 22 * MiB, WS_SUBK = 26 * MiB, WS_SSQ = 27 * MiB;
constexpr size_t WS_EU = 28 * MiB, WS_EV = 44 * MiB, WS_BIG = 60 * MiB, WS_END = 252 * MiB;
constexpr size_t B_QKV = 0, B_GG = 96 * MiB, B_PR = 160 * MiB, B_MG = 0, B_H2B = 32 * MiB, B_QP = 96 * MiB, B_SEL = 64 * MiB, B_GATE = 72 * MiB;

__device__ __forceinline__ unsigned cvtpk(float lo, float hi) { f32x2_t v = {lo, hi}; bf16x2_t b = __builtin_convertvector(v, bf16x2_t); return __builtin_bit_cast(unsigned, b); }
__device__ __forceinline__ float wave_sum(float v) {
#pragma unroll
    for (int o = 1; o < 64; o <<= 1) v += __shfl_xor(v, o);
    return v;
}
#define LDS_WAIT() asm volatile("s_waitcnt lgkmcnt(0)" ::: "memory")

struct Params {
    const float* x; const float* norm1_g; const float* w_in; const float* lambda_qk; const float* subln_g; const float* conv_w;
    const float* w_attn_o; const float* w_conv_o; const float* w_out; const float* norm2_g; const float* w_query; const float* sub_keys;
    const float* expert_u; const float* expert_v; const float* final_g;
    float* out; unsigned char* ws; int lo, hi;
};

__device__ __forceinline__ void transpose_item(const float* W, int K, int N, bf16* WT, int remap, int dpitch, int koff, const float* kscale, LAS float* scr, int item, int lane) {
    const int nblk = N / 32, kb = item / nblk, nb = item % nblk, k0 = 64 * kb, n0 = 32 * nb;
    int d0 = n0, dstr = 1;
    if (remap) { if (n0 < 3072) d0 = n0; else if (n0 < 4096) d0 = n0 + 2048; else if (n0 < 5120) { d0 = 6144 + 2 * (n0 - 4096); dstr = 2; } else if (n0 < 6144) { d0 = 6144 + 2 * (n0 - 5120) + 1; dstr = 2; } else d0 = n0 - 3072; }
#pragma unroll 8
    for (int i = 0; i < 32; ++i) { const int kk = 2 * i + (lane >> 5); float v = W[(size_t)(k0 + kk) * N + n0 + (lane & 31)]; if (kscale) v *= kscale[k0 + kk]; scr[kk * 33 + (lane & 31)] = v; }
    LDS_WAIT(); asm volatile("" ::: "memory");
    const int c = lane & 7;
#pragma unroll
    for (int j = 0; j < 4; ++j) { const int n = (lane >> 3) + 8 * j; const LAS float* sp = scr + (8 * c) * 33 + n;
        u32x4 o; o.x = cvtpk(sp[0 * 33], sp[1 * 33]); o.y = cvtpk(sp[2 * 33], sp[3 * 33]); o.z = cvtpk(sp[4 * 33], sp[5 * 33]); o.w = cvtpk(sp[6 * 33], sp[7 * 33]);
        *(u32x4*)(WT + (size_t)(d0 + n * dstr) * dpitch + koff + k0 + 8 * c) = o; }
    LDS_WAIT(); asm volatile("" ::: "memory");
}
__device__ __forceinline__ void cvt_flat(const float* src, bf16* dst, size_t n8, size_t gtid, size_t nthr) {
    for (size_t i = gtid; i < n8; i += nthr) { const f32x4 a = *(const f32x4*)(src + i * 8), b = *(const f32x4*)(src + i * 8 + 4);
        u32x4 o; o.x = cvtpk(a[0], a[1]); o.y = cvtpk(a[2], a[3]); o.z = cvtpk(b[0], b[1]); o.w = cvtpk(b[2], b[3]); *(u32x4*)(dst + i * 8) = o; }
}
__device__ __forceinline__ void cvt_flat_fp8(const float* src, unsigned char* dst, size_t n16, float sc, size_t gtid, size_t nthr) {
    for (size_t i = gtid; i < n16; i += nthr) { u32x4 o;
#pragma unroll
        for (int q = 0; q < 4; ++q) { const f32x4 a = *(const f32x4*)(src + i * 16 + 4 * q) * sc; int w = 0;
            w = __builtin_amdgcn_cvt_pk_fp8_f32(a[0], a[1], w, false); w = __builtin_amdgcn_cvt_pk_fp8_f32(a[2], a[3], w, true); o[q] = (unsigned)w; }
        *(u32x4*)(dst + i * 16) = o; }
}
__device__ __forceinline__ void phase0(const Params& p, LAS unsigned char* lds, int G, int bid, int wave, int lane) {
    unsigned char* ws = p.ws;
    LAS float* scr = (LAS float*)(lds + wave * 16384);
    const int gw = bid * NWAVES + wave, NGW = G * NWAVES;
    constexpr int I_IN = 16 * 256, I_SQ = 16 * 32, I_Q = 16 * 64, NITEMS = I_IN + 3 * I_SQ + I_Q;
    for (int it = gw; it < NITEMS; it += NGW) {
        int r = it;
        if (r < I_IN) { transpose_item(p.w_in, 1024, 8192, (bf16*)(ws + WS_WIN), 1, 1024, 0, nullptr, scr, r, lane); continue; } r -= I_IN;
        if (r < I_SQ) { transpose_item(p.w_attn_o, 1024, 1024, (bf16*)(ws + WS_WAC), 0, 2048, 0, nullptr, scr, r, lane); continue; } r -= I_SQ;
        if (r < I_SQ) { transpose_item(p.w_conv_o, 1024, 1024, (bf16*)(ws + WS_WAC), 0, 2048, 1024, nullptr, scr, r, lane); continue; } r -= I_SQ;
        if (r < I_SQ) { transpose_item(p.w_out, 1024, 1024, (bf16*)(ws + WS_WOUT), 0, 1024, 0, nullptr, scr, r, lane); continue; } r -= I_SQ;
        transpose_item(p.w_query, 1024, 2048, (bf16*)(ws + WS_WQ), 0, 1024, 0, p.norm2_g, scr, r, lane);
    }
    const size_t gtid = (size_t)bid * NTHR + wave * 64 + lane, nthr = (size_t)G * NTHR;
    cvt_flat(p.sub_keys, (bf16*)(ws + WS_SUBK), (size_t)(8 * 2 * 128 * 128) / 8, gtid, nthr);
    bf16* N1 = (bf16*)p.out;
    f32x4 gv[4];
#pragma unroll
    for (int j = 0; j < 4; ++j) gv[j] = *((const f32x4*)p.norm1_g + lane + 64 * j);
    for (int m = gw; m < T; m += NGW) {
        const f32x4* xr = (const f32x4*)(p.x + (size_t)m * DM) + lane; f32x4 v[4]; float s = 0.f;
#pragma unroll
        for (int j = 0; j < 4; ++j) { v[j] = xr[64 * j]; s += (v[j][0] * v[j][0] + v[j][1] * v[j][1]) + (v[j][2] * v[j][2] + v[j][3] * v[j][3]); }
        const float r = rsqrtf(wave_sum(s) * (1.f / DM) + EPS);
        u32x2* o8 = (u32x2*)(N1 + (size_t)m * 2048) + lane;
#pragma unroll
        for (int j = 0; j < 4; ++j) { u32x2 o; o.x = cvtpk(v[j][0] * r * gv[j][0], v[j][1] * r * gv[j][1]); o.y = cvtpk(v[j][2] * r * gv[j][2], v[j][3] * r * gv[j][3]); o8[64 * j] = o; }
    }
}

__device__ __forceinline__ void up8(const bf16* p, float (&f)[8]) { const u32x4 w = *(const u32x4*)p; pg8::unpack8(w, f); }
__device__ __forceinline__ void phase_conv(const Params& p, int G, int bid, int tid) {
    const bf16* PR = (const bf16*)(p.ws + WS_BIG + B_PR); bf16* CBU = (bf16*)p.out + 1024;
    const size_t nthr = (size_t)G * NTHR;
    for (size_t it = (size_t)bid * NTHR + tid; it < (size_t)T * 128; it += nthr) {
        const int t = (int)(it >> 7), c8 = (int)(it & 127) * 8, s = t & (SEQ - 1);
        const bf16* row = PR + (size_t)t * 1024 + c8;
        float cb[8], a[8], acc[8];
        up8(CBU + (size_t)t * 2048 + c8, cb); up8(row, a);
        const f32x4 w2a = *(const f32x4*)(p.conv_w + 2048 + c8), w2b = *(const f32x4*)(p.conv_w + 2048 + c8 + 4);
#pragma unroll
        for (int i = 0; i < 8; ++i) acc[i] = (i < 4 ? w2a[i] : w2b[i - 4]) * a[i];
        if (s >= 1) { up8(row - 1024, a);
            const f32x4 w1a = *(const f32x4*)(p.conv_w + 1024 + c8), w1b = *(const f32x4*)(p.conv_w + 1024 + c8 + 4);
#pragma unroll
            for (int i = 0; i < 8; ++i) acc[i] += (i < 4 ? w1a[i] : w1b[i - 4]) * a[i]; }
        if (s >= 2) { up8(row - 2048, a);
            const f32x4 w0a = *(const f32x4*)(p.conv_w + c8), w0b = *(const f32x4*)(p.conv_w + c8 + 4);
#pragma unroll
            for (int i = 0; i < 8; ++i) acc[i] += (i < 4 ? w0a[i] : w0b[i - 4]) * a[i]; }
        u32x4 o; o.x = cvtpk(cb[0] * acc[0], cb[1] * acc[1]); o.y = cvtpk(cb[2] * acc[2], cb[3] * acc[3]); o.z = cvtpk(cb[4] * acc[4], cb[5] * acc[5]); o.w = cvtpk(cb[6] * acc[6], cb[7] * acc[7]);
        *(u32x4*)(CBU + (size_t)t * 2048 + c8) = o;
    }
}

constexpr int KPITCH = 272, VPITCH = 320, KBYTES = 64 * KPITCH, STAGEB = KBYTES + 64 * VPITCH;
constexpr int XOFF = 0, OSTOFF = 65536, OSTPITCH = 272, OSTB = 32 * OSTPITCH;
__device__ __forceinline__ s16x4 vtr(const LAS unsigned char* p) { return __builtin_amdgcn_ds_read_tr16_b64_v4i16((LAS s16x4*)p); }

__device__ __forceinline__ void attn_unit(LAS unsigned char* lds, const bf16* QKV, bf16* ON, const float* subg, float lam, int b, int h, int qb, int tid) {
    const int w = __builtin_amdgcn_readfirstlane(tid >> 6), lane = tid & 63, map = w >> 2, wq = w & 3, l31 = lane & 31, half = lane >> 5;
    const size_t trow0 = (size_t)b * SEQ;
    const int q0 = qb * 128 + wq * 32;
    bf16x8 qf[4];
    { const bf16* qp = QKV + (trow0 + q0 + l31) * 3072 + h * 128 + map * 64 + 8 * half;
#pragma unroll
      for (int s = 0; s < 4; ++s) qf[s] = *(const bf16x8*)(qp + 16 * s); }
    f32x16 O[4];
#pragma unroll
    for (int e = 0; e < 4; ++e)
#pragma unroll
        for (int r = 0; r < 16; ++r) O[e][r] = 0.f;
    float m_run = 0.f, l_run = 0.f;
    const int ntile = 2 * (qb + 1);
    const int skey = tid >> 4, sch = tid & 15;
    const bf16* gk = QKV + (trow0 + skey) * 3072 + 1024 + h * 128 + sch * 8;
    const int dk = skey * KPITCH + sch * 16, dv = KBYTES + skey * VPITCH + sch * 16;
    u32x4 stg[4];
#define GLOAD(j) do { const bf16* g_ = gk + (size_t)(j) * 64 * 3072; stg[0] = *(const u32x4*)g_; stg[1] = *(const u32x4*)(g_ + 32 * 3072); stg[2] = *(const u32x4*)(g_ + 1024); stg[3] = *(const u32x4*)(g_ + 32 * 3072 + 1024); } while (0)
#define LSTORE(st) do { LAS unsigned char* b_ = lds + (st) * STAGEB; *(LAS u32x4*)(b_ + dk) = stg[0]; *(LAS u32x4*)(b_ + dk + 32 * KPITCH) = stg[1]; *(LAS u32x4*)(b_ + dv) = stg[2]; *(LAS u32x4*)(b_ + dv + 32 * VPITCH) = stg[3]; } while (0)
    GLOAD(0); LSTORE(0); __syncthreads();
    const int koff = l31 * KPITCH + map * 128 + half * 16;
    const int voff = KBYTES + (4 * half + ((lane & 15) >> 2)) * VPITCH + (((lane >> 4) & 1) * 16 + (lane & 3) * 4) * 2;
    const int qi = q0 + l31;
    for (int j = 0; j < ntile; ++j) {
        if (j + 1 < ntile) GLOAD(j + 1);
        const int kbase = 64 * j;
        if (kbase <= q0 + 31) {
            const LAS unsigned char* sb = lds + (j & 1) * STAGEB;
            f32x16 s0, s1;
            const float negm = -m_run;
#pragma unroll
            for (int r = 0; r < 16; ++r) { s0[r] = negm; s1[r] = negm; }
#pragma unroll
            for (int s = 0; s < 4; ++s) { const bf16x8 k0 = *(const LAS bf16x8*)(sb + koff + s * 32), k1 = *(const LAS bf16x8*)(sb + koff + 32 * KPITCH + s * 32);
                s0 = __builtin_amdgcn_mfma_f32_32x32x16_bf16(k0, qf[s], s0, 0, 0, 0); s1 = __builtin_amdgcn_mfma_f32_32x32x16_bf16(k1, qf[s], s1, 0, 0, 0); }
            const LAS unsigned char* vb = sb + voff;
            s16x4 vlo[4][4], vhi[4][4];
#pragma unroll
            for (int kk = 0; kk < 0; ++kk)
#pragma unroll
                for (int e = 0; e < 4; ++e) { vlo[kk][e] = vtr(vb + kk * 16 * VPITCH + e * 64); vhi[kk][e] = vtr(vb + (kk * 16 + 8) * VPITCH + e * 64); }
            __builtin_amdgcn_sched_barrier(0);
            if (kbase + 63 > q0) {
#pragma unroll
                for (int r = 0; r < 16; ++r) { const int key = kbase + (r & 3) + 8 * (r >> 2) + 4 * half;
                    s0[r] = (key <= qi) ? s0[r] : -1e30f; s1[r] = (key + 32 <= qi) ? s1[r] : -1e30f; }
            }
            float mx = fmaxf(s0[0], s1[0]);
#pragma unroll
            for (int r = 1; r < 16; ++r) mx = fmaxf(mx, fmaxf(s0[r], s1[r]));
            mx = fmaxf(mx, __shfl_xor(mx, 32));
            float ps = 0.f;
            const bool first = (j == 0), move = first || (__ballot(mx > 8.f) != 0ull);
            const float delta = move ? (first ? mx : fmaxf(mx, 0.f)) : 0.f;
#pragma unroll
            for (int r = 0; r < 16; ++r) { s0[r] = __builtin_amdgcn_exp2f(s0[r] - delta); s1[r] = __builtin_amdgcn_exp2f(s1[r] - delta); ps += s0[r] + s1[r]; }
            if (move) {
                const float alpha = first ? 0.f : __builtin_amdgcn_exp2f(-delta); m_run += delta;
                l_run = l_run * alpha + ps;
                if (!first) {
#pragma unroll
                    for (int e = 0; e < 4; ++e) O[e] = O[e] * alpha;
                }
            } else l_run += ps;
            bf16x8 pf[4];
#pragma unroll
            for (int kk = 0; kk < 4; ++kk) { u32x4 wv;
                if (kk < 2) { wv.x = cvtpk(s0[8 * kk + 0], s0[8 * kk + 1]); wv.y = cvtpk(s0[8 * kk + 2], s0[8 * kk + 3]); wv.z = cvtpk(s0[8 * kk + 4], s0[8 * kk + 5]); wv.w = cvtpk(s0[8 * kk + 6], s0[8 * kk + 7]); }
                else { const int k2 = kk - 2; wv.x = cvtpk(s1[8 * k2 + 0], s1[8 * k2 + 1]); wv.y = cvtpk(s1[8 * k2 + 2], s1[8 * k2 + 3]); wv.z = cvtpk(s1[8 * k2 + 4], s1[8 * k2 + 5]); wv.w = cvtpk(s1[8 * k2 + 6], s1[8 * k2 + 7]); }
                pf[kk] = __builtin_bit_cast(bf16x8, wv); }
#pragma unroll
            for (int kk = 0; kk < 2; ++kk)
#pragma unroll
                for (int e = 0; e < 4; ++e) { vlo[kk][e] = vtr(vb + kk * 16 * VPITCH + e * 64); vhi[kk][e] = vtr(vb + (kk * 16 + 8) * VPITCH + e * 64); }
            __builtin_amdgcn_sched_barrier(0);
#pragma unroll
            for (int kk = 0; kk < 4; ++kk)
#pragma unroll
                for (int e = 0; e < 4; ++e) {
                    if (kk == 0 && e == 0) {
#pragma unroll
                        for (int k2 = 2; k2 < 4; ++k2)
#pragma unroll
                            for (int e2 = 0; e2 < 4; ++e2) { vlo[k2][e2] = vtr(vb + k2 * 16 * VPITCH + e2 * 64); vhi[k2][e2] = vtr(vb + (k2 * 16 + 8) * VPITCH + e2 * 64); }
                    }
                    const s16x4 lo = vlo[kk][e], hi = vhi[kk][e];
                    bf16x8 a; a[0] = lo[0]; a[1] = lo[1]; a[2] = lo[2]; a[3] = lo[3]; a[4] = hi[0]; a[5] = hi[1]; a[6] = hi[2]; a[7] = hi[3];
                    O[e] = __builtin_amdgcn_mfma_f32_32x32x16_bf16(a, pf[kk], O[e], 0, 0, 0); }
        }
        if (j + 1 < ntile) LSTORE((j + 1) & 1);
        __syncthreads();
    }
#undef GLOAD
#undef LSTORE
    const float ltot = l_run + __shfl_xor(l_run, 32), inv = 1.f / ltot;
    LAS float* X = (LAS float*)(lds + XOFF) + wq * 4096 + lane;
    if (map == 1) {
        const float sc = inv * lam;
#pragma unroll
        for (int e = 0; e < 4; ++e)
#pragma unroll
            for (int r = 0; r < 16; ++r) X[(e * 16 + r) * 64] = O[e][r] * sc;
    }
    __syncthreads();
    if (map == 0) {
        float ssq = 0.f;
#pragma unroll
        for (int e = 0; e < 4; ++e)
#pragma unroll
            for (int r = 0; r < 16; ++r) { const float o = O[e][r] * inv - X[(e * 16 + r) * 64]; O[e][r] = o; ssq += o * o; }
        ssq += __shfl_xor(ssq, 32);
        const float rms = rsqrtf(ssq * (1.f / 128.f) + EPS) * 0.8f;
        LAS unsigned char* ost = lds + OSTOFF + wq * OSTB;
#pragma unroll
        for (int e = 0; e < 4; ++e)
#pragma unroll
            for (int rq = 0; rq < 4; ++rq) { const int e0 = 32 * e + 8 * rq + 4 * half; const f32x4 g = *(const f32x4*)(subg + e0);
                u32x2 o; o.x = cvtpk(O[e][4 * rq + 0] * rms * g[0], O[e][4 * rq + 1] * rms * g[1]); o.y = cvtpk(O[e][4 * rq + 2] * rms * g[2], O[e][4 * rq + 3] * rms * g[3]);
                *(LAS u32x2*)(ost + l31 * OSTPITCH + e0 * 2) = o; }
        LDS_WAIT(); __builtin_amdgcn_wave_barrier();
#pragma unroll
        for (int jj = 0; jj < 8; ++jj) { const int c = lane + 64 * jj, row = c >> 4, ch = c & 15;
            const u32x4 v = *(const LAS u32x4*)(ost + row * OSTPITCH + ch * 16);
            *(u32x4*)(ON + (trow0 + q0 + row) * 2048 + h * 128 + ch * 8) = v; }
    }
    __syncthreads();
}

__device__ __forceinline__ void phase_attn(const Params& p, LAS unsigned char* lds, int G, int bid, int tid) {
    const bf16* QKV = (const bf16*)(p.ws + WS_BIG); bf16* ON = (bf16*)p.out;
    const int lane = tid & 63;
    const float a = p.lambda_qk[lane] * p.lambda_qk[64 + lane], b = p.lambda_qk[128 + lane] * p.lambda_qk[192 + lane];
    const float lam = expf(wave_sum(a)) - expf(wave_sum(b)) + 0.2f;
    for (int c = bid; c < 256; c += G) {
        const int bh = c >> 2, quad = c & 3, b_ = bh >> 3, h = bh & 7;
        attn_unit(lds, QKV, ON, p.subln_g, lam, b_, h, 15 - 2 * quad, tid);
        attn_unit(lds, QKV, ON, p.subln_g, lam, b_, h, 2 * quad, tid);
        attn_unit(lds, QKV, ON, p.subln_g, lam, b_, h, 14 - 2 * quad, tid);
        attn_unit(lds, QKV, ON, p.subln_g, lam, b_, h, 2 * quad + 1, tid);
    }
}

__device__ __forceinline__ unsigned mono(float v) { const unsigned u = __builtin_bit_cast(unsigned, v); return (u & 0x80000000u) ? ~u : (u | 0x80000000u); }
__device__ __forceinline__ float unmono(unsigned k) { const unsigned u = (k & 0x80000000u) ? (k ^ 0x80000000u) : ~k; return __builtin_bit_cast(float, u); }
#define CE_(x, y) do { const unsigned t_ = max(x, y); y = min(x, y); x = t_; } while (0)
__device__ __forceinline__ void sort16(unsigned (&a)[16]) {
    CE_(a[0], a[1]); CE_(a[2], a[3]); CE_(a[0], a[2]); CE_(a[1], a[3]); CE_(a[1], a[2]); CE_(a[4], a[5]); CE_(a[6], a[7]); CE_(a[4], a[6]); CE_(a[5], a[7]); CE_(a[5], a[6]); CE_(a[0], a[4]); CE_(a[2], a[6]); CE_(a[2], a[4]); CE_(a[1], a[5]); CE_(a[3], a[7]); CE_(a[3], a[5]); CE_(a[1], a[2]); CE_(a[3], a[4]); CE_(a[5], a[6]); CE_(a[8], a[9]); CE_(a[10], a[11]); CE_(a[8], a[10]); CE_(a[9], a[11]); CE_(a[9], a[10]); CE_(a[12], a[13]); CE_(a[14], a[15]); CE_(a[12], a[14]); CE_(a[13], a[15]); CE_(a[13], a[14]); CE_(a[8], a[12]); CE_(a[10], a[14]); CE_(a[10], a[12]); CE_(a[9], a[13]); CE_(a[11], a[15]); CE_(a[11], a[13]); CE_(a[9], a[10]); CE_(a[11], a[12]); CE_(a[13], a[14]); CE_(a[0], a[8]); CE_(a[4], a[12]); CE_(a[4], a[8]); CE_(a[2], a[10]); CE_(a[6], a[14]); CE_(a[6], a[10]); CE_(a[2], a[4]); CE_(a[6], a[8]); CE_(a[10], a[12]); CE_(a[1], a[9]); CE_(a[5], a[13]); CE_(a[5], a[9]); CE_(a[3], a[11]); CE_(a[7], a[15]); CE_(a[7], a[11]); CE_(a[3], a[5]); CE_(a[7], a[9]); CE_(a[11], a[13]); CE_(a[1], a[2]); CE_(a[3], a[4]); CE_(a[5], a[6]); CE_(a[7], a[8]); CE_(a[9], a[10]); CE_(a[11], a[12]); CE_(a[13], a[14]);
}
__device__ __forceinline__ void merge16(unsigned (&a)[16], const unsigned (&b)[16]) {
    a[0] = max(a[0], b[15]); a[1] = max(a[1], b[14]); a[2] = max(a[2], b[13]); a[3] = max(a[3], b[12]); a[4] = max(a[4], b[11]); a[5] = max(a[5], b[10]); a[6] = max(a[6], b[9]); a[7] = max(a[7], b[8]); a[8] = max(a[8], b[7]); a[9] = max(a[9], b[6]); a[10] = max(a[10], b[5]); a[11] = max(a[11], b[4]); a[12] = max(a[12], b[3]); a[13] = max(a[13], b[2]); a[14] = max(a[14], b[1]); a[15] = max(a[15], b[0]);
    CE_(a[0], a[8]); CE_(a[1], a[9]); CE_(a[2], a[10]); CE_(a[3], a[11]); CE_(a[4], a[12]); CE_(a[5], a[13]); CE_(a[6], a[14]); CE_(a[7], a[15]); CE_(a[0], a[4]); CE_(a[1], a[5]); CE_(a[2], a[6]); CE_(a[3], a[7]); CE_(a[8], a[12]); CE_(a[9], a[13]); CE_(a[10], a[14]); CE_(a[11], a[15]); CE_(a[0], a[2]); CE_(a[1], a[3]); CE_(a[4], a[6]); CE_(a[5], a[7]); CE_(a[8], a[10]); CE_(a[9], a[11]); CE_(a[12], a[14]); CE_(a[13], a[15]); CE_(a[0], a[1]); CE_(a[2], a[3]); CE_(a[4], a[5]); CE_(a[6], a[7]); CE_(a[8], a[9]); CE_(a[10], a[11]); CE_(a[12], a[13]); CE_(a[14], a[15]);
}

__device__ __forceinline__ void convert_experts(const Params& p, size_t gtid, size_t nthr) {
    cvt_flat_fp8(p.expert_u, p.ws + WS_EU, (size_t)16384 * 1024 / 16, ESCALE, gtid, nthr);
    cvt_flat_fp8(p.expert_v, p.ws + WS_EV, (size_t)16384 * 1024 / 16, ESCALE, gtid, nthr);
}
__device__ __forceinline__ void phase_topk(const Params& p, LAS unsigned char* lds, int G, int bid, int wave, int lane) {
    const bf16* QP = (const bf16*)(p.ws + WS_BIG + B_QP); const bf16* SK = (const bf16*)(p.ws + WS_SUBK);
    int* SEL = (int*)(p.ws + WS_BIG + B_SEL); float* GATE = (float*)(p.ws + WS_BIG + B_GATE);
    const int gw = bid * NWAVES + wave, NGW = G * NWAVES, l31 = lane & 31, half = lane >> 5;
    LAS int* tab = (LAS int*)(lds + wave * 4096) + l31 * 32;
    const size_t cg_tid = (size_t)bid * 256 + (wave & 3) * 64 + lane, cg_n = (size_t)G * 256;
    if (wave < 4) cvt_flat_fp8(p.expert_u, p.ws + WS_EU, (size_t)16384 * 1024 / 16, ESCALE, cg_tid, cg_n);
    for (int task = gw; task < 512 * 8; task += NGW) {
        const int tg = task >> 3, h = task & 7, t = tg * 32 + l31;
        unsigned lists[2][16];
#pragma unroll
        for (int m = 0; m < 2; ++m) {
            f32x16 acc[4];
#pragma unroll
            for (int kb = 0; kb < 4; ++kb)
#pragma unroll
                for (int r = 0; r < 16; ++r) acc[kb][r] = 0.f;
            const bf16* qp = QP + (size_t)t * 2048 + h * 256 + m * 128 + 8 * half;
            const bf16* kp = SK + ((size_t)(h * 2 + m) * 128 + l31) * 128 + 8 * half;
#pragma unroll 1
            for (int s = 0; s < 8; ++s) { const bf16x8 bq = *(const bf16x8*)(qp + 16 * s);
#pragma unroll
                for (int kb = 0; kb < 4; ++kb) { const bf16x8 ak = *(const bf16x8*)(kp + kb * 32 * 128 + 16 * s); acc[kb] = __builtin_amdgcn_mfma_f32_32x32x16_bf16(ak, bq, acc[kb], 0, 0, 0); } }
            unsigned top[16], oth[16];
#pragma unroll
            for (int kb = 0; kb < 4; ++kb) {
#pragma unroll
                for (int r = 0; r < 16; ++r) { const int kidx = 32 * kb + (r & 3) + 8 * (r >> 2) + 4 * half; oth[r] = (mono(acc[kb][r]) & ~127u) | (unsigned)(127 - kidx); }
                sort16(oth);
                if (kb == 0) {
#pragma unroll
                    for (int i = 0; i < 16; ++i) top[i] = oth[i];
                } else merge16(top, oth);
            }
#pragma unroll
            for (int i = 0; i < 16; ++i) oth[i] = (unsigned)__shfl_xor((int)top[i], 32);
            merge16(top, oth);
#pragma unroll
            for (int i = 0; i < 16; ++i) lists[m][i] = top[i];
        }
        float va[16], vb[16];
#pragma unroll
        for (int i = 0; i < 16; ++i) { va[i] = unmono(lists[0][i] & ~127u); vb[i] = unmono(lists[1][i] & ~127u);
            tab[i] = 127 - (int)(lists[0][i] & 127u); tab[16 + i] = 127 - (int)(lists[1][i] & 127u); }
#define CKEY(i, j) ((mono(va[i] + vb[j]) & ~255u) | (unsigned)(255 - ((i) * 16 + (j))))
        unsigned ct[16], l1[16], l2[16], l3[16];
#pragma unroll
        for (int j = 0; j < 16; ++j) ct[j] = CKEY(0, j);
#pragma unroll
        for (int j = 0; j < 8; ++j) l1[j] = CKEY(1, j);
#pragma unroll
        for (int j = 0; j < 5; ++j) l1[8 + j] = CKEY(2, j);
        l1[13] = 0u; l1[14] = 0u; l1[15] = 0u;
#pragma unroll
        for (int j = 0; j < 4; ++j) l2[j] = CKEY(3, j);
#pragma unroll
        for (int j = 0; j < 3; ++j) l2[4 + j] = CKEY(4, j);
#pragma unroll
        for (int j = 0; j < 2; ++j) { l2[7 + j] = CKEY(5, j); l2[9 + j] = CKEY(6, j); l2[11 + j] = CKEY(7, j); }
        l2[13] = 0u; l2[14] = 0u; l2[15] = 0u;
#pragma unroll
        for (int i = 0; i < 8; ++i) { l3[i] = CKEY(8 + i, 0); l3[8 + i] = 0u; }
#undef CKEY
        sort16(l1); sort16(l2); sort16(l3);
        merge16(ct, l1); merge16(l2, l3); merge16(ct, l2);
        LDS_WAIT(); __builtin_amdgcn_wave_barrier();
        const float s0 = unmono(ct[0] & ~255u);
        float ev[16], es = 0.f; int ex[16];
#pragma unroll
        for (int r = 0; r < 16; ++r) { const int pos = 255 - (int)(ct[r] & 255u); ev[r] = __expf(unmono(ct[r] & ~255u) - s0); es += ev[r];
            ex[r] = tab[pos >> 4] * 128 + tab[16 + (pos & 15)]; }
        const float ie = 1.f / es;
        int* so = SEL + (size_t)t * 128 + h * 16; float* go = GATE + (size_t)t * 128 + h * 16;
        if (half == 0) {
#pragma unroll
            for (int r = 0; r < 8; ++r) { so[r] = ex[r]; go[r] = ev[r] * ie; }
        } else {
#pragma unroll
            for (int r = 8; r < 16; ++r) { so[r] = ex[r]; go[r] = ev[r] * ie; }
        }
        LDS_WAIT(); __builtin_amdgcn_wave_barrier();
    }
    if (wave >= 4) cvt_flat_fp8(p.expert_v, p.ws + WS_EV, (size_t)16384 * 1024 / 16, ESCALE, cg_tid, cg_n);
}

__device__ __forceinline__ void phase_gather(const Params& p, LAS unsigned char* lds, int G, int bid, int wave, int lane) {
    const int* SEL = (const int*)(p.ws + WS_BIG + B_SEL); const float* GATE = (const float*)(p.ws + WS_BIG + B_GATE);
    const unsigned char* EU = p.ws + WS_EU; const unsigned char* EV = p.ws + WS_EV;
    float* H2 = p.out;
    const int gw = bid * NWAVES + wave, NGW = G * NWAVES, l15 = lane & 15, g4 = lane >> 4;
    LAS unsigned char* wl = lds + wave * 4096;
    LAS unsigned char* xnb = wl; LAS int* selb = (LAS int*)(wl + 1024); LAS float* gateb = (LAS float*)(wl + 1536); LAS float* hb = (LAS float*)(wl + 2048);
    f32x4 g2[4], fg[4];
#pragma unroll
    for (int j = 0; j < 4; ++j) { g2[j] = *(const f32x4*)(p.norm2_g + 16 * lane + 4 * j); fg[j] = *(const f32x4*)(p.final_g + 16 * lane + 4 * j); }
    for (int t = gw; t < T; t += NGW) {
        float* hrow = H2 + (size_t)t * DM + 16 * lane;
        f32x4 hv[4];
#pragma unroll
        for (int j = 0; j < 4; ++j) hv[j] = *(const f32x4*)(hrow + 4 * j);
        const int selA = SEL[(size_t)t * 128 + lane], selB = SEL[(size_t)t * 128 + 64 + lane];
        const float gtA = GATE[(size_t)t * 128 + lane], gtB = GATE[(size_t)t * 128 + 64 + lane];
        float ssq = 0.f;
#pragma unroll
        for (int j = 0; j < 4; ++j) ssq += (hv[j][0] * hv[j][0] + hv[j][1] * hv[j][1]) + (hv[j][2] * hv[j][2] + hv[j][3] * hv[j][3]);
        const float r2 = rsqrtf(wave_sum(ssq) * (1.f / DM) + EPS);
        { u32x4 o;
#pragma unroll
          for (int j = 0; j < 4; ++j) { const f32x4 a = hv[j] * r2 * g2[j]; int w = 0;
              w = __builtin_amdgcn_cvt_pk_fp8_f32(a[0], a[1], w, false); w = __builtin_amdgcn_cvt_pk_fp8_f32(a[2], a[3], w, true); o[j] = (unsigned)w; }
          *(LAS u32x4*)(xnb + 16 * lane) = o; }
        selb[lane] = selA; selb[64 + lane] = selB; gateb[lane] = gtA; gateb[64 + lane] = gtB;
        LDS_WAIT(); __builtin_amdgcn_wave_barrier();
        f32x4 acc[8];
#pragma unroll
        for (int Gi = 0; Gi < 8; ++Gi) {
            acc[Gi] = (f32x4){0.f, 0.f, 0.f, 0.f};
            const int e = selb[16 * Gi + l15];
            const unsigned char* up = EU + (size_t)e * DM + 16 * g4;
#pragma unroll
            for (int s2 = 0; s2 < 16; ++s2) { const u32x4 a = *(const u32x4*)(up + 64 * s2); const u32x4 bx = *(const LAS u32x4*)(xnb + 64 * s2 + 16 * g4);
                const long a0 = (long)(((unsigned long long)a.y << 32) | a.x), a1 = (long)(((unsigned long long)a.w << 32) | a.z);
                const long b0 = (long)(((unsigned long long)bx.y << 32) | bx.x), b1 = (long)(((unsigned long long)bx.w << 32) | bx.z);
                acc[Gi] = __builtin_amdgcn_mfma_f32_16x16x32_fp8_fp8(a0, b0, acc[Gi], 0, 0, 0);
                acc[Gi] = __builtin_amdgcn_mfma_f32_16x16x32_fp8_fp8(a1, b1, acc[Gi], 0, 0, 0); }
        }
        if (l15 == 0) {
#pragma unroll
            for (int Gi = 0; Gi < 8; ++Gi)
#pragma unroll
                for (int j = 0; j < 4; ++j) { const float a = acc[Gi][j] * (1.f / ESCALE);
                    hb[16 * Gi + 4 * g4 + j] = 0.5f * a * (1.f + erff(a * 0.70710678118654752f)) * gateb[16 * Gi + 4 * g4 + j] * (1.f / ESCALE); }
        }
        LDS_WAIT(); __builtin_amdgcn_wave_barrier();
        f32x2_t y[8];
#pragma unroll
        for (int i = 0; i < 8; ++i) y[i] = (f32x2_t){0.f, 0.f};
#pragma unroll 8
        for (int e = 0; e < 128; ++e) { const int idx = selb[e]; const float hs = hb[e];
            const u32x4 v = *(const u32x4*)(EV + (size_t)idx * DM + 16 * lane);
#pragma unroll
            for (int q = 0; q < 4; ++q) { const f32x2_t lo = __builtin_amdgcn_cvt_pk_f32_fp8((int)v[q], false), hi = __builtin_amdgcn_cvt_pk_f32_fp8((int)v[q], true);
                y[2 * q] += lo * hs; y[2 * q + 1] += hi * hs; } }
        f32x4 h3[4]; float s3 = 0.f;
#pragma unroll
        for (int j = 0; j < 4; ++j) { h3[j][0] = hv[j][0] + y[2 * j][0]; h3[j][1] = hv[j][1] + y[2 * j][1]; h3[j][2] = hv[j][2] + y[2 * j + 1][0]; h3[j][3] = hv[j][3] + y[2 * j + 1][1];
            s3 += (h3[j][0] * h3[j][0] + h3[j][1] * h3[j][1]) + (h3[j][2] * h3[j][2] + h3[j][3] * h3[j][3]); }
        const float r3 = rsqrtf(wave_sum(s3) * (1.f / DM) + EPS);
#pragma unroll
        for (int j = 0; j < 4; ++j) *(f32x4*)(hrow + 4 * j) = h3[j] * r3 * fg[j];
        LDS_WAIT(); __builtin_amdgcn_wave_barrier();
    }
}

#define XB_TMO      128
#define XB_XCNT(j)  (256  + 64 * (j))
#define XB_XSUB(j)  (1280 + 64 * (j))
#define XB_XGEN(j)  (2304 + 64 * (j))
#define XB_TOP      3328
#define XB_TOPGEN   3392
#define XCD_BAR_WORDS 3456
#define XB_SPIN_CAP (1u << 18)

__device__ __forceinline__ unsigned xb_ld(unsigned* p)              { return __hip_atomic_load(p, __ATOMIC_RELAXED, __HIP_MEMORY_SCOPE_AGENT); }
__device__ __forceinline__ unsigned xb_add(unsigned* p, unsigned v) { return __hip_atomic_fetch_add(p, v, __ATOMIC_RELAXED, __HIP_MEMORY_SCOPE_AGENT); }
__device__ __forceinline__ unsigned xb_xcc_id() { return (unsigned)__builtin_amdgcn_s_getreg((3 << 11) | 20) & 0xFu; }
#define XB_SPIN(cond, bar) do { unsigned _sp = 0; while (cond) { __builtin_amdgcn_s_sleep(1); \
    if ((++_sp & 255u) == 0u) { if (xb_ld(&(bar)[XB_TMO])) break; if (_sp > XB_SPIN_CAP) { atomicAdd(&(bar)[XB_TMO], 1u); break; } } } } while (0)

struct XcdBarrier {
    unsigned* bar; unsigned x;
    volatile LAS unsigned* st;
};

__device__ __forceinline__ XcdBarrier xcd_barrier_post(unsigned* bar, volatile LAS unsigned* st) {
    XcdBarrier b; b.bar = bar; b.x = xb_xcc_id(); b.st = st;
    if (threadIdx.x == 0) (void)xb_add(&bar[XB_XCNT(b.x)], 1u);
    return b;
}
__device__ __forceinline__ void xcd_barrier_complete(unsigned* bar, unsigned x, unsigned& nloc, unsigned& nx) {
    const unsigned G = gridDim.x * gridDim.y * gridDim.z;
    unsigned sum, cnt, mine, sp = 0u;
    for (;;) {
        sum = 0u; cnt = 0u; mine = 0u;
#pragma unroll
        for (unsigned j = 0; j < 16; ++j) { const unsigned c = xb_ld(&bar[XB_XCNT(j)]); sum += c; cnt += (c > 0u) ? 1u : 0u; mine = (j == x) ? c : mine; }
        if (sum == G) break;
        __builtin_amdgcn_s_sleep(1);
        if ((++sp & 255u) == 0u) { if (xb_ld(&bar[XB_TMO])) break; if (sp > XB_SPIN_CAP) { atomicAdd(&bar[XB_TMO], 1u); break; } }
    }
    nloc = mine > 0u ? mine : 1u; nx = cnt > 0u ? cnt : 1u;
}

__device__ __forceinline__ void xcd_barrier(const XcdBarrier& b) {
    asm volatile("s_waitcnt vmcnt(0)" ::: "memory");
    __syncthreads();
    if (threadIdx.x == 0) {
        unsigned* bar = b.bar;
        __builtin_amdgcn_s_waitcnt(0);
        unsigned nloc = b.st[0], nx = b.st[1];
        if (nloc == 0u) { xcd_barrier_complete(bar, b.x, nloc, nx); b.st[0] = nloc; b.st[1] = nx; }
        const unsigned old = xb_add(&bar[XB_XSUB(b.x)], 1u);
        const unsigned gen = old / nloc;
        if (old + 1u == (gen + 1u) * nloc) {
            __builtin_amdgcn_fence(__ATOMIC_RELEASE, "agent");
            asm volatile("s_waitcnt vmcnt(0)" ::: "memory");
            const unsigned og = xb_add(&bar[XB_TOP], 1u);
            const unsigned tg = og / nx;
            if (og + 1u == (tg + 1u) * nx) xb_add(&bar[XB_TOPGEN], 1u);
            else XB_SPIN(xb_ld(&bar[XB_TOPGEN]) == tg, bar);
            __builtin_amdgcn_fence(__ATOMIC_ACQUIRE, "agent");
            xb_add(&bar[XB_XGEN(b.x)], 1u);
            asm volatile("s_waitcnt vmcnt(0)" ::: "memory");
        } else {
            XB_SPIN(xb_ld(&bar[XB_XGEN(b.x)]) == gen, bar);
            __builtin_amdgcn_fence(__ATOMIC_ACQUIRE, "agent");
            asm volatile("s_waitcnt vmcnt(0)" ::: "memory");
        }
    }
    __syncthreads();
}

#ifndef ONE_LAUNCH
#define ONE_LAUNCH 1
#endif
constexpr int NPHASE = 8;
__global__ void __launch_bounds__(NTHR, 2) hybrid_fwd(Params p) {
    extern __shared__ __attribute__((aligned(16))) unsigned char lds_raw[];
    LAS unsigned char* lds = (LAS unsigned char*)lds_raw;
    const int tid = threadIdx.x, lane = tid & 63, wave = __builtin_amdgcn_readfirstlane(tid >> 6), G = gridDim.x, bid = blockIdx.x;
    unsigned char* ws = p.ws;
    volatile LAS unsigned* xst = (volatile LAS unsigned*)(lds + 139264);
    if (tid < 2) xst[tid] = 0u;
    __syncthreads();
    XcdBarrier xbar; xbar.bar = (unsigned*)(ws + WS_END); xbar.x = 0; xbar.st = xst;
    if (ONE_LAUNCH && p.hi - p.lo > 1) { xbar = xcd_barrier_post((unsigned*)(ws + WS_END), xst); cg::this_grid().sync(); }
    const pg8::bf16_t* N1 = (const pg8::bf16_t*)p.out;
#ifdef ONLY
#define PH(k) if ((k) == ONLY && p.lo <= (k) && (k) < p.hi)
#else
#define PH(k) if (p.lo <= (k) && (k) < p.hi)
#endif
#define SEAM(k) do { if (ONE_LAUNCH && p.lo <= (k) && (k) + 1 < p.hi) { xcd_barrier(xbar); } } while (0)
    unsigned char* big = ws + WS_BIG;
    PH(0) { phase0(p, lds, G, bid, wave, lane); SEAM(0); }
    PH(1) { pg8::Gemm g{N1, (const pg8::bf16_t*)(ws + WS_WIN), T, 8192, 1024, 2048, 1024}; pg8::StaticOrder S; S.init(T, 8192, G, bid);
        pg8::EpiG1 E{(pg8::bf16_t*)(big + B_QKV), (pg8::bf16_t*)(big + B_GG), (pg8::bf16_t*)p.out + 1024, (pg8::bf16_t*)(big + B_PR), C2};
        pg8::gemm_phase<pg8::EpiG1, pg8::StaticOrder, true, true>(lds, g, S, E); SEAM(1); }
    PH(2) { phase_attn(p, lds, G, bid, tid); phase_conv(p, G, bid, tid); SEAM(2); }
    PH(3) { pg8::Gemm g{(const pg8::bf16_t*)p.out, (const pg8::bf16_t*)(ws + WS_WAC), T, 1024, 1024, 2048, 2048}; pg8::SplitKOrder S; S.base.init(T, 1024, G, bid);
        pg8::EpiMerged E{(const pg8::bf16_t*)(big + B_GG), (pg8::bf16_t*)(big + B_MG)};
        pg8::gemm_phase<pg8::EpiMerged, pg8::SplitKOrder, false, true>(lds, g, S, E); SEAM(3); }
    PH(4) { pg8::Gemm g{(const pg8::bf16_t*)(big + B_MG), (const pg8::bf16_t*)(ws + WS_WOUT), T, 1024, 1024, 1024, 1024}; pg8::StaticOrder S; S.init(T, 1024, G, bid);
        pg8::EpiResid E{p.x, p.out, (pg8::bf16_t*)(big + B_H2B), (float*)(ws + WS_SSQ)};
        pg8::gemm_phase<pg8::EpiResid, pg8::StaticOrder, false, true>(lds, g, S, E); SEAM(4); }
    PH(5) { pg8::Gemm g{(const pg8::bf16_t*)(big + B_H2B), (const pg8::bf16_t*)(ws + WS_WQ), T, 2048, 1024, 1024, 1024}; pg8::StaticOrder S; S.init(T, 2048, G, bid);
        pg8::EpiRowScale E{(const float*)(ws + WS_SSQ), (pg8::bf16_t*)(big + B_QP)};
        pg8::gemm_phase<pg8::EpiRowScale, pg8::StaticOrder, true, true>(lds, g, S, E); SEAM(5); }
    PH(6) { phase_topk(p, lds, G, bid, wave, lane); SEAM(6); }
    PH(7) { phase_gather(p, lds, G, bid, wave, lane); }
#undef PH
#undef SEAM
}

extern "C" void kernel_launch(void* const* d_in, const int* in_sizes, int n_in, void* d_out, int out_size, void* d_ws, size_t ws_size, hipStream_t stream) {
    static int grid = 0;
    if (grid == 0) {
        if (n_in != 15 || out_size != T * DM || ws_size < WS_END) { fprintf(stderr, "kernel_launch: unexpected problem (n_in %d out %d ws %zu)\n", n_in, out_size, ws_size); grid = -1; return; }
        int dev = 0, cus = 0, per_cu = 0;
        hipGetDevice(&dev); hipDeviceGetAttribute(&cus, hipDeviceAttributeMultiprocessorCount, dev);
        if (hipFuncSetAttribute((const void*)hybrid_fwd, hipFuncAttributeMaxDynamicSharedMemorySize, LDS_BYTES) != hipSuccess) { fprintf(stderr, "kernel_launch: hipFuncSetAttribute failed\n"); grid = -1; return; }
        if (hipOccupancyMaxActiveBlocksPerMultiprocessor(&per_cu, (const void*)hybrid_fwd, NTHR, LDS_BYTES) != hipSuccess || per_cu < 1) { fprintf(stderr, "kernel_launch: occupancy query says %d\n", per_cu); per_cu = 1; }
        (void)hipGetLastError();
        grid = cus * per_cu;
    }
    if (grid < 0) return;
    Params p{};
    p.x = (const float*)d_in[0]; p.norm1_g = (const float*)d_in[1]; p.w_in = (const float*)d_in[2]; p.lambda_qk = (const float*)d_in[3]; p.subln_g = (const float*)d_in[4];
    p.conv_w = (const float*)d_in[5]; p.w_attn_o = (const float*)d_in[6]; p.w_conv_o = (const float*)d_in[7]; p.w_out = (const float*)d_in[8]; p.norm2_g = (const float*)d_in[9];
    p.w_query = (const float*)d_in[10]; p.sub_keys = (const float*)d_in[11]; p.expert_u = (const float*)d_in[12]; p.expert_v = (const float*)d_in[13]; p.final_g = (const float*)d_in[14];
    p.out = (float*)d_out; p.ws = (unsigned char*)d_ws;
#if ONE_LAUNCH
    p.lo = 0; p.hi = NPHASE;
    (void)hipMemsetAsync((char*)d_ws + WS_END, 0, 16384, stream);
    void* args[] = {&p};
    hipError_t e = hipLaunchCooperativeKernel((const void*)hybrid_fwd, dim3(grid), dim3(NTHR), args, LDS_BYTES, stream);
    if (e != hipSuccess) fprintf(stderr, "cooperative launch failed: %s (grid %d)\n", hipGetErrorString(e), grid);
#else
    for (int k = 0; k < NPHASE; ++k) {
        p.lo = k; p.hi = k + 1; hipLaunchKernelGGL(hybrid_fwd, dim3(grid), dim3(NTHR), LDS_BYTES, stream, p); }
#endif
}
```

```cpp
#include <hip/hip_runtime.h>
#include <hip/hip_cooperative_groups.h>
#include <cstdio>
#include <cstdint>
namespace cg = cooperative_groups;
namespace pg8 {
#define PG8_LAS __attribute__((address_space(3)))
typedef unsigned short bf16_t;
typedef short bf16x8 __attribute__((ext_vector_type(8)));
typedef float f32x4 __attribute__((ext_vector_type(4)));
typedef unsigned u32x4 __attribute__((ext_vector_type(4)));
constexpr int BM = 256, BK = 64, HALF = 128, HTB = HALF * BK * 2  , STAGE_BYTES = 8 * HTB, NXCD = 8, WGM = 8;

__host__ __device__ __forceinline__ int lds_byte(int r, int c) { const int st = (r >> 4) * 2 + (c >> 5), rr = r & 15, cc = c & 31, ob = rr * 64 + cc * 2; return st * 1024 + (ob ^ (((ob >> 9) & 1) << 5)); }
__host__ __device__ __forceinline__ void stage_rc(int b, int& R, int& C) { const int st = b / 1024, sb = b % 1024, swz = sb ^ (((sb >> 9) & 1) << 5); R = (st >> 1) * 16 + swz / 64; C = (st & 1) * 32 + (swz % 64) / 2; }
__host__ __device__ __forceinline__ int perm32(int rho) { const int n = rho >> 4, i = rho & 15; return 8 * (i >> 2) + 4 * n + (i & 3); }

struct Unit { int pm, pn, kh; };
struct Gemm { const bf16_t* A; const bf16_t* Bt; int M, N, K, lda, ldb; };
struct StaticOrder {
    int nM, nN, nwg, G, c;
    __host__ __device__ void init(int M, int N, int G_, int c_) { nM = M / BM; nN = N / BM; nwg = nM * nN; G = G_; c = c_; }
    __host__ __device__ bool next(int i, Unit& u) const {
        const long L = (long)i * G + c; if (L >= nwg) return false;
        int wgid = (int)L; { const int q = nwg / NXCD, r = nwg % NXCD, xcd = wgid % NXCD, off = wgid / NXCD; wgid = (xcd < r ? xcd * (q + 1) : r * (q + 1) + (xcd - r) * q) + off; }
        const int nig = WGM * nN, gid = wgid / nig, fm = gid * WGM, gsz = (nM - fm) < WGM ? (nM - fm) : WGM;
        u.pm = fm + ((wgid % nig) % gsz); u.pn = (wgid % nig) / gsz; u.kh = 0; return true;
    }
    __device__ __forceinline__ void a_ready(const Unit&) const {}
    __device__ __forceinline__ void done(const Unit&) const {}
};
struct SplitKOrder {
    StaticOrder base;
    __host__ __device__ bool next(int i, Unit& u) const { if (!base.next(i >> 1, u)) return false; u.kh = i & 1; return true; }
    __device__ __forceinline__ void a_ready(const Unit&) const {}
    __device__ __forceinline__ void done(const Unit&) const {}
};
__device__ __forceinline__ unsigned cvt_pk_bf16(float lo, float hi) { unsigned r; asm volatile("v_cvt_pk_bf16_f32 %0, %1, %2" : "=v"(r) : "v"(lo), "v"(hi)); return r; }
typedef float f32x2 __attribute__((ext_vector_type(2)));
typedef float f32x2 __attribute__((ext_vector_type(2)));
typedef unsigned u32x2 __attribute__((ext_vector_type(2)));
__device__ __forceinline__ void unpack8(const u32x4 w, float (&f)[8]) {
    f[0] = __builtin_bit_cast(float, w.x << 16); f[1] = __builtin_bit_cast(float, w.x & 0xffff0000u);
    f[2] = __builtin_bit_cast(float, w.y << 16); f[3] = __builtin_bit_cast(float, w.y & 0xffff0000u);
    f[4] = __builtin_bit_cast(float, w.z << 16); f[5] = __builtin_bit_cast(float, w.z & 0xffff0000u);
    f[6] = __builtin_bit_cast(float, w.w << 16); f[7] = __builtin_bit_cast(float, w.w & 0xffff0000u);
}
__device__ __forceinline__ u32x4 pack8(const f32x4 v0, const f32x4 v1) { u32x4 w; w.x = cvt_pk_bf16(v0[0], v0[1]); w.y = cvt_pk_bf16(v0[2], v0[3]); w.z = cvt_pk_bf16(v1[0], v1[1]); w.w = cvt_pk_bf16(v1[2], v1[3]); return w; }
struct EpiPlain {
    static constexpr bool PERM = true, AFTER_DRAIN = false, MID = false;
    bf16_t* O; int ldc;
    __device__ __forceinline__ void operator()(const f32x4 (&acc)[2][2][4][2], const Unit& u, int wr, int wc, int fr, int fq) const {
        const int row0 = u.pm * BM + wr * 64 + fr, col0 = u.pn * BM + wc * 32 + 8 * fq;
#pragma unroll
        for (int ai = 0; ai < 2; ++ai)
#pragma unroll
            for (int m = 0; m < 4; ++m) { bf16_t* rowp = O + (size_t)(row0 + ai * HALF + m * 16) * ldc + col0;
#pragma unroll
                for (int bj = 0; bj < 2; ++bj) *(u32x4*)(rowp + bj * HALF) = pack8(acc[ai][bj][m][0], acc[ai][bj][m][1]); }
    }
};
struct EpiQKVG {
    static constexpr bool PERM = true, AFTER_DRAIN = false, MID = false;
    bf16_t* QKV; bf16_t* GG; float c2;
    __device__ __forceinline__ void operator()(const f32x4 (&acc)[2][2][4][2], const Unit& u, int wr, int wc, int fr, int fq) const {
        int colt = u.pn * BM; bf16_t* base = QKV; int ldc = 3072; float sc = 1.f; bool sig = false;
        if (colt < 1024) sc = c2; else if (colt >= 3072) { base = GG; ldc = 2048; colt -= 3072; sig = true; }
        const int row0 = u.pm * BM + wr * 64 + fr, col0 = colt + wc * 32 + 8 * fq;
#pragma unroll
        for (int ai = 0; ai < 2; ++ai)
#pragma unroll
            for (int m = 0; m < 4; ++m) { bf16_t* rowp = base + (size_t)(row0 + ai * HALF + m * 16) * ldc + col0;
#pragma unroll
                for (int bj = 0; bj < 2; ++bj) { f32x4 v0 = acc[ai][bj][m][0], v1 = acc[ai][bj][m][1];
                    if (sig) {
#pragma unroll
                        for (int i = 0; i < 4; ++i) { v0[i] = __builtin_amdgcn_rcpf(1.f + __expf(-v0[i])); v1[i] = __builtin_amdgcn_rcpf(1.f + __expf(-v1[i])); }
                    } else { v0 = v0 * sc; v1 = v1 * sc; }
                    *(u32x4*)(rowp + bj * HALF) = pack8(v0, v1); } }
    }
};
struct EpiGateA {
    static constexpr bool PERM = true, AFTER_DRAIN = false, MID = false;
    const bf16_t* GG; float* TMP;
    __device__ __forceinline__ void operator()(const f32x4 (&acc)[2][2][4][2], const Unit& u, int wr, int wc, int fr, int fq) const {
        const int row0 = u.pm * BM + wr * 64 + fr, col0 = u.pn * BM + wc * 32 + 8 * fq;
#pragma unroll
        for (int ai = 0; ai < 2; ++ai)
#pragma unroll
            for (int m = 0; m < 4; ++m) { const size_t row = (size_t)(row0 + ai * HALF + m * 16);
#pragma unroll
                for (int bj = 0; bj < 2; ++bj) { const int col = col0 + bj * HALF; float g[8]; unpack8(*(const u32x4*)(GG + row * 2048 + col), g);
                    f32x4 v0 = acc[ai][bj][m][0], v1 = acc[ai][bj][m][1];
                    v0[0] *= g[0]; v0[1] *= g[1]; v0[2] *= g[2]; v0[3] *= g[3]; v1[0] *= g[4]; v1[1] *= g[5]; v1[2] *= g[6]; v1[3] *= g[7];
                    *(f32x4*)(TMP + row * 1024 + col) = v0; *(f32x4*)(TMP + row * 1024 + col + 4) = v1; } }
    }
};
struct EpiGateC {
    static constexpr bool PERM = true, AFTER_DRAIN = false, MID = false;
    const bf16_t* GG; const float* TMP; bf16_t* MG;
    __device__ __forceinline__ void operator()(const f32x4 (&acc)[2][2][4][2], const Unit& u, int wr, int wc, int fr, int fq) const {
        const int row0 = u.pm * BM + wr * 64 + fr, col0 = u.pn * BM + wc * 32 + 8 * fq;
#pragma unroll
        for (int ai = 0; ai < 2; ++ai)
#pragma unroll
            for (int m = 0; m < 4; ++m) { const size_t row = (size_t)(row0 + ai * HALF + m * 16);
#pragma unroll
                for (int bj = 0; bj < 2; ++bj) { const int col = col0 + bj * HALF; float g[8]; unpack8(*(const u32x4*)(GG + row * 2048 + 1024 + col), g);
                    const f32x4 t0 = *(const f32x4*)(TMP + row * 1024 + col), t1 = *(const f32x4*)(TMP + row * 1024 + col + 4);
                    f32x4 v0 = acc[ai][bj][m][0], v1 = acc[ai][bj][m][1];
                    v0[0] = t0[0] + v0[0] * g[0]; v0[1] = t0[1] + v0[1] * g[1]; v0[2] = t0[2] + v0[2] * g[2]; v0[3] = t0[3] + v0[3] * g[3];
                    v1[0] = t1[0] + v1[0] * g[4]; v1[1] = t1[1] + v1[1] * g[5]; v1[2] = t1[2] + v1[2] * g[6]; v1[3] = t1[3] + v1[3] * g[7];
                    *(u32x4*)(MG + row * 1024 + col) = pack8(v0, v1); } }
    }
};
struct EpiG1 {
    static constexpr bool PERM = true, AFTER_DRAIN = false, MID = false;
    bf16_t* QKV; bf16_t* GG; bf16_t* CB; bf16_t* PR; float c2;
    __device__ __forceinline__ void operator()(const f32x4 (&acc)[2][2][4][2], const Unit& u, int wr, int wc, int fr, int fq) const {
        int colt = u.pn * BM; const int row0 = u.pm * BM + wr * 64 + fr;
        if (colt >= 6144) {
            const int ch0 = (colt - 6144) / 2 + wc * 16 + 4 * fq;
#pragma unroll
            for (int ai = 0; ai < 2; ++ai)
#pragma unroll
                for (int m = 0; m < 4; ++m) { bf16_t* rowp = PR + (size_t)(row0 + ai * HALF + m * 16) * 1024 + ch0;
#pragma unroll
                    for (int bj = 0; bj < 2; ++bj) { const f32x4 v0 = acc[ai][bj][m][0], v1 = acc[ai][bj][m][1];
                        u32x2 w; w.x = cvt_pk_bf16(v0[0] * v0[1], v0[2] * v0[3]); w.y = cvt_pk_bf16(v1[0] * v1[1], v1[2] * v1[3]);
                        *(u32x2*)(rowp + bj * (HALF / 2)) = w; } }
            return;
        }
        bf16_t* base = QKV; int ldc = 3072; float sc = 1.f; bool sig = false;
        if (colt < 1024) sc = c2; else if (colt >= 5120) { base = CB; ldc = 2048; colt -= 5120; } else if (colt >= 3072) { base = GG; ldc = 2048; colt -= 3072; sig = true; }
        const int col0 = colt + wc * 32 + 8 * fq;
#pragma unroll
        for (int ai = 0; ai < 2; ++ai)
#pragma unroll
            for (int m = 0; m < 4; ++m) { bf16_t* rowp = base + (size_t)(row0 + ai * HALF + m * 16) * ldc + col0;
#pragma unroll
                for (int bj = 0; bj < 2; ++bj) { f32x4 v0 = acc[ai][bj][m][0], v1 = acc[ai][bj][m][1];
                    if (sig) {
#pragma unroll
                        for (int i = 0; i < 4; ++i) { v0[i] = __builtin_amdgcn_rcpf(1.f + __expf(-v0[i])); v1[i] = __builtin_amdgcn_rcpf(1.f + __expf(-v1[i])); }
                    } else { v0 = v0 * sc; v1 = v1 * sc; }
                    *(u32x4*)(rowp + bj * HALF) = pack8(v0, v1); } }
    }
};
struct EpiMerged {
    static constexpr bool PERM = true, AFTER_DRAIN = false, MID = true;
    const bf16_t* GG; bf16_t* MG;
    __device__ __forceinline__ void mid(f32x4 (&acc)[2][2][4][2], const Unit& u, int wr, int wc, int fr, int fq) const {
        const int row0 = u.pm * BM + wr * 64 + fr, col0 = u.pn * BM + wc * 32 + 8 * fq;
#pragma unroll
        for (int ai = 0; ai < 2; ++ai)
#pragma unroll
            for (int m = 0; m < 4; ++m) { const size_t row = (size_t)(row0 + ai * HALF + m * 16);
#pragma unroll
                for (int bj = 0; bj < 2; ++bj) { const int col = col0 + bj * HALF; float ga[8], gc[8];
                    unpack8(*(const u32x4*)(GG + row * 2048 + col), ga); unpack8(*(const u32x4*)(GG + row * 2048 + 1024 + col), gc);
#pragma unroll
                    for (int i = 0; i < 4; ++i) { acc[ai][bj][m][0][i] *= ga[i] * __builtin_amdgcn_rcpf(gc[i]); acc[ai][bj][m][1][i] *= ga[4 + i] * __builtin_amdgcn_rcpf(gc[4 + i]); }
                    asm volatile("" ::: "memory"); } }
    }
    __device__ __forceinline__ void operator()(const f32x4 (&acc)[2][2][4][2], const Unit& u, int wr, int wc, int fr, int fq) const {
        const int row0 = u.pm * BM + wr * 64 + fr, col0 = u.pn * BM + wc * 32 + 8 * fq;
#pragma unroll
        for (int ai = 0; ai < 2; ++ai)
#pragma unroll
            for (int m = 0; m < 4; ++m) { const size_t row = (size_t)(row0 + ai * HALF + m * 16);
#pragma unroll
                for (int bj = 0; bj < 2; ++bj) { const int col = col0 + bj * HALF; float gc[8]; unpack8(*(const u32x4*)(GG + row * 2048 + 1024 + col), gc);
                    f32x4 v0 = acc[ai][bj][m][0], v1 = acc[ai][bj][m][1];
#pragma unroll
                    for (int i = 0; i < 4; ++i) { v0[i] *= gc[i]; v1[i] *= gc[4 + i]; }
                    *(u32x4*)(MG + row * 1024 + col) = pack8(v0, v1); } }
    }
};
struct EpiResid {
    static constexpr bool PERM = true, AFTER_DRAIN = false, MID = false;
    const float* X; float* H2; bf16_t* H2B; float* SSQ;
    __device__ __forceinline__ void operator()(const f32x4 (&acc)[2][2][4][2], const Unit& u, int wr, int wc, int fr, int fq) const {
        const int row0 = u.pm * BM + wr * 64 + fr, col0 = u.pn * BM + wc * 32 + 8 * fq;
#pragma unroll
        for (int ai = 0; ai < 2; ++ai)
#pragma unroll
            for (int m = 0; m < 4; ++m) { const size_t row = (size_t)(row0 + ai * HALF + m * 16); float s = 0.f;
#pragma unroll
                for (int bj = 0; bj < 2; ++bj) { const size_t o = row * 1024 + col0 + bj * HALF;
                    const f32x4 v0 = acc[ai][bj][m][0] + *(const f32x4*)(X + o), v1 = acc[ai][bj][m][1] + *(const f32x4*)(X + o + 4);
                    *(f32x4*)(H2 + o) = v0; *(f32x4*)(H2 + o + 4) = v1; *(u32x4*)(H2B + o) = pack8(v0, v1);
                    s += (v0[0] * v0[0] + v0[1] * v0[1]) + (v0[2] * v0[2] + v0[3] * v0[3]) + (v1[0] * v1[0] + v1[1] * v1[1]) + (v1[2] * v1[2] + v1[3] * v1[3]); }
                s += __shfl_xor(s, 16); s += __shfl_xor(s, 32);
                if (fq == 0) SSQ[row * 16 + u.pn * 4 + wc] = s; }
    }
};
struct EpiRowScale {
    static constexpr bool PERM = true, AFTER_DRAIN = false, MID = false;
    const float* SSQ; bf16_t* O;
    __device__ __forceinline__ void operator()(const f32x4 (&acc)[2][2][4][2], const Unit& u, int wr, int wc, int fr, int fq) const {
        const int row0 = u.pm * BM + wr * 64 + fr, col0 = u.pn * BM + wc * 32 + 8 * fq;
#pragma unroll
        for (int ai = 0; ai < 2; ++ai)
#pragma unroll
            for (int m = 0; m < 4; ++m) { const size_t row = (size_t)(row0 + ai * HALF + m * 16);
                const f32x4* sp = (const f32x4*)(SSQ + row * 16); const f32x4 a = sp[0] + sp[1], b = sp[2] + sp[3], c = a + b;
                const float rs = rsqrtf(((c[0] + c[1]) + (c[2] + c[3])) * (1.f / 1024.f) + 1e-6f);
#pragma unroll
                for (int bj = 0; bj < 2; ++bj) *(u32x4*)(O + row * 2048 + col0 + bj * HALF) = pack8(acc[ai][bj][m][0] * rs, acc[ai][bj][m][1] * rs); }
    }
};
template <class Epi, class Sched, bool ALIGN_EPI = false, bool SP2 = false>
__device__ __forceinline__ void gemm_phase(PG8_LAS unsigned char* lds, const Gemm g, const Sched& S, const Epi& E) {
    const int tid = threadIdx.x, wid = __builtin_amdgcn_readfirstlane(tid >> 6), lane = tid & 63, wr = wid >> 2, wc = wid & 3, fr = lane & 15, fq = lane >> 4;
    const int K = g.K, nt = K / BK;
    unsigned voffA[2], voffB[2];
#pragma unroll
    for (int i = 0; i < 2; ++i) { int R, C; stage_rc(tid * 16 + i * 8192, R, C); const int Rb = Epi::PERM ? ((R & ~31) + perm32(R & 31)) : R;
        voffA[i] = (unsigned)(R * g.lda + C) * 2u; voffB[i] = (unsigned)(Rb * g.ldb + C) * 2u; }
    const size_t kstep = (size_t)(BK * 2);
    const size_t hstep = (size_t)HALF * g.ldb * 2;
    const size_t tstep = 2 * hstep;
    const size_t hstepA = (size_t)HALF * g.lda * 2, tstepA = 2 * hstepA;
    const unsigned ldsw = (unsigned)wid * 1024u;
    const int aoff = lds_byte(wr * 64 + fr, fq * 8), boff = lds_byte(wc * 32 + fr, fq * 8);
#define PG8_SA(b, h) (((b) * 2 + (h)) * HTB)
#define PG8_SB(b, h) ((4 + (b) * 2 + (h)) * HTB)
#define PG8_STAGE(bufoff, gbase, voff) do { _Pragma("unroll") for (int _i = 0; _i < 2; ++_i) \
        __builtin_amdgcn_global_load_lds((const unsigned*)((const char*)(gbase) + (voff)[_i]), (PG8_LAS unsigned*)(lds + (bufoff) + ldsw + _i * 8192), 16, 0, 0); } while (0)
#define PG8_LDA(dst, b, h) do { _Pragma("unroll") for (int m = 0; m < 4; ++m) _Pragma("unroll") for (int k = 0; k < 2; ++k) dst[m][k] = *(const PG8_LAS bf16x8*)(lds + PG8_SA(b, h) + aoff + m * 2048 + k * 1024); } while (0)
#define PG8_LDB(dst, b, h) do { _Pragma("unroll") for (int n = 0; n < 2; ++n) _Pragma("unroll") for (int k = 0; k < 2; ++k) dst[n][k] = *(const PG8_LAS bf16x8*)(lds + PG8_SB(b, h) + boff + n * 2048 + k * 1024); } while (0)
#define PG8_MMA(ai, bj, At, Bt) do { __builtin_amdgcn_s_setprio(1); _Pragma("unroll") for (int m = 0; m < 4; ++m) _Pragma("unroll") for (int n = 0; n < 2; ++n) _Pragma("unroll") for (int k = 0; k < 2; ++k) \
        acc[ai][bj][m][n] = __builtin_amdgcn_mfma_f32_16x16x32_bf16(Bt[n][k], At[m][k], acc[ai][bj][m][n], 0, 0, 0); __builtin_amdgcn_s_setprio(0); } while (0)
#define PG8_WAIT_V(n) asm volatile("s_waitcnt vmcnt(" #n ")" ::: "memory")
#define PG8_WAIT_L(n) asm volatile("s_waitcnt lgkmcnt(" #n ")" ::: "memory")
#define PG8_BAR __builtin_amdgcn_s_barrier()
#define PG8_SCHED __builtin_amdgcn_sched_barrier(0)
    Unit cur, nxt; int ui = 0;
    if (!S.next(0, cur)) return;
    f32x4 acc[2][2][4][2];
#pragma unroll
    for (int a = 0; a < 2; ++a)
#pragma unroll
        for (int b = 0; b < 2; ++b)
#pragma unroll
            for (int m = 0; m < 4; ++m)
#pragma unroll
                for (int n = 0; n < 2; ++n) acc[a][b][m][n] = (f32x4){0.f, 0.f, 0.f, 0.f};
    bf16x8 At[4][2], B0[2][2], B1[2][2];
    const char* cA = (const char*)g.A + (size_t)cur.pm * tstepA + (size_t)cur.kh * K * 2; const char* cB = (const char*)g.Bt + (size_t)cur.pn * tstep + (size_t)cur.kh * K * 2;
    S.a_ready(cur);
    if constexpr (SP2) {
        PG8_STAGE(PG8_SB(0, 0), cB, voffB); PG8_STAGE(PG8_SB(0, 1), cB + hstep, voffB); PG8_STAGE(PG8_SA(0, 0), cA, voffA); PG8_STAGE(PG8_SA(0, 1), cA + hstepA, voffA);
        if (wr == 1) PG8_BAR;
        PG8_WAIT_V(2); PG8_BAR;
        PG8_STAGE(PG8_SB(1, 0), cB + kstep, voffB); PG8_STAGE(PG8_SA(1, 0), cA + kstep, voffA); PG8_STAGE(PG8_SB(1, 1), cB + hstep + kstep, voffB);
        PG8_WAIT_V(6); PG8_BAR;
    } else {
        PG8_STAGE(PG8_SB(0, 0), cB, voffB); PG8_STAGE(PG8_SA(0, 0), cA, voffA); PG8_STAGE(PG8_SB(0, 1), cB + hstep, voffB); PG8_STAGE(PG8_SA(0, 1), cA + hstepA, voffA);
        if (wr == 1) PG8_BAR;
        PG8_WAIT_V(4); PG8_BAR;
        PG8_STAGE(PG8_SB(1, 0), cB + kstep, voffB); PG8_STAGE(PG8_SA(1, 0), cA + kstep, voffA); PG8_STAGE(PG8_SB(1, 1), cB + hstep + kstep, voffB);
        PG8_WAIT_V(6); PG8_BAR;
    }
    for (;;) {
        const bool has_next = S.next(ui + 1, nxt);
        const char* nA = has_next ? (const char*)g.A + (size_t)nxt.pm * tstepA + (size_t)nxt.kh * K * 2 : cA; const char* nB = has_next ? (const char*)g.Bt + (size_t)nxt.pn * tstep + (size_t)nxt.kh * K * 2 : cB;
        for (int t = 0; t < nt; t += 2) {
            const bool last = (t == nt - 2);
            const char* a1 = cA + (size_t)(t + 1) * kstep;
            const char* a2 = last ? nA : cA + (size_t)(t + 2) * kstep; const char* b2 = last ? nB : cB + (size_t)(t + 2) * kstep;
            const char* a3 = a2 + kstep; const char* b3 = b2 + kstep;
            if (last && has_next) S.a_ready(nxt);
            if constexpr (SP2) {
            PG8_LDB(B0, 0, 0); PG8_LDB(B1, 0, 1); PG8_SCHED; PG8_LDA(At, 0, 0); PG8_STAGE(PG8_SA(1, 1), a1 + hstepA, voffA);
            PG8_WAIT_V(8); PG8_WAIT_L(0); PG8_BAR; PG8_MMA(0, 0, At, B0); PG8_MMA(0, 1, At, B1); PG8_BAR; PG8_SCHED;
            PG8_LDA(At, 0, 1); PG8_STAGE(PG8_SB(0, 0), b2, voffB); PG8_STAGE(PG8_SB(0, 1), b2 + hstep, voffB); PG8_STAGE(PG8_SA(0, 0), a2, voffA);
            PG8_WAIT_V(8); PG8_WAIT_L(0); PG8_BAR; PG8_MMA(1, 0, At, B0); PG8_MMA(1, 1, At, B1); PG8_BAR; PG8_SCHED;
            PG8_LDB(B0, 1, 0); PG8_LDB(B1, 1, 1); PG8_SCHED; PG8_LDA(At, 1, 0); PG8_STAGE(PG8_SA(0, 1), a2 + hstepA, voffA);
            PG8_WAIT_V(8); PG8_WAIT_L(0); PG8_BAR; PG8_MMA(0, 0, At, B0); PG8_MMA(0, 1, At, B1); PG8_BAR; PG8_SCHED;
            PG8_LDA(At, 1, 1); PG8_STAGE(PG8_SB(1, 0), b3, voffB); PG8_STAGE(PG8_SB(1, 1), b3 + hstep, voffB); PG8_STAGE(PG8_SA(1, 0), a3, voffA);
            PG8_WAIT_V(8); PG8_WAIT_L(0); PG8_BAR; PG8_MMA(1, 0, At, B0); PG8_MMA(1, 1, At, B1); PG8_BAR; PG8_SCHED;
            } else {
            PG8_LDB(B0, 0, 0); PG8_SCHED; PG8_LDA(At, 0, 0); PG8_STAGE(PG8_SA(1, 1), a1 + hstepA, voffA);
            PG8_WAIT_L(8); PG8_BAR; PG8_WAIT_L(0); PG8_MMA(0, 0, At, B0); PG8_BAR; PG8_SCHED;
            PG8_LDB(B1, 0, 1); PG8_STAGE(PG8_SB(0, 0), b2, voffB);
            PG8_BAR; PG8_WAIT_L(0); PG8_MMA(0, 1, At, B1); PG8_BAR;
            PG8_LDA(At, 0, 1); PG8_STAGE(PG8_SA(0, 0), a2, voffA);
            PG8_BAR; PG8_WAIT_L(0); PG8_MMA(1, 0, At, B0); PG8_BAR; PG8_SCHED;
            PG8_STAGE(PG8_SB(0, 1), b2 + hstep, voffB);
            PG8_WAIT_V(6); PG8_BAR; PG8_MMA(1, 1, At, B1); PG8_BAR;
            PG8_LDB(B0, 1, 0); PG8_SCHED; PG8_LDA(At, 1, 0); PG8_STAGE(PG8_SA(0, 1), a2 + hstepA, voffA);
            PG8_WAIT_L(8); PG8_BAR; PG8_WAIT_L(0); PG8_MMA(0, 0, At, B0); PG8_BAR; PG8_SCHED;
            PG8_LDB(B1, 1, 1); PG8_STAGE(PG8_SB(1, 0), b3, voffB);
            PG8_BAR; PG8_WAIT_L(0); PG8_MMA(0, 1, At, B1); PG8_BAR;
            PG8_LDA(At, 1, 1); PG8_STAGE(PG8_SA(1, 0), a3, voffA);
            PG8_BAR; PG8_WAIT_L(0); PG8_MMA(1, 0, At, B0); PG8_BAR; PG8_SCHED;
            PG8_STAGE(PG8_SB(1, 1), b3 + hstep, voffB);
            PG8_WAIT_V(6); PG8_BAR; PG8_MMA(1, 1, At, B1); PG8_BAR;
            }
        }
        if constexpr (ALIGN_EPI) { if (wr == 0) PG8_BAR; }
        bool keep_acc = false;
        if constexpr (Epi::MID) { if (cur.kh == 0) { E.mid(acc, cur, wr, wc, fr, fq); keep_acc = true; } }
        if constexpr (!Epi::AFTER_DRAIN) { if (!keep_acc) { E(acc, cur, wr, wc, fr, fq); S.done(cur); } }
        if (!has_next) break;
        if (!keep_acc)
#pragma unroll
        for (int a = 0; a < 2; ++a)
#pragma unroll
            for (int b = 0; b < 2; ++b)
#pragma unroll
                for (int m = 0; m < 4; ++m)
#pragma unroll
                    for (int n = 0; n < 2; ++n) acc[a][b][m][n] = (f32x4){0.f, 0.f, 0.f, 0.f};
        cur = nxt; cA = nA; cB = nB; ++ui;
        if constexpr (ALIGN_EPI) { if (wr == 1) PG8_BAR; }
    }
    PG8_WAIT_V(0);
    if constexpr (!ALIGN_EPI) { if (wr == 0) PG8_BAR; }
    PG8_BAR;
    if constexpr (Epi::AFTER_DRAIN) { E.fused(acc, cur, wr, wc, fr, fq, lds, wid, lane); S.done(cur); }
#undef PG8_SA
#undef PG8_SB
#undef PG8_STAGE
#undef PG8_LDA
#undef PG8_LDB
#undef PG8_MMA
#undef PG8_WAIT_V
#undef PG8_WAIT_L
#undef PG8_BAR
#undef PG8_SCHED
}
}
#define LAS __attribute__((address_space(3)))
typedef unsigned short bf16;
typedef short bf16x8 __attribute__((ext_vector_type(8)));
typedef short s16x4 __attribute__((ext_vector_type(4)));
typedef float f32x4 __attribute__((ext_vector_type(4)));
typedef float f32x16 __attribute__((ext_vector_type(16)));
typedef unsigned u32x4 __attribute__((ext_vector_type(4)));
typedef unsigned u32x2 __attribute__((ext_vector_type(2)));
typedef float f32x2_t __attribute__((ext_vector_type(2))); typedef __bf16 bf16x2_t __attribute__((ext_vector_type(2)));

constexpr int T = 16384, DM = 1024, SEQ = 2048;
constexpr int NWAVES = 8, NTHR = 512;
constexpr int LDS_BYTES = 147456;
constexpr float EPS = 1e-6f;
constexpr float ESCALE = 64.f;
constexpr float C2 = 0.125f * 1.4426950408889634f;
constexpr size_t MiB = 1u << 20;
constexpr size_t WS_WIN = 0, WS_WAC = 16 * MiB, WS_WOUT = 20 * MiB, WS_WQ = 22 * MiB, WS_SUBK = 26 * MiB, WS_SSQ = 27 * MiB;
constexpr size_t WS_EU = 28 * MiB, WS_EV = 44 * MiB, WS_BIG = 60 * MiB, WS_END = 252 * MiB;
constexpr size_t B_QKV = 0, B_GG = 96 * MiB, B_PR = 160 * MiB, B_MG = 0, B_H2B = 32 * MiB, B_QP = 96 * MiB, B_SEL = 64 * MiB, B_GATE = 72 * MiB;

__device__ __forceinline__ unsigned cvtpk(float lo, float hi) { f32x2_t v = {lo, hi}; bf16x2_t b = __builtin_convertvector(v, bf16x2_t); return __builtin_bit_cast(unsigned, b); }
__device__ __forceinline__ float wave_sum(float v) {
#pragma unroll
    for (int o = 1; o < 64; o <<= 1) v += __shfl_xor(v, o);
    return v;
}
#define LDS_WAIT() asm volatile("s_waitcnt lgkmcnt(0)" ::: "memory")

struct Params {
    const float* x; const float* norm1_g; const float* w_in; const float* lambda_qk; const float* subln_g; const float* conv_w;
    const float* w_attn_o; const float* w_conv_o; const float* w_out; const float* norm2_g; const float* w_query; const float* sub_keys;
    const float* expert_u; const float* expert_v; const float* final_g;
    float* out; unsigned char* ws; int lo, hi;
};

__device__ __forceinline__ void transpose_item(const float* W, int K, int N, bf16* WT, int remap, int dpitch, int koff, const float* kscale, LAS float* scr, int item, int lane) {
    const int nblk = N / 32, kb = item / nblk, nb = item % nblk, k0 = 64 * kb, n0 = 32 * nb;
    int d0 = n0, dstr = 1;
    if (remap) { if (n0 < 3072) d0 = n0; else if (n0 < 4096) d0 = n0 + 2048; else if (n0 < 5120) { d0 = 6144 + 2 * (n0 - 4096); dstr = 2; } else if (n0 < 6144) { d0 = 6144 + 2 * (n0 - 5120) + 1; dstr = 2; } else d0 = n0 - 3072; }
#pragma unroll 8
    for (int i = 0; i < 32; ++i) { const int kk = 2 * i + (lane >> 5); float v = W[(size_t)(k0 + kk) * N + n0 + (lane & 31)]; if (kscale) v *= kscale[k0 + kk]; scr[kk * 33 + (lane & 31)] = v; }
    LDS_WAIT(); asm volatile("" ::: "memory");
    const int c = lane & 7;
#pragma unroll
    for (int j = 0; j < 4; ++j) { const int n = (lane >> 3) + 8 * j; const LAS float* sp = scr + (8 * c) * 33 + n;
        u32x4 o; o.x = cvtpk(sp[0 * 33], sp[1 * 33]); o.y = cvtpk(sp[2 * 33], sp[3 * 33]); o.z = cvtpk(sp[4 * 33], sp[5 * 33]); o.w = cvtpk(sp[6 * 33], sp[7 * 33]);
        *(u32x4*)(WT + (size_t)(d0 + n * dstr) * dpitch + koff + k0 + 8 * c) = o; }
    LDS_WAIT(); asm volatile("" ::: "memory");
}
__device__ __forceinline__ void cvt_flat(const float* src, bf16* dst, size_t n8, size_t gtid, size_t nthr) {
    for (size_t i = gtid; i < n8; i += nthr) { const f32x4 a = *(const f32x4*)(src + i * 8), b = *(const f32x4*)(src + i * 8 + 4);
        u32x4 o; o.x = cvtpk(a[0], a[1]); o.y = cvtpk(a[2], a[3]); o.z = cvtpk(b[0], b[1]); o.w = cvtpk(b[2], b[3]); *(u32x4*)(dst + i * 8) = o; }
}
__device__ __forceinline__ void cvt_flat_fp8(const float* src, unsigned char* dst, size_t n16, float sc, size_t gtid, size_t nthr) {
    for (size_t i = gtid; i < n16; i += nthr) { u32x4 o;
#pragma unroll
        for (int q = 0; q < 4; ++q) { const f32x4 a = *(const f32x4*)(src + i * 16 + 4 * q) * sc; int w = 0;
            w = __builtin_amdgcn_cvt_pk_fp8_f32(a[0], a[1], w, false); w = __builtin_amdgcn_cvt_pk_fp8_f32(a[2], a[3], w, true); o[q] = (unsigned)w; }
        *(u32x4*)(dst + i * 16) = o; }
}
__device__ __forceinline__ void phase0(const Params& p, LAS unsigned char* lds, int G, int bid, int wave, int lane) {
    unsigned char* ws = p.ws;
    LAS float* scr = (LAS float*)(lds + wave * 16384);
    const int gw = bid * NWAVES + wave, NGW = G * NWAVES;
    constexpr int I_IN = 16 * 256, I_SQ = 16 * 32, I_Q = 16 * 64, NITEMS = I_IN + 3 * I_SQ + I_Q;
    for (int it = gw; it < NITEMS; it += NGW) {
        int r = it;
        if (r < I_IN) { transpose_item(p.w_in, 1024, 8192, (bf16*)(ws + WS_WIN), 1, 1024, 0, nullptr, scr, r, lane); continue; } r -= I_IN;
        if (r < I_SQ) { transpose_item(p.w_attn_o, 1024, 1024, (bf16*)(ws + WS_WAC), 0, 2048, 0, nullptr, scr, r, lane); continue; } r -= I_SQ;
        if (r < I_SQ) { transpose_item(p.w_conv_o, 1024, 1024, (bf16*)(ws + WS_WAC), 0, 2048, 1024, nullptr, scr, r, lane); continue; } r -= I_SQ;
        if (r < I_SQ) { transpose_item(p.w_out, 1024, 1024, (bf16*)(ws + WS_WOUT), 0, 1024, 0, nullptr, scr, r, lane); continue; } r -= I_SQ;
        transpose_item(p.w_query, 1024, 2048, (bf16*)(ws + WS_WQ), 0, 1024, 0, p.norm2_g, scr, r, lane);
    }
    const size_t gtid = (size_t)bid * NTHR + wave * 64 + lane, nthr = (size_t)G * NTHR;
    cvt_flat(p.sub_keys, (bf16*)(ws + WS_SUBK), (size_t)(8 * 2 * 128 * 128) / 8, gtid, nthr);
    bf16* N1 = (bf16*)p.out;
    f32x4 gv[4];
#pragma unroll
    for (int j = 0; j < 4; ++j) gv[j] = *((const f32x4*)p.norm1_g + lane + 64 * j);
    for (int m = gw; m < T; m += NGW) {
        const f32x4* xr = (const f32x4*)(p.x + (size_t)m * DM) + lane; f32x4 v[4]; float s = 0.f;
#pragma unroll
        for (int j = 0; j < 4; ++j) { v[j] = xr[64 * j]; s += (v[j][0] * v[j][0] + v[j][1] * v[j][1]) + (v[j][2] * v[j][2] + v[j][3] * v[j][3]); }
        const float r = rsqrtf(wave_sum(s) * (1.f / DM) + EPS);
        u32x2* o8 = (u32x2*)(N1 + (size_t)m * 2048) + lane;
#pragma unroll
        for (int j = 0; j < 4; ++j) { u32x2 o; o.x = cvtpk(v[j][0] * r * gv[j][0], v[j][1] * r * gv[j][1]); o.y = cvtpk(v[j][2] * r * gv[j][2], v[j][3] * r * gv[j][3]); o8[64 * j] = o; }
    }
}

__device__ __forceinline__ void up8(const bf16* p, float (&f)[8]) { const u32x4 w = *(const u32x4*)p; pg8::unpack8(w, f); }
__device__ __forceinline__ void phase_conv(const Params& p, int G, int bid, int tid) {
    const bf16* PR = (const bf16*)(p.ws + WS_BIG + B_PR); bf16* CBU = (bf16*)p.out + 1024;
    const size_t nthr = (size_t)G * NTHR;
    for (size_t it = (size_t)bid * NTHR + tid; it < (size_t)T * 128; it += nthr) {
        const int t = (int)(it >> 7), c8 = (int)(it & 127) * 8, s = t & (SEQ - 1);
        const bf16* row = PR + (size_t)t * 1024 + c8;
        float cb[8], a[8], acc[8];
        up8(CBU + (size_t)t * 2048 + c8, cb); up8(row, a);
        const f32x4 w2a = *(const f32x4*)(p.conv_w + 2048 + c8), w2b = *(const f32x4*)(p.conv_w + 2048 + c8 + 4);
#pragma unroll
        for (int i = 0; i < 8; ++i) acc[i] = (i < 4 ? w2a[i] : w2b[i - 4]) * a[i];
        if (s >= 1) { up8(row - 1024, a);
            const f32x4 w1a = *(const f32x4*)(p.conv_w + 1024 + c8), w1b = *(const f32x4*)(p.conv_w + 1024 + c8 + 4);
#pragma unroll
            for (int i = 0; i < 8; ++i) acc[i] += (i < 4 ? w1a[i] : w1b[i - 4]) * a[i]; }
        if (s >= 2) { up8(row - 2048, a);
            const f32x4 w0a = *(const f32x4*)(p.conv_w + c8), w0b = *(const f32x4*)(p.conv_w + c8 + 4);
#pragma unroll
            for (int i = 0; i < 8; ++i) acc[i] += (i < 4 ? w0a[i] : w0b[i - 4]) * a[i]; }
        u32x4 o; o.x = cvtpk(cb[0] * acc[0], cb[1] * acc[1]); o.y = cvtpk(cb[2] * acc[2], cb[3] * acc[3]); o.z = cvtpk(cb[4] * acc[4], cb[5] * acc[5]); o.w = cvtpk(cb[6] * acc[6], cb[7] * acc[7]);
        *(u32x4*)(CBU + (size_t)t * 2048 + c8) = o;
    }
}

constexpr int KPITCH = 272, VPITCH = 320, KBYTES = 64 * KPITCH, STAGEB = KBYTES + 64 * VPITCH;
constexpr int XOFF = 0, OSTOFF = 65536, OSTPITCH = 272, OSTB = 32 * OSTPITCH;
__device__ __forceinline__ s16x4 vtr(const LAS unsigned char* p) { return __builtin_amdgcn_ds_read_tr16_b64_v4i16((LAS s16x4*)p); }

__device__ __forceinline__ void attn_unit(LAS unsigned char* lds, const bf16* QKV, bf16* ON, const float* subg, float lam, int b, int h, int qb, int tid) {
    const int w = __builtin_amdgcn_readfirstlane(tid >> 6), lane = tid & 63, map = w >> 2, wq = w & 3, l31 = lane & 31, half = lane >> 5;
    const size_t trow0 = (size_t)b * SEQ;
    const int q0 = qb * 128 + wq * 32;
    bf16x8 qf[4];
    { const bf16* qp = QKV + (trow0 + q0 + l31) * 3072 + h * 128 + map * 64 + 8 * half;
#pragma unroll
      for (int s = 0; s < 4; ++s) qf[s] = *(const bf16x8*)(qp + 16 * s); }
    f32x16 O[4];
#pragma unroll
    for (int e = 0; e < 4; ++e)
#pragma unroll
        for (int r = 0; r < 16; ++r) O[e][r] = 0.f;
    float m_run = 0.f, l_run = 0.f;
    const int ntile = 2 * (qb + 1);
    const int skey = tid >> 4, sch = tid & 15;
    const bf16* gk = QKV + (trow0 + skey) * 3072 + 1024 + h * 128 + sch * 8;
    const int dk = skey * KPITCH + sch * 16, dv = KBYTES + skey * VPITCH + sch * 16;
    u32x4 stg[4];
#define GLOAD(j) do { const bf16* g_ = gk + (size_t)(j) * 64 * 3072; stg[0] = *(const u32x4*)g_; stg[1] = *(const u32x4*)(g_ + 32 * 3072); stg[2] = *(const u32x4*)(g_ + 1024); stg[3] = *(const u32x4*)(g_ + 32 * 3072 + 1024); } while (0)
#define LSTORE(st) do { LAS unsigned char* b_ = lds + (st) * STAGEB; *(LAS u32x4*)(b_ + dk) = stg[0]; *(LAS u32x4*)(b_ + dk + 32 * KPITCH) = stg[1]; *(LAS u32x4*)(b_ + dv) = stg[2]; *(LAS u32x4*)(b_ + dv + 32 * VPITCH) = stg[3]; } while (0)
    GLOAD(0); LSTORE(0); __syncthreads();
    const int koff = l31 * KPITCH + map * 128 + half * 16;
    const int voff = KBYTES + (4 * half + ((lane & 15) >> 2)) * VPITCH + (((lane >> 4) & 1) * 16 + (lane & 3) * 4) * 2;
    const int qi = q0 + l31;
    for (int j = 0; j < ntile; ++j) {
        if (j + 1 < ntile) GLOAD(j + 1);
        const int kbase = 64 * j;
        if (kbase <= q0 + 31) {
            const LAS unsigned char* sb = lds + (j & 1) * STAGEB;
            f32x16 s0, s1;
            const float negm = -m_run;
#pragma unroll
            for (int r = 0; r < 16; ++r) { s0[r] = negm; s1[r] = negm; }
#pragma unroll
            for (int s = 0; s < 4; ++s) { const bf16x8 k0 = *(const LAS bf16x8*)(sb + koff + s * 32), k1 = *(const LAS bf16x8*)(sb + koff + 32 * KPITCH + s * 32);
                s0 = __builtin_amdgcn_mfma_f32_32x32x16_bf16(k0, qf[s], s0, 0, 0, 0); s1 = __builtin_amdgcn_mfma_f32_32x32x16_bf16(k1, qf[s], s1, 0, 0, 0); }
            const LAS unsigned char* vb = sb + voff;
            s16x4 vlo[4][4], vhi[4][4];
            if (kbase + 63 > q0) {
#pragma unroll
                for (int r = 0; r < 16; ++r) { const int key = kbase + (r & 3) + 8 * (r >> 2) + 4 * half;
                    s0[r] = (key <= qi) ? s0[r] : -1e30f; s1[r] = (key + 32 <= qi) ? s1[r] : -1e30f; }
            }
            float mx = fmaxf(s0[0], s1[0]);
#pragma unroll
            for (int r = 1; r < 16; ++r) mx = fmaxf(mx, fmaxf(s0[r], s1[r]));
            mx = fmaxf(mx, __shfl_xor(mx, 32));
            float ps = 0.f;
            const bool first = (j == 0), move = first || (__ballot(mx > 8.f) != 0ull);
            const float delta = move ? (first ? mx : fmaxf(mx, 0.f)) : 0.f;
#pragma unroll
            for (int r = 0; r < 16; ++r) { s0[r] = __builtin_amdgcn_exp2f(s0[r] - delta); s1[r] = __builtin_amdgcn_exp2f(s1[r] - delta); ps += s0[r] + s1[r]; }
            if (move) {
                const float alpha = first ? 0.f : __builtin_amdgcn_exp2f(-delta); m_run += delta;
                l_run = l_run * alpha + ps;
                if (!first) {
#pragma unroll
                    for (int e = 0; e < 4; ++e) O[e] = O[e] * alpha;
                }
            } else l_run += ps;
            bf16x8 pf[4];
#pragma unroll
            for (int kk = 0; kk < 4; ++kk) { u32x4 wv;
                if (kk < 2) { wv.x = cvtpk(s0[8 * kk + 0], s0[8 * kk + 1]); wv.y = cvtpk(s0[8 * kk + 2], s0[8 * kk + 3]); wv.z = cvtpk(s0[8 * kk + 4], s0[8 * kk + 5]); wv.w = cvtpk(s0[8 * kk + 6], s0[8 * kk + 7]); }
                else { const int k2 = kk - 2; wv.x = cvtpk(s1[8 * k2 + 0], s1[8 * k2 + 1]); wv.y = cvtpk(s1[8 * k2 + 2], s1[8 * k2 + 3]); wv.z = cvtpk(s1[8 * k2 + 4], s1[8 * k2 + 5]); wv.w = cvtpk(s1[8 * k2 + 6], s1[8 * k2 + 7]); }
                pf[kk] = __builtin_bit_cast(bf16x8, wv); }
#pragma unroll
            for (int e = 0; e < 4; ++e) { vlo[0][e] = vtr(vb + e * 64); vhi[0][e] = vtr(vb + 8 * VPITCH + e * 64); }
#pragma unroll
            for (int kk = 0; kk < 4; ++kk)
#pragma unroll
                for (int e = 0; e < 4; ++e) {
                    if (e == 0 && kk < 3) {
#pragma unroll
                        for (int e2 = 0; e2 < 4; ++e2) { vlo[kk + 1][e2] = vtr(vb + (kk + 1) * 16 * VPITCH + e2 * 64); vhi[kk + 1][e2] = vtr(vb + ((kk + 1) * 16 + 8) * VPITCH + e2 * 64); }
                        __builtin_amdgcn_sched_barrier(0);
                    }
                    const s16x4 lo = vlo[kk][e], hi = vhi[kk][e];
                    bf16x8 a; a[0] = lo[0]; a[1] = lo[1]; a[2] = lo[2]; a[3] = lo[3]; a[4] = hi[0]; a[5] = hi[1]; a[6] = hi[2]; a[7] = hi[3];
                    O[e] = __builtin_amdgcn_mfma_f32_32x32x16_bf16(a, pf[kk], O[e], 0, 0, 0); }
        }
        if (j + 1 < ntile) LSTORE((j + 1) & 1);
        __syncthreads();
    }
#undef GLOAD
#undef LSTORE
    const float ltot = l_run + __shfl_xor(l_run, 32), inv = 1.f / ltot;
    LAS float* X = (LAS float*)(lds + XOFF) + wq * 4096 + lane;
    if (map == 1) {
        const float sc = inv * lam;
#pragma unroll
        for (int e = 0; e < 4; ++e)
#pragma unroll
            for (int r = 0; r < 16; ++r) X[(e * 16 + r) * 64] = O[e][r] * sc;
    }
    __syncthreads();
    if (map == 0) {
        float ssq = 0.f;
#pragma unroll
        for (int e = 0; e < 4; ++e)
#pragma unroll
            for (int r = 0; r < 16; ++r) { const float o = O[e][r] * inv - X[(e * 16 + r) * 64]; O[e][r] = o; ssq += o * o; }
        ssq += __shfl_xor(ssq, 32);
        const float rms = rsqrtf(ssq * (1.f / 128.f) + EPS) * 0.8f;
        LAS unsigned char* ost = lds + OSTOFF + wq * OSTB;
#pragma unroll
        for (int e = 0; e < 4; ++e)
#pragma unroll
            for (int rq = 0; rq < 4; ++rq) { const int e0 = 32 * e + 8 * rq + 4 * half; const f32x4 g = *(const f32x4*)(subg + e0);
                u32x2 o; o.x = cvtpk(O[e][4 * rq + 0] * rms * g[0], O[e][4 * rq + 1] * rms * g[1]); o.y = cvtpk(O[e][4 * rq + 2] * rms * g[2], O[e][4 * rq + 3] * rms * g[3]);
                *(LAS u32x2*)(ost + l31 * OSTPITCH + e0 * 2) = o; }
        LDS_WAIT(); __builtin_amdgcn_wave_barrier();
#pragma unroll
        for (int jj = 0; jj < 8; ++jj) { const int c = lane + 64 * jj, row = c >> 4, ch = c & 15;
            const u32x4 v = *(const LAS u32x4*)(ost + row * OSTPITCH + ch * 16);
            *(u32x4*)(ON + (trow0 + q0 + row) * 2048 + h * 128 + ch * 8) = v; }
    }
    __syncthreads();
}

__device__ __forceinline__ void phase_attn(const Params& p, LAS unsigned char* lds, int G, int bid, int tid) {
    const bf16* QKV = (const bf16*)(p.ws + WS_BIG); bf16* ON = (bf16*)p.out;
    const int lane = tid & 63;
    const float a = p.lambda_qk[lane] * p.lambda_qk[64 + lane], b = p.lambda_qk[128 + lane] * p.lambda_qk[192 + lane];
    const float lam = expf(wave_sum(a)) - expf(wave_sum(b)) + 0.2f;
    for (int c = bid; c < 256; c += G) {
        const int bh = c >> 2, quad = c & 3, b_ = bh >> 3, h = bh & 7;
        attn_unit(lds, QKV, ON, p.subln_g, lam, b_, h, 15 - 2 * quad, tid);
        attn_unit(lds, QKV, ON, p.subln_g, lam, b_, h, 2 * quad, tid);
        attn_unit(lds, QKV, ON, p.subln_g, lam, b_, h, 14 - 2 * quad, tid);
        attn_unit(lds, QKV, ON, p.subln_g, lam, b_, h, 2 * quad + 1, tid);
    }
}

__device__ __forceinline__ unsigned mono(float v) { const unsigned u = __builtin_bit_cast(unsigned, v); return (u & 0x80000000u) ? ~u : (u | 0x80000000u); }
__device__ __forceinline__ float unmono(unsigned k) { const unsigned u = (k & 0x80000000u) ? (k ^ 0x80000000u) : ~k; return __builtin_bit_cast(float, u); }
#define CE_(x, y) do { const unsigned t_ = max(x, y); y = min(x, y); x = t_; } while (0)
__device__ __forceinline__ void sort16(unsigned (&a)[16]) {
    CE_(a[0], a[1]); CE_(a[2], a[3]); CE_(a[0], a[2]); CE_(a[1], a[3]); CE_(a[1], a[2]); CE_(a[4], a[5]); CE_(a[6], a[7]); CE_(a[4], a[6]); CE_(a[5], a[7]); CE_(a[5], a[6]); CE_(a[0], a[4]); CE_(a[2], a[6]); CE_(a[2], a[4]); CE_(a[1], a[5]); CE_(a[3], a[7]); CE_(a[3], a[5]); CE_(a[1], a[2]); CE_(a[3], a[4]); CE_(a[5], a[6]); CE_(a[8], a[9]); CE_(a[10], a[11]); CE_(a[8], a[10]); CE_(a[9], a[11]); CE_(a[9], a[10]); CE_(a[12], a[13]); CE_(a[14], a[15]); CE_(a[12], a[14]); CE_(a[13], a[15]); CE_(a[13], a[14]); CE_(a[8], a[12]); CE_(a[10], a[14]); CE_(a[10], a[12]); CE_(a[9], a[13]); CE_(a[11], a[15]); CE_(a[11], a[13]); CE_(a[9], a[10]); CE_(a[11], a[12]); CE_(a[13], a[14]); CE_(a[0], a[8]); CE_(a[4], a[12]); CE_(a[4], a[8]); CE_(a[2], a[10]); CE_(a[6], a[14]); CE_(a[6], a[10]); CE_(a[2], a[4]); CE_(a[6], a[8]); CE_(a[10], a[12]); CE_(a[1], a[9]); CE_(a[5], a[13]); CE_(a[5], a[9]); CE_(a[3], a[11]); CE_(a[7], a[15]); CE_(a[7], a[11]); CE_(a[3], a[5]); CE_(a[7], a[9]); CE_(a[11], a[13]); CE_(a[1], a[2]); CE_(a[3], a[4]); CE_(a[5], a[6]); CE_(a[7], a[8]); CE_(a[9], a[10]); CE_(a[11], a[12]); CE_(a[13], a[14]);
}
__device__ __forceinline__ void merge16(unsigned (&a)[16], const unsigned (&b)[16]) {
    a[0] = max(a[0], b[15]); a[1] = max(a[1], b[14]); a[2] = max(a[2], b[13]); a[3] = max(a[3], b[12]); a[4] = max(a[4], b[11]); a[5] = max(a[5], b[10]); a[6] = max(a[6], b[9]); a[7] = max(a[7], b[8]); a[8] = max(a[8], b[7]); a[9] = max(a[9], b[6]); a[10] = max(a[10], b[5]); a[11] = max(a[11], b[4]); a[12] = max(a[12], b[3]); a[13] = max(a[13], b[2]); a[14] = max(a[14], b[1]); a[15] = max(a[15], b[0]);
    CE_(a[0], a[8]); CE_(a[1], a[9]); CE_(a[2], a[10]); CE_(a[3], a[11]); CE_(a[4], a[12]); CE_(a[5], a[13]); CE_(a[6], a[14]); CE_(a[7], a[15]); CE_(a[0], a[4]); CE_(a[1], a[5]); CE_(a[2], a[6]); CE_(a[3], a[7]); CE_(a[8], a[12]); CE_(a[9], a[13]); CE_(a[10], a[14]); CE_(a[11], a[15]); CE_(a[0], a[2]); CE_(a[1], a[3]); CE_(a[4], a[6]); CE_(a[5], a[7]); CE_(a[8], a[10]); CE_(a[9], a[11]); CE_(a[12], a[14]); CE_(a[13], a[15]); CE_(a[0], a[1]); CE_(a[2], a[3]); CE_(a[4], a[5]); CE_(a[6], a[7]); CE_(a[8], a[9]); CE_(a[10], a[11]); CE_(a[12], a[13]); CE_(a[14], a[15]);
}

__device__ __forceinline__ void convert_experts(const Params& p, size_t gtid, size_t nthr) {
    cvt_flat_fp8(p.expert_u, p.ws + WS_EU, (size_t)16384 * 1024 / 16, ESCALE, gtid, nthr);
    cvt_flat_fp8(p.expert_v, p.ws + WS_EV, (size_t)16384 * 1024 / 16, ESCALE, gtid, nthr);
}
__device__ __forceinline__ void phase_topk(const Params& p, LAS unsigned char* lds, int G, int bid, int wave, int lane) {
    const bf16* QP = (const bf16*)(p.ws + WS_BIG + B_QP); const bf16* SK = (const bf16*)(p.ws + WS_SUBK);
    int* SEL = (int*)(p.ws + WS_BIG + B_SEL); float* GATE = (float*)(p.ws + WS_BIG + B_GATE);
    const int gw = bid * NWAVES + wave, NGW = G * NWAVES, l31 = lane & 31, half = lane >> 5;
    LAS int* tab = (LAS int*)(lds + wave * 4096) + l31 * 32;
    const size_t cg_tid = (size_t)bid * 256 + (wave & 3) * 64 + lane, cg_n = (size_t)G * 256;
    if (wave < 4) cvt_flat_fp8(p.expert_u, p.ws + WS_EU, (size_t)16384 * 1024 / 16, ESCALE, cg_tid, cg_n);
    for (int task = gw; task < 512 * 8; task += NGW) {
        const int tg = task >> 3, h = task & 7, t = tg * 32 + l31;
        unsigned lists[2][16];
#pragma unroll
        for (int m = 0; m < 2; ++m) {
            f32x16 acc[4];
#pragma unroll
            for (int kb = 0; kb < 4; ++kb)
#pragma unroll
                for (int r = 0; r < 16; ++r) acc[kb][r] = 0.f;
            const bf16* qp = QP + (size_t)t * 2048 + h * 256 + m * 128 + 8 * half;
            const bf16* kp = SK + ((size_t)(h * 2 + m) * 128 + l31) * 128 + 8 * half;
#pragma unroll 1
            for (int s = 0; s < 8; ++s) { const bf16x8 bq = *(const bf16x8*)(qp + 16 * s);
#pragma unroll
                for (int kb = 0; kb < 4; ++kb) { const bf16x8 ak = *(const bf16x8*)(kp + kb * 32 * 128 + 16 * s); acc[kb] = __builtin_amdgcn_mfma_f32_32x32x16_bf16(ak, bq, acc[kb], 0, 0, 0); } }
            unsigned top[16], oth[16];
#pragma unroll
            for (int kb = 0; kb < 4; ++kb) {
#pragma unroll
                for (int r = 0; r < 16; ++r) { const int kidx = 32 * kb + (r & 3) + 8 * (r >> 2) + 4 * half; oth[r] = (mono(acc[kb][r]) & ~127u) | (unsigned)(127 - kidx); }
                sort16(oth);
                if (kb == 0) {
#pragma unroll
                    for (int i = 0; i < 16; ++i) top[i] = oth[i];
                } else merge16(top, oth);
            }
#pragma unroll
            for (int i = 0; i < 16; ++i) oth[i] = (unsigned)__shfl_xor((int)top[i], 32);
            merge16(top, oth);
#pragma unroll
            for (int i = 0; i < 16; ++i) lists[m][i] = top[i];
        }
        float va[16], vb[16];
#pragma unroll
        for (int i = 0; i < 16; ++i) { va[i] = unmono(lists[0][i] & ~127u); vb[i] = unmono(lists[1][i] & ~127u);
            tab[i] = 127 - (int)(lists[0][i] & 127u); tab[16 + i] = 127 - (int)(lists[1][i] & 127u); }
#define CKEY(i, j) ((mono(va[i] + vb[j]) & ~255u) | (unsigned)(255 - ((i) * 16 + (j))))
        unsigned ct[16], l1[16], l2[16], l3[16];
#pragma unroll
        for (int j = 0; j < 16; ++j) ct[j] = CKEY(0, j);
#pragma unroll
        for (int j = 0; j < 8; ++j) l1[j] = CKEY(1, j);
#pragma unroll
        for (int j = 0; j < 5; ++j) l1[8 + j] = CKEY(2, j);
        l1[13] = 0u; l1[14] = 0u; l1[15] = 0u;
#pragma unroll
        for (int j = 0; j < 4; ++j) l2[j] = CKEY(3, j);
#pragma unroll
        for (int j = 0; j < 3; ++j) l2[4 + j] = CKEY(4, j);
#pragma unroll
        for (int j = 0; j < 2; ++j) { l2[7 + j] = CKEY(5, j); l2[9 + j] = CKEY(6, j); l2[11 + j] = CKEY(7, j); }
        l2[13] = 0u; l2[14] = 0u; l2[15] = 0u;
#pragma unroll
        for (int i = 0; i < 8; ++i) { l3[i] = CKEY(8 + i, 0); l3[8 + i] = 0u; }
#undef CKEY
        sort16(l1); sort16(l2); sort16(l3);
        merge16(ct, l1); merge16(l2, l3); merge16(ct, l2);
        LDS_WAIT(); __builtin_amdgcn_wave_barrier();
        const float s0 = unmono(ct[0] & ~255u);
        float ev[16], es = 0.f; int ex[16];
#pragma unroll
        for (int r = 0; r < 16; ++r) { const int pos = 255 - (int)(ct[r] & 255u); ev[r] = __expf(unmono(ct[r] & ~255u) - s0); es += ev[r];
            ex[r] = tab[pos >> 4] * 128 + tab[16 + (pos & 15)]; }
        const float ie = 1.f / es;
        int* so = SEL + (size_t)t * 128 + h * 16; float* go = GATE + (size_t)t * 128 + h * 16;
        if (half == 0) {
#pragma unroll
            for (int r = 0; r < 8; ++r) { so[r] = ex[r]; go[r] = ev[r] * ie; }
        } else {
#pragma unroll
            for (int r = 8; r < 16; ++r) { so[r] = ex[r]; go[r] = ev[r] * ie; }
        }
        LDS_WAIT(); __builtin_amdgcn_wave_barrier();
    }
    if (wave >= 4) cvt_flat_fp8(p.expert_v, p.ws + WS_EV, (size_t)16384 * 1024 / 16, ESCALE, cg_tid, cg_n);
}

constexpr int KT = 4;
constexpr int GW_LDS = 16896;
__device__ __forceinline__ void phase_gather(const Params& p, LAS unsigned char* lds, int G, int bid, int wave, int lane) {
    const int* SEL = (const int*)(p.ws + WS_BIG + B_SEL); const float* GATE = (const float*)(p.ws + WS_BIG + B_GATE);
    const unsigned char* EU = p.ws + WS_EU; const unsigned char* EV = p.ws + WS_EV;
    float* H2 = p.out;
    const int gw = bid * NWAVES + wave, NGW = G * NWAVES, l15 = lane & 15, g4 = lane >> 4;
    LAS unsigned char* wl = lds + wave * GW_LDS;
    LAS unsigned char* xnb = wl; LAS int* selb = (LAS int*)(wl + 8192); LAS float* gateb = (LAS float*)(wl + 12288); LAS float* hb = (LAS float*)(wl + 16384);
    f32x4 g2[4], fg[4];
#pragma unroll
    for (int j = 0; j < 4; ++j) { g2[j] = *(const f32x4*)(p.norm2_g + 16 * lane + 4 * j); fg[j] = *(const f32x4*)(p.final_g + 16 * lane + 4 * j); }
    for (int tb = gw * KT; tb < T; tb += NGW * KT) {
#pragma unroll 1
        for (int k = 0; k < KT; ++k) {
            const int t = tb + k;
            const float* hrow = H2 + (size_t)t * DM + 16 * lane;
            f32x4 hv[4];
#pragma unroll
            for (int j = 0; j < 4; ++j) hv[j] = *(const f32x4*)(hrow + 4 * j);
            const int selA = SEL[(size_t)t * 128 + lane], selB = SEL[(size_t)t * 128 + 64 + lane];
            const float gtA = GATE[(size_t)t * 128 + lane], gtB = GATE[(size_t)t * 128 + 64 + lane];
            float ssq = 0.f;
#pragma unroll
            for (int j = 0; j < 4; ++j) ssq += (hv[j][0] * hv[j][0] + hv[j][1] * hv[j][1]) + (hv[j][2] * hv[j][2] + hv[j][3] * hv[j][3]);
            const float r2 = rsqrtf(wave_sum(ssq) * (1.f / DM) + EPS);
            { u32x4 o;
#pragma unroll
              for (int j = 0; j < 4; ++j) { const f32x4 a = hv[j] * r2 * g2[j]; int w = 0;
                  w = __builtin_amdgcn_cvt_pk_fp8_f32(a[0], a[1], w, false); w = __builtin_amdgcn_cvt_pk_fp8_f32(a[2], a[3], w, true); o[j] = (unsigned)w; }
              *(LAS u32x4*)(xnb + k * 1024 + 16 * lane) = o; }
            const int bA = selA >> 10, bB = selB >> 10; int posA = 0, posB = 0, off = 0;
#pragma unroll
            for (int b = 0; b < 16; ++b) {
                const unsigned long long mA = __ballot(bA == b), mB = __ballot(bB == b);
                const int cA = __popcll(mA), cB = __popcll(mB);
                const int rA = (int)__builtin_amdgcn_mbcnt_hi((unsigned)(mA >> 32), __builtin_amdgcn_mbcnt_lo((unsigned)mA, 0u));
                const int rB = (int)__builtin_amdgcn_mbcnt_hi((unsigned)(mB >> 32), __builtin_amdgcn_mbcnt_lo((unsigned)mB, 0u));
                if (bA == b) posA = off + rA;
                if (bB == b) posB = off + cA + rB;
                off += cA + cB;
            }
            selb[k * 128 + posA] = selA; gateb[k * 128 + posA] = gtA; selb[k * 128 + posB] = selB; gateb[k * 128 + posB] = gtB;
        }
        LDS_WAIT(); __builtin_amdgcn_wave_barrier();
        f32x2_t y[KT][8];
#pragma unroll
        for (int k = 0; k < KT; ++k)
#pragma unroll
            for (int i = 0; i < 8; ++i) y[k][i] = (f32x2_t){0.f, 0.f};
#pragma unroll 1
        for (int g = 0; g < 8; ++g) {
#pragma unroll
            for (int k = 0; k < KT; ++k) {
                asm volatile("" ::: "memory");
                f32x4 acc = (f32x4){0.f, 0.f, 0.f, 0.f};
                const int e = selb[k * 128 + 16 * g + l15];
                const unsigned char* up = EU + (size_t)e * DM + 16 * g4;
                const LAS unsigned char* xk = xnb + k * 1024 + 16 * g4;
#pragma unroll
                for (int s2 = 0; s2 < 16; ++s2) { const u32x4 a = *(const u32x4*)(up + 64 * s2); const u32x4 bx = *(const LAS u32x4*)(xk + 64 * s2);
                    const long a0 = (long)(((unsigned long long)a.y << 32) | a.x), a1 = (long)(((unsigned long long)a.w << 32) | a.z);
                    const long b0 = (long)(((unsigned long long)bx.y << 32) | bx.x), b1 = (long)(((unsigned long long)bx.w << 32) | bx.z);
                    acc = __builtin_amdgcn_mfma_f32_16x16x32_fp8_fp8(a0, b0, acc, 0, 0, 0);
                    acc = __builtin_amdgcn_mfma_f32_16x16x32_fp8_fp8(a1, b1, acc, 0, 0, 0); }
                if (l15 == 0) {
#pragma unroll
                    for (int j = 0; j < 4; ++j) { const float a = acc[j] * (1.f / ESCALE);
                        hb[k * 16 + 4 * g4 + j] = 0.5f * a * (1.f + erff(a * 0.70710678118654752f)) * gateb[k * 128 + 16 * g + 4 * g4 + j] * (1.f / ESCALE); }
                }
            }
            LDS_WAIT(); __builtin_amdgcn_wave_barrier();
#pragma unroll
            for (int k = 0; k < KT; ++k) {
                asm volatile("" ::: "memory");
                u32x4 vr[2][4];
#pragma unroll
                for (int i = 0; i < 4; ++i) vr[0][i] = *(const u32x4*)(EV + (size_t)selb[k * 128 + 16 * g + i] * DM + 16 * lane);
#pragma unroll
                for (int bt = 0; bt < 4; ++bt) {
                    if (bt < 3) {
#pragma unroll
                        for (int i = 0; i < 4; ++i) vr[(bt + 1) & 1][i] = *(const u32x4*)(EV + (size_t)selb[k * 128 + 16 * g + 4 * (bt + 1) + i] * DM + 16 * lane);
                    }
                    asm volatile("" ::: "memory");
#pragma unroll
                    for (int i = 0; i < 4; ++i) { const float hs = hb[k * 16 + 4 * bt + i]; const u32x4 v = vr[bt & 1][i];
#pragma unroll
                        for (int q = 0; q < 4; ++q) { const f32x2_t lo = __builtin_amdgcn_cvt_pk_f32_fp8((int)v[q], false), hi = __builtin_amdgcn_cvt_pk_f32_fp8((int)v[q], true);
                            y[k][2 * q] += lo * hs; y[k][2 * q + 1] += hi * hs; } }
                }
            }
            LDS_WAIT(); __builtin_amdgcn_wave_barrier();
        }
#pragma unroll
        for (int k = 0; k < KT; ++k) {
            float* hrow = H2 + (size_t)(tb + k) * DM + 16 * lane;
            f32x4 h3[4]; float s3 = 0.f;
#pragma unroll
            for (int j = 0; j < 4; ++j) { const f32x4 hv = *(const f32x4*)(hrow + 4 * j);
                h3[j][0] = hv[0] + y[k][2 * j][0]; h3[j][1] = hv[1] + y[k][2 * j][1]; h3[j][2] = hv[2] + y[k][2 * j + 1][0]; h3[j][3] = hv[3] + y[k][2 * j + 1][1];
                s3 += (h3[j][0] * h3[j][0] + h3[j][1] * h3[j][1]) + (h3[j][2] * h3[j][2] + h3[j][3] * h3[j][3]); }
            const float r3 = rsqrtf(wave_sum(s3) * (1.f / DM) + EPS);
#pragma unroll
            for (int j = 0; j < 4; ++j) *(f32x4*)(hrow + 4 * j) = h3[j] * r3 * fg[j];
        }
        LDS_WAIT(); __builtin_amdgcn_wave_barrier();
    }
}

#define XB_TMO      128
#define XB_XCNT(j)  (256  + 64 * (j))
#define XB_XSUB(j)  (1280 + 64 * (j))
#define XB_XGEN(j)  (2304 + 64 * (j))
#define XB_TOP      3328
#define XB_TOPGEN   3392
#define XCD_BAR_WORDS 3456
#define XB_SPIN_CAP (1u << 18)

__device__ __forceinline__ unsigned xb_ld(unsigned* p)              { return __hip_atomic_load(p, __ATOMIC_RELAXED, __HIP_MEMORY_SCOPE_AGENT); }
__device__ __forceinline__ unsigned xb_add(unsigned* p, unsigned v) { return __hip_atomic_fetch_add(p, v, __ATOMIC_RELAXED, __HIP_MEMORY_SCOPE_AGENT); }
__device__ __forceinline__ unsigned xb_xcc_id() { return (unsigned)__builtin_amdgcn_s_getreg((3 << 11) | 20) & 0xFu; }
#define XB_SPIN(cond, bar) do { unsigned _sp = 0; while (cond) { __builtin_amdgcn_s_sleep(1); \
    if ((++_sp & 255u) == 0u) { if (xb_ld(&(bar)[XB_TMO])) break; if (_sp > XB_SPIN_CAP) { atomicAdd(&(bar)[XB_TMO], 1u); break; } } } } while (0)

struct XcdBarrier {
    unsigned* bar; unsigned x;
    volatile LAS unsigned* st;
};

__device__ __forceinline__ XcdBarrier xcd_barrier_post(unsigned* bar, volatile LAS unsigned* st) {
    XcdBarrier b; b.bar = bar; b.x = xb_xcc_id(); b.st = st;
    if (threadIdx.x == 0) (void)xb_add(&bar[XB_XCNT(b.x)], 1u);
    return b;
}
__device__ __forceinline__ void xcd_barrier_complete(unsigned* bar, unsigned x, unsigned& nloc, unsigned& nx) {
    const unsigned G = gridDim.x * gridDim.y * gridDim.z;
    unsigned sum, cnt, mine, sp = 0u;
    for (;;) {
        sum = 0u; cnt = 0u; mine = 0u;
#pragma unroll
        for (unsigned j = 0; j < 16; ++j) { const unsigned c = xb_ld(&bar[XB_XCNT(j)]); sum += c; cnt += (c > 0u) ? 1u : 0u; mine = (j == x) ? c : mine; }
        if (sum == G) break;
        __builtin_amdgcn_s_sleep(1);
        if ((++sp & 255u) == 0u) { if (xb_ld(&bar[XB_TMO])) break; if (sp > XB_SPIN_CAP) { atomicAdd(&bar[XB_TMO], 1u); break; } }
    }
    nloc = mine > 0u ? mine : 1u; nx = cnt > 0u ? cnt : 1u;
}

__device__ __forceinline__ void xcd_barrier(const XcdBarrier& b) {
    asm volatile("s_waitcnt vmcnt(0)" ::: "memory");
    __syncthreads();
    if (threadIdx.x == 0) {
        unsigned* bar = b.bar;
        __builtin_amdgcn_s_waitcnt(0);
        unsigned nloc = b.st[0], nx = b.st[1];
        if (nloc == 0u) { xcd_barrier_complete(bar, b.x, nloc, nx); b.st[0] = nloc; b.st[1] = nx; }
        const unsigned old = xb_add(&bar[XB_XSUB(b.x)], 1u);
        const unsigned gen = old / nloc;
        if (old + 1u == (gen + 1u) * nloc) {
            __builtin_amdgcn_fence(__ATOMIC_RELEASE, "agent");
            asm volatile("s_waitcnt vmcnt(0)" ::: "memory");
            const unsigned og = xb_add(&bar[XB_TOP], 1u);
            const unsigned tg = og / nx;
            if (og + 1u == (tg + 1u) * nx) xb_add(&bar[XB_TOPGEN], 1u);
            else XB_SPIN(xb_ld(&bar[XB_TOPGEN]) == tg, bar);
            __builtin_amdgcn_fence(__ATOMIC_ACQUIRE, "agent");
            xb_add(&bar[XB_XGEN(b.x)], 1u);
            asm volatile("s_waitcnt vmcnt(0)" ::: "memory");
        } else {
            XB_SPIN(xb_ld(&bar[XB_XGEN(b.x)]) == gen, bar);
            __builtin_amdgcn_fence(__ATOMIC_ACQUIRE, "agent");
            asm volatile("s_waitcnt vmcnt(0)" ::: "memory");
        }
    }
    __syncthreads();
}

#ifndef ONE_LAUNCH
#define ONE_LAUNCH 1
#endif
constexpr int NPHASE = 8;
__global__ void __launch_bounds__(NTHR, 2) hybrid_fwd(Params p) {
    extern __shared__ __attribute__((aligned(16))) unsigned char lds_raw[];
    LAS unsigned char* lds = (LAS unsigned char*)lds_raw;
    const int tid = threadIdx.x, lane = tid & 63, wave = __builtin_amdgcn_readfirstlane(tid >> 6), G = gridDim.x, bid = blockIdx.x;
    unsigned char* ws = p.ws;
    volatile LAS unsigned* xst = (volatile LAS unsigned*)(lds + 139264);
    if (tid < 2) xst[tid] = 0u;
    __syncthreads();
    XcdBarrier xbar; xbar.bar = (unsigned*)(ws + WS_END); xbar.x = 0; xbar.st = xst;
    if (ONE_LAUNCH && p.hi - p.lo > 1) { xbar = xcd_barrier_post((unsigned*)(ws + WS_END), xst); cg::this_grid().sync(); }
    const pg8::bf16_t* N1 = (const pg8::bf16_t*)p.out;
#ifdef ONLY
#define PH(k) if ((k) == ONLY && p.lo <= (k) && (k) < p.hi)
#else
#define PH(k) if (p.lo <= (k) && (k) < p.hi)
#endif
#define SEAM(k) do { if (ONE_LAUNCH && p.lo <= (k) && (k) + 1 < p.hi) { xcd_barrier(xbar); } } while (0)
#define FRESH_IDS int tid = threadIdx.x; asm volatile("" : "+v"(tid)); const int lane = tid & 63, wave = __builtin_amdgcn_readfirstlane(tid >> 6); (void)lane; (void)wave
    unsigned char* big = ws + WS_BIG;
    PH(0) { FRESH_IDS; phase0(p, lds, G, bid, wave, lane); SEAM(0); }
    PH(1) { FRESH_IDS; pg8::Gemm g{N1, (const pg8::bf16_t*)(ws + WS_WIN), T, 8192, 1024, 2048, 1024}; pg8::StaticOrder S; S.init(T, 8192, G, bid);
        pg8::EpiG1 E{(pg8::bf16_t*)(big + B_QKV), (pg8::bf16_t*)(big + B_GG), (pg8::bf16_t*)p.out + 1024, (pg8::bf16_t*)(big + B_PR), C2};
        pg8::gemm_phase<pg8::EpiG1, pg8::StaticOrder, true, true>(lds, g, S, E); SEAM(1); }
    PH(2) { FRESH_IDS; phase_attn(p, lds, G, bid, tid); phase_conv(p, G, bid, tid); SEAM(2); }
    PH(3) { FRESH_IDS; pg8::Gemm g{(const pg8::bf16_t*)p.out, (const pg8::bf16_t*)(ws + WS_WAC), T, 1024, 1024, 2048, 2048}; pg8::SplitKOrder S; S.base.init(T, 1024, G, bid);
        pg8::EpiMerged E{(const pg8::bf16_t*)(big + B_GG), (pg8::bf16_t*)(big + B_MG)};
        pg8::gemm_phase<pg8::EpiMerged, pg8::SplitKOrder, false, true>(lds, g, S, E); SEAM(3); }
    PH(4) { FRESH_IDS; pg8::Gemm g{(const pg8::bf16_t*)(big + B_MG), (const pg8::bf16_t*)(ws + WS_WOUT), T, 1024, 1024, 1024, 1024}; pg8::StaticOrder S; S.init(T, 1024, G, bid);
        pg8::EpiResid E{p.x, p.out, (pg8::bf16_t*)(big + B_H2B), (float*)(ws + WS_SSQ)};
        pg8::gemm_phase<pg8::EpiResid, pg8::StaticOrder, false, true>(lds, g, S, E); SEAM(4); }
    PH(5) { FRESH_IDS; pg8::Gemm g{(const pg8::bf16_t*)(big + B_H2B), (const pg8::bf16_t*)(ws + WS_WQ), T, 2048, 1024, 1024, 1024}; pg8::StaticOrder S; S.init(T, 2048, G, bid);
        pg8::EpiRowScale E{(const float*)(ws + WS_SSQ), (pg8::bf16_t*)(big + B_QP)};
        pg8::gemm_phase<pg8::EpiRowScale, pg8::StaticOrder, true, true>(lds, g, S, E); SEAM(5); }
    PH(6) { FRESH_IDS; phase_topk(p, lds, G, bid, wave, lane); SEAM(6); }
    PH(7) { FRESH_IDS; phase_gather(p, lds, G, bid, wave, lane); }
#undef PH
#undef SEAM
}

extern "C" void kernel_launch(void* const* d_in, const int* in_sizes, int n_in, void* d_out, int out_size, void* d_ws, size_t ws_size, hipStream_t stream) {
    static int grid = 0;
    if (grid == 0) {
        if (n_in != 15 || out_size != T * DM || ws_size < WS_END) { fprintf(stderr, "kernel_launch: unexpected problem (n_in %d out %d ws %zu)\n", n_in, out_size, ws_size); grid = -1; return; }
        int dev = 0, cus = 0, per_cu = 0;
        hipGetDevice(&dev); hipDeviceGetAttribute(&cus, hipDeviceAttributeMultiprocessorCount, dev);
        if (hipFuncSetAttribute((const void*)hybrid_fwd, hipFuncAttributeMaxDynamicSharedMemorySize, LDS_BYTES) != hipSuccess) { fprintf(stderr, "kernel_launch: hipFuncSetAttribute failed\n"); grid = -1; return; }
        if (hipOccupancyMaxActiveBlocksPerMultiprocessor(&per_cu, (const void*)hybrid_fwd, NTHR, LDS_BYTES) != hipSuccess || per_cu < 1) { fprintf(stderr, "kernel_launch: occupancy query says %d\n", per_cu); per_cu = 1; }
        (void)hipGetLastError();
        grid = cus * per_cu;
    }
    if (grid < 0) return;
    Params p{};
    p.x = (const float*)d_in[0]; p.norm1_g = (const float*)d_in[1]; p.w_in = (const float*)d_in[2]; p.lambda_qk = (const float*)d_in[3]; p.subln_g = (const float*)d_in[4];
    p.conv_w = (const float*)d_in[5]; p.w_attn_o = (const float*)d_in[6]; p.w_conv_o = (const float*)d_in[7]; p.w_out = (const float*)d_in[8]; p.norm2_g = (const float*)d_in[9];
    p.w_query = (const float*)d_in[10]; p.sub_keys = (const float*)d_in[11]; p.expert_u = (const float*)d_in[12]; p.expert_v = (const float*)d_in[13]; p.final_g = (const float*)d_in[14];
    p.out = (float*)d_out; p.ws = (unsigned char*)d_ws;
#if ONE_LAUNCH
    p.lo = 0; p.hi = NPHASE;
    (void)hipMemsetAsync((char*)d_ws + WS_END, 0, 16384, stream);
    void* args[] = {&p};
    hipError_t e = hipLaunchCooperativeKernel((const void*)hybrid_fwd, dim3(grid), dim3(NTHR), args, LDS_BYTES, stream);
    if (e != hipSuccess) fprintf(stderr, "cooperative launch failed: %s (grid %d)\n", hipGetErrorString(e), grid);
#else
    for (int k = 0; k < NPHASE; ++k) {
        p.lo = k; p.hi = k + 1; hipLaunchKernelGGL(hybrid_fwd, dim3(grid), dim3(NTHR), LDS_BYTES, stream, p); }
#endif
}
```

```cpp
#include <hip/hip_runtime.h>
#include <hip/hip_cooperative_groups.h>
#include <cstdio>
#include <cstdint>
namespace cg = cooperative_groups;
namespace pg8 {
#define PG8_LAS __attribute__((address_space(3)))
typedef unsigned short bf16_t;
typedef short bf16x8 __attribute__((ext_vector_type(8)));
typedef float f32x4 __attribute__((ext_vector_type(4)));
typedef unsigned u32x4 __attribute__((ext_vector_type(4)));
constexpr int BM = 256, BK = 64, HALF = 128, HTB = HALF * BK * 2  , STAGE_BYTES = 8 * HTB, NXCD = 8, WGM = 8;

__host__ __device__ __forceinline__ int lds_byte(int r, int c) { const int st = (r >> 4) * 2 + (c >> 5), rr = r & 15, cc = c & 31, ob = rr * 64 + cc * 2; return st * 1024 + (ob ^ (((ob >> 9) & 1) << 5)); }
__host__ __device__ __forceinline__ void stage_rc(int b, int& R, int& C) { const int st = b / 1024, sb = b % 1024, swz = sb ^ (((sb >> 9) & 1) << 5); R = (st >> 1) * 16 + swz / 64; C = (st & 1) * 32 + (swz % 64) / 2; }
__host__ __device__ __forceinline__ int perm32(int rho) { const int n = rho >> 4, i = rho & 15; return 8 * (i >> 2) + 4 * n + (i & 3); }

struct Unit { int pm, pn, kh; };
struct Gemm { const bf16_t* A; const bf16_t* Bt; int M, N, K, lda, ldb; };
struct StaticOrder {
    int nM, nN, nwg, G, c;
    __host__ __device__ void init(int M, int N, int G_, int c_) { nM = M / BM; nN = N / BM; nwg = nM * nN; G = G_; c = c_; }
    __host__ __device__ bool next(int i, Unit& u) const {
        const long L = (long)i * G + c; if (L >= nwg) return false;
        int wgid = (int)L; { const int q = nwg / NXCD, r = nwg % NXCD, xcd = wgid % NXCD, off = wgid / NXCD; wgid = (xcd < r ? xcd * (q + 1) : r * (q + 1) + (xcd - r) * q) + off; }
        const int nig = WGM * nN, gid = wgid / nig, fm = gid * WGM, gsz = (nM - fm) < WGM ? (nM - fm) : WGM;
        u.pm = fm + ((wgid % nig) % gsz); u.pn = (wgid % nig) / gsz; u.kh = 0; return true;
    }
    __device__ __forceinline__ void a_ready(const Unit&) const {}
    __device__ __forceinline__ void done(const Unit&) const {}
};
struct SplitKOrder {
    StaticOrder base;
    __host__ __device__ bool next(int i, Unit& u) const { if (!base.next(i >> 1, u)) return false; u.kh = i & 1; return true; }
    __device__ __forceinline__ void a_ready(const Unit&) const {}
    __device__ __forceinline__ void done(const Unit&) const {}
};
__device__ __forceinline__ unsigned cvt_pk_bf16(float lo, float hi) { unsigned r; asm volatile("v_cvt_pk_bf16_f32 %0, %1, %2" : "=v"(r) : "v"(lo), "v"(hi)); return r; }
typedef float f32x2 __attribute__((ext_vector_type(2)));
typedef float f32x2 __attribute__((ext_vector_type(2)));
typedef unsigned u32x2 __attribute__((ext_vector_type(2)));
__device__ __forceinline__ void unpack8(const u32x4 w, float (&f)[8]) {
    f[0] = __builtin_bit_cast(float, w.x << 16); f[1] = __builtin_bit_cast(float, w.x & 0xffff0000u);
    f[2] = __builtin_bit_cast(float, w.y << 16); f[3] = __builtin_bit_cast(float, w.y & 0xffff0000u);
    f[4] = __builtin_bit_cast(float, w.z << 16); f[5] = __builtin_bit_cast(float, w.z & 0xffff0000u);
    f[6] = __builtin_bit_cast(float, w.w << 16); f[7] = __builtin_bit_cast(float, w.w & 0xffff0000u);
}
__device__ __forceinline__ u32x4 pack8(const f32x4 v0, const f32x4 v1) { u32x4 w; w.x = cvt_pk_bf16(v0[0], v0[1]); w.y = cvt_pk_bf16(v0[2], v0[3]); w.z = cvt_pk_bf16(v1[0], v1[1]); w.w = cvt_pk_bf16(v1[2], v1[3]); return w; }
struct EpiPlain {
    static constexpr bool PERM = true, AFTER_DRAIN = false, MID = false;
    bf16_t* O; int ldc;
    __device__ __forceinline__ void operator()(const f32x4 (&acc)[2][2][4][2], const Unit& u, int wr, int wc, int fr, int fq) const {
        const int row0 = u.pm * BM + wr * 64 + fr, col0 = u.pn * BM + wc * 32 + 8 * fq;
#pragma unroll
        for (int ai = 0; ai < 2; ++ai)
#pragma unroll
            for (int m = 0; m < 4; ++m) { bf16_t* rowp = O + (size_t)(row0 + ai * HALF + m * 16) * ldc + col0;
#pragma unroll
                for (int bj = 0; bj < 2; ++bj) *(u32x4*)(rowp + bj * HALF) = pack8(acc[ai][bj][m][0], acc[ai][bj][m][1]); }
    }
};
struct EpiQKVG {
    static constexpr bool PERM = true, AFTER_DRAIN = false, MID = false;
    bf16_t* QKV; bf16_t* GG; float c2;
    __device__ __forceinline__ void operator()(const f32x4 (&acc)[2][2][4][2], const Unit& u, int wr, int wc, int fr, int fq) const {
        int colt = u.pn * BM; bf16_t* base = QKV; int ldc = 3072; float sc = 1.f; bool sig = false;
        if (colt < 1024) sc = c2; else if (colt >= 3072) { base = GG; ldc = 2048; colt -= 3072; sig = true; }
        const int row0 = u.pm * BM + wr * 64 + fr, col0 = colt + wc * 32 + 8 * fq;
#pragma unroll
        for (int ai = 0; ai < 2; ++ai)
#pragma unroll
            for (int m = 0; m < 4; ++m) { bf16_t* rowp = base + (size_t)(row0 + ai * HALF + m * 16) * ldc + col0;
#pragma unroll
                for (int bj = 0; bj < 2; ++bj) { f32x4 v0 = acc[ai][bj][m][0], v1 = acc[ai][bj][m][1];
                    if (sig) {
#pragma unroll
                        for (int i = 0; i < 4; ++i) { v0[i] = __builtin_amdgcn_rcpf(1.f + __expf(-v0[i])); v1[i] = __builtin_amdgcn_rcpf(1.f + __expf(-v1[i])); }
                    } else { v0 = v0 * sc; v1 = v1 * sc; }
                    *(u32x4*)(rowp + bj * HALF) = pack8(v0, v1); } }
    }
};
struct EpiGateA {
    static constexpr bool PERM = true, AFTER_DRAIN = false, MID = false;
    const bf16_t* GG; float* TMP;
    __device__ __forceinline__ void operator()(const f32x4 (&acc)[2][2][4][2], const Unit& u, int wr, int wc, int fr, int fq) const {
        const int row0 = u.pm * BM + wr * 64 + fr, col0 = u.pn * BM + wc * 32 + 8 * fq;
#pragma unroll
        for (int ai = 0; ai < 2; ++ai)
#pragma unroll
            for (int m = 0; m < 4; ++m) { const size_t row = (size_t)(row0 + ai * HALF + m * 16);
#pragma unroll
                for (int bj = 0; bj < 2; ++bj) { const int col = col0 + bj * HALF; float g[8]; unpack8(*(const u32x4*)(GG + row * 2048 + col), g);
                    f32x4 v0 = acc[ai][bj][m][0], v1 = acc[ai][bj][m][1];
                    v0[0] *= g[0]; v0[1] *= g[1]; v0[2] *= g[2]; v0[3] *= g[3]; v1[0] *= g[4]; v1[1] *= g[5]; v1[2] *= g[6]; v1[3] *= g[7];
                    *(f32x4*)(TMP + row * 1024 + col) = v0; *(f32x4*)(TMP + row * 1024 + col + 4) = v1; } }
    }
};
struct EpiGateC {
    static constexpr bool PERM = true, AFTER_DRAIN = false, MID = false;
    const bf16_t* GG; const float* TMP; bf16_t* MG;
    __device__ __forceinline__ void operator()(const f32x4 (&acc)[2][2][4][2], const Unit& u, int wr, int wc, int fr, int fq) const {
        const int row0 = u.pm * BM + wr * 64 + fr, col0 = u.pn * BM + wc * 32 + 8 * fq;
#pragma unroll
        for (int ai = 0; ai < 2; ++ai)
#pragma unroll
            for (int m = 0; m < 4; ++m) { const size_t row = (size_t)(row0 + ai * HALF + m * 16);
#pragma unroll
                for (int bj = 0; bj < 2; ++bj) { const int col = col0 + bj * HALF; float g[8]; unpack8(*(const u32x4*)(GG + row * 2048 + 1024 + col), g);
                    const f32x4 t0 = *(const f32x4*)(TMP + row * 1024 + col), t1 = *(const f32x4*)(TMP + row * 1024 + col + 4);
                    f32x4 v0 = acc[ai][bj][m][0], v1 = acc[ai][bj][m][1];
                    v0[0] = t0[0] + v0[0] * g[0]; v0[1] = t0[1] + v0[1] * g[1]; v0[2] = t0[2] + v0[2] * g[2]; v0[3] = t0[3] + v0[3] * g[3];
                    v1[0] = t1[0] + v1[0] * g[4]; v1[1] = t1[1] + v1[1] * g[5]; v1[2] = t1[2] + v1[2] * g[6]; v1[3] = t1[3] + v1[3] * g[7];
                    *(u32x4*)(MG + row * 1024 + col) = pack8(v0, v1); } }
    }
};
struct EpiG1 {
    static constexpr bool PERM = true, AFTER_DRAIN = false, MID = false;
    bf16_t* QKV; bf16_t* GG; bf16_t* CB; bf16_t* PR; float c2;
    __device__ __forceinline__ void operator()(const f32x4 (&acc)[2][2][4][2], const Unit& u, int wr, int wc, int fr, int fq) const {
        int colt = u.pn * BM; const int row0 = u.pm * BM + wr * 64 + fr;
        if (colt >= 6144) {
            const int ch0 = (colt - 6144) / 2 + wc * 16 + 4 * fq;
#pragma unroll
            for (int ai = 0; ai < 2; ++ai)
#pragma unroll
                for (int m = 0; m < 4; ++m) { bf16_t* rowp = PR + (size_t)(row0 + ai * HALF + m * 16) * 1024 + ch0;
#pragma unroll
                    for (int bj = 0; bj < 2; ++bj) { const f32x4 v0 = acc[ai][bj][m][0], v1 = acc[ai][bj][m][1];
                        u32x2 w; w.x = cvt_pk_bf16(v0[0] * v0[1], v0[2] * v0[3]); w.y = cvt_pk_bf16(v1[0] * v1[1], v1[2] * v1[3]);
                        *(u32x2*)(rowp + bj * (HALF / 2)) = w; } }
            return;
        }
        bf16_t* base = QKV; int ldc = 3072; float sc = 1.f; bool sig = false;
        if (colt < 1024) sc = c2; else if (colt >= 5120) { base = CB; ldc = 2048; colt -= 5120; } else if (colt >= 3072) { base = GG; ldc = 2048; colt -= 3072; sig = true; }
        const int col0 = colt + wc * 32 + 8 * fq;
#pragma unroll
        for (int ai = 0; ai < 2; ++ai)
#pragma unroll
            for (int m = 0; m < 4; ++m) { bf16_t* rowp = base + (size_t)(row0 + ai * HALF + m * 16) * ldc + col0;
#pragma unroll
                for (int bj = 0; bj < 2; ++bj) { f32x4 v0 = acc[ai][bj][m][0], v1 = acc[ai][bj][m][1];
                    if (sig) {
#pragma unroll
                        for (int i = 0; i < 4; ++i) { v0[i] = __builtin_amdgcn_rcpf(1.f + __expf(-v0[i])); v1[i] = __builtin_amdgcn_rcpf(1.f + __expf(-v1[i])); }
                    } else { v0 = v0 * sc; v1 = v1 * sc; }
                    *(u32x4*)(rowp + bj * HALF) = pack8(v0, v1); } }
    }
};
struct EpiMerged {
    static constexpr bool PERM = true, AFTER_DRAIN = false, MID = true;
    const bf16_t* GG; bf16_t* MG;
    __device__ __forceinline__ void mid(f32x4 (&acc)[2][2][4][2], const Unit& u, int wr, int wc, int fr, int fq) const {
        const int row0 = u.pm * BM + wr * 64 + fr, col0 = u.pn * BM + wc * 32 + 8 * fq;
#pragma unroll
        for (int ai = 0; ai < 2; ++ai)
#pragma unroll
            for (int m = 0; m < 4; ++m) { const size_t row = (size_t)(row0 + ai * HALF + m * 16);
#pragma unroll
                for (int bj = 0; bj < 2; ++bj) { const int col = col0 + bj * HALF; float ga[8], gc[8];
                    unpack8(*(const u32x4*)(GG + row * 2048 + col), ga); unpack8(*(const u32x4*)(GG + row * 2048 + 1024 + col), gc);
#pragma unroll
                    for (int i = 0; i < 4; ++i) { acc[ai][bj][m][0][i] *= ga[i] * __builtin_amdgcn_rcpf(gc[i]); acc[ai][bj][m][1][i] *= ga[4 + i] * __builtin_amdgcn_rcpf(gc[4 + i]); }
                    asm volatile("" ::: "memory"); } }
    }
    __device__ __forceinline__ void operator()(const f32x4 (&acc)[2][2][4][2], const Unit& u, int wr, int wc, int fr, int fq) const {
        const int row0 = u.pm * BM + wr * 64 + fr, col0 = u.pn * BM + wc * 32 + 8 * fq;
#pragma unroll
        for (int ai = 0; ai < 2; ++ai)
#pragma unroll
            for (int m = 0; m < 4; ++m) { const size_t row = (size_t)(row0 + ai * HALF + m * 16);
#pragma unroll
                for (int bj = 0; bj < 2; ++bj) { const int col = col0 + bj * HALF; float gc[8]; unpack8(*(const u32x4*)(GG + row * 2048 + 1024 + col), gc);
                    f32x4 v0 = acc[ai][bj][m][0], v1 = acc[ai][bj][m][1];
#pragma unroll
                    for (int i = 0; i < 4; ++i) { v0[i] *= gc[i]; v1[i] *= gc[4 + i]; }
                    *(u32x4*)(MG + row * 1024 + col) = pack8(v0, v1); } }
    }
};
struct EpiResid {
    static constexpr bool PERM = true, AFTER_DRAIN = false, MID = false;
    const float* X; float* H2; bf16_t* H2B; float* SSQ;
    __device__ __forceinline__ void operator()(const f32x4 (&acc)[2][2][4][2], const Unit& u, int wr, int wc, int fr, int fq) const {
        const int row0 = u.pm * BM + wr * 64 + fr, col0 = u.pn * BM + wc * 32 + 8 * fq;
#pragma unroll
        for (int ai = 0; ai < 2; ++ai)
#pragma unroll
            for (int m = 0; m < 4; ++m) { const size_t row = (size_t)(row0 + ai * HALF + m * 16); float s = 0.f;
#pragma unroll
                for (int bj = 0; bj < 2; ++bj) { const size_t o = row * 1024 + col0 + bj * HALF;
                    const f32x4 v0 = acc[ai][bj][m][0] + *(const f32x4*)(X + o), v1 = acc[ai][bj][m][1] + *(const f32x4*)(X + o + 4);
                    *(f32x4*)(H2 + o) = v0; *(f32x4*)(H2 + o + 4) = v1; *(u32x4*)(H2B + o) = pack8(v0, v1);
                    s += (v0[0] * v0[0] + v0[1] * v0[1]) + (v0[2] * v0[2] + v0[3] * v0[3]) + (v1[0] * v1[0] + v1[1] * v1[1]) + (v1[2] * v1[2] + v1[3] * v1[3]); }
                s += __shfl_xor(s, 16); s += __shfl_xor(s, 32);
                if (fq == 0) SSQ[row * 16 + u.pn * 4 + wc] = s; }
    }
};
struct EpiRowScale {
    static constexpr bool PERM = true, AFTER_DRAIN = false, MID = false;
    const float* SSQ; bf16_t* O;
    __device__ __forceinline__ void operator()(const f32x4 (&acc)[2][2][4][2], const Unit& u, int wr, int wc, int fr, int fq) const {
        const int row0 = u.pm * BM + wr * 64 + fr, col0 = u.pn * BM + wc * 32 + 8 * fq;
#pragma unroll
        for (int ai = 0; ai < 2; ++ai)
#pragma unroll
            for (int m = 0; m < 4; ++m) { const size_t row = (size_t)(row0 + ai * HALF + m * 16);
                const f32x4* sp = (const f32x4*)(SSQ + row * 16); const f32x4 a = sp[0] + sp[1], b = sp[2] + sp[3], c = a + b;
                const float rs = rsqrtf(((c[0] + c[1]) + (c[2] + c[3])) * (1.f / 1024.f) + 1e-6f);
#pragma unroll
                for (int bj = 0; bj < 2; ++bj) *(u32x4*)(O + row * 2048 + col0 + bj * HALF) = pack8(acc[ai][bj][m][0] * rs, acc[ai][bj][m][1] * rs); }
    }
};
template <class Epi, class Sched, bool ALIGN_EPI = false, bool SP2 = false>
__device__ __forceinline__ void gemm_phase(PG8_LAS unsigned char* lds, const Gemm g, const Sched& S, const Epi& E) {
    const int tid = threadIdx.x, wid = __builtin_amdgcn_readfirstlane(tid >> 6), lane = tid & 63, wr = wid >> 2, wc = wid & 3, fr = lane & 15, fq = lane >> 4;
    const int K = g.K, nt = K / BK;
    unsigned voffA[2], voffB[2];
#pragma unroll
    for (int i = 0; i < 2; ++i) { int R, C; stage_rc(tid * 16 + i * 8192, R, C); const int Rb = Epi::PERM ? ((R & ~31) + perm32(R & 31)) : R;
        voffA[i] = (unsigned)(R * g.lda + C) * 2u; voffB[i] = (unsigned)(Rb * g.ldb + C) * 2u; }
    const size_t kstep = (size_t)(BK * 2);
    const size_t hstep = (size_t)HALF * g.ldb * 2;
    const size_t tstep = 2 * hstep;
    const size_t hstepA = (size_t)HALF * g.lda * 2, tstepA = 2 * hstepA;
    const unsigned ldsw = (unsigned)wid * 1024u;
    const int aoff = lds_byte(wr * 64 + fr, fq * 8), boff = lds_byte(wc * 32 + fr, fq * 8);
#define PG8_SA(b, h) (((b) * 2 + (h)) * HTB)
#define PG8_SB(b, h) ((4 + (b) * 2 + (h)) * HTB)
#define PG8_STAGE(bufoff, gbase, voff) do { _Pragma("unroll") for (int _i = 0; _i < 2; ++_i) \
        __builtin_amdgcn_global_load_lds((const unsigned*)((const char*)(gbase) + (voff)[_i]), (PG8_LAS unsigned*)(lds + (bufoff) + ldsw + _i * 8192), 16, 0, 0); } while (0)
#define PG8_LDA(dst, b, h) do { _Pragma("unroll") for (int m = 0; m < 4; ++m) _Pragma("unroll") for (int k = 0; k < 2; ++k) dst[m][k] = *(const PG8_LAS bf16x8*)(lds + PG8_SA(b, h) + aoff + m * 2048 + k * 1024); } while (0)
#define PG8_LDB(dst, b, h) do { _Pragma("unroll") for (int n = 0; n < 2; ++n) _Pragma("unroll") for (int k = 0; k < 2; ++k) dst[n][k] = *(const PG8_LAS bf16x8*)(lds + PG8_SB(b, h) + boff + n * 2048 + k * 1024); } while (0)
#define PG8_MMA(ai, bj, At, Bt) do { __builtin_amdgcn_s_setprio(1); _Pragma("unroll") for (int m = 0; m < 4; ++m) _Pragma("unroll") for (int n = 0; n < 2; ++n) _Pragma("unroll") for (int k = 0; k < 2; ++k) \
        acc[ai][bj][m][n] = __builtin_amdgcn_mfma_f32_16x16x32_bf16(Bt[n][k], At[m][k], acc[ai][bj][m][n], 0, 0, 0); __builtin_amdgcn_s_setprio(0); } while (0)
#define PG8_WAIT_V(n) asm volatile("s_waitcnt vmcnt(" #n ")" ::: "memory")
#define PG8_WAIT_L(n) asm volatile("s_waitcnt lgkmcnt(" #n ")" ::: "memory")
#define PG8_BAR __builtin_amdgcn_s_barrier()
#define PG8_SCHED __builtin_amdgcn_sched_barrier(0)
    Unit cur, nxt; int ui = 0;
    if (!S.next(0, cur)) return;
    f32x4 acc[2][2][4][2];
#pragma unroll
    for (int a = 0; a < 2; ++a)
#pragma unroll
        for (int b = 0; b < 2; ++b)
#pragma unroll
            for (int m = 0; m < 4; ++m)
#pragma unroll
                for (int n = 0; n < 2; ++n) acc[a][b][m][n] = (f32x4){0.f, 0.f, 0.f, 0.f};
    bf16x8 At[4][2], B0[2][2], B1[2][2];
    const char* cA = (const char*)g.A + (size_t)cur.pm * tstepA + (size_t)cur.kh * K * 2; const char* cB = (const char*)g.Bt + (size_t)cur.pn * tstep + (size_t)cur.kh * K * 2;
    S.a_ready(cur);
    if constexpr (SP2) {
        PG8_STAGE(PG8_SB(0, 0), cB, voffB); PG8_STAGE(PG8_SB(0, 1), cB + hstep, voffB); PG8_STAGE(PG8_SA(0, 0), cA, voffA); PG8_STAGE(PG8_SA(0, 1), cA + hstepA, voffA);
        if (wr == 1) PG8_BAR;
        PG8_WAIT_V(2); PG8_BAR;
        PG8_STAGE(PG8_SB(1, 0), cB + kstep, voffB); PG8_STAGE(PG8_SA(1, 0), cA + kstep, voffA); PG8_STAGE(PG8_SB(1, 1), cB + hstep + kstep, voffB);
        PG8_WAIT_V(6); PG8_BAR;
    } else {
        PG8_STAGE(PG8_SB(0, 0), cB, voffB); PG8_STAGE(PG8_SA(0, 0), cA, voffA); PG8_STAGE(PG8_SB(0, 1), cB + hstep, voffB); PG8_STAGE(PG8_SA(0, 1), cA + hstepA, voffA);
        if (wr == 1) PG8_BAR;
        PG8_WAIT_V(4); PG8_BAR;
        PG8_STAGE(PG8_SB(1, 0), cB + kstep, voffB); PG8_STAGE(PG8_SA(1, 0), cA + kstep, voffA); PG8_STAGE(PG8_SB(1, 1), cB + hstep + kstep, voffB);
        PG8_WAIT_V(6); PG8_BAR;
    }
    for (;;) {
        const bool has_next = S.next(ui + 1, nxt);
        const char* nA = has_next ? (const char*)g.A + (size_t)nxt.pm * tstepA + (size_t)nxt.kh * K * 2 : cA; const char* nB = has_next ? (const char*)g.Bt + (size_t)nxt.pn * tstep + (size_t)nxt.kh * K * 2 : cB;
        for (int t = 0; t < nt; t += 2) {
            const bool last = (t == nt - 2);
            const char* a1 = cA + (size_t)(t + 1) * kstep;
            const char* a2 = last ? nA : cA + (size_t)(t + 2) * kstep; const char* b2 = last ? nB : cB + (size_t)(t + 2) * kstep;
            const char* a3 = a2 + kstep; const char* b3 = b2 + kstep;
            if (last && has_next) S.a_ready(nxt);
            if constexpr (SP2) {
            PG8_LDB(B0, 0, 0); PG8_LDB(B1, 0, 1); PG8_SCHED; PG8_LDA(At, 0, 0); PG8_STAGE(PG8_SA(1, 1), a1 + hstepA, voffA);
            PG8_WAIT_V(8); PG8_WAIT_L(0); PG8_BAR; PG8_MMA(0, 0, At, B0); PG8_MMA(0, 1, At, B1); PG8_BAR; PG8_SCHED;
            PG8_LDA(At, 0, 1); PG8_STAGE(PG8_SB(0, 0), b2, voffB); PG8_STAGE(PG8_SB(0, 1), b2 + hstep, voffB); PG8_STAGE(PG8_SA(0, 0), a2, voffA);
            PG8_WAIT_V(8); PG8_WAIT_L(0); PG8_BAR; PG8_MMA(1, 0, At, B0); PG8_MMA(1, 1, At, B1); PG8_BAR; PG8_SCHED;
            PG8_LDB(B0, 1, 0); PG8_LDB(B1, 1, 1); PG8_SCHED; PG8_LDA(At, 1, 0); PG8_STAGE(PG8_SA(0, 1), a2 + hstepA, voffA);
            PG8_WAIT_V(8); PG8_WAIT_L(0); PG8_BAR; PG8_MMA(0, 0, At, B0); PG8_MMA(0, 1, At, B1); PG8_BAR; PG8_SCHED;
            PG8_LDA(At, 1, 1); PG8_STAGE(PG8_SB(1, 0), b3, voffB); PG8_STAGE(PG8_SB(1, 1), b3 + hstep, voffB); PG8_STAGE(PG8_SA(1, 0), a3, voffA);
            PG8_WAIT_V(8); PG8_WAIT_L(0); PG8_BAR; PG8_MMA(1, 0, At, B0); PG8_MMA(1, 1, At, B1); PG8_BAR; PG8_SCHED;
            } else {
            PG8_LDB(B0, 0, 0); PG8_SCHED; PG8_LDA(At, 0, 0); PG8_STAGE(PG8_SA(1, 1), a1 + hstepA, voffA);
            PG8_WAIT_L(8); PG8_BAR; PG8_WAIT_L(0); PG8_MMA(0, 0, At, B0); PG8_BAR; PG8_SCHED;
            PG8_LDB(B1, 0, 1); PG8_STAGE(PG8_SB(0, 0), b2, voffB);
            PG8_BAR; PG8_WAIT_L(0); PG8_MMA(0, 1, At, B1); PG8_BAR;
            PG8_LDA(At, 0, 1); PG8_STAGE(PG8_SA(0, 0), a2, voffA);
            PG8_BAR; PG8_WAIT_L(0); PG8_MMA(1, 0, At, B0); PG8_BAR; PG8_SCHED;
            PG8_STAGE(PG8_SB(0, 1), b2 + hstep, voffB);
            PG8_WAIT_V(6); PG8_BAR; PG8_MMA(1, 1, At, B1); PG8_BAR;
            PG8_LDB(B0, 1, 0); PG8_SCHED; PG8_LDA(At, 1, 0); PG8_STAGE(PG8_SA(0, 1), a2 + hstepA, voffA);
            PG8_WAIT_L(8); PG8_BAR; PG8_WAIT_L(0); PG8_MMA(0, 0, At, B0); PG8_BAR; PG8_SCHED;
            PG8_LDB(B1, 1, 1); PG8_STAGE(PG8_SB(1, 0), b3, voffB);
            PG8_BAR; PG8_WAIT_L(0); PG8_MMA(0, 1, At, B1); PG8_BAR;
            PG8_LDA(At, 1, 1); PG8_STAGE(PG8_SA(1, 0), a3, voffA);
            PG8_BAR; PG8_WAIT_L(0); PG8_MMA(1, 0, At, B0); PG8_BAR; PG8_SCHED;
            PG8_STAGE(PG8_SB(1, 1), b3 + hstep, voffB);
            PG8_WAIT_V(6); PG8_BAR; PG8_MMA(1, 1, At, B1); PG8_BAR;
            }
        }
        if constexpr (ALIGN_EPI) { if (wr == 0) PG8_BAR; }
        bool keep_acc = false;
        if constexpr (Epi::MID) { if (cur.kh == 0) { E.mid(acc, cur, wr, wc, fr, fq); keep_acc = true; } }
        if constexpr (!Epi::AFTER_DRAIN) { if (!keep_acc) { E(acc, cur, wr, wc, fr, fq); S.done(cur); } }
        if (!has_next) break;
        if (!keep_acc)
#pragma unroll
        for (int a = 0; a < 2; ++a)
#pragma unroll
            for (int b = 0; b < 2; ++b)
#pragma unroll
                for (int m = 0; m < 4; ++m)
#pragma unroll
                    for (int n = 0; n < 2; ++n) acc[a][b][m][n] = (f32x4){0.f, 0.f, 0.f, 0.f};
        cur = nxt; cA = nA; cB = nB; ++ui;
        if constexpr (ALIGN_EPI) { if (wr == 1) PG8_BAR; }
    }
    PG8_WAIT_V(0);
    if constexpr (!ALIGN_EPI) { if (wr == 0) PG8_BAR; }
    PG8_BAR;
    if constexpr (Epi::AFTER_DRAIN) { E.fused(acc, cur, wr, wc, fr, fq, lds, wid, lane); S.done(cur); }
#undef PG8_SA
#undef PG8_SB
#undef PG8_STAGE
#undef PG8_LDA
#undef PG8_LDB
#undef PG8_MMA
#undef PG8_WAIT_V
#undef PG8_WAIT_L
#undef PG8_BAR
#undef PG8_SCHED
}
}
#define LAS __attribute__((address_space(3)))
typedef unsigned short bf16;
typedef short bf16x8 __attribute__((ext_vector_type(8)));
typedef short s16x4 __attribute__((ext_vector_type(4)));
typedef float f32x4 __attribute__((ext_vector_type(4)));
typedef float f32x16 __attribute__((ext_vector_type(16)));
typedef unsigned u32x4 __attribute__((ext_vector_type(4)));
typedef unsigned u32x2 __attribute__((ext_vector_type(2)));
typedef float f32x2_t __attribute__((ext_vector_type(2))); typedef __bf16 bf16x2_t __attribute__((ext_vector_type(2)));

constexpr int T = 16384, DM = 1024, SEQ = 2048;
constexpr int NWAVES = 8, NTHR = 512;
constexpr int LDS_BYTES = 147456;
constexpr float EPS = 1e-6f;
constexpr float ESCALE = 64.f;
constexpr float C2 = 0.125f * 1.4426950408889634f;
constexpr size_t MiB = 1u << 20;
constexpr size_t WS_WIN = 0, WS_WAC = 16 * MiB, WS_WOUT = 20 * MiB, WS_WQ = 22 * MiB, WS_SUBK = 26 * MiB, WS_SSQ = 27 * MiB;
constexpr size_t WS_EU = 28 * MiB, WS_EV = 44 * MiB, WS_BIG = 60 * MiB, WS_END = 252 * MiB;
constexpr size_t B_QKV = 0, B_GG = 96 * MiB, B_PR = 160 * MiB, B_MG = 0, B_H2B = 32 * MiB, B_QP = 96 * MiB, B_SEL = 64 * MiB, B_GATE = 72 * MiB;

__device__ __forceinline__ unsigned cvtpk(float lo, float hi) { f32x2_t v = {lo, hi}; bf16x2_t b = __builtin_convertvector(v, bf16x2_t); return __builtin_bit_cast(unsigned, b); }
__device__ __forceinline__ float wave_sum(float v) {
#pragma unroll
    for (int o = 1; o < 64; o <<= 1) v += __shfl_xor(v, o);
    return v;
}
#define LDS_WAIT() asm volatile("s_waitcnt lgkmcnt(0)" ::: "memory")

struct Params {
    const float* x; const float* norm1_g; const float* w_in; const float* lambda_qk; const float* subln_g; const float* conv_w;
    const float* w_attn_o; const float* w_conv_o; const float* w_out; const float* norm2_g; const float* w_query; const float* sub_keys;
    const float* expert_u; const float* expert_v; const float* final_g;
    float* out; unsigned char* ws; int lo, hi;
};

__device__ __forceinline__ void transpose_item(const float* W, int K, int N, bf16* WT, int remap, int dpitch, int koff, const float* kscale, LAS float* scr, int item, int lane) {
    const int nblk = N / 32, kb = item / nblk, nb = item % nblk, k0 = 64 * kb, n0 = 32 * nb;
    int d0 = n0, dstr = 1;
    if (remap) { if (n0 < 3072) d0 = n0; else if (n0 < 4096) d0 = n0 + 2048; else if (n0 < 5120) { d0 = 6144 + 2 * (n0 - 4096); dstr = 2; } else if (n0 < 6144) { d0 = 6144 + 2 * (n0 - 5120) + 1; dstr = 2; } else d0 = n0 - 3072; }
#pragma unroll 8
    for (int i = 0; i < 32; ++i) { const int kk = 2 * i + (lane >> 5); float v = W[(size_t)(k0 + kk) * N + n0 + (lane & 31)]; if (kscale) v *= kscale[k0 + kk]; scr[kk * 33 + (lane & 31)] = v; }
    LDS_WAIT(); asm volatile("" ::: "memory");
    const int c = lane & 7;
#pragma unroll
    for (int j = 0; j < 4; ++j) { const int n = (lane >> 3) + 8 * j; const LAS float* sp = scr + (8 * c) * 33 + n;
        u32x4 o; o.x = cvtpk(sp[0 * 33], sp[1 * 33]); o.y = cvtpk(sp[2 * 33], sp[3 * 33]); o.z = cvtpk(sp[4 * 33], sp[5 * 33]); o.w = cvtpk(sp[6 * 33], sp[7 * 33]);
        *(u32x4*)(WT + (size_t)(d0 + n * dstr) * dpitch + koff + k0 + 8 * c) = o; }
    LDS_WAIT(); asm volatile("" ::: "memory");
}
__device__ __forceinline__ void cvt_flat(const float* src, bf16* dst, size_t n8, size_t gtid, size_t nthr) {
    for (size_t i = gtid; i < n8; i += nthr) { const f32x4 a = *(const f32x4*)(src + i * 8), b = *(const f32x4*)(src + i * 8 + 4);
        u32x4 o; o.x = cvtpk(a[0], a[1]); o.y = cvtpk(a[2], a[3]); o.z = cvtpk(b[0], b[1]); o.w = cvtpk(b[2], b[3]); *(u32x4*)(dst + i * 8) = o; }
}
__device__ __forceinline__ void cvt_flat_fp8(const float* src, unsigned char* dst, size_t n16, float sc, size_t gtid, size_t nthr) {
    for (size_t i = gtid; i < n16; i += nthr) { u32x4 o;
#pragma unroll
        for (int q = 0; q < 4; ++q) { const f32x4 a = *(const f32x4*)(src + i * 16 + 4 * q) * sc; int w = 0;
            w = __builtin_amdgcn_cvt_pk_fp8_f32(a[0], a[1], w, false); w = __builtin_amdgcn_cvt_pk_fp8_f32(a[2], a[3], w, true); o[q] = (unsigned)w; }
        *(u32x4*)(dst + i * 16) = o; }
}
__device__ __forceinline__ void phase0(const Params& p, LAS unsigned char* lds, int G, int bid, int wave, int lane) {
    unsigned char* ws = p.ws;
    LAS float* scr = (LAS float*)(lds + wave * 16384);
    const int gw = bid * NWAVES + wave, NGW = G * NWAVES;
    constexpr int I_IN = 16 * 256, I_SQ = 16 * 32, I_Q = 16 * 64, NITEMS = I_IN + 3 * I_SQ + I_Q;
    for (int it = gw; it < NITEMS; it += NGW) {
        int r = it;
        if (r < I_IN) { transpose_item(p.w_in, 1024, 8192, (bf16*)(ws + WS_WIN), 1, 1024, 0, nullptr, scr, r, lane); continue; } r -= I_IN;
        if (r < I_SQ) { transpose_item(p.w_attn_o, 1024, 1024, (bf16*)(ws + WS_WAC), 0, 2048, 0, nullptr, scr, r, lane); continue; } r -= I_SQ;
        if (r < I_SQ) { transpose_item(p.w_conv_o, 1024, 1024, (bf16*)(ws + WS_WAC), 0, 2048, 1024, nullptr, scr, r, lane); continue; } r -= I_SQ;
        if (r < I_SQ) { transpose_item(p.w_out, 1024, 1024, (bf16*)(ws + WS_WOUT), 0, 1024, 0, nullptr, scr, r, lane); continue; } r -= I_SQ;
        transpose_item(p.w_query, 1024, 2048, (bf16*)(ws + WS_WQ), 0, 1024, 0, p.norm2_g, scr, r, lane);
    }
    const size_t gtid = (size_t)bid * NTHR + wave * 64 + lane, nthr = (size_t)G * NTHR;
    cvt_flat(p.sub_keys, (bf16*)(ws + WS_SUBK), (size_t)(8 * 2 * 128 * 128) / 8, gtid, nthr);
    bf16* N1 = (bf16*)p.out;
    f32x4 gv[4];
#pragma unroll
    for (int j = 0; j < 4; ++j) gv[j] = *((const f32x4*)p.norm1_g + lane + 64 * j);
    for (int m = gw; m < T; m += NGW) {
        const f32x4* xr = (const f32x4*)(p.x + (size_t)m * DM) + lane; f32x4 v[4]; float s = 0.f;
#pragma unroll
        for (int j = 0; j < 4; ++j) { v[j] = xr[64 * j]; s += (v[j][0] * v[j][0] + v[j][1] * v[j][1]) + (v[j][2] * v[j][2] + v[j][3] * v[j][3]); }
        const float r = rsqrtf(wave_sum(s) * (1.f / DM) + EPS);
        u32x2* o8 = (u32x2*)(N1 + (size_t)m * 2048) + lane;
#pragma unroll
        for (int j = 0; j < 4; ++j) { u32x2 o; o.x = cvtpk(v[j][0] * r * gv[j][0], v[j][1] * r * gv[j][1]); o.y = cvtpk(v[j][2] * r * gv[j][2], v[j][3] * r * gv[j][3]); o8[64 * j] = o; }
    }
}

__device__ __forceinline__ void up8(const bf16* p, float (&f)[8]) { const u32x4 w = *(const u32x4*)p; pg8::unpack8(w, f); }
__device__ __forceinline__ void phase_conv(const Params& p, int G, int bid, int tid) {
    const bf16* PR = (const bf16*)(p.ws + WS_BIG + B_PR); bf16* CBU = (bf16*)p.out + 1024;
    const size_t nthr = (size_t)G * NTHR;
    for (size_t it = (size_t)bid * NTHR + tid; it < (size_t)T * 128; it += nthr) {
        const int t = (int)(it >> 7), c8 = (int)(it & 127) * 8, s = t & (SEQ - 1);
        const bf16* row = PR + (size_t)t * 1024 + c8;
        float cb[8], a[8], acc[8];
        up8(CBU + (size_t)t * 2048 + c8, cb); up8(row, a);
        const f32x4 w2a = *(const f32x4*)(p.conv_w + 2048 + c8), w2b = *(const f32x4*)(p.conv_w + 2048 + c8 + 4);
#pragma unroll
        for (int i = 0; i < 8; ++i) acc[i] = (i < 4 ? w2a[i] : w2b[i - 4]) * a[i];
        if (s >= 1) { up8(row - 1024, a);
            const f32x4 w1a = *(const f32x4*)(p.conv_w + 1024 + c8), w1b = *(const f32x4*)(p.conv_w + 1024 + c8 + 4);
#pragma unroll
            for (int i = 0; i < 8; ++i) acc[i] += (i < 4 ? w1a[i] : w1b[i - 4]) * a[i]; }
        if (s >= 2) { up8(row - 2048, a);
            const f32x4 w0a = *(const f32x4*)(p.conv_w + c8), w0b = *(const f32x4*)(p.conv_w + c8 + 4);
#pragma unroll
            for (int i = 0; i < 8; ++i) acc[i] += (i < 4 ? w0a[i] : w0b[i - 4]) * a[i]; }
        u32x4 o; o.x = cvtpk(cb[0] * acc[0], cb[1] * acc[1]); o.y = cvtpk(cb[2] * acc[2], cb[3] * acc[3]); o.z = cvtpk(cb[4] * acc[4], cb[5] * acc[5]); o.w = cvtpk(cb[6] * acc[6], cb[7] * acc[7]);
        *(u32x4*)(CBU + (size_t)t * 2048 + c8) = o;
    }
}

constexpr int KPITCH = 272, VPITCH = 320, KBYTES = 64 * KPITCH, STAGEB = KBYTES + 64 * VPITCH;
constexpr int XOFF = 0, OSTOFF = 65536, OSTPITCH = 272, OSTB = 32 * OSTPITCH;
__device__ __forceinline__ s16x4 vtr(const LAS unsigned char* p) { return __builtin_amdgcn_ds_read_tr16_b64_v4i16((LAS s16x4*)p); }

__device__ __forceinline__ void attn_unit(LAS unsigned char* lds, const bf16* QKV, bf16* ON, const float* subg, float lam, int b, int h, int qb, int tid) {
    const int w = __builtin_amdgcn_readfirstlane(tid >> 6), lane = tid & 63, map = w >> 2, wq = w & 3, l31 = lane & 31, half = lane >> 5;
    const size_t trow0 = (size_t)b * SEQ;
    const int q0 = qb * 128 + wq * 32;
    bf16x8 qf[4];
    { const bf16* qp = QKV + (trow0 + q0 + l31) * 3072 + h * 128 + map * 64 + 8 * half;
#pragma unroll
      for (int s = 0; s < 4; ++s) qf[s] = *(const bf16x8*)(qp + 16 * s); }
    f32x16 O[4];
#pragma unroll
    for (int e = 0; e < 4; ++e)
#pragma unroll
        for (int r = 0; r < 16; ++r) O[e][r] = 0.f;
    float m_run = 0.f, l_run = 0.f;
    const int ntile = 2 * (qb + 1);
    const int skey = tid >> 4, sch = tid & 15;
    const bf16* gk = QKV + (trow0 + skey) * 3072 + 1024 + h * 128 + sch * 8;
    const int dk = skey * KPITCH + sch * 16, dv = KBYTES + skey * VPITCH + sch * 16;
    u32x4 stg[4];
#define GLOAD(j) do { const bf16* g_ = gk + (size_t)(j) * 64 * 3072; stg[0] = *(const u32x4*)g_; stg[1] = *(const u32x4*)(g_ + 32 * 3072); stg[2] = *(const u32x4*)(g_ + 1024); stg[3] = *(const u32x4*)(g_ + 32 * 3072 + 1024); } while (0)
#define LSTORE(st) do { LAS unsigned char* b_ = lds + (st) * STAGEB; *(LAS u32x4*)(b_ + dk) = stg[0]; *(LAS u32x4*)(b_ + dk + 32 * KPITCH) = stg[1]; *(LAS u32x4*)(b_ + dv) = stg[2]; *(LAS u32x4*)(b_ + dv + 32 * VPITCH) = stg[3]; } while (0)
    GLOAD(0); LSTORE(0); __syncthreads();
    const int koff = l31 * KPITCH + map * 128 + half * 16;
    const int voff = KBYTES + (4 * half + ((lane & 15) >> 2)) * VPITCH + (((lane >> 4) & 1) * 16 + (lane & 3) * 4) * 2;
    const int qi = q0 + l31;
    for (int j = 0; j < ntile; ++j) {
        if (j + 1 < ntile) GLOAD(j + 1);
        const int kbase = 64 * j;
        if (kbase <= q0 + 31) {
            const LAS unsigned char* sb = lds + (j & 1) * STAGEB;
            f32x16 s0, s1;
            const float negm = -m_run;
#pragma unroll
            for (int r = 0; r < 16; ++r) { s0[r] = negm; s1[r] = negm; }
#pragma unroll
            for (int s = 0; s < 4; ++s) { const bf16x8 k0 = *(const LAS bf16x8*)(sb + koff + s * 32), k1 = *(const LAS bf16x8*)(sb + koff + 32 * KPITCH + s * 32);
                s0 = __builtin_amdgcn_mfma_f32_32x32x16_bf16(k0, qf[s], s0, 0, 0, 0); s1 = __builtin_amdgcn_mfma_f32_32x32x16_bf16(k1, qf[s], s1, 0, 0, 0); }
            const LAS unsigned char* vb = sb + voff;
            s16x4 vlo[4][4], vhi[4][4];
            if (kbase + 63 > q0) {
#pragma unroll
                for (int r = 0; r < 16; ++r) { const int key = kbase + (r & 3) + 8 * (r >> 2) + 4 * half;
                    s0[r] = (key <= qi) ? s0[r] : -1e30f; s1[r] = (key + 32 <= qi) ? s1[r] : -1e30f; }
            }
            float mx = fmaxf(s0[0], s1[0]);
#pragma unroll
            for (int r = 1; r < 16; ++r) mx = fmaxf(mx, fmaxf(s0[r], s1[r]));
            mx = fmaxf(mx, __shfl_xor(mx, 32));
            float ps = 0.f;
            const bool first = (j == 0), move = first || (__ballot(mx > 8.f) != 0ull);
            const float delta = move ? (first ? mx : fmaxf(mx, 0.f)) : 0.f;
#pragma unroll
            for (int r = 0; r < 16; ++r) { s0[r] = __builtin_amdgcn_exp2f(s0[r] - delta); s1[r] = __builtin_amdgcn_exp2f(s1[r] - delta); ps += s0[r] + s1[r]; }
            if (move) {
                const float alpha = first ? 0.f : __builtin_amdgcn_exp2f(-delta); m_run += delta;
                l_run = l_run * alpha + ps;
                if (!first) {
#pragma unroll
                    for (int e = 0; e < 4; ++e) O[e] = O[e] * alpha;
                }
            } else l_run += ps;
            bf16x8 pf[4];
#pragma unroll
            for (int kk = 0; kk < 4; ++kk) { u32x4 wv;
                if (kk < 2) { wv.x = cvtpk(s0[8 * kk + 0], s0[8 * kk + 1]); wv.y = cvtpk(s0[8 * kk + 2], s0[8 * kk + 3]); wv.z = cvtpk(s0[8 * kk + 4], s0[8 * kk + 5]); wv.w = cvtpk(s0[8 * kk + 6], s0[8 * kk + 7]); }
                else { const int k2 = kk - 2; wv.x = cvtpk(s1[8 * k2 + 0], s1[8 * k2 + 1]); wv.y = cvtpk(s1[8 * k2 + 2], s1[8 * k2 + 3]); wv.z = cvtpk(s1[8 * k2 + 4], s1[8 * k2 + 5]); wv.w = cvtpk(s1[8 * k2 + 6], s1[8 * k2 + 7]); }
                pf[kk] = __builtin_bit_cast(bf16x8, wv); }
#pragma unroll
            for (int e = 0; e < 4; ++e) { vlo[0][e] = vtr(vb + e * 64); vhi[0][e] = vtr(vb + 8 * VPITCH + e * 64); }
#pragma unroll
            for (int kk = 0; kk < 4; ++kk)
#pragma unroll
                for (int e = 0; e < 4; ++e) {
                    if (e == 0 && kk < 3) {
#pragma unroll
                        for (int e2 = 0; e2 < 4; ++e2) { vlo[kk + 1][e2] = vtr(vb + (kk + 1) * 16 * VPITCH + e2 * 64); vhi[kk + 1][e2] = vtr(vb + ((kk + 1) * 16 + 8) * VPITCH + e2 * 64); }
                        __builtin_amdgcn_sched_barrier(0);
                    }
                    const s16x4 lo = vlo[kk][e], hi = vhi[kk][e];
                    bf16x8 a; a[0] = lo[0]; a[1] = lo[1]; a[2] = lo[2]; a[3] = lo[3]; a[4] = hi[0]; a[5] = hi[1]; a[6] = hi[2]; a[7] = hi[3];
                    O[e] = __builtin_amdgcn_mfma_f32_32x32x16_bf16(a, pf[kk], O[e], 0, 0, 0); }
        }
        if (j + 1 < ntile) LSTORE((j + 1) & 1);
        __syncthreads();
    }
#undef GLOAD
#undef LSTORE
    const float ltot = l_run + __shfl_xor(l_run, 32), inv = 1.f / ltot;
    LAS float* X = (LAS float*)(lds + XOFF) + wq * 4096 + lane;
    if (map == 1) {
        const float sc = inv * lam;
#pragma unroll
        for (int e = 0; e < 4; ++e)
#pragma unroll
            for (int r = 0; r < 16; ++r) X[(e * 16 + r) * 64] = O[e][r] * sc;
    }
    __syncthreads();
    if (map == 0) {
        float ssq = 0.f;
#pragma unroll
        for (int e = 0; e < 4; ++e)
#pragma unroll
            for (int r = 0; r < 16; ++r) { const float o = O[e][r] * inv - X[(e * 16 + r) * 64]; O[e][r] = o; ssq += o * o; }
        ssq += __shfl_xor(ssq, 32);
        const float rms = rsqrtf(ssq * (1.f / 128.f) + EPS) * 0.8f;
        LAS unsigned char* ost = lds + OSTOFF + wq * OSTB;
#pragma unroll
        for (int e = 0; e < 4; ++e)
#pragma unroll
            for (int rq = 0; rq < 4; ++rq) { const int e0 = 32 * e + 8 * rq + 4 * half; const f32x4 g = *(const f32x4*)(subg + e0);
                u32x2 o; o.x = cvtpk(O[e][4 * rq + 0] * rms * g[0], O[e][4 * rq + 1] * rms * g[1]); o.y = cvtpk(O[e][4 * rq + 2] * rms * g[2], O[e][4 * rq + 3] * rms * g[3]);
                *(LAS u32x2*)(ost + l31 * OSTPITCH + e0 * 2) = o; }
        LDS_WAIT(); __builtin_amdgcn_wave_barrier();
#pragma unroll
        for (int jj = 0; jj < 8; ++jj) { const int c = lane + 64 * jj, row = c >> 4, ch = c & 15;
            const u32x4 v = *(const LAS u32x4*)(ost + row * OSTPITCH + ch * 16);
            *(u32x4*)(ON + (trow0 + q0 + row) * 2048 + h * 128 + ch * 8) = v; }
    }
    __syncthreads();
}

__device__ __forceinline__ void phase_attn(const Params& p, LAS unsigned char* lds, int G, int bid, int tid) {
    const bf16* QKV = (const bf16*)(p.ws + WS_BIG); bf16* ON = (bf16*)p.out;
    const int lane = tid & 63;
    const float a = p.lambda_qk[lane] * p.lambda_qk[64 + lane], b = p.lambda_qk[128 + lane] * p.lambda_qk[192 + lane];
    const float lam = expf(wave_sum(a)) - expf(wave_sum(b)) + 0.2f;
    for (int c = bid; c < 256; c += G) {
        const int bh = c >> 2, quad = c & 3, b_ = bh >> 3, h = bh & 7;
        attn_unit(lds, QKV, ON, p.subln_g, lam, b_, h, 15 - 2 * quad, tid);
        attn_unit(lds, QKV, ON, p.subln_g, lam, b_, h, 2 * quad, tid);
        attn_unit(lds, QKV, ON, p.subln_g, lam, b_, h, 14 - 2 * quad, tid);
        attn_unit(lds, QKV, ON, p.subln_g, lam, b_, h, 2 * quad + 1, tid);
    }
}

__device__ __forceinline__ unsigned mono(float v) { const unsigned u = __builtin_bit_cast(unsigned, v); return (u & 0x80000000u) ? ~u : (u | 0x80000000u); }
__device__ __forceinline__ float unmono(unsigned k) { const unsigned u = (k & 0x80000000u) ? (k ^ 0x80000000u) : ~k; return __builtin_bit_cast(float, u); }
#define CE_(x, y) do { const unsigned t_ = max(x, y); y = min(x, y); x = t_; } while (0)
__device__ __forceinline__ void sort16(unsigned (&a)[16]) {
    CE_(a[0], a[1]); CE_(a[2], a[3]); CE_(a[0], a[2]); CE_(a[1], a[3]); CE_(a[1], a[2]); CE_(a[4], a[5]); CE_(a[6], a[7]); CE_(a[4], a[6]); CE_(a[5], a[7]); CE_(a[5], a[6]); CE_(a[0], a[4]); CE_(a[2], a[6]); CE_(a[2], a[4]); CE_(a[1], a[5]); CE_(a[3], a[7]); CE_(a[3], a[5]); CE_(a[1], a[2]); CE_(a[3], a[4]); CE_(a[5], a[6]); CE_(a[8], a[9]); CE_(a[10], a[11]); CE_(a[8], a[10]); CE_(a[9], a[11]); CE_(a[9], a[10]); CE_(a[12], a[13]); CE_(a[14], a[15]); CE_(a[12], a[14]); CE_(a[13], a[15]); CE_(a[13], a[14]); CE_(a[8], a[12]); CE_(a[10], a[14]); CE_(a[10], a[12]); CE_(a[9], a[13]); CE_(a[11], a[15]); CE_(a[11], a[13]); CE_(a[9], a[10]); CE_(a[11], a[12]); CE_(a[13], a[14]); CE_(a[0], a[8]); CE_(a[4], a[12]); CE_(a[4], a[8]); CE_(a[2], a[10]); CE_(a[6], a[14]); CE_(a[6], a[10]); CE_(a[2], a[4]); CE_(a[6], a[8]); CE_(a[10], a[12]); CE_(a[1], a[9]); CE_(a[5], a[13]); CE_(a[5], a[9]); CE_(a[3], a[11]); CE_(a[7], a[15]); CE_(a[7], a[11]); CE_(a[3], a[5]); CE_(a[7], a[9]); CE_(a[11], a[13]); CE_(a[1], a[2]); CE_(a[3], a[4]); CE_(a[5], a[6]); CE_(a[7], a[8]); CE_(a[9], a[10]); CE_(a[11], a[12]); CE_(a[13], a[14]);
}
__device__ __forceinline__ void merge16(unsigned (&a)[16], const unsigned (&b)[16]) {
    a[0] = max(a[0], b[15]); a[1] = max(a[1], b[14]); a[2] = max(a[2], b[13]); a[3] = max(a[3], b[12]); a[4] = max(a[4], b[11]); a[5] = max(a[5], b[10]); a[6] = max(a[6], b[9]); a[7] = max(a[7], b[8]); a[8] = max(a[8], b[7]); a[9] = max(a[9], b[6]); a[10] = max(a[10], b[5]); a[11] = max(a[11], b[4]); a[12] = max(a[12], b[3]); a[13] = max(a[13], b[2]); a[14] = max(a[14], b[1]); a[15] = max(a[15], b[0]);
    CE_(a[0], a[8]); CE_(a[1], a[9]); CE_(a[2], a[10]); CE_(a[3], a[11]); CE_(a[4], a[12]); CE_(a[5], a[13]); CE_(a[6], a[14]); CE_(a[7], a[15]); CE_(a[0], a[4]); CE_(a[1], a[5]); CE_(a[2], a[6]); CE_(a[3], a[7]); CE_(a[8], a[12]); CE_(a[9], a[13]); CE_(a[10], a[14]); CE_(a[11], a[15]); CE_(a[0], a[2]); CE_(a[1], a[3]); CE_(a[4], a[6]); CE_(a[5], a[7]); CE_(a[8], a[10]); CE_(a[9], a[11]); CE_(a[12], a[14]); CE_(a[13], a[15]); CE_(a[0], a[1]); CE_(a[2], a[3]); CE_(a[4], a[5]); CE_(a[6], a[7]); CE_(a[8], a[9]); CE_(a[10], a[11]); CE_(a[12], a[13]); CE_(a[14], a[15]);
}

__device__ __forceinline__ void convert_experts(const Params& p, size_t gtid, size_t nthr) {
    cvt_flat_fp8(p.expert_u, p.ws + WS_EU, (size_t)16384 * 1024 / 16, ESCALE, gtid, nthr);
    cvt_flat_fp8(p.expert_v, p.ws + WS_EV, (size_t)16384 * 1024 / 16, ESCALE, gtid, nthr);
}
__device__ __forceinline__ void phase_topk(const Params& p, LAS unsigned char* lds, int G, int bid, int wave, int lane) {
    const bf16* QP = (const bf16*)(p.ws + WS_BIG + B_QP); const bf16* SK = (const bf16*)(p.ws + WS_SUBK);
    int* SEL = (int*)(p.ws + WS_BIG + B_SEL); float* GATE = (float*)(p.ws + WS_BIG + B_GATE);
    const int gw = bid * NWAVES + wave, NGW = G * NWAVES, l31 = lane & 31, half = lane >> 5;
    LAS int* tab = (LAS int*)(lds + wave * 4096) + l31 * 32;
    const size_t cg_tid = (size_t)bid * 256 + (wave & 3) * 64 + lane, cg_n = (size_t)G * 256;
    if (wave < 4) cvt_flat_fp8(p.expert_u, p.ws + WS_EU, (size_t)16384 * 1024 / 16, ESCALE, cg_tid, cg_n);
    for (int task = gw; task < 512 * 8; task += NGW) {
        const int tg = task >> 3, h = task & 7, t = tg * 32 + l31;
        unsigned lists[2][16];
#pragma unroll
        for (int m = 0; m < 2; ++m) {
            f32x16 acc[4];
#pragma unroll
            for (int kb = 0; kb < 4; ++kb)
#pragma unroll
                for (int r = 0; r < 16; ++r) acc[kb][r] = 0.f;
            const bf16* qp = QP + (size_t)t * 2048 + h * 256 + m * 128 + 8 * half;
            const bf16* kp = SK + ((size_t)(h * 2 + m) * 128 + l31) * 128 + 8 * half;
#pragma unroll 1
            for (int s = 0; s < 8; ++s) { const bf16x8 bq = *(const bf16x8*)(qp + 16 * s);
#pragma unroll
                for (int kb = 0; kb < 4; ++kb) { const bf16x8 ak = *(const bf16x8*)(kp + kb * 32 * 128 + 16 * s); acc[kb] = __builtin_amdgcn_mfma_f32_32x32x16_bf16(ak, bq, acc[kb], 0, 0, 0); } }
            unsigned top[16], oth[16];
#pragma unroll
            for (int kb = 0; kb < 4; ++kb) {
#pragma unroll
                for (int r = 0; r < 16; ++r) { const int kidx = 32 * kb + (r & 3) + 8 * (r >> 2) + 4 * half; oth[r] = (mono(acc[kb][r]) & ~127u) | (unsigned)(127 - kidx); }
                sort16(oth);
                if (kb == 0) {
#pragma unroll
                    for (int i = 0; i < 16; ++i) top[i] = oth[i];
                } else merge16(top, oth);
            }
#pragma unroll
            for (int i = 0; i < 16; ++i) oth[i] = (unsigned)__shfl_xor((int)top[i], 32);
            merge16(top, oth);
#pragma unroll
            for (int i = 0; i < 16; ++i) lists[m][i] = top[i];
        }
        float va[16], vb[16];
#pragma unroll
        for (int i = 0; i < 16; ++i) { va[i] = unmono(lists[0][i] & ~127u); vb[i] = unmono(lists[1][i] & ~127u);
            tab[i] = 127 - (int)(lists[0][i] & 127u); tab[16 + i] = 127 - (int)(lists[1][i] & 127u); }
#define CKEY(i, j) ((mono(va[i] + vb[j]) & ~255u) | (unsigned)(255 - ((i) * 16 + (j))))
        unsigned ct[16], l1[16], l2[16], l3[16];
#pragma unroll
        for (int j = 0; j < 16; ++j) ct[j] = CKEY(0, j);
#pragma unroll
        for (int j = 0; j < 8; ++j) l1[j] = CKEY(1, j);
#pragma unroll
        for (int j = 0; j < 5; ++j) l1[8 + j] = CKEY(2, j);
        l1[13] = 0u; l1[14] = 0u; l1[15] = 0u;
#pragma unroll
        for (int j = 0; j < 4; ++j) l2[j] = CKEY(3, j);
#pragma unroll
        for (int j = 0; j < 3; ++j) l2[4 + j] = CKEY(4, j);
#pragma unroll
        for (int j = 0; j < 2; ++j) { l2[7 + j] = CKEY(5, j); l2[9 + j] = CKEY(6, j); l2[11 + j] = CKEY(7, j); }
        l2[13] = 0u; l2[14] = 0u; l2[15] = 0u;
#pragma unroll
        for (int i = 0; i < 8; ++i) { l3[i] = CKEY(8 + i, 0); l3[8 + i] = 0u; }
#undef CKEY
        sort16(l1); sort16(l2); sort16(l3);
        merge16(ct, l1); merge16(l2, l3); merge16(ct, l2);
        LDS_WAIT(); __builtin_amdgcn_wave_barrier();
        const float s0 = unmono(ct[0] & ~255u);
        float ev[16], es = 0.f; int ex[16];
#pragma unroll
        for (int r = 0; r < 16; ++r) { const int pos = 255 - (int)(ct[r] & 255u); ev[r] = __expf(unmono(ct[r] & ~255u) - s0); es += ev[r];
            ex[r] = tab[pos >> 4] * 128 + tab[16 + (pos & 15)]; }
        const float ie = 1.f / es;
        int* so = SEL + (size_t)t * 128 + h * 16; float* go = GATE + (size_t)t * 128 + h * 16;
        if (half == 0) {
#pragma unroll
            for (int r = 0; r < 8; ++r) { so[r] = ex[r]; go[r] = ev[r] * ie; }
        } else {
#pragma unroll
            for (int r = 8; r < 16; ++r) { so[r] = ex[r]; go[r] = ev[r] * ie; }
        }
        LDS_WAIT(); __builtin_amdgcn_wave_barrier();
    }
    if (wave >= 4) cvt_flat_fp8(p.expert_v, p.ws + WS_EV, (size_t)16384 * 1024 / 16, ESCALE, cg_tid, cg_n);
}

__device__ __forceinline__ float gelu_as(float v) {
    const float av = fabsf(v), t = __builtin_amdgcn_rcpf(av * 0.2316418882f + 1.0f);
    float q = t * 0.5307027145f + (-0.7265760135f); q = q * t + 0.7107068705f; q = q * t + (-0.142248368f); q = q * t + 0.127414796f; q = q * t;
    const float e = __builtin_amdgcn_exp2f((v * v) * (-0.72134752044f)), m = v * (q * e);
    return v < 0.f ? m : v - m;
}
constexpr int KT = 4;
constexpr int GW_LDS = 16896;
__device__ __forceinline__ void phase_gather(const Params& p, LAS unsigned char* lds, int G, int bid, int wave, int lane) {
    const int* SEL = (const int*)(p.ws + WS_BIG + B_SEL); const float* GATE = (const float*)(p.ws + WS_BIG + B_GATE);
    const unsigned char* EU = p.ws + WS_EU; const unsigned char* EV = p.ws + WS_EV;
    float* H2 = p.out;
    const int gw = bid * NWAVES + wave, NGW = G * NWAVES, l15 = lane & 15, g4 = lane >> 4;
    LAS unsigned char* wl = lds + wave * GW_LDS;
    LAS unsigned char* xnb = wl; LAS int* selb = (LAS int*)(wl + 8192); LAS float* gateb = (LAS float*)(wl + 12288); LAS float* hb = (LAS float*)(wl + 16384);
    for (int tb = gw * KT; tb < T; tb += NGW * KT) {
#pragma unroll 1
        for (int k = 0; k < KT; ++k) {
            const int t = tb + k;
            const float* hrow = H2 + (size_t)t * DM + 16 * lane;
            f32x4 hv[4];
#pragma unroll
            for (int j = 0; j < 4; ++j) hv[j] = *(const f32x4*)(hrow + 4 * j);
            const int selA = SEL[(size_t)t * 128 + lane], selB = SEL[(size_t)t * 128 + 64 + lane];
            const float gtA = GATE[(size_t)t * 128 + lane], gtB = GATE[(size_t)t * 128 + 64 + lane];
            float ssq = 0.f;
#pragma unroll
            for (int j = 0; j < 4; ++j) ssq += (hv[j][0] * hv[j][0] + hv[j][1] * hv[j][1]) + (hv[j][2] * hv[j][2] + hv[j][3] * hv[j][3]);
            const float r2 = rsqrtf(wave_sum(ssq) * (1.f / DM) + EPS);
            { u32x4 o;
#pragma unroll
              for (int j = 0; j < 4; ++j) { const f32x4 a = hv[j] * r2 * *(const f32x4*)(p.norm2_g + 16 * lane + 4 * j); int w = 0;
                  w = __builtin_amdgcn_cvt_pk_fp8_f32(a[0], a[1], w, false); w = __builtin_amdgcn_cvt_pk_fp8_f32(a[2], a[3], w, true); o[j] = (unsigned)w; }
              *(LAS u32x4*)(xnb + k * 1024 + 16 * lane) = o; }
            const int bA = selA >> 10, bB = selB >> 10; int posA = 0, posB = 0, off = 0;
#pragma unroll
            for (int b = 0; b < 16; ++b) {
                const unsigned long long mA = __ballot(bA == b), mB = __ballot(bB == b);
                const int cA = __popcll(mA), cB = __popcll(mB);
                const int rA = (int)__builtin_amdgcn_mbcnt_hi((unsigned)(mA >> 32), __builtin_amdgcn_mbcnt_lo((unsigned)mA, 0u));
                const int rB = (int)__builtin_amdgcn_mbcnt_hi((unsigned)(mB >> 32), __builtin_amdgcn_mbcnt_lo((unsigned)mB, 0u));
                if (bA == b) posA = off + rA;
                if (bB == b) posB = off + cA + rB;
                off += cA + cB;
            }
            selb[k * 128 + posA] = selA; gateb[k * 128 + posA] = gtA; selb[k * 128 + posB] = selB; gateb[k * 128 + posB] = gtB;
        }
        LDS_WAIT(); __builtin_amdgcn_wave_barrier();
        f32x2_t y[KT][8];
#pragma unroll
        for (int k = 0; k < KT; ++k)
#pragma unroll
            for (int i = 0; i < 8; ++i) y[k][i] = (f32x2_t){0.f, 0.f};
#pragma unroll 1
        for (int g = 0; g < 8; ++g) {
#pragma unroll
            for (int k = 0; k < KT; ++k) {
                asm volatile("" ::: "memory");
                f32x4 acc = (f32x4){0.f, 0.f, 0.f, 0.f};
                const int e = selb[k * 128 + 16 * g + l15];
                const unsigned char* up = EU + (size_t)e * DM + 16 * g4;
                const LAS unsigned char* xk = xnb + k * 1024 + 16 * g4;
#pragma unroll
                for (int s2 = 0; s2 < 16; ++s2) { const u32x4 a = *(const u32x4*)(up + 64 * s2); const u32x4 bx = *(const LAS u32x4*)(xk + 64 * s2);
                    const long a0 = (long)(((unsigned long long)a.y << 32) | a.x), a1 = (long)(((unsigned long long)a.w << 32) | a.z);
                    const long b0 = (long)(((unsigned long long)bx.y << 32) | bx.x), b1 = (long)(((unsigned long long)bx.w << 32) | bx.z);
                    acc = __builtin_amdgcn_mfma_f32_16x16x32_fp8_fp8(a0, b0, acc, 0, 0, 0);
                    acc = __builtin_amdgcn_mfma_f32_16x16x32_fp8_fp8(a1, b1, acc, 0, 0, 0); }
                if (l15 == 0) {
#pragma unroll
                    for (int j = 0; j < 4; ++j) { const float a = acc[j] * (1.f / ESCALE);
                        hb[k * 16 + 4 * g4 + j] = gelu_as(a) * gateb[k * 128 + 16 * g + 4 * g4 + j] * (1.f / ESCALE); }
                }
            }
            LDS_WAIT(); __builtin_amdgcn_wave_barrier();
#pragma unroll
            for (int k = 0; k < KT; ++k) {
                asm volatile("" ::: "memory");
                u32x4 vr[2][4];
#pragma unroll
                for (int i = 0; i < 4; ++i) vr[0][i] = *(const u32x4*)(EV + (size_t)selb[k * 128 + 16 * g + i] * DM + 16 * lane);
#pragma unroll
                for (int bt = 0; bt < 4; ++bt) {
                    if (bt < 3) {
#pragma unroll
                        for (int i = 0; i < 4; ++i) vr[(bt + 1) & 1][i] = *(const u32x4*)(EV + (size_t)selb[k * 128 + 16 * g + 4 * (bt + 1) + i] * DM + 16 * lane);
                    }
                    asm volatile("" ::: "memory");
#pragma unroll
                    for (int i = 0; i < 4; ++i) { const float hs = hb[k * 16 + 4 * bt + i]; const u32x4 v = vr[bt & 1][i];
#pragma unroll
                        for (int q = 0; q < 4; ++q) { const f32x2_t lo = __builtin_amdgcn_cvt_pk_f32_fp8((int)v[q], false), hi = __builtin_amdgcn_cvt_pk_f32_fp8((int)v[q], true);
                            y[k][2 * q] += lo * hs; y[k][2 * q + 1] += hi * hs; } }
                }
            }
            LDS_WAIT(); __builtin_amdgcn_wave_barrier();
        }
#pragma unroll
        for (int k = 0; k < KT; ++k) {
            float* hrow = H2 + (size_t)(tb + k) * DM + 16 * lane;
            f32x4 h3[4]; float s3 = 0.f;
#pragma unroll
            for (int j = 0; j < 4; ++j) { const f32x4 hv = *(const f32x4*)(hrow + 4 * j);
                h3[j][0] = hv[0] + y[k][2 * j][0]; h3[j][1] = hv[1] + y[k][2 * j][1]; h3[j][2] = hv[2] + y[k][2 * j + 1][0]; h3[j][3] = hv[3] + y[k][2 * j + 1][1];
                s3 += (h3[j][0] * h3[j][0] + h3[j][1] * h3[j][1]) + (h3[j][2] * h3[j][2] + h3[j][3] * h3[j][3]); }
            const float r3 = rsqrtf(wave_sum(s3) * (1.f / DM) + EPS);
#pragma unroll
            for (int j = 0; j < 4; ++j) *(f32x4*)(hrow + 4 * j) = h3[j] * r3 * *(const f32x4*)(p.final_g + 16 * lane + 4 * j);
        }
        LDS_WAIT(); __builtin_amdgcn_wave_barrier();
    }
}

#define XB_TMO      128
#define XB_XCNT(j)  (256  + 64 * (j))
#define XB_XSUB(j)  (1280 + 64 * (j))
#define XB_XGEN(j)  (2304 + 64 * (j))
#define XB_TOP      3328
#define XB_TOPGEN   3392
#define XCD_BAR_WORDS 3456
#define XB_SPIN_CAP (1u << 18)

__device__ __forceinline__ unsigned xb_ld(unsigned* p)              { return __hip_atomic_load(p, __ATOMIC_RELAXED, __HIP_MEMORY_SCOPE_AGENT); }
__device__ __forceinline__ unsigned xb_add(unsigned* p, unsigned v) { return __hip_atomic_fetch_add(p, v, __ATOMIC_RELAXED, __HIP_MEMORY_SCOPE_AGENT); }
__device__ __forceinline__ unsigned xb_xcc_id() { return (unsigned)__builtin_amdgcn_s_getreg((3 << 11) | 20) & 0xFu; }
#define XB_SPIN(cond, bar) do { unsigned _sp = 0; while (cond) { __builtin_amdgcn_s_sleep(1); \
    if ((++_sp & 255u) == 0u) { if (xb_ld(&(bar)[XB_TMO])) break; if (_sp > XB_SPIN_CAP) { atomicAdd(&(bar)[XB_TMO], 1u); break; } } } } while (0)

struct XcdBarrier {
    unsigned* bar; unsigned x;
    volatile LAS unsigned* st;
};

__device__ __forceinline__ XcdBarrier xcd_barrier_post(unsigned* bar, volatile LAS unsigned* st) {
    XcdBarrier b; b.bar = bar; b.x = xb_xcc_id(); b.st = st;
    if (threadIdx.x == 0) (void)xb_add(&bar[XB_XCNT(b.x)], 1u);
    return b;
}
__device__ __forceinline__ void xcd_barrier_complete(unsigned* bar, unsigned x, unsigned& nloc, unsigned& nx) {
    const unsigned G = gridDim.x * gridDim.y * gridDim.z;
    unsigned sum, cnt, mine, sp = 0u;
    for (;;) {
        sum = 0u; cnt = 0u; mine = 0u;
#pragma unroll
        for (unsigned j = 0; j < 16; ++j) { const unsigned c = xb_ld(&bar[XB_XCNT(j)]); sum += c; cnt += (c > 0u) ? 1u : 0u; mine = (j == x) ? c : mine; }
        if (sum == G) break;
        __builtin_amdgcn_s_sleep(1);
        if ((++sp & 255u) == 0u) { if (xb_ld(&bar[XB_TMO])) break; if (sp > XB_SPIN_CAP) { atomicAdd(&bar[XB_TMO], 1u); break; } }
    }
    nloc = mine > 0u ? mine : 1u; nx = cnt > 0u ? cnt : 1u;
}

__device__ __forceinline__ void xcd_barrier(const XcdBarrier& b) {
    asm volatile("s_waitcnt vmcnt(0)" ::: "memory");
    __syncthreads();
    if (threadIdx.x == 0) {
        unsigned* bar = b.bar;
        __builtin_amdgcn_s_waitcnt(0);
        unsigned nloc = b.st[0], nx = b.st[1];
        if (nloc == 0u) { xcd_barrier_complete(bar, b.x, nloc, nx); b.st[0] = nloc; b.st[1] = nx; }
        const unsigned old = xb_add(&bar[XB_XSUB(b.x)], 1u);
        const unsigned gen = old / nloc;
        if (old + 1u == (gen + 1u) * nloc) {
            __builtin_amdgcn_fence(__ATOMIC_RELEASE, "agent");
            asm volatile("s_waitcnt vmcnt(0)" ::: "memory");
            const unsigned og = xb_add(&bar[XB_TOP], 1u);
            const unsigned tg = og / nx;
            if (og + 1u == (tg + 1u) * nx) xb_add(&bar[XB_TOPGEN], 1u);
            else XB_SPIN(xb_ld(&bar[XB_TOPGEN]) == tg, bar);
            __builtin_amdgcn_fence(__ATOMIC_ACQUIRE, "agent");
            xb_add(&bar[XB_XGEN(b.x)], 1u);
            asm volatile("s_waitcnt vmcnt(0)" ::: "memory");
        } else {
            XB_SPIN(xb_ld(&bar[XB_XGEN(b.x)]) == gen, bar);
            __builtin_amdgcn_fence(__ATOMIC_ACQUIRE, "agent");
            asm volatile("s_waitcnt vmcnt(0)" ::: "memory");
        }
    }
    __syncthreads();
}

#ifndef ONE_LAUNCH
#define ONE_LAUNCH 1
#endif
constexpr int NPHASE = 8;
__global__ void __launch_bounds__(NTHR, 2) hybrid_fwd(Params p) {
    extern __shared__ __attribute__((aligned(16))) unsigned char lds_raw[];
    LAS unsigned char* lds = (LAS unsigned char*)lds_raw;
    const int tid = threadIdx.x, lane = tid & 63, wave = __builtin_amdgcn_readfirstlane(tid >> 6), G = gridDim.x, bid = blockIdx.x;
    unsigned char* ws = p.ws;
    volatile LAS unsigned* xst = (volatile LAS unsigned*)(lds + 139264);
    if (tid < 2) xst[tid] = 0u;
    __syncthreads();
    XcdBarrier xbar; xbar.bar = (unsigned*)(ws + WS_END); xbar.x = 0; xbar.st = xst;
    if (ONE_LAUNCH && p.hi - p.lo > 1) { xbar = xcd_barrier_post((unsigned*)(ws + WS_END), xst); cg::this_grid().sync(); }
    const pg8::bf16_t* N1 = (const pg8::bf16_t*)p.out;
#ifdef ONLY
#define PH(k) if ((k) == ONLY && p.lo <= (k) && (k) < p.hi)
#else
#define PH(k) if (p.lo <= (k) && (k) < p.hi)
#endif
#define SEAM(k) do { if (ONE_LAUNCH && p.lo <= (k) && (k) + 1 < p.hi) { xcd_barrier(xbar); } } while (0)
#define FRESH_IDS int tid = threadIdx.x; asm volatile("" : "+v"(tid)); const int lane = tid & 63, wave = __builtin_amdgcn_readfirstlane(tid >> 6); (void)lane; (void)wave
    unsigned char* big = ws + WS_BIG;
    PH(0) { FRESH_IDS; phase0(p, lds, G, bid, wave, lane); SEAM(0); }
    PH(1) { FRESH_IDS; pg8::Gemm g{N1, (const pg8::bf16_t*)(ws + WS_WIN), T, 8192, 1024, 2048, 1024}; pg8::StaticOrder S; S.init(T, 8192, G, bid);
        pg8::EpiG1 E{(pg8::bf16_t*)(big + B_QKV), (pg8::bf16_t*)(big + B_GG), (pg8::bf16_t*)p.out + 1024, (pg8::bf16_t*)(big + B_PR), C2};
        pg8::gemm_phase<pg8::EpiG1, pg8::StaticOrder, true, true>(lds, g, S, E); SEAM(1); }
    PH(2) { FRESH_IDS; phase_attn(p, lds, G, bid, tid); phase_conv(p, G, bid, tid); SEAM(2); }
    PH(3) { FRESH_IDS; pg8::Gemm g{(const pg8::bf16_t*)p.out, (const pg8::bf16_t*)(ws + WS_WAC), T, 1024, 1024, 2048, 2048}; pg8::SplitKOrder S; S.base.init(T, 1024, G, bid);
        pg8::EpiMerged E{(const pg8::bf16_t*)(big + B_GG), (pg8::bf16_t*)(big + B_MG)};
        pg8::gemm_phase<pg8::EpiMerged, pg8::SplitKOrder, false, true>(lds, g, S, E); SEAM(3); }
    PH(4) { FRESH_IDS; pg8::Gemm g{(const pg8::bf16_t*)(big + B_MG), (const pg8::bf16_t*)(ws + WS_WOUT), T, 1024, 1024, 1024, 1024}; pg8::StaticOrder S; S.init(T, 1024, G, bid);
        pg8::EpiResid E{p.x, p.out, (pg8::bf16_t*)(big + B_H2B), (float*)(ws + WS_SSQ)};
        pg8::gemm_phase<pg8::EpiResid, pg8::StaticOrder, false, true>(lds, g, S, E); SEAM(4); }
    PH(5) { FRESH_IDS; pg8::Gemm g{(const pg8::bf16_t*)(big + B_H2B), (const pg8::bf16_t*)(ws + WS_WQ), T, 2048, 1024, 1024, 1024}; pg8::StaticOrder S; S.init(T, 2048, G, bid);
        pg8::EpiRowScale E{(const float*)(ws + WS_SSQ), (pg8::bf16_t*)(big + B_QP)};
        pg8::gemm_phase<pg8::EpiRowScale, pg8::StaticOrder, true, true>(lds, g, S, E); SEAM(5); }
    PH(6) { FRESH_IDS; phase_topk(p, lds, G, bid, wave, lane); SEAM(6); }
    PH(7) { FRESH_IDS; phase_gather(p, lds, G, bid, wave, lane); }
#undef PH
#undef SEAM
}

extern "C" void kernel_launch(void* const* d_in, const int* in_sizes, int n_in, void* d_out, int out_size, void* d_ws, size_t ws_size, hipStream_t stream) {
    static int grid = 0;
    if (grid == 0) {
        if (n_in != 15 || out_size != T * DM || ws_size < WS_END) { fprintf(stderr, "kernel_launch: unexpected problem (n_in %d out %d ws %zu)\n", n_in, out_size, ws_size); grid = -1; return; }
        int dev = 0, cus = 0, per_cu = 0;
        hipGetDevice(&dev); hipDeviceGetAttribute(&cus, hipDeviceAttributeMultiprocessorCount, dev);
        if (hipFuncSetAttribute((const void*)hybrid_fwd, hipFuncAttributeMaxDynamicSharedMemorySize, LDS_BYTES) != hipSuccess) { fprintf(stderr, "kernel_launch: hipFuncSetAttribute failed\n"); grid = -1; return; }
        if (hipOccupancyMaxActiveBlocksPerMultiprocessor(&per_cu, (const void*)hybrid_fwd, NTHR, LDS_BYTES) != hipSuccess || per_cu < 1) { fprintf(stderr, "kernel_launch: occupancy query says %d\n", per_cu); per_cu = 1; }
        (void)hipGetLastError();
        grid = cus * per_cu;
    }
    if (grid < 0) return;
    Params p{};
    p.x = (const float*)d_in[0]; p.norm1_g = (const float*)d_in[1]; p.w_in = (const float*)d_in[2]; p.lambda_qk = (const float*)d_in[3]; p.subln_g = (const float*)d_in[4];
    p.conv_w = (const float*)d_in[5]; p.w_attn_o = (const float*)d_in[6]; p.w_conv_o = (const float*)d_in[7]; p.w_out = (const float*)d_in[8]; p.norm2_g = (const float*)d_in[9];
    p.w_query = (const float*)d_in[10]; p.sub_keys = (const float*)d_in[11]; p.expert_u = (const float*)d_in[12]; p.expert_v = (const float*)d_in[13]; p.final_g = (const float*)d_in[14];
    p.out = (float*)d_out; p.ws = (unsigned char*)d_ws;
#if ONE_LAUNCH
    p.lo = 0; p.hi = NPHASE;
    (void)hipMemsetAsync((char*)d_ws + WS_END, 0, 16384, stream);
    void* args[] = {&p};
    hipError_t e = hipLaunchCooperativeKernel((const void*)hybrid_fwd, dim3(grid), dim3(NTHR), args, LDS_BYTES, stream);
    if (e != hipSuccess) fprintf(stderr, "cooperative launch failed: %s (grid %d)\n", hipGetErrorString(e), grid);
#else
    for (int k = 0; k < NPHASE; ++k) {
        p.lo = k; p.hi = k + 1; hipLaunchKernelGGL(hybrid_fwd, dim3(grid), dim3(NTHR), LDS_BYTES, stream, p); }
#endif
}
```

```cpp
#include <hip/hip_runtime.h>
#include <hip/hip_cooperative_groups.h>
#include <cstdio>
#include <cstdint>
namespace cg = cooperative_groups;
namespace pg8 {
#define PG8_LAS __attribute__((address_space(3)))
typedef unsigned short bf16_t;
typedef short bf16x8 __attribute__((ext_vector_type(8)));
typedef float f32x4 __attribute__((ext_vector_type(4)));
typedef unsigned u32x4 __attribute__((ext_vector_type(4)));
constexpr int BM = 256, BK = 64, HALF = 128, HTB = HALF * BK * 2  , STAGE_BYTES = 8 * HTB, NXCD = 8, WGM = 8;

__host__ __device__ __forceinline__ int lds_byte(int r, int c) { const int st = (r >> 4) * 2 + (c >> 5), rr = r & 15, cc = c & 31, ob = rr * 64 + cc * 2; return st * 1024 + (ob ^ (((ob >> 9) & 1) << 5)); }
__host__ __device__ __forceinline__ void stage_rc(int b, int& R, int& C) { const int st = b / 1024, sb = b % 1024, swz = sb ^ (((sb >> 9) & 1) << 5); R = (st >> 1) * 16 + swz / 64; C = (st & 1) * 32 + (swz % 64) / 2; }
__host__ __device__ __forceinline__ int perm32(int rho) { const int n = rho >> 4, i = rho & 15; return 8 * (i >> 2) + 4 * n + (i & 3); }

struct Unit { int pm, pn, kh; };
struct Gemm { const bf16_t* A; const bf16_t* Bt; int M, N, K, lda, ldb; };
struct StaticOrder {
    int nM, nN, nwg, G, c;
    __host__ __device__ void init(int M, int N, int G_, int c_) { nM = M / BM; nN = N / BM; nwg = nM * nN; G = G_; c = c_; }
    __host__ __device__ bool next(int i, Unit& u) const {
        const long L = (long)i * G + c; if (L >= nwg) return false;
        int wgid = (int)L; { const int q = nwg / NXCD, r = nwg % NXCD, xcd = wgid % NXCD, off = wgid / NXCD; wgid = (xcd < r ? xcd * (q + 1) : r * (q + 1) + (xcd - r) * q) + off; }
        const int nig = WGM * nN, gid = wgid / nig, fm = gid * WGM, gsz = (nM - fm) < WGM ? (nM - fm) : WGM;
        u.pm = fm + ((wgid % nig) % gsz); u.pn = (wgid % nig) / gsz; u.kh = 0; return true;
    }
    __device__ __forceinline__ void a_ready(const Unit&) const {}
    __device__ __forceinline__ void done(const Unit&) const {}
};
struct SplitKOrder {
    StaticOrder base;
    __host__ __device__ bool next(int i, Unit& u) const { if (!base.next(i >> 1, u)) return false; u.kh = i & 1; return true; }
    __device__ __forceinline__ void a_ready(const Unit&) const {}
    __device__ __forceinline__ void done(const Unit&) const {}
};
__device__ __forceinline__ unsigned cvt_pk_bf16(float lo, float hi) { unsigned r; asm volatile("v_cvt_pk_bf16_f32 %0, %1, %2" : "=v"(r) : "v"(lo), "v"(hi)); return r; }
typedef float f32x2 __attribute__((ext_vector_type(2)));
typedef float f32x2 __attribute__((ext_vector_type(2)));
typedef unsigned u32x2 __attribute__((ext_vector_type(2)));
__device__ __forceinline__ void unpack8(const u32x4 w, float (&f)[8]) {
    f[0] = __builtin_bit_cast(float, w.x << 16); f[1] = __builtin_bit_cast(float, w.x & 0xffff0000u);
    f[2] = __builtin_bit_cast(float, w.y << 16); f[3] = __builtin_bit_cast(float, w.y & 0xffff0000u);
    f[4] = __builtin_bit_cast(float, w.z << 16); f[5] = __builtin_bit_cast(float, w.z & 0xffff0000u);
    f[6] = __builtin_bit_cast(float, w.w << 16); f[7] = __builtin_bit_cast(float, w.w & 0xffff0000u);
}
__device__ __forceinline__ u32x4 pack8(const f32x4 v0, const f32x4 v1) { u32x4 w; w.x = cvt_pk_bf16(v0[0], v0[1]); w.y = cvt_pk_bf16(v0[2], v0[3]); w.z = cvt_pk_bf16(v1[0], v1[1]); w.w = cvt_pk_bf16(v1[2], v1[3]); return w; }
struct EpiPlain {
    static constexpr bool PERM = true, AFTER_DRAIN = false, MID = false;
    bf16_t* O; int ldc;
    __device__ __forceinline__ void operator()(const f32x4 (&acc)[2][2][4][2], const Unit& u, int wr, int wc, int fr, int fq) const {
        const int row0 = u.pm * BM + wr * 64 + fr, col0 = u.pn * BM + wc * 32 + 8 * fq;
#pragma unroll
        for (int ai = 0; ai < 2; ++ai)
#pragma unroll
            for (int m = 0; m < 4; ++m) { bf16_t* rowp = O + (size_t)(row0 + ai * HALF + m * 16) * ldc + col0;
#pragma unroll
                for (int bj = 0; bj < 2; ++bj) *(u32x4*)(rowp + bj * HALF) = pack8(acc[ai][bj][m][0], acc[ai][bj][m][1]); }
    }
};
struct EpiQKVG {
    static constexpr bool PERM = true, AFTER_DRAIN = false, MID = false;
    bf16_t* QKV; bf16_t* GG; float c2;
    __device__ __forceinline__ void operator()(const f32x4 (&acc)[2][2][4][2], const Unit& u, int wr, int wc, int fr, int fq) const {
        int colt = u.pn * BM; bf16_t* base = QKV; int ldc = 3072; float sc = 1.f; bool sig = false;
        if (colt < 1024) sc = c2; else if (colt >= 3072) { base = GG; ldc = 2048; colt -= 3072; sig = true; }
        const int row0 = u.pm * BM + wr * 64 + fr, col0 = colt + wc * 32 + 8 * fq;
#pragma unroll
        for (int ai = 0; ai < 2; ++ai)
#pragma unroll
            for (int m = 0; m < 4; ++m) { bf16_t* rowp = base + (size_t)(row0 + ai * HALF + m * 16) * ldc + col0;
#pragma unroll
                for (int bj = 0; bj < 2; ++bj) { f32x4 v0 = acc[ai][bj][m][0], v1 = acc[ai][bj][m][1];
                    if (sig) {
#pragma unroll
                        for (int i = 0; i < 4; ++i) { v0[i] = __builtin_amdgcn_rcpf(1.f + __expf(-v0[i])); v1[i] = __builtin_amdgcn_rcpf(1.f + __expf(-v1[i])); }
                    } else { v0 = v0 * sc; v1 = v1 * sc; }
                    *(u32x4*)(rowp + bj * HALF) = pack8(v0, v1); } }
    }
};
struct EpiGateA {
    static constexpr bool PERM = true, AFTER_DRAIN = false, MID = false;
    const bf16_t* GG; float* TMP;
    __device__ __forceinline__ void operator()(const f32x4 (&acc)[2][2][4][2], const Unit& u, int wr, int wc, int fr, int fq) const {
        const int row0 = u.pm * BM + wr * 64 + fr, col0 = u.pn * BM + wc * 32 + 8 * fq;
#pragma unroll
        for (int ai = 0; ai < 2; ++ai)
#pragma unroll
            for (int m = 0; m < 4; ++m) { const size_t row = (size_t)(row0 + ai * HALF + m * 16);
#pragma unroll
                for (int bj = 0; bj < 2; ++bj) { const int col = col0 + bj * HALF; float g[8]; unpack8(*(const u32x4*)(GG + row * 2048 + col), g);
                    f32x4 v0 = acc[ai][bj][m][0], v1 = acc[ai][bj][m][1];
                    v0[0] *= g[0]; v0[1] *= g[1]; v0[2] *= g[2]; v0[3] *= g[3]; v1[0] *= g[4]; v1[1] *= g[5]; v1[2] *= g[6]; v1[3] *= g[7];
                    *(f32x4*)(TMP + row * 1024 + col) = v0; *(f32x4*)(TMP + row * 1024 + col + 4) = v1; } }
    }
};
struct EpiGateC {
    static constexpr bool PERM = true, AFTER_DRAIN = false, MID = false;
    const bf16_t* GG; const float* TMP; bf16_t* MG;
    __device__ __forceinline__ void operator()(const f32x4 (&acc)[2][2][4][2], const Unit& u, int wr, int wc, int fr, int fq) const {
        const int row0 = u.pm * BM + wr * 64 + fr, col0 = u.pn * BM + wc * 32 + 8 * fq;
#pragma unroll
        for (int ai = 0; ai < 2; ++ai)
#pragma unroll
            for (int m = 0; m < 4; ++m) { const size_t row = (size_t)(row0 + ai * HALF + m * 16);
#pragma unroll
                for (int bj = 0; bj < 2; ++bj) { const int col = col0 + bj * HALF; float g[8]; unpack8(*(const u32x4*)(GG + row * 2048 + 1024 + col), g);
                    const f32x4 t0 = *(const f32x4*)(TMP + row * 1024 + col), t1 = *(const f32x4*)(TMP + row * 1024 + col + 4);
                    f32x4 v0 = acc[ai][bj][m][0], v1 = acc[ai][bj][m][1];
                    v0[0] = t0[0] + v0[0] * g[0]; v0[1] = t0[1] + v0[1] * g[1]; v0[2] = t0[2] + v0[2] * g[2]; v0[3] = t0[3] + v0[3] * g[3];
                    v1[0] = t1[0] + v1[0] * g[4]; v1[1] = t1[1] + v1[1] * g[5]; v1[2] = t1[2] + v1[2] * g[6]; v1[3] = t1[3] + v1[3] * g[7];
                    *(u32x4*)(MG + row * 1024 + col) = pack8(v0, v1); } }
    }
};
struct EpiG1 {
    static constexpr bool PERM = true, AFTER_DRAIN = false, MID = false;
    bf16_t* QKV; bf16_t* GG; bf16_t* CB; bf16_t* PR; float c2;
    __device__ __forceinline__ void operator()(const f32x4 (&acc)[2][2][4][2], const Unit& u, int wr, int wc, int fr, int fq) const {
        int colt = u.pn * BM; const int row0 = u.pm * BM + wr * 64 + fr;
        if (colt >= 6144) {
            const int ch0 = (colt - 6144) / 2 + wc * 16 + 4 * fq;
#pragma unroll
            for (int ai = 0; ai < 2; ++ai)
#pragma unroll
                for (int m = 0; m < 4; ++m) { bf16_t* rowp = PR + (size_t)(row0 + ai * HALF + m * 16) * 1024 + ch0;
#pragma unroll
                    for (int bj = 0; bj < 2; ++bj) { const f32x4 v0 = acc[ai][bj][m][0], v1 = acc[ai][bj][m][1];
                        u32x2 w; w.x = cvt_pk_bf16(v0[0] * v0[1], v0[2] * v0[3]); w.y = cvt_pk_bf16(v1[0] * v1[1], v1[2] * v1[3]);
                        *(u32x2*)(rowp + bj * (HALF / 2)) = w; } }
            return;
        }
        bf16_t* base = QKV; int ldc = 3072; float sc = 1.f; bool sig = false;
        if (colt < 1024) sc = c2; else if (colt >= 5120) { base = CB; ldc = 2048; colt -= 5120; } else if (colt >= 3072) { base = GG; ldc = 2048; colt -= 3072; sig = true; }
        const int col0 = colt + wc * 32 + 8 * fq;
#pragma unroll
        for (int ai = 0; ai < 2; ++ai)
#pragma unroll
            for (int m = 0; m < 4; ++m) { bf16_t* rowp = base + (size_t)(row0 + ai * HALF + m * 16) * ldc + col0;
#pragma unroll
                for (int bj = 0; bj < 2; ++bj) { f32x4 v0 = acc[ai][bj][m][0], v1 = acc[ai][bj][m][1];
                    if (sig) {
#pragma unroll
                        for (int i = 0; i < 4; ++i) { v0[i] = __builtin_amdgcn_rcpf(1.f + __expf(-v0[i])); v1[i] = __builtin_amdgcn_rcpf(1.f + __expf(-v1[i])); }
                    } else { v0 = v0 * sc; v1 = v1 * sc; }
                    *(u32x4*)(rowp + bj * HALF) = pack8(v0, v1); } }
    }
};
struct EpiMerged {
    static constexpr bool PERM = true, AFTER_DRAIN = false, MID = true;
    const bf16_t* GG; bf16_t* MG;
    __device__ __forceinline__ void mid(f32x4 (&acc)[2][2][4][2], const Unit& u, int wr, int wc, int fr, int fq) const {
        const int row0 = u.pm * BM + wr * 64 + fr, col0 = u.pn * BM + wc * 32 + 8 * fq;
#pragma unroll
        for (int ai = 0; ai < 2; ++ai)
#pragma unroll
            for (int m = 0; m < 4; ++m) { const size_t row = (size_t)(row0 + ai * HALF + m * 16);
#pragma unroll
                for (int bj = 0; bj < 2; ++bj) { const int col = col0 + bj * HALF; float ga[8], gc[8];
                    unpack8(*(const u32x4*)(GG + row * 2048 + col), ga); unpack8(*(const u32x4*)(GG + row * 2048 + 1024 + col), gc);
#pragma unroll
                    for (int i = 0; i < 4; ++i) { acc[ai][bj][m][0][i] *= ga[i] * __builtin_amdgcn_rcpf(gc[i]); acc[ai][bj][m][1][i] *= ga[4 + i] * __builtin_amdgcn_rcpf(gc[4 + i]); }
                    asm volatile("" ::: "memory"); } }
    }
    __device__ __forceinline__ void operator()(const f32x4 (&acc)[2][2][4][2], const Unit& u, int wr, int wc, int fr, int fq) const {
        const int row0 = u.pm * BM + wr * 64 + fr, col0 = u.pn * BM + wc * 32 + 8 * fq;
#pragma unroll
        for (int ai = 0; ai < 2; ++ai)
#pragma unroll
            for (int m = 0; m < 4; ++m) { const size_t row = (size_t)(row0 + ai * HALF + m * 16);
#pragma unroll
                for (int bj = 0; bj < 2; ++bj) { const int col = col0 + bj * HALF; float gc[8]; unpack8(*(const u32x4*)(GG + row * 2048 + 1024 + col), gc);
                    f32x4 v0 = acc[ai][bj][m][0], v1 = acc[ai][bj][m][1];
#pragma unroll
                    for (int i = 0; i < 4; ++i) { v0[i] *= gc[i]; v1[i] *= gc[4 + i]; }
                    *(u32x4*)(MG + row * 1024 + col) = pack8(v0, v1); } }
    }
};
struct EpiResid {
    static constexpr bool PERM = true, AFTER_DRAIN = false, MID = false;
    const float* X; float* H2; bf16_t* H2B; float* SSQ;
    __device__ __forceinline__ void operator()(const f32x4 (&acc)[2][2][4][2], const Unit& u, int wr, int wc, int fr, int fq) const {
        const int row0 = u.pm * BM + wr * 64 + fr, col0 = u.pn * BM + wc * 32 + 8 * fq;
#pragma unroll
        for (int ai = 0; ai < 2; ++ai)
#pragma unroll
            for (int m = 0; m < 4; ++m) { const size_t row = (size_t)(row0 + ai * HALF + m * 16); float s = 0.f;
#pragma unroll
                for (int bj = 0; bj < 2; ++bj) { const size_t o = row * 1024 + col0 + bj * HALF;
                    const f32x4 v0 = acc[ai][bj][m][0] + *(const f32x4*)(X + o), v1 = acc[ai][bj][m][1] + *(const f32x4*)(X + o + 4);
                    *(f32x4*)(H2 + o) = v0; *(f32x4*)(H2 + o + 4) = v1; *(u32x4*)(H2B + o) = pack8(v0, v1);
                    s += (v0[0] * v0[0] + v0[1] * v0[1]) + (v0[2] * v0[2] + v0[3] * v0[3]) + (v1[0] * v1[0] + v1[1] * v1[1]) + (v1[2] * v1[2] + v1[3] * v1[3]); }
                s += __shfl_xor(s, 16); s += __shfl_xor(s, 32);
                if (fq == 0) SSQ[row * 16 + u.pn * 4 + wc] = s; }
    }
};
struct EpiRowScale {
    static constexpr bool PERM = true, AFTER_DRAIN = false, MID = false;
    const float* SSQ; bf16_t* O;
    __device__ __forceinline__ void operator()(const f32x4 (&acc)[2][2][4][2], const Unit& u, int wr, int wc, int fr, int fq) const {
        const int row0 = u.pm * BM + wr * 64 + fr, col0 = u.pn * BM + wc * 32 + 8 * fq;
#pragma unroll
        for (int ai = 0; ai < 2; ++ai)
#pragma unroll
            for (int m = 0; m < 4; ++m) { const size_t row = (size_t)(row0 + ai * HALF + m * 16);
                const f32x4* sp = (const f32x4*)(SSQ + row * 16); const f32x4 a = sp[0] + sp[1], b = sp[2] + sp[3], c = a + b;
                const float rs = rsqrtf(((c[0] + c[1]) + (c[2] + c[3])) * (1.f / 1024.f) + 1e-6f);
#pragma unroll
                for (int bj = 0; bj < 2; ++bj) *(u32x4*)(O + row * 2048 + col0 + bj * HALF) = pack8(acc[ai][bj][m][0] * rs, acc[ai][bj][m][1] * rs); }
    }
};
template <class Epi, class Sched, bool ALIGN_EPI = false, bool SP2 = false>
__device__ __forceinline__ void gemm_phase(PG8_LAS unsigned char* lds, const Gemm g, const Sched& S, const Epi& E) {
    const int tid = threadIdx.x, wid = __builtin_amdgcn_readfirstlane(tid >> 6), lane = tid & 63, wr = wid >> 2, wc = wid & 3, fr = lane & 15, fq = lane >> 4;
    const int K = g.K, nt = K / BK;
    unsigned voffA[2], voffB[2];
#pragma unroll
    for (int i = 0; i < 2; ++i) { int R, C; stage_rc(tid * 16 + i * 8192, R, C); const int Rb = Epi::PERM ? ((R & ~31) + perm32(R & 31)) : R;
        voffA[i] = (unsigned)(R * g.lda + C) * 2u; voffB[i] = (unsigned)(Rb * g.ldb + C) * 2u; }
    const size_t kstep = (size_t)(BK * 2);
    const size_t hstep = (size_t)HALF * g.ldb * 2;
    const size_t tstep = 2 * hstep;
    const size_t hstepA = (size_t)HALF * g.lda * 2, tstepA = 2 * hstepA;
    const unsigned ldsw = (unsigned)wid * 1024u;
    const int aoff = lds_byte(wr * 64 + fr, fq * 8), boff = lds_byte(wc * 32 + fr, fq * 8);
#define PG8_SA(b, h) (((b) * 2 + (h)) * HTB)
#define PG8_SB(b, h) ((4 + (b) * 2 + (h)) * HTB)
#define PG8_STAGE(bufoff, gbase, voff) do { _Pragma("unroll") for (int _i = 0; _i < 2; ++_i) \
        __builtin_amdgcn_global_load_lds((const unsigned*)((const char*)(gbase) + (voff)[_i]), (PG8_LAS unsigned*)(lds + (bufoff) + ldsw + _i * 8192), 16, 0, 0); } while (0)
#define PG8_LDA(dst, b, h) do { _Pragma("unroll") for (int m = 0; m < 4; ++m) _Pragma("unroll") for (int k = 0; k < 2; ++k) dst[m][k] = *(const PG8_LAS bf16x8*)(lds + PG8_SA(b, h) + aoff + m * 2048 + k * 1024); } while (0)
#define PG8_LDB(dst, b, h) do { _Pragma("unroll") for (int n = 0; n < 2; ++n) _Pragma("unroll") for (int k = 0; k < 2; ++k) dst[n][k] = *(const PG8_LAS bf16x8*)(lds + PG8_SB(b, h) + boff + n * 2048 + k * 1024); } while (0)
#define PG8_MMA(ai, bj, At, Bt) do { __builtin_amdgcn_s_setprio(1); _Pragma("unroll") for (int m = 0; m < 4; ++m) _Pragma("unroll") for (int n = 0; n < 2; ++n) _Pragma("unroll") for (int k = 0; k < 2; ++k) \
        acc[ai][bj][m][n] = __builtin_amdgcn_mfma_f32_16x16x32_bf16(Bt[n][k], At[m][k], acc[ai][bj][m][n], 0, 0, 0); __builtin_amdgcn_s_setprio(0); } while (0)
#define PG8_WAIT_V(n) asm volatile("s_waitcnt vmcnt(" #n ")" ::: "memory")
#define PG8_WAIT_L(n) asm volatile("s_waitcnt lgkmcnt(" #n ")" ::: "memory")
#define PG8_BAR __builtin_amdgcn_s_barrier()
#define PG8_SCHED __builtin_amdgcn_sched_barrier(0)
    Unit cur, nxt; int ui = 0;
    if (!S.next(0, cur)) return;
    f32x4 acc[2][2][4][2];
#pragma unroll
    for (int a = 0; a < 2; ++a)
#pragma unroll
        for (int b = 0; b < 2; ++b)
#pragma unroll
            for (int m = 0; m < 4; ++m)
#pragma unroll
                for (int n = 0; n < 2; ++n) acc[a][b][m][n] = (f32x4){0.f, 0.f, 0.f, 0.f};
    bf16x8 At[4][2], B0[2][2], B1[2][2];
    const char* cA = (const char*)g.A + (size_t)cur.pm * tstepA + (size_t)cur.kh * K * 2; const char* cB = (const char*)g.Bt + (size_t)cur.pn * tstep + (size_t)cur.kh * K * 2;
    S.a_ready(cur);
    if constexpr (SP2) {
        PG8_STAGE(PG8_SB(0, 0), cB, voffB); PG8_STAGE(PG8_SB(0, 1), cB + hstep, voffB); PG8_STAGE(PG8_SA(0, 0), cA, voffA); PG8_STAGE(PG8_SA(0, 1), cA + hstepA, voffA);
        if (wr == 1) PG8_BAR;
        PG8_WAIT_V(2); PG8_BAR;
        PG8_STAGE(PG8_SB(1, 0), cB + kstep, voffB); PG8_STAGE(PG8_SA(1, 0), cA + kstep, voffA); PG8_STAGE(PG8_SB(1, 1), cB + hstep + kstep, voffB);
        PG8_WAIT_V(6); PG8_BAR;
    } else {
        PG8_STAGE(PG8_SB(0, 0), cB, voffB); PG8_STAGE(PG8_SA(0, 0), cA, voffA); PG8_STAGE(PG8_SB(0, 1), cB + hstep, voffB); PG8_STAGE(PG8_SA(0, 1), cA + hstepA, voffA);
        if (wr == 1) PG8_BAR;
        PG8_WAIT_V(4); PG8_BAR;
        PG8_STAGE(PG8_SB(1, 0), cB + kstep, voffB); PG8_STAGE(PG8_SA(1, 0), cA + kstep, voffA); PG8_STAGE(PG8_SB(1, 1), cB + hstep + kstep, voffB);
        PG8_WAIT_V(6); PG8_BAR;
    }
    for (;;) {
        const bool has_next = S.next(ui + 1, nxt);
        const char* nA = has_next ? (const char*)g.A + (size_t)nxt.pm * tstepA + (size_t)nxt.kh * K * 2 : cA; const char* nB = has_next ? (const char*)g.Bt + (size_t)nxt.pn * tstep + (size_t)nxt.kh * K * 2 : cB;
        for (int t = 0; t < nt; t += 2) {
            const bool last = (t == nt - 2);
            const char* a1 = cA + (size_t)(t + 1) * kstep;
            const char* a2 = last ? nA : cA + (size_t)(t + 2) * kstep; const char* b2 = last ? nB : cB + (size_t)(t + 2) * kstep;
            const char* a3 = a2 + kstep; const char* b3 = b2 + kstep;
            if (last && has_next) S.a_ready(nxt);
            if constexpr (SP2) {
            PG8_LDB(B0, 0, 0); PG8_LDB(B1, 0, 1); PG8_SCHED; PG8_LDA(At, 0, 0); PG8_STAGE(PG8_SA(1, 1), a1 + hstepA, voffA);
            PG8_WAIT_V(8); PG8_WAIT_L(0); PG8_BAR; PG8_MMA(0, 0, At, B0); PG8_MMA(0, 1, At, B1); PG8_BAR; PG8_SCHED;
            PG8_LDA(At, 0, 1); PG8_STAGE(PG8_SB(0, 0), b2, voffB); PG8_STAGE(PG8_SB(0, 1), b2 + hstep, voffB); PG8_STAGE(PG8_SA(0, 0), a2, voffA);
            PG8_WAIT_V(8); PG8_WAIT_L(0); PG8_BAR; PG8_MMA(1, 0, At, B0); PG8_MMA(1, 1, At, B1); PG8_BAR; PG8_SCHED;
            PG8_LDB(B0, 1, 0); PG8_LDB(B1, 1, 1); PG8_SCHED; PG8_LDA(At, 1, 0); PG8_STAGE(PG8_SA(0, 1), a2 + hstepA, voffA);
            PG8_WAIT_V(8); PG8_WAIT_L(0); PG8_BAR; PG8_MMA(0, 0, At, B0); PG8_MMA(0, 1, At, B1); PG8_BAR; PG8_SCHED;
            PG8_LDA(At, 1, 1); PG8_STAGE(PG8_SB(1, 0), b3, voffB); PG8_STAGE(PG8_SB(1, 1), b3 + hstep, voffB); PG8_STAGE(PG8_SA(1, 0), a3, voffA);
            PG8_WAIT_V(8); PG8_WAIT_L(0); PG8_BAR; PG8_MMA(1, 0, At, B0); PG8_MMA(1, 1, At, B1); PG8_BAR; PG8_SCHED;
            } else {
            PG8_LDB(B0, 0, 0); PG8_SCHED; PG8_LDA(At, 0, 0); PG8_STAGE(PG8_SA(1, 1), a1 + hstepA, voffA);
            PG8_WAIT_L(8); PG8_BAR; PG8_WAIT_L(0); PG8_MMA(0, 0, At, B0); PG8_BAR; PG8_SCHED;
            PG8_LDB(B1, 0, 1); PG8_STAGE(PG8_SB(0, 0), b2, voffB);
            PG8_BAR; PG8_WAIT_L(0); PG8_MMA(0, 1, At, B1); PG8_BAR;
            PG8_LDA(At, 0, 1); PG8_STAGE(PG8_SA(0, 0), a2, voffA);
            PG8_BAR; PG8_WAIT_L(0); PG8_MMA(1, 0, At, B0); PG8_BAR; PG8_SCHED;
            PG8_STAGE(PG8_SB(0, 1), b2 + hstep, voffB);
            PG8_WAIT_V(6); PG8_BAR; PG8_MMA(1, 1, At, B1); PG8_BAR;
            PG8_LDB(B0, 1, 0); PG8_SCHED; PG8_LDA(At, 1, 0); PG8_STAGE(PG8_SA(0, 1), a2 + hstepA, voffA);
            PG8_WAIT_L(8); PG8_BAR; PG8_WAIT_L(0); PG8_MMA(0, 0, At, B0); PG8_BAR; PG8_SCHED;
            PG8_LDB(B1, 1, 1); PG8_STAGE(PG8_SB(1, 0), b3, voffB);
            PG8_BAR; PG8_WAIT_L(0); PG8_MMA(0, 1, At, B1); PG8_BAR;
            PG8_LDA(At, 1, 1); PG8_STAGE(PG8_SA(1, 0), a3, voffA);
            PG8_BAR; PG8_WAIT_L(0); PG8_MMA(1, 0, At, B0); PG8_BAR; PG8_SCHED;
            PG8_STAGE(PG8_SB(1, 1), b3 + hstep, voffB);
            PG8_WAIT_V(6); PG8_BAR; PG8_MMA(1, 1, At, B1); PG8_BAR;
            }
        }
        if constexpr (ALIGN_EPI) { if (wr == 0) PG8_BAR; }
        bool keep_acc = false;
        if constexpr (Epi::MID) { if (cur.kh == 0) { E.mid(acc, cur, wr, wc, fr, fq); keep_acc = true; } }
        if constexpr (!Epi::AFTER_DRAIN) { if (!keep_acc) { E(acc, cur, wr, wc, fr, fq); S.done(cur); } }
        if (!has_next) break;
        if (!keep_acc)
#pragma unroll
        for (int a = 0; a < 2; ++a)
#pragma unroll
            for (int b = 0; b < 2; ++b)
#pragma unroll
                for (int m = 0; m < 4; ++m)
#pragma unroll
                    for (int n = 0; n < 2; ++n) acc[a][b][m][n] = (f32x4){0.f, 0.f, 0.f, 0.f};
        cur = nxt; cA = nA; cB = nB; ++ui;
        if constexpr (ALIGN_EPI) { if (wr == 1) PG8_BAR; }
    }
    PG8_WAIT_V(0);
    if constexpr (!ALIGN_EPI) { if (wr == 0) PG8_BAR; }
    PG8_BAR;
    if constexpr (Epi::AFTER_DRAIN) { E.fused(acc, cur, wr, wc, fr, fq, lds, wid, lane); S.done(cur); }
#undef PG8_SA
#undef PG8_SB
#undef PG8_STAGE
#undef PG8_LDA
#undef PG8_LDB
#undef PG8_MMA
#undef PG8_WAIT_V
#undef PG8_WAIT_L
#undef PG8_BAR
#undef PG8_SCHED
}
}
#define LAS __attribute__((address_space(3)))
typedef unsigned short bf16;
typedef short bf16x8 __attribute__((ext_vector_type(8)));
typedef short s16x4 __attribute__((ext_vector_type(4)));
typedef float f32x4 __attribute__((ext_vector_type(4)));
typedef float f32x16 __attribute__((ext_vector_type(16)));
typedef unsigned u32x4 __attribute__((ext_vector_type(4)));
typedef unsigned u32x2 __attribute__((ext_vector_type(2)));
typedef float f32x2_t __attribute__((ext_vector_type(2))); typedef __bf16 bf16x2_t __attribute__((ext_vector_type(2)));

constexpr int T = 16384, DM = 1024, SEQ = 2048;
constexpr int NWAVES = 8, NTHR = 512;
constexpr int LDS_BYTES = 147456;
constexpr float EPS = 1e-6f;
constexpr float ESCALE = 64.f;
constexpr float C2 = 0.125f * 1.4426950408889634f;
constexpr size_t MiB = 1u << 20;
constexpr size_t WS_WIN = 0, WS_WAC = 16 * MiB, WS_WOUT = 20 * MiB, WS_WQ = 22 * MiB, WS_SUBK = 26 * MiB, WS_SSQ = 27 * MiB;
constexpr size_t WS_EU = 28 * MiB, WS_EV = 44 * MiB, WS_BIG = 60 * MiB, WS_END = 252 * MiB;
constexpr size_t B_QKV = 0, B_GG = 96 * MiB, B_PR = 160 * MiB, B_MG = 0, B_H2B = 32 * MiB, B_QP = 96 * MiB, B_SEL = 64 * MiB, B_GATE = 72 * MiB;

__device__ __forceinline__ unsigned cvtpk(float lo, float hi) { f32x2_t v = {lo, hi}; bf16x2_t b = __builtin_convertvector(v, bf16x2_t); return __builtin_bit_cast(unsigned, b); }
__device__ __forceinline__ float wave_sum(float v) {
#pragma unroll
    for (int o = 1; o < 64; o <<= 1) v += __shfl_xor(v, o);
    return v;
}
#define LDS_WAIT() asm volatile("s_waitcnt lgkmcnt(0)" ::: "memory")

struct Params {
    const float* x; const float* norm1_g; const float* w_in; const float* lambda_qk; const float* subln_g; const float* conv_w;
    const float* w_attn_o; const float* w_conv_o; const float* w_out; const float* norm2_g; const float* w_query; const float* sub_keys;
    const float* expert_u; const float* expert_v; const float* final_g;
    float* out; unsigned char* ws; int lo, hi;
};

__device__ __forceinline__ void transpose_item(const float* W, int K, int N, bf16* WT, int remap, int dpitch, int koff, const float* kscale, LAS float* scr, int item, int lane) {
    const int nblk = N / 32, kb = item / nblk, nb = item % nblk, k0 = 64 * kb, n0 = 32 * nb;
    int d0 = n0, dstr = 1;
    if (remap) { if (n0 < 3072) d0 = n0; else if (n0 < 4096) d0 = n0 + 2048; else if (n0 < 5120) { d0 = 6144 + 2 * (n0 - 4096); dstr = 2; } else if (n0 < 6144) { d0 = 6144 + 2 * (n0 - 5120) + 1; dstr = 2; } else d0 = n0 - 3072; }
#pragma unroll 8
    for (int i = 0; i < 32; ++i) { const int kk = 2 * i + (lane >> 5); float v = W[(size_t)(k0 + kk) * N + n0 + (lane & 31)]; if (kscale) v *= kscale[k0 + kk]; scr[kk * 33 + (lane & 31)] = v; }
    LDS_WAIT(); asm volatile("" ::: "memory");
    const int c = lane & 7;
#pragma unroll
    for (int j = 0; j < 4; ++j) { const int n = (lane >> 3) + 8 * j; const LAS float* sp = scr + (8 * c) * 33 + n;
        u32x4 o; o.x = cvtpk(sp[0 * 33], sp[1 * 33]); o.y = cvtpk(sp[2 * 33], sp[3 * 33]); o.z = cvtpk(sp[4 * 33], sp[5 * 33]); o.w = cvtpk(sp[6 * 33], sp[7 * 33]);
        *(u32x4*)(WT + (size_t)(d0 + n * dstr) * dpitch + koff + k0 + 8 * c) = o; }
    LDS_WAIT(); asm volatile("" ::: "memory");
}
__device__ __forceinline__ void cvt_flat(const float* src, bf16* dst, size_t n8, size_t gtid, size_t nthr) {
    for (size_t i = gtid; i < n8; i += nthr) { const f32x4 a = *(const f32x4*)(src + i * 8), b = *(const f32x4*)(src + i * 8 + 4);
        u32x4 o; o.x = cvtpk(a[0], a[1]); o.y = cvtpk(a[2], a[3]); o.z = cvtpk(b[0], b[1]); o.w = cvtpk(b[2], b[3]); *(u32x4*)(dst + i * 8) = o; }
}
__device__ __forceinline__ void cvt_flat_fp8(const float* src, unsigned char* dst, size_t n16, float sc, size_t gtid, size_t nthr) {
    for (size_t i = gtid; i < n16; i += nthr) { u32x4 o;
#pragma unroll
        for (int q = 0; q < 4; ++q) { const f32x4 a = *(const f32x4*)(src + i * 16 + 4 * q) * sc; int w = 0;
            w = __builtin_amdgcn_cvt_pk_fp8_f32(a[0], a[1], w, false); w = __builtin_amdgcn_cvt_pk_fp8_f32(a[2], a[3], w, true); o[q] = (unsigned)w; }
        *(u32x4*)(dst + i * 16) = o; }
}
__device__ __forceinline__ void phase0(const Params& p, LAS unsigned char* lds, int G, int bid, int wave, int lane) {
    unsigned char* ws = p.ws;
    LAS float* scr = (LAS float*)(lds + wave * 16384);
    const int gw = bid * NWAVES + wave, NGW = G * NWAVES;
    constexpr int I_IN = 16 * 256, I_SQ = 16 * 32, I_Q = 16 * 64, NITEMS = I_IN + 3 * I_SQ + I_Q;
    for (int it = gw; it < NITEMS; it += NGW) {
        int r = it;
        if (r < I_IN) { transpose_item(p.w_in, 1024, 8192, (bf16*)(ws + WS_WIN), 1, 1024, 0, nullptr, scr, r, lane); continue; } r -= I_IN;
        if (r < I_SQ) { transpose_item(p.w_attn_o, 1024, 1024, (bf16*)(ws + WS_WAC), 0, 2048, 0, nullptr, scr, r, lane); continue; } r -= I_SQ;
        if (r < I_SQ) { transpose_item(p.w_conv_o, 1024, 1024, (bf16*)(ws + WS_WAC), 0, 2048, 1024, nullptr, scr, r, lane); continue; } r -= I_SQ;
        if (r < I_SQ) { transpose_item(p.w_out, 1024, 1024, (bf16*)(ws + WS_WOUT), 0, 1024, 0, nullptr, scr, r, lane); continue; } r -= I_SQ;
        transpose_item(p.w_query, 1024, 2048, (bf16*)(ws + WS_WQ), 0, 1024, 0, p.norm2_g, scr, r, lane);
    }
    const size_t gtid = (size_t)bid * NTHR + wave * 64 + lane, nthr = (size_t)G * NTHR;
    cvt_flat(p.sub_keys, (bf16*)(ws + WS_SUBK), (size_t)(8 * 2 * 128 * 128) / 8, gtid, nthr);
    bf16* N1 = (bf16*)p.out;
    f32x4 gv[4];
#pragma unroll
    for (int j = 0; j < 4; ++j) gv[j] = *((const f32x4*)p.norm1_g + lane + 64 * j);
    for (int m = gw; m < T; m += NGW) {
        const f32x4* xr = (const f32x4*)(p.x + (size_t)m * DM) + lane; f32x4 v[4]; float s = 0.f;
#pragma unroll
        for (int j = 0; j < 4; ++j) { v[j] = xr[64 * j]; s += (v[j][0] * v[j][0] + v[j][1] * v[j][1]) + (v[j][2] * v[j][2] + v[j][3] * v[j][3]); }
        const float r = rsqrtf(wave_sum(s) * (1.f / DM) + EPS);
        u32x2* o8 = (u32x2*)(N1 + (size_t)m * 2048) + lane;
#pragma unroll
        for (int j = 0; j < 4; ++j) { u32x2 o; o.x = cvtpk(v[j][0] * r * gv[j][0], v[j][1] * r * gv[j][1]); o.y = cvtpk(v[j][2] * r * gv[j][2], v[j][3] * r * gv[j][3]); o8[64 * j] = o; }
    }
}

__device__ __forceinline__ void up8(const bf16* p, float (&f)[8]) { const u32x4 w = *(const u32x4*)p; pg8::unpack8(w, f); }
__device__ __forceinline__ void phase_conv(const Params& p, int G, int bid, int tid) {
    const bf16* PR = (const bf16*)(p.ws + WS_BIG + B_PR); bf16* CBU = (bf16*)p.out + 1024;
    const size_t nthr = (size_t)G * NTHR;
    for (size_t it = (size_t)bid * NTHR + tid; it < (size_t)T * 128; it += nthr) {
        const int t = (int)(it >> 7), c8 = (int)(it & 127) * 8, s = t & (SEQ - 1);
        const bf16* row = PR + (size_t)t * 1024 + c8;
        float cb[8], a[8], acc[8];
        up8(CBU + (size_t)t * 2048 + c8, cb); up8(row, a);
        const f32x4 w2a = *(const f32x4*)(p.conv_w + 2048 + c8), w2b = *(const f32x4*)(p.conv_w + 2048 + c8 + 4);
#pragma unroll
        for (int i = 0; i < 8; ++i) acc[i] = (i < 4 ? w2a[i] : w2b[i - 4]) * a[i];
        if (s >= 1) { up8(row - 1024, a);
            const f32x4 w1a = *(const f32x4*)(p.conv_w + 1024 + c8), w1b = *(const f32x4*)(p.conv_w + 1024 + c8 + 4);
#pragma unroll
            for (int i = 0; i < 8; ++i) acc[i] += (i < 4 ? w1a[i] : w1b[i - 4]) * a[i]; }
        if (s >= 2) { up8(row - 2048, a);
            const f32x4 w0a = *(const f32x4*)(p.conv_w + c8), w0b = *(const f32x4*)(p.conv_w + c8 + 4);
#pragma unroll
            for (int i = 0; i < 8; ++i) acc[i] += (i < 4 ? w0a[i] : w0b[i - 4]) * a[i]; }
        u32x4 o; o.x = cvtpk(cb[0] * acc[0], cb[1] * acc[1]); o.y = cvtpk(cb[2] * acc[2], cb[3] * acc[3]); o.z = cvtpk(cb[4] * acc[4], cb[5] * acc[5]); o.w = cvtpk(cb[6] * acc[6], cb[7] * acc[7]);
        *(u32x4*)(CBU + (size_t)t * 2048 + c8) = o;
    }
}

constexpr int KPITCH = 272, VPITCH = 320, KBYTES = 64 * KPITCH, STAGEB = KBYTES + 64 * VPITCH;
constexpr int XOFF = 0, OSTOFF = 65536, OSTPITCH = 272, OSTB = 32 * OSTPITCH;
__device__ __forceinline__ s16x4 vtr(const LAS unsigned char* p) { return __builtin_amdgcn_ds_read_tr16_b64_v4i16((LAS s16x4*)p); }

__device__ __forceinline__ void attn_unit(LAS unsigned char* lds, const bf16* QKV, bf16* ON, const float* subg, float lam, int b, int h, int qb, int tid) {
    const int w = __builtin_amdgcn_readfirstlane(tid >> 6), lane = tid & 63, map = w >> 2, wq = w & 3, l31 = lane & 31, half = lane >> 5;
    const size_t trow0 = (size_t)b * SEQ;
    const int q0 = qb * 128 + wq * 32;
    bf16x8 qf[4];
    { const bf16* qp = QKV + (trow0 + q0 + l31) * 3072 + h * 128 + map * 64 + 8 * half;
#pragma unroll
      for (int s = 0; s < 4; ++s) qf[s] = *(const bf16x8*)(qp + 16 * s); }
    f32x16 O[4];
#pragma unroll
    for (int e = 0; e < 4; ++e)
#pragma unroll
        for (int r = 0; r < 16; ++r) O[e][r] = 0.f;
    float m_run = 0.f, l_run = 0.f;
    const int ntile = 2 * (qb + 1);
    const int skey = tid >> 4, sch = tid & 15;
    const bf16* gk = QKV + (trow0 + skey) * 3072 + 1024 + h * 128 + sch * 8;
    const int dk = skey * KPITCH + sch * 16, dv = KBYTES + skey * VPITCH + sch * 16;
    u32x4 stg[4];
#define GLOAD(j) do { const bf16* g_ = gk + (size_t)(j) * 64 * 3072; stg[0] = *(const u32x4*)g_; stg[1] = *(const u32x4*)(g_ + 32 * 3072); stg[2] = *(const u32x4*)(g_ + 1024); stg[3] = *(const u32x4*)(g_ + 32 * 3072 + 1024); } while (0)
#define LSTORE(st) do { LAS unsigned char* b_ = lds + (st) * STAGEB; *(LAS u32x4*)(b_ + dk) = stg[0]; *(LAS u32x4*)(b_ + dk + 32 * KPITCH) = stg[1]; *(LAS u32x4*)(b_ + dv) = stg[2]; *(LAS u32x4*)(b_ + dv + 32 * VPITCH) = stg[3]; } while (0)
    GLOAD(0); LSTORE(0); __syncthreads();
    const int koff = l31 * KPITCH + map * 128 + half * 16;
    const int voff = KBYTES + (4 * half + ((lane & 15) >> 2)) * VPITCH + (((lane >> 4) & 1) * 16 + (lane & 3) * 4) * 2;
    const int qi = q0 + l31;
    for (int j = 0; j < ntile; ++j) {
        if (j + 1 < ntile) GLOAD(j + 1);
        const int kbase = 64 * j;
        if (kbase <= q0 + 31) {
            const LAS unsigned char* sb = lds + (j & 1) * STAGEB;
            f32x16 s0, s1;
            const float negm = -m_run;
#pragma unroll
            for (int r = 0; r < 16; ++r) { s0[r] = negm; s1[r] = negm; }
#pragma unroll
            for (int s = 0; s < 4; ++s) { const bf16x8 k0 = *(const LAS bf16x8*)(sb + koff + s * 32), k1 = *(const LAS bf16x8*)(sb + koff + 32 * KPITCH + s * 32);
                s0 = __builtin_amdgcn_mfma_f32_32x32x16_bf16(k0, qf[s], s0, 0, 0, 0); s1 = __builtin_amdgcn_mfma_f32_32x32x16_bf16(k1, qf[s], s1, 0, 0, 0); }
            const LAS unsigned char* vb = sb + voff;
            s16x4 vlo[4][4], vhi[4][4];
            if (kbase + 63 > q0) {
#pragma unroll
                for (int r = 0; r < 16; ++r) { const int key = kbase + (r & 3) + 8 * (r >> 2) + 4 * half;
                    s0[r] = (key <= qi) ? s0[r] : -1e30f; s1[r] = (key + 32 <= qi) ? s1[r] : -1e30f; }
            }
            float mx = fmaxf(s0[0], s1[0]);
#pragma unroll
            for (int r = 1; r < 16; ++r) mx = fmaxf(mx, fmaxf(s0[r], s1[r]));
            mx = fmaxf(mx, __shfl_xor(mx, 32));
            float ps = 0.f;
            const bool first = (j == 0), move = first || (__ballot(mx > 8.f) != 0ull);
            const float delta = move ? (first ? mx : fmaxf(mx, 0.f)) : 0.f;
#pragma unroll
            for (int r = 0; r < 16; ++r) { s0[r] = __builtin_amdgcn_exp2f(s0[r] - delta); s1[r] = __builtin_amdgcn_exp2f(s1[r] - delta); ps += s0[r] + s1[r]; }
            if (move) {
                const float alpha = first ? 0.f : __builtin_amdgcn_exp2f(-delta); m_run += delta;
                l_run = l_run * alpha + ps;
                if (!first) {
#pragma unroll
                    for (int e = 0; e < 4; ++e) O[e] = O[e] * alpha;
                }
            } else l_run += ps;
            bf16x8 pf[4];
#pragma unroll
            for (int kk = 0; kk < 4; ++kk) { u32x4 wv;
                if (kk < 2) { wv.x = cvtpk(s0[8 * kk + 0], s0[8 * kk + 1]); wv.y = cvtpk(s0[8 * kk + 2], s0[8 * kk + 3]); wv.z = cvtpk(s0[8 * kk + 4], s0[8 * kk + 5]); wv.w = cvtpk(s0[8 * kk + 6], s0[8 * kk + 7]); }
                else { const int k2 = kk - 2; wv.x = cvtpk(s1[8 * k2 + 0], s1[8 * k2 + 1]); wv.y = cvtpk(s1[8 * k2 + 2], s1[8 * k2 + 3]); wv.z = cvtpk(s1[8 * k2 + 4], s1[8 * k2 + 5]); wv.w = cvtpk(s1[8 * k2 + 6], s1[8 * k2 + 7]); }
                pf[kk] = __builtin_bit_cast(bf16x8, wv); }
#pragma unroll
            for (int e = 0; e < 4; ++e) { vlo[0][e] = vtr(vb + e * 64); vhi[0][e] = vtr(vb + 8 * VPITCH + e * 64); }
#pragma unroll
            for (int kk = 0; kk < 4; ++kk)
#pragma unroll
                for (int e = 0; e < 4; ++e) {
                    if (e == 0 && kk < 3) {
#pragma unroll
                        for (int e2 = 0; e2 < 4; ++e2) { vlo[kk + 1][e2] = vtr(vb + (kk + 1) * 16 * VPITCH + e2 * 64); vhi[kk + 1][e2] = vtr(vb + ((kk + 1) * 16 + 8) * VPITCH + e2 * 64); }
                        __builtin_amdgcn_sched_barrier(0);
                    }
                    const s16x4 lo = vlo[kk][e], hi = vhi[kk][e];
                    bf16x8 a; a[0] = lo[0]; a[1] = lo[1]; a[2] = lo[2]; a[3] = lo[3]; a[4] = hi[0]; a[5] = hi[1]; a[6] = hi[2]; a[7] = hi[3];
                    O[e] = __builtin_amdgcn_mfma_f32_32x32x16_bf16(a, pf[kk], O[e], 0, 0, 0); }
        }
        if (j + 1 < ntile) LSTORE((j + 1) & 1);
        __syncthreads();
    }
#undef GLOAD
#undef LSTORE
    const float ltot = l_run + __shfl_xor(l_run, 32), inv = 1.f / ltot;
    LAS float* X = (LAS float*)(lds + XOFF) + wq * 4096 + lane;
    if (map == 1) {
        const float sc = inv * lam;
#pragma unroll
        for (int e = 0; e < 4; ++e)
#pragma unroll
            for (int r = 0; r < 16; ++r) X[(e * 16 + r) * 64] = O[e][r] * sc;
    }
    __syncthreads();
    if (map == 0) {
        float ssq = 0.f;
#pragma unroll
        for (int e = 0; e < 4; ++e)
#pragma unroll
            for (int r = 0; r < 16; ++r) { const float o = O[e][r] * inv - X[(e * 16 + r) * 64]; O[e][r] = o; ssq += o * o; }
        ssq += __shfl_xor(ssq, 32);
        const float rms = rsqrtf(ssq * (1.f / 128.f) + EPS) * 0.8f;
        LAS unsigned char* ost = lds + OSTOFF + wq * OSTB;
#pragma unroll
        for (int e = 0; e < 4; ++e)
#pragma unroll
            for (int rq = 0; rq < 4; ++rq) { const int e0 = 32 * e + 8 * rq + 4 * half; const f32x4 g = *(const f32x4*)(subg + e0);
                u32x2 o; o.x = cvtpk(O[e][4 * rq + 0] * rms * g[0], O[e][4 * rq + 1] * rms * g[1]); o.y = cvtpk(O[e][4 * rq + 2] * rms * g[2], O[e][4 * rq + 3] * rms * g[3]);
                *(LAS u32x2*)(ost + l31 * OSTPITCH + e0 * 2) = o; }
        LDS_WAIT(); __builtin_amdgcn_wave_barrier();
#pragma unroll
        for (int jj = 0; jj < 8; ++jj) { const int c = lane + 64 * jj, row = c >> 4, ch = c & 15;
            const u32x4 v = *(const LAS u32x4*)(ost + row * OSTPITCH + ch * 16);
            *(u32x4*)(ON + (trow0 + q0 + row) * 2048 + h * 128 + ch * 8) = v; }
    }
    __syncthreads();
}

__device__ __forceinline__ void phase_attn(const Params& p, LAS unsigned char* lds, int G, int bid, int tid) {
    const bf16* QKV = (const bf16*)(p.ws + WS_BIG); bf16* ON = (bf16*)p.out;
    const int lane = tid & 63;
    const float a = p.lambda_qk[lane] * p.lambda_qk[64 + lane], b = p.lambda_qk[128 + lane] * p.lambda_qk[192 + lane];
    const float lam = expf(wave_sum(a)) - expf(wave_sum(b)) + 0.2f;
    for (int c = bid; c < 256; c += G) {
        const int bh = c >> 2, quad = c & 3, b_ = bh >> 3, h = bh & 7;
        attn_unit(lds, QKV, ON, p.subln_g, lam, b_, h, 15 - 2 * quad, tid);
        attn_unit(lds, QKV, ON, p.subln_g, lam, b_, h, 2 * quad, tid);
        attn_unit(lds, QKV, ON, p.subln_g, lam, b_, h, 14 - 2 * quad, tid);
        attn_unit(lds, QKV, ON, p.subln_g, lam, b_, h, 2 * quad + 1, tid);
    }
}

__device__ __forceinline__ unsigned mono(float v) { const unsigned u = __builtin_bit_cast(unsigned, v); return (u & 0x80000000u) ? ~u : (u | 0x80000000u); }
__device__ __forceinline__ float unmono(unsigned k) { const unsigned u = (k & 0x80000000u) ? (k ^ 0x80000000u) : ~k; return __builtin_bit_cast(float, u); }
#define CE_(x, y) do { const unsigned t_ = max(x, y); y = min(x, y); x = t_; } while (0)
__device__ __forceinline__ void sort16(unsigned (&a)[16]) {
    CE_(a[0], a[1]); CE_(a[2], a[3]); CE_(a[0], a[2]); CE_(a[1], a[3]); CE_(a[1], a[2]); CE_(a[4], a[5]); CE_(a[6], a[7]); CE_(a[4], a[6]); CE_(a[5], a[7]); CE_(a[5], a[6]); CE_(a[0], a[4]); CE_(a[2], a[6]); CE_(a[2], a[4]); CE_(a[1], a[5]); CE_(a[3], a[7]); CE_(a[3], a[5]); CE_(a[1], a[2]); CE_(a[3], a[4]); CE_(a[5], a[6]); CE_(a[8], a[9]); CE_(a[10], a[11]); CE_(a[8], a[10]); CE_(a[9], a[11]); CE_(a[9], a[10]); CE_(a[12], a[13]); CE_(a[14], a[15]); CE_(a[12], a[14]); CE_(a[13], a[15]); CE_(a[13], a[14]); CE_(a[8], a[12]); CE_(a[10], a[14]); CE_(a[10], a[12]); CE_(a[9], a[13]); CE_(a[11], a[15]); CE_(a[11], a[13]); CE_(a[9], a[10]); CE_(a[11], a[12]); CE_(a[13], a[14]); CE_(a[0], a[8]); CE_(a[4], a[12]); CE_(a[4], a[8]); CE_(a[2], a[10]); CE_(a[6], a[14]); CE_(a[6], a[10]); CE_(a[2], a[4]); CE_(a[6], a[8]); CE_(a[10], a[12]); CE_(a[1], a[9]); CE_(a[5], a[13]); CE_(a[5], a[9]); CE_(a[3], a[11]); CE_(a[7], a[15]); CE_(a[7], a[11]); CE_(a[3], a[5]); CE_(a[7], a[9]); CE_(a[11], a[13]); CE_(a[1], a[2]); CE_(a[3], a[4]); CE_(a[5], a[6]); CE_(a[7], a[8]); CE_(a[9], a[10]); CE_(a[11], a[12]); CE_(a[13], a[14]);
}
__device__ __forceinline__ void merge16(unsigned (&a)[16], const unsigned (&b)[16]) {
    a[0] = max(a[0], b[15]); a[1] = max(a[1], b[14]); a[2] = max(a[2], b[13]); a[3] = max(a[3], b[12]); a[4] = max(a[4], b[11]); a[5] = max(a[5], b[10]); a[6] = max(a[6], b[9]); a[7] = max(a[7], b[8]); a[8] = max(a[8], b[7]); a[9] = max(a[9], b[6]); a[10] = max(a[10], b[5]); a[11] = max(a[11], b[4]); a[12] = max(a[12], b[3]); a[13] = max(a[13], b[2]); a[14] = max(a[14], b[1]); a[15] = max(a[15], b[0]);
    CE_(a[0], a[8]); CE_(a[1], a[9]); CE_(a[2], a[10]); CE_(a[3], a[11]); CE_(a[4], a[12]); CE_(a[5], a[13]); CE_(a[6], a[14]); CE_(a[7], a[15]); CE_(a[0], a[4]); CE_(a[1], a[5]); CE_(a[2], a[6]); CE_(a[3], a[7]); CE_(a[8], a[12]); CE_(a[9], a[13]); CE_(a[10], a[14]); CE_(a[11], a[15]); CE_(a[0], a[2]); CE_(a[1], a[3]); CE_(a[4], a[6]); CE_(a[5], a[7]); CE_(a[8], a[10]); CE_(a[9], a[11]); CE_(a[12], a[14]); CE_(a[13], a[15]); CE_(a[0], a[1]); CE_(a[2], a[3]); CE_(a[4], a[5]); CE_(a[6], a[7]); CE_(a[8], a[9]); CE_(a[10], a[11]); CE_(a[12], a[13]); CE_(a[14], a[15]);
}

__device__ __forceinline__ void convert_experts(const Params& p, size_t gtid, size_t nthr) {
    cvt_flat_fp8(p.expert_u, p.ws + WS_EU, (size_t)16384 * 1024 / 16, ESCALE, gtid, nthr);
    cvt_flat_fp8(p.expert_v, p.ws + WS_EV, (size_t)16384 * 1024 / 16, ESCALE, gtid, nthr);
}
__device__ __forceinline__ void phase_topk(const Params& p, LAS unsigned char* lds, int G, int bid, int wave, int lane) {
    const bf16* QP = (const bf16*)(p.ws + WS_BIG + B_QP); const bf16* SK = (const bf16*)(p.ws + WS_SUBK);
    int* SEL = (int*)(p.ws + WS_BIG + B_SEL); float* GATE = (float*)(p.ws + WS_BIG + B_GATE);
    const int gw = bid * NWAVES + wave, NGW = G * NWAVES, l31 = lane & 31, half = lane >> 5;
    LAS int* tab = (LAS int*)(lds + wave * 4096) + l31 * 32;
    const size_t cg_tid = (size_t)bid * 256 + (wave & 3) * 64 + lane, cg_n = (size_t)G * 256;
    if (wave < 4) cvt_flat_fp8(p.expert_u, p.ws + WS_EU, (size_t)16384 * 1024 / 16, ESCALE, cg_tid, cg_n);
    for (int task = gw; task < 512 * 8; task += NGW) {
        const int tg = task >> 3, h = task & 7, t = tg * 32 + l31;
        unsigned lists[2][16];
#pragma unroll
        for (int m = 0; m < 2; ++m) {
            f32x16 acc[4];
#pragma unroll
            for (int kb = 0; kb < 4; ++kb)
#pragma unroll
                for (int r = 0; r < 16; ++r) acc[kb][r] = 0.f;
            const bf16* qp = QP + (size_t)t * 2048 + h * 256 + m * 128 + 8 * half;
            const bf16* kp = SK + ((size_t)(h * 2 + m) * 128 + l31) * 128 + 8 * half;
#pragma unroll 1
            for (int s = 0; s < 8; ++s) { const bf16x8 bq = *(const bf16x8*)(qp + 16 * s);
#pragma unroll
                for (int kb = 0; kb < 4; ++kb) { const bf16x8 ak = *(const bf16x8*)(kp + kb * 32 * 128 + 16 * s); acc[kb] = __builtin_amdgcn_mfma_f32_32x32x16_bf16(ak, bq, acc[kb], 0, 0, 0); } }
            unsigned top[16], oth[16];
#pragma unroll
            for (int kb = 0; kb < 4; ++kb) {
#pragma unroll
                for (int r = 0; r < 16; ++r) { const int kidx = 32 * kb + (r & 3) + 8 * (r >> 2) + 4 * half; oth[r] = (mono(acc[kb][r]) & ~127u) | (unsigned)(127 - kidx); }
                sort16(oth);
                if (kb == 0) {
#pragma unroll
                    for (int i = 0; i < 16; ++i) top[i] = oth[i];
                } else merge16(top, oth);
            }
#pragma unroll
            for (int i = 0; i < 16; ++i) oth[i] = (unsigned)__shfl_xor((int)top[i], 32);
            merge16(top, oth);
#pragma unroll
            for (int i = 0; i < 16; ++i) lists[m][i] = top[i];
        }
        float va[16], vb[16];
#pragma unroll
        for (int i = 0; i < 16; ++i) { va[i] = unmono(lists[0][i] & ~127u); vb[i] = unmono(lists[1][i] & ~127u);
            tab[i] = 127 - (int)(lists[0][i] & 127u); tab[16 + i] = 127 - (int)(lists[1][i] & 127u); }
#define CKEY(i, j) ((mono(va[i] + vb[j]) & ~255u) | (unsigned)(255 - ((i) * 16 + (j))))
        unsigned ct[16], l1[16], l2[16], l3[16];
#pragma unroll
        for (int j = 0; j < 16; ++j) ct[j] = CKEY(0, j);
#pragma unroll
        for (int j = 0; j < 8; ++j) l1[j] = CKEY(1, j);
#pragma unroll
        for (int j = 0; j < 5; ++j) l1[8 + j] = CKEY(2, j);
        l1[13] = 0u; l1[14] = 0u; l1[15] = 0u;
#pragma unroll
        for (int j = 0; j < 4; ++j) l2[j] = CKEY(3, j);
#pragma unroll
        for (int j = 0; j < 3; ++j) l2[4 + j] = CKEY(4, j);
#pragma unroll
        for (int j = 0; j < 2; ++j) { l2[7 + j] = CKEY(5, j); l2[9 + j] = CKEY(6, j); l2[11 + j] = CKEY(7, j); }
        l2[13] = 0u; l2[14] = 0u; l2[15] = 0u;
#pragma unroll
        for (int i = 0; i < 8; ++i) { l3[i] = CKEY(8 + i, 0); l3[8 + i] = 0u; }
#undef CKEY
        sort16(l1); sort16(l2); sort16(l3);
        merge16(ct, l1); merge16(l2, l3); merge16(ct, l2);
        LDS_WAIT(); __builtin_amdgcn_wave_barrier();
        const float s0 = unmono(ct[0] & ~255u);
        float ev[16], es = 0.f; int ex[16];
#pragma unroll
        for (int r = 0; r < 16; ++r) { const int pos = 255 - (int)(ct[r] & 255u); ev[r] = __expf(unmono(ct[r] & ~255u) - s0); es += ev[r];
            ex[r] = tab[pos >> 4] * 128 + tab[16 + (pos & 15)]; }
        const float ie = 1.f / es;
        int* so = SEL + (size_t)t * 128 + h * 16; float* go = GATE + (size_t)t * 128 + h * 16;
        if (half == 0) {
#pragma unroll
            for (int r = 0; r < 8; ++r) { so[r] = ex[r]; go[r] = ev[r] * ie; }
        } else {
#pragma unroll
            for (int r = 8; r < 16; ++r) { so[r] = ex[r]; go[r] = ev[r] * ie; }
        }
        LDS_WAIT(); __builtin_amdgcn_wave_barrier();
    }
    if (wave >= 4) cvt_flat_fp8(p.expert_v, p.ws + WS_EV, (size_t)16384 * 1024 / 16, ESCALE, cg_tid, cg_n);
}

__device__ __forceinline__ float gelu_as(float v) {
    const float av = fabsf(v), t = __builtin_amdgcn_rcpf(av * 0.2316418882f + 1.0f);
    float q = t * 0.5307027145f + (-0.7265760135f); q = q * t + 0.7107068705f; q = q * t + (-0.142248368f); q = q * t + 0.127414796f; q = q * t;
    const float e = __builtin_amdgcn_exp2f((v * v) * (-0.72134752044f)), m = v * (q * e);
    return v < 0.f ? m : v - m;
}
constexpr int KT = 4;
constexpr int GW_LDS = 17152;
constexpr int UPITCH = 272, USTG = 16 * UPITCH;
static_assert(KT == 4, "LDS map of the gather phase is laid out for 4 tokens per wave");
__device__ __forceinline__ void phase_gather(const Params& p, LAS unsigned char* lds, int G, int bid, int wave, int lane) {
    const int* SEL = (const int*)(p.ws + WS_BIG + B_SEL); const float* GATE = (const float*)(p.ws + WS_BIG + B_GATE);
    const unsigned char* EU = p.ws + WS_EU; const unsigned char* EV = p.ws + WS_EV;
    float* H2 = p.out;
    const int gw = bid * NWAVES + wave, NGW = G * NWAVES, l15 = lane & 15, g4 = lane >> 4;
    LAS unsigned char* wl = lds + wave * GW_LDS;
    LAS unsigned char* xnb = wl; LAS int* selb = (LAS int*)(wl + 4096); LAS float* gateb = (LAS float*)(wl + 6144); LAS float* hb = (LAS float*)(wl + 8192); LAS unsigned char* ustg = wl + 8448;
    for (int tb = gw * KT; tb < T; tb += NGW * KT) {
#pragma unroll 1
        for (int k = 0; k < KT; ++k) {
            const int t = tb + k;
            const float* hrow = H2 + (size_t)t * DM + 16 * lane;
            f32x4 hv[4];
#pragma unroll
            for (int j = 0; j < 4; ++j) hv[j] = *(const f32x4*)(hrow + 4 * j);
            const int selA = SEL[(size_t)t * 128 + lane], selB = SEL[(size_t)t * 128 + 64 + lane];
            const float gtA = GATE[(size_t)t * 128 + lane], gtB = GATE[(size_t)t * 128 + 64 + lane];
            float ssq = 0.f;
#pragma unroll
            for (int j = 0; j < 4; ++j) ssq += (hv[j][0] * hv[j][0] + hv[j][1] * hv[j][1]) + (hv[j][2] * hv[j][2] + hv[j][3] * hv[j][3]);
            const float r2 = rsqrtf(wave_sum(ssq) * (1.f / DM) + EPS);
            { u32x4 o;
#pragma unroll
              for (int j = 0; j < 4; ++j) { const f32x4 a = hv[j] * r2 * *(const f32x4*)(p.norm2_g + 16 * lane + 4 * j); int w = 0;
                  w = __builtin_amdgcn_cvt_pk_fp8_f32(a[0], a[1], w, false); w = __builtin_amdgcn_cvt_pk_fp8_f32(a[2], a[3], w, true); o[j] = (unsigned)w; }
              *(LAS u32x4*)(xnb + k * 1024 + 16 * lane) = o; }
            const int bA = selA >> 10, bB = selB >> 10; int posA = 0, posB = 0, off = 0;
#pragma unroll
            for (int b = 0; b < 16; ++b) {
                const unsigned long long mA = __ballot(bA == b), mB = __ballot(bB == b);
                const int cA = __popcll(mA), cB = __popcll(mB);
                const int rA = (int)__builtin_amdgcn_mbcnt_hi((unsigned)(mA >> 32), __builtin_amdgcn_mbcnt_lo((unsigned)mA, 0u));
                const int rB = (int)__builtin_amdgcn_mbcnt_hi((unsigned)(mB >> 32), __builtin_amdgcn_mbcnt_lo((unsigned)mB, 0u));
                if (bA == b) posA = off + rA;
                if (bB == b) posB = off + cA + rB;
                off += cA + cB;
            }
            selb[k * 128 + posA] = selA; gateb[k * 128 + posA] = gtA; selb[k * 128 + posB] = selB; gateb[k * 128 + posB] = gtB;
        }
        LDS_WAIT(); __builtin_amdgcn_wave_barrier();
        f32x2_t y[KT][8];
#pragma unroll
        for (int k = 0; k < KT; ++k)
#pragma unroll
            for (int i = 0; i < 8; ++i) y[k][i] = (f32x2_t){0.f, 0.f};
#pragma unroll 1
        for (int g = 0; g < 8; ++g) {
#pragma unroll
            for (int k = 0; k < KT; ++k) {
                asm volatile("" ::: "memory");
                f32x4 acc = (f32x4){0.f, 0.f, 0.f, 0.f};
                const int rr = lane >> 4, cc = lane & 15;
                const unsigned char* rp[4];
#pragma unroll
                for (int i = 0; i < 4; ++i) rp[i] = EU + (size_t)selb[k * 128 + 16 * g + 4 * i + rr] * DM + 16 * cc;
                u32x4 ld[4];
#pragma unroll
                for (int i = 0; i < 4; ++i) ld[i] = *(const u32x4*)(rp[i]);
#pragma unroll
                for (int qd = 0; qd < 4; ++qd) {
                    LAS unsigned char* sb = ustg + (qd & 1) * USTG;
#pragma unroll
                    for (int i = 0; i < 4; ++i) *(LAS u32x4*)(sb + (4 * i + rr) * UPITCH + 16 * cc) = ld[i];
                    if (qd < 3) {
#pragma unroll
                        for (int i = 0; i < 4; ++i) ld[i] = *(const u32x4*)(rp[i] + 256 * (qd + 1));
                    }
                    LDS_WAIT(); __builtin_amdgcn_wave_barrier();
                    const LAS unsigned char* ar = sb + l15 * UPITCH + 64 * g4;
                    const LAS unsigned char* xk = xnb + k * 1024 + 256 * qd + 64 * g4;
#pragma unroll
                    for (int i = 0; i < 4; ++i) { const u32x4 a = *(const LAS u32x4*)(ar + 16 * i); const u32x4 bx = *(const LAS u32x4*)(xk + 16 * i);
                        const long a0 = (long)(((unsigned long long)a.y << 32) | a.x), a1 = (long)(((unsigned long long)a.w << 32) | a.z);
                        const long b0 = (long)(((unsigned long long)bx.y << 32) | bx.x), b1 = (long)(((unsigned long long)bx.w << 32) | bx.z);
                        acc = __builtin_amdgcn_mfma_f32_16x16x32_fp8_fp8(a0, b0, acc, 0, 0, 0);
                        acc = __builtin_amdgcn_mfma_f32_16x16x32_fp8_fp8(a1, b1, acc, 0, 0, 0); }
                }
                if (l15 == 0) {
#pragma unroll
                    for (int j = 0; j < 4; ++j) { const float a = acc[j] * (1.f / ESCALE);
                        hb[k * 16 + 4 * g4 + j] = gelu_as(a) * gateb[k * 128 + 16 * g + 4 * g4 + j] * (1.f / ESCALE); }
                }
            }
            LDS_WAIT(); __builtin_amdgcn_wave_barrier();
#pragma unroll
            for (int k = 0; k < KT; ++k) {
                asm volatile("" ::: "memory");
                u32x4 vr[2][4];
#pragma unroll
                for (int i = 0; i < 4; ++i) vr[0][i] = *(const u32x4*)(EV + (size_t)selb[k * 128 + 16 * g + i] * DM + 16 * lane);
#pragma unroll
                for (int bt = 0; bt < 4; ++bt) {
                    if (bt < 3) {
#pragma unroll
                        for (int i = 0; i < 4; ++i) vr[(bt + 1) & 1][i] = *(const u32x4*)(EV + (size_t)selb[k * 128 + 16 * g + 4 * (bt + 1) + i] * DM + 16 * lane);
                    }
                    asm volatile("" ::: "memory");
#pragma unroll
                    for (int i = 0; i < 4; ++i) { const float hs = hb[k * 16 + 4 * bt + i]; const u32x4 v = vr[bt & 1][i];
#pragma unroll
                        for (int q = 0; q < 4; ++q) { const f32x2_t lo = __builtin_amdgcn_cvt_pk_f32_fp8((int)v[q], false), hi = __builtin_amdgcn_cvt_pk_f32_fp8((int)v[q], true);
                            y[k][2 * q] += lo * hs; y[k][2 * q + 1] += hi * hs; } }
                }
            }
            LDS_WAIT(); __builtin_amdgcn_wave_barrier();
        }
#pragma unroll
        for (int k = 0; k < KT; ++k) {
            float* hrow = H2 + (size_t)(tb + k) * DM + 16 * lane;
            f32x4 h3[4]; float s3 = 0.f;
#pragma unroll
            for (int j = 0; j < 4; ++j) { const f32x4 hv = *(const f32x4*)(hrow + 4 * j);
                h3[j][0] = hv[0] + y[k][2 * j][0]; h3[j][1] = hv[1] + y[k][2 * j][1]; h3[j][2] = hv[2] + y[k][2 * j + 1][0]; h3[j][3] = hv[3] + y[k][2 * j + 1][1];
                s3 += (h3[j][0] * h3[j][0] + h3[j][1] * h3[j][1]) + (h3[j][2] * h3[j][2] + h3[j][3] * h3[j][3]); }
            const float r3 = rsqrtf(wave_sum(s3) * (1.f / DM) + EPS);
#pragma unroll
            for (int j = 0; j < 4; ++j) *(f32x4*)(hrow + 4 * j) = h3[j] * r3 * *(const f32x4*)(p.final_g + 16 * lane + 4 * j);
        }
        LDS_WAIT(); __builtin_amdgcn_wave_barrier();
    }
}

#define XB_TMO      128
#define XB_XCNT(j)  (256  + 64 * (j))
#define XB_XSUB(j)  (1280 + 64 * (j))
#define XB_XGEN(j)  (2304 + 64 * (j))
#define XB_TOP      3328
#define XB_TOPGEN   3392
#define XCD_BAR_WORDS 3456
#define XB_SPIN_CAP (1u << 18)

__device__ __forceinline__ unsigned xb_ld(unsigned* p)              { return __hip_atomic_load(p, __ATOMIC_RELAXED, __HIP_MEMORY_SCOPE_AGENT); }
__device__ __forceinline__ unsigned xb_add(unsigned* p, unsigned v) { return __hip_atomic_fetch_add(p, v, __ATOMIC_RELAXED, __HIP_MEMORY_SCOPE_AGENT); }
__device__ __forceinline__ unsigned xb_xcc_id() { return (unsigned)__builtin_amdgcn_s_getreg((3 << 11) | 20) & 0xFu; }
#define XB_SPIN(cond, bar) do { unsigned _sp = 0; while (cond) { __builtin_amdgcn_s_sleep(1); \
    if ((++_sp & 255u) == 0u) { if (xb_ld(&(bar)[XB_TMO])) break; if (_sp > XB_SPIN_CAP) { atomicAdd(&(bar)[XB_TMO], 1u); break; } } } } while (0)

struct XcdBarrier {
    unsigned* bar; unsigned x;
    volatile LAS unsigned* st;
};

__device__ __forceinline__ XcdBarrier xcd_barrier_post(unsigned* bar, volatile LAS unsigned* st) {
    XcdBarrier b; b.bar = bar; b.x = xb_xcc_id(); b.st = st;
    if (threadIdx.x == 0) (void)xb_add(&bar[XB_XCNT(b.x)], 1u);
    return b;
}
__device__ __forceinline__ void xcd_barrier_complete(unsigned* bar, unsigned x, unsigned& nloc, unsigned& nx) {
    const unsigned G = gridDim.x * gridDim.y * gridDim.z;
    unsigned sum, cnt, mine, sp = 0u;
    for (;;) {
        sum = 0u; cnt = 0u; mine = 0u;
#pragma unroll
        for (unsigned j = 0; j < 16; ++j) { const unsigned c = xb_ld(&bar[XB_XCNT(j)]); sum += c; cnt += (c > 0u) ? 1u : 0u; mine = (j == x) ? c : mine; }
        if (sum == G) break;
        __builtin_amdgcn_s_sleep(1);
        if ((++sp & 255u) == 0u) { if (xb_ld(&bar[XB_TMO])) break; if (sp > XB_SPIN_CAP) { atomicAdd(&bar[XB_TMO], 1u); break; } }
    }
    nloc = mine > 0u ? mine : 1u; nx = cnt > 0u ? cnt : 1u;
}

__device__ __forceinline__ void xcd_barrier(const XcdBarrier& b) {
    asm volatile("s_waitcnt vmcnt(0)" ::: "memory");
    __syncthreads();
    if (threadIdx.x == 0) {
        unsigned* bar = b.bar;
        __builtin_amdgcn_s_waitcnt(0);
        unsigned nloc = b.st[0], nx = b.st[1];
        if (nloc == 0u) { xcd_barrier_complete(bar, b.x, nloc, nx); b.st[0] = nloc; b.st[1] = nx; }
        const unsigned old = xb_add(&bar[XB_XSUB(b.x)], 1u);
        const unsigned gen = old / nloc;
        if (old + 1u == (gen + 1u) * nloc) {
            __builtin_amdgcn_fence(__ATOMIC_RELEASE, "agent");
            asm volatile("s_waitcnt vmcnt(0)" ::: "memory");
            const unsigned og = xb_add(&bar[XB_TOP], 1u);
            const unsigned tg = og / nx;
            if (og + 1u == (tg + 1u) * nx) xb_add(&bar[XB_TOPGEN], 1u);
            else XB_SPIN(xb_ld(&bar[XB_TOPGEN]) == tg, bar);
            __builtin_amdgcn_fence(__ATOMIC_ACQUIRE, "agent");
            xb_add(&bar[XB_XGEN(b.x)], 1u);
            asm volatile("s_waitcnt vmcnt(0)" ::: "memory");
        } else {
            XB_SPIN(xb_ld(&bar[XB_XGEN(b.x)]) == gen, bar);
            __builtin_amdgcn_fence(__ATOMIC_ACQUIRE, "agent");
            asm volatile("s_waitcnt vmcnt(0)" ::: "memory");
        }
    }
    __syncthreads();
}

#ifndef ONE_LAUNCH
#define ONE_LAUNCH 1
#endif
constexpr int NPHASE = 8;
__global__ void __launch_bounds__(NTHR, 2) hybrid_fwd(Params p) {
    extern __shared__ __attribute__((aligned(16))) unsigned char lds_raw[];
    LAS unsigned char* lds = (LAS unsigned char*)lds_raw;
    const int tid = threadIdx.x, lane = tid & 63, wave = __builtin_amdgcn_readfirstlane(tid >> 6), G = gridDim.x, bid = blockIdx.x;
    unsigned char* ws = p.ws;
    volatile LAS unsigned* xst = (volatile LAS unsigned*)(lds + 139264);
    if (tid < 2) xst[tid] = 0u;
    __syncthreads();
    XcdBarrier xbar; xbar.bar = (unsigned*)(ws + WS_END); xbar.x = 0; xbar.st = xst;
    if (ONE_LAUNCH && p.hi - p.lo > 1) { xbar = xcd_barrier_post((unsigned*)(ws + WS_END), xst); cg::this_grid().sync(); }
    const pg8::bf16_t* N1 = (const pg8::bf16_t*)p.out;
#ifdef ONLY
#define PH(k) if ((k) == ONLY && p.lo <= (k) && (k) < p.hi)
#else
#define PH(k) if (p.lo <= (k) && (k) < p.hi)
#endif
#define SEAM(k) do { if (ONE_LAUNCH && p.lo <= (k) && (k) + 1 < p.hi) { xcd_barrier(xbar); } } while (0)
#define FRESH_IDS int tid = threadIdx.x; asm volatile("" : "+v"(tid)); const int lane = tid & 63, wave = __builtin_amdgcn_readfirstlane(tid >> 6); (void)lane; (void)wave
    unsigned char* big = ws + WS_BIG;
    PH(0) { FRESH_IDS; phase0(p, lds, G, bid, wave, lane); SEAM(0); }
    PH(1) { FRESH_IDS; pg8::Gemm g{N1, (const pg8::bf16_t*)(ws + WS_WIN), T, 8192, 1024, 2048, 1024}; pg8::StaticOrder S; S.init(T, 8192, G, bid);
        pg8::EpiG1 E{(pg8::bf16_t*)(big + B_QKV), (pg8::bf16_t*)(big + B_GG), (pg8::bf16_t*)p.out + 1024, (pg8::bf16_t*)(big + B_PR), C2};
        pg8::gemm_phase<pg8::EpiG1, pg8::StaticOrder, true, true>(lds, g, S, E); SEAM(1); }
    PH(2) { FRESH_IDS; phase_attn(p, lds, G, bid, tid); phase_conv(p, G, bid, tid); SEAM(2); }
    PH(3) { FRESH_IDS; pg8::Gemm g{(const pg8::bf16_t*)p.out, (const pg8::bf16_t*)(ws + WS_WAC), T, 1024, 1024, 2048, 2048}; pg8::SplitKOrder S; S.base.init(T, 1024, G, bid);
        pg8::EpiMerged E{(const pg8::bf16_t*)(big + B_GG), (pg8::bf16_t*)(big + B_MG)};
        pg8::gemm_phase<pg8::EpiMerged, pg8::SplitKOrder, false, true>(lds, g, S, E); SEAM(3); }
    PH(4) { FRESH_IDS; pg8::Gemm g{(const pg8::bf16_t*)(big + B_MG), (const pg8::bf16_t*)(ws + WS_WOUT), T, 1024, 1024, 1024, 1024}; pg8::StaticOrder S; S.init(T, 1024, G, bid);
        pg8::EpiResid E{p.x, p.out, (pg8::bf16_t*)(big + B_H2B), (float*)(ws + WS_SSQ)};
        pg8::gemm_phase<pg8::EpiResid, pg8::StaticOrder, false, true>(lds, g, S, E); SEAM(4); }
    PH(5) { FRESH_IDS; pg8::Gemm g{(const pg8::bf16_t*)(big + B_H2B), (const pg8::bf16_t*)(ws + WS_WQ), T, 2048, 1024, 1024, 1024}; pg8::StaticOrder S; S.init(T, 2048, G, bid);
        pg8::EpiRowScale E{(const float*)(ws + WS_SSQ), (pg8::bf16_t*)(big + B_QP)};
        pg8::gemm_phase<pg8::EpiRowScale, pg8::StaticOrder, true, true>(lds, g, S, E); SEAM(5); }
    PH(6) { FRESH_IDS; phase_topk(p, lds, G, bid, wave, lane); SEAM(6); }
    PH(7) { FRESH_IDS; phase_gather(p, lds, G, bid, wave, lane); }
#undef PH
#undef SEAM
}

extern "C" void kernel_launch(void* const* d_in, const int* in_sizes, int n_in, void* d_out, int out_size, void* d_ws, size_t ws_size, hipStream_t stream) {
    static int grid = 0;
    if (grid == 0) {
        if (n_in != 15 || out_size != T * DM || ws_size < WS_END) { fprintf(stderr, "kernel_launch: unexpected problem (n_in %d out %d ws %zu)\n", n_in, out_size, ws_size); grid = -1; return; }
        int dev = 0, cus = 0, per_cu = 0;
        hipGetDevice(&dev); hipDeviceGetAttribute(&cus, hipDeviceAttributeMultiprocessorCount, dev);
        if (hipFuncSetAttribute((const void*)hybrid_fwd, hipFuncAttributeMaxDynamicSharedMemorySize, LDS_BYTES) != hipSuccess) { fprintf(stderr, "kernel_launch: hipFuncSetAttribute failed\n"); grid = -1; return; }
        if (hipOccupancyMaxActiveBlocksPerMultiprocessor(&per_cu, (const void*)hybrid_fwd, NTHR, LDS_BYTES) != hipSuccess || per_cu < 1) { fprintf(stderr, "kernel_launch: occupancy query says %d\n", per_cu); per_cu = 1; }
        (void)hipGetLastError();
        grid = cus * per_cu;
    }
    if (grid < 0) return;
    Params p{};
    p.x = (const float*)d_in[0]; p.norm1_g = (const float*)d_in[1]; p.w_in = (const float*)d_in[2]; p.lambda_qk = (const float*)d_in[3]; p.subln_g = (const float*)d_in[4];
    p.conv_w = (const float*)d_in[5]; p.w_attn_o = (const float*)d_in[6]; p.w_conv_o = (const float*)d_in[7]; p.w_out = (const float*)d_in[8]; p.norm2_g = (const float*)d_in[9];
    p.w_query = (const float*)d_in[10]; p.sub_keys = (const float*)d_in[11]; p.expert_u = (const float*)d_in[12]; p.expert_v = (const float*)d_in[13]; p.final_g = (const float*)d_in[14];
    p.out = (float*)d_out; p.ws = (unsigned char*)d_ws;
#if ONE_LAUNCH
    p.lo = 0; p.hi = NPHASE;
    (void)hipMemsetAsync((char*)d_ws + WS_END, 0, 16384, stream);
    void* args[] = {&p};
    hipError_t e = hipLaunchCooperativeKernel((const void*)hybrid_fwd, dim3(grid), dim3(NTHR), args, LDS_BYTES, stream);
    if (e != hipSuccess) fprintf(stderr, "cooperative launch failed: %s (grid %d)\n", hipGetErrorString(e), grid);
#else
    for (int k = 0; k < NPHASE; ++k) {
        p.lo = k; p.hi = k + 1; hipLaunchKernelGGL(hybrid_fwd, dim3(grid), dim3(NTHR), LDS_BYTES, stream, p); }
#endif
}
```

```cpp
#include <hip/hip_runtime.h>
#include <hip/hip_cooperative_groups.h>
#include <cstdio>
#include <cstdint>
namespace cg = cooperative_groups;
namespace pg8 {
#define PG8_LAS __attribute__((address_space(3)))
typedef unsigned short bf16_t;
typedef short bf16x8 __attribute__((ext_vector_type(8)));
typedef float f32x4 __attribute__((ext_vector_type(4)));
typedef unsigned u32x4 __attribute__((ext_vector_type(4)));
constexpr int BM = 256, BK = 64, HALF = 128, HTB = HALF * BK * 2  , STAGE_BYTES = 8 * HTB, NXCD = 8, WGM = 8;

__host__ __device__ __forceinline__ int lds_byte(int r, int c) { const int st = (r >> 4) * 2 + (c >> 5), rr = r & 15, cc = c & 31, ob = rr * 64 + cc * 2; return st * 1024 + (ob ^ (((ob >> 9) & 1) << 5)); }
__host__ __device__ __forceinline__ void stage_rc(int b, int& R, int& C) { const int st = b / 1024, sb = b % 1024, swz = sb ^ (((sb >> 9) & 1) << 5); R = (st >> 1) * 16 + swz / 64; C = (st & 1) * 32 + (swz % 64) / 2; }
__host__ __device__ __forceinline__ int perm32(int rho) { const int n = rho >> 4, i = rho & 15; return 8 * (i >> 2) + 4 * n + (i & 3); }

struct Unit { int pm, pn, kh; };
struct Gemm { const bf16_t* A; const bf16_t* Bt; int M, N, K, lda, ldb; };
struct StaticOrder {
    int nM, nN, nwg, G, c;
    __host__ __device__ void init(int M, int N, int G_, int c_) { nM = M / BM; nN = N / BM; nwg = nM * nN; G = G_; c = c_; }
    __host__ __device__ bool next(int i, Unit& u) const {
        const long L = (long)i * G + c; if (L >= nwg) return false;
        int wgid = (int)L; { const int q = nwg / NXCD, r = nwg % NXCD, xcd = wgid % NXCD, off = wgid / NXCD; wgid = (xcd < r ? xcd * (q + 1) : r * (q + 1) + (xcd - r) * q) + off; }
        const int nig = WGM * nN, gid = wgid / nig, fm = gid * WGM, gsz = (nM - fm) < WGM ? (nM - fm) : WGM;
        u.pm = fm + ((wgid % nig) % gsz); u.pn = (wgid % nig) / gsz; u.kh = 0; return true;
    }
    __device__ __forceinline__ void a_ready(const Unit&) const {}
    __device__ __forceinline__ void done(const Unit&) const {}
};
struct SplitKOrder {
    StaticOrder base;
    __host__ __device__ bool next(int i, Unit& u) const { if (!base.next(i >> 1, u)) return false; u.kh = i & 1; return true; }
    __device__ __forceinline__ void a_ready(const Unit&) const {}
    __device__ __forceinline__ void done(const Unit&) const {}
};
__device__ __forceinline__ unsigned cvt_pk_bf16(float lo, float hi) { unsigned r; asm volatile("v_cvt_pk_bf16_f32 %0, %1, %2" : "=v"(r) : "v"(lo), "v"(hi)); return r; }
typedef float f32x2 __attribute__((ext_vector_type(2)));
typedef float f32x2 __attribute__((ext_vector_type(2)));
typedef unsigned u32x2 __attribute__((ext_vector_type(2)));
__device__ __forceinline__ void unpack8(const u32x4 w, float (&f)[8]) {
    f[0] = __builtin_bit_cast(float, w.x << 16); f[1] = __builtin_bit_cast(float, w.x & 0xffff0000u);
    f[2] = __builtin_bit_cast(float, w.y << 16); f[3] = __builtin_bit_cast(float, w.y & 0xffff0000u);
    f[4] = __builtin_bit_cast(float, w.z << 16); f[5] = __builtin_bit_cast(float, w.z & 0xffff0000u);
    f[6] = __builtin_bit_cast(float, w.w << 16); f[7] = __builtin_bit_cast(float, w.w & 0xffff0000u);
}
__device__ __forceinline__ u32x4 pack8(const f32x4 v0, const f32x4 v1) { u32x4 w; w.x = cvt_pk_bf16(v0[0], v0[1]); w.y = cvt_pk_bf16(v0[2], v0[3]); w.z = cvt_pk_bf16(v1[0], v1[1]); w.w = cvt_pk_bf16(v1[2], v1[3]); return w; }
struct EpiPlain {
    static constexpr bool PERM = true, AFTER_DRAIN = false, MID = false;
    bf16_t* O; int ldc;
    __device__ __forceinline__ void operator()(const f32x4 (&acc)[2][2][4][2], const Unit& u, int wr, int wc, int fr, int fq) const {
        const int row0 = u.pm * BM + wr * 64 + fr, col0 = u.pn * BM + wc * 32 + 8 * fq;
#pragma unroll
        for (int ai = 0; ai < 2; ++ai)
#pragma unroll
            for (int m = 0; m < 4; ++m) { bf16_t* rowp = O + (size_t)(row0 + ai * HALF + m * 16) * ldc + col0;
#pragma unroll
                for (int bj = 0; bj < 2; ++bj) *(u32x4*)(rowp + bj * HALF) = pack8(acc[ai][bj][m][0], acc[ai][bj][m][1]); }
    }
};
struct EpiQKVG {
    static constexpr bool PERM = true, AFTER_DRAIN = false, MID = false;
    bf16_t* QKV; bf16_t* GG; float c2;
    __device__ __forceinline__ void operator()(const f32x4 (&acc)[2][2][4][2], const Unit& u, int wr, int wc, int fr, int fq) const {
        int colt = u.pn * BM; bf16_t* base = QKV; int ldc = 3072; float sc = 1.f; bool sig = false;
        if (colt < 1024) sc = c2; else if (colt >= 3072) { base = GG; ldc = 2048; colt -= 3072; sig = true; }
        const int row0 = u.pm * BM + wr * 64 + fr, col0 = colt + wc * 32 + 8 * fq;
#pragma unroll
        for (int ai = 0; ai < 2; ++ai)
#pragma unroll
            for (int m = 0; m < 4; ++m) { bf16_t* rowp = base + (size_t)(row0 + ai * HALF + m * 16) * ldc + col0;
#pragma unroll
                for (int bj = 0; bj < 2; ++bj) { f32x4 v0 = acc[ai][bj][m][0], v1 = acc[ai][bj][m][1];
                    if (sig) {
#pragma unroll
                        for (int i = 0; i < 4; ++i) { v0[i] = __builtin_amdgcn_rcpf(1.f + __expf(-v0[i])); v1[i] = __builtin_amdgcn_rcpf(1.f + __expf(-v1[i])); }
                    } else { v0 = v0 * sc; v1 = v1 * sc; }
                    *(u32x4*)(rowp + bj * HALF) = pack8(v0, v1); } }
    }
};
struct EpiGateA {
    static constexpr bool PERM = true, AFTER_DRAIN = false, MID = false;
    const bf16_t* GG; float* TMP;
    __device__ __forceinline__ void operator()(const f32x4 (&acc)[2][2][4][2], const Unit& u, int wr, int wc, int fr, int fq) const {
        const int row0 = u.pm * BM + wr * 64 + fr, col0 = u.pn * BM + wc * 32 + 8 * fq;
#pragma unroll
        for (int ai = 0; ai < 2; ++ai)
#pragma unroll
            for (int m = 0; m < 4; ++m) { const size_t row = (size_t)(row0 + ai * HALF + m * 16);
#pragma unroll
                for (int bj = 0; bj < 2; ++bj) { const int col = col0 + bj * HALF; float g[8]; unpack8(*(const u32x4*)(GG + row * 2048 + col), g);
                    f32x4 v0 = acc[ai][bj][m][0], v1 = acc[ai][bj][m][1];
                    v0[0] *= g[0]; v0[1] *= g[1]; v0[2] *= g[2]; v0[3] *= g[3]; v1[0] *= g[4]; v1[1] *= g[5]; v1[2] *= g[6]; v1[3] *= g[7];
                    *(f32x4*)(TMP + row * 1024 + col) = v0; *(f32x4*)(TMP + row * 1024 + col + 4) = v1; } }
    }
};
struct EpiGateC {
    static constexpr bool PERM = true, AFTER_DRAIN = false, MID = false;
    const bf16_t* GG; const float* TMP; bf16_t* MG;
    __device__ __forceinline__ void operator()(const f32x4 (&acc)[2][2][4][2], const Unit& u, int wr, int wc, int fr, int fq) const {
        const int row0 = u.pm * BM + wr * 64 + fr, col0 = u.pn * BM + wc * 32 + 8 * fq;
#pragma unroll
        for (int ai = 0; ai < 2; ++ai)
#pragma unroll
            for (int m = 0; m < 4; ++m) { const size_t row = (size_t)(row0 + ai * HALF + m * 16);
#pragma unroll
                for (int bj = 0; bj < 2; ++bj) { const int col = col0 + bj * HALF; float g[8]; unpack8(*(const u32x4*)(GG + row * 2048 + 1024 + col), g);
                    const f32x4 t0 = *(const f32x4*)(TMP + row * 1024 + col), t1 = *(const f32x4*)(TMP + row * 1024 + col + 4);
                    f32x4 v0 = acc[ai][bj][m][0], v1 = acc[ai][bj][m][1];
                    v0[0] = t0[0] + v0[0] * g[0]; v0[1] = t0[1] + v0[1] * g[1]; v0[2] = t0[2] + v0[2] * g[2]; v0[3] = t0[3] + v0[3] * g[3];
                    v1[0] = t1[0] + v1[0] * g[4]; v1[1] = t1[1] + v1[1] * g[5]; v1[2] = t1[2] + v1[2] * g[6]; v1[3] = t1[3] + v1[3] * g[7];
                    *(u32x4*)(MG + row * 1024 + col) = pack8(v0, v1); } }
    }
};
struct EpiG1 {
    static constexpr bool PERM = true, AFTER_DRAIN = false, MID = false;
    bf16_t* QKV; bf16_t* GG; bf16_t* CB; bf16_t* PR; float c2;
    __device__ __forceinline__ void operator()(const f32x4 (&acc)[2][2][4][2], const Unit& u, int wr, int wc, int fr, int fq) const {
        int colt = u.pn * BM; const int row0 = u.pm * BM + wr * 64 + fr;
        if (colt >= 6144) {
            const int ch0 = (colt - 6144) / 2 + wc * 16 + 4 * fq;
#pragma unroll
            for (int ai = 0; ai < 2; ++ai)
#pragma unroll
                for (int m = 0; m < 4; ++m) { bf16_t* rowp = PR + (size_t)(row0 + ai * HALF + m * 16) * 1024 + ch0;
#pragma unroll
                    for (int bj = 0; bj < 2; ++bj) { const f32x4 v0 = acc[ai][bj][m][0], v1 = acc[ai][bj][m][1];
                        u32x2 w; w.x = cvt_pk_bf16(v0[0] * v0[1], v0[2] * v0[3]); w.y = cvt_pk_bf16(v1[0] * v1[1], v1[2] * v1[3]);
                        *(u32x2*)(rowp + bj * (HALF / 2)) = w; } }
            return;
        }
        bf16_t* base = QKV; int ldc = 3072; float sc = 1.f; bool sig = false;
        if (colt < 1024) sc = c2; else if (colt >= 5120) { base = CB; ldc = 2048; colt -= 5120; } else if (colt >= 3072) { base = GG; ldc = 2048; colt -= 3072; sig = true; }
        const int col0 = colt + wc * 32 + 8 * fq;
#pragma unroll
        for (int ai = 0; ai < 2; ++ai)
#pragma unroll
            for (int m = 0; m < 4; ++m) { bf16_t* rowp = base + (size_t)(row0 + ai * HALF + m * 16) * ldc + col0;
#pragma unroll
                for (int bj = 0; bj < 2; ++bj) { f32x4 v0 = acc[ai][bj][m][0], v1 = acc[ai][bj][m][1];
                    if (sig) {
#pragma unroll
                        for (int i = 0; i < 4; ++i) { v0[i] = __builtin_amdgcn_rcpf(1.f + __expf(-v0[i])); v1[i] = __builtin_amdgcn_rcpf(1.f + __expf(-v1[i])); }
                    } else { v0 = v0 * sc; v1 = v1 * sc; }
                    *(u32x4*)(rowp + bj * HALF) = pack8(v0, v1); } }
    }
};
struct EpiMerged {
    static constexpr bool PERM = true, AFTER_DRAIN = false, MID = true;
    const bf16_t* GG; bf16_t* MG;
    __device__ __forceinline__ void mid(f32x4 (&acc)[2][2][4][2], const Unit& u, int wr, int wc, int fr, int fq) const {
        const int row0 = u.pm * BM + wr * 64 + fr, col0 = u.pn * BM + wc * 32 + 8 * fq;
#pragma unroll
        for (int ai = 0; ai < 2; ++ai)
#pragma unroll
            for (int m = 0; m < 4; ++m) { const size_t row = (size_t)(row0 + ai * HALF + m * 16);
#pragma unroll
                for (int bj = 0; bj < 2; ++bj) { const int col = col0 + bj * HALF; float ga[8], gc[8];
                    unpack8(*(const u32x4*)(GG + row * 2048 + col), ga); unpack8(*(const u32x4*)(GG + row * 2048 + 1024 + col), gc);
#pragma unroll
                    for (int i = 0; i < 4; ++i) { acc[ai][bj][m][0][i] *= ga[i] * __builtin_amdgcn_rcpf(gc[i]); acc[ai][bj][m][1][i] *= ga[4 + i] * __builtin_amdgcn_rcpf(gc[4 + i]); }
                    asm volatile("" ::: "memory"); } }
    }
    __device__ __forceinline__ void operator()(const f32x4 (&acc)[2][2][4][2], const Unit& u, int wr, int wc, int fr, int fq) const {
        const int row0 = u.pm * BM + wr * 64 + fr, col0 = u.pn * BM + wc * 32 + 8 * fq;
#pragma unroll
        for (int ai = 0; ai < 2; ++ai)
#pragma unroll
            for (int m = 0; m < 4; ++m) { const size_t row = (size_t)(row0 + ai * HALF + m * 16);
#pragma unroll
                for (int bj = 0; bj < 2; ++bj) { const int col = col0 + bj * HALF; float gc[8]; unpack8(*(const u32x4*)(GG + row * 2048 + 1024 + col), gc);
                    f32x4 v0 = acc[ai][bj][m][0], v1 = acc[ai][bj][m][1];
#pragma unroll
                    for (int i = 0; i < 4; ++i) { v0[i] *= gc[i]; v1[i] *= gc[4 + i]; }
                    *(u32x4*)(MG + row * 1024 + col) = pack8(v0, v1); } }
    }
};
struct EpiResid {
    static constexpr bool PERM = true, AFTER_DRAIN = false, MID = false;
    const float* X; float* H2; bf16_t* H2B; float* SSQ;
    __device__ __forceinline__ void operator()(const f32x4 (&acc)[2][2][4][2], const Unit& u, int wr, int wc, int fr, int fq) const {
        const int row0 = u.pm * BM + wr * 64 + fr, col0 = u.pn * BM + wc * 32 + 8 * fq;
#pragma unroll
        for (int ai = 0; ai < 2; ++ai)
#pragma unroll
            for (int m = 0; m < 4; ++m) { const size_t row = (size_t)(row0 + ai * HALF + m * 16); float s = 0.f;
#pragma unroll
                for (int bj = 0; bj < 2; ++bj) { const size_t o = row * 1024 + col0 + bj * HALF;
                    const f32x4 v0 = acc[ai][bj][m][0] + *(const f32x4*)(X + o), v1 = acc[ai][bj][m][1] + *(const f32x4*)(X + o + 4);
                    *(f32x4*)(H2 + o) = v0; *(f32x4*)(H2 + o + 4) = v1; *(u32x4*)(H2B + o) = pack8(v0, v1);
                    s += (v0[0] * v0[0] + v0[1] * v0[1]) + (v0[2] * v0[2] + v0[3] * v0[3]) + (v1[0] * v1[0] + v1[1] * v1[1]) + (v1[2] * v1[2] + v1[3] * v1[3]); }
                s += __shfl_xor(s, 16); s += __shfl_xor(s, 32);
                if (fq == 0) SSQ[row * 16 + u.pn * 4 + wc] = s; }
    }
};
struct EpiRowScale {
    static constexpr bool PERM = true, AFTER_DRAIN = false, MID = false;
    const float* SSQ; bf16_t* O;
    __device__ __forceinline__ void operator()(const f32x4 (&acc)[2][2][4][2], const Unit& u, int wr, int wc, int fr, int fq) const {
        const int row0 = u.pm * BM + wr * 64 + fr, col0 = u.pn * BM + wc * 32 + 8 * fq;
#pragma unroll
        for (int ai = 0; ai < 2; ++ai)
#pragma unroll
            for (int m = 0; m < 4; ++m) { const size_t row = (size_t)(row0 + ai * HALF + m * 16);
                const f32x4* sp = (const f32x4*)(SSQ + row * 16); const f32x4 a = sp[0] + sp[1], b = sp[2] + sp[3], c = a + b;
                const float rs = rsqrtf(((c[0] + c[1]) + (c[2] + c[3])) * (1.f / 1024.f) + 1e-6f);
#pragma unroll
                for (int bj = 0; bj < 2; ++bj) *(u32x4*)(O + row * 2048 + col0 + bj * HALF) = pack8(acc[ai][bj][m][0] * rs, acc[ai][bj][m][1] * rs); }
    }
};
template <class Epi, class Sched, bool ALIGN_EPI = false, bool SP2 = false>
__device__ __forceinline__ void gemm_phase(PG8_LAS unsigned char* lds, const Gemm g, const Sched& S, const Epi& E) {
    const int tid = threadIdx.x, wid = __builtin_amdgcn_readfirstlane(tid >> 6), lane = tid & 63, wr = wid >> 2, wc = wid & 3, fr = lane & 15, fq = lane >> 4;
    const int K = g.K, nt = K / BK;
    unsigned voffA[2], voffB[2];
#pragma unroll
    for (int i = 0; i < 2; ++i) { int R, C; stage_rc(tid * 16 + i * 8192, R, C); const int Rb = Epi::PERM ? ((R & ~31) + perm32(R & 31)) : R;
        voffA[i] = (unsigned)(R * g.lda + C) * 2u; voffB[i] = (unsigned)(Rb * g.ldb + C) * 2u; }
    const size_t kstep = (size_t)(BK * 2);
    const size_t hstep = (size_t)HALF * g.ldb * 2;
    const size_t tstep = 2 * hstep;
    const size_t hstepA = (size_t)HALF * g.lda * 2, tstepA = 2 * hstepA;
    const unsigned ldsw = (unsigned)wid * 1024u;
    const int aoff = lds_byte(wr * 64 + fr, fq * 8), boff = lds_byte(wc * 32 + fr, fq * 8);
#define PG8_SA(b, h) (((b) * 2 + (h)) * HTB)
#define PG8_SB(b, h) ((4 + (b) * 2 + (h)) * HTB)
#define PG8_STAGE(bufoff, gbase, voff) do { _Pragma("unroll") for (int _i = 0; _i < 2; ++_i) \
        __builtin_amdgcn_global_load_lds((const unsigned*)((const char*)(gbase) + (voff)[_i]), (PG8_LAS unsigned*)(lds + (bufoff) + ldsw + _i * 8192), 16, 0, 0); } while (0)
#define PG8_LDA(dst, b, h) do { _Pragma("unroll") for (int m = 0; m < 4; ++m) _Pragma("unroll") for (int k = 0; k < 2; ++k) dst[m][k] = *(const PG8_LAS bf16x8*)(lds + PG8_SA(b, h) + aoff + m * 2048 + k * 1024); } while (0)
#define PG8_LDB(dst, b, h) do { _Pragma("unroll") for (int n = 0; n < 2; ++n) _Pragma("unroll") for (int k = 0; k < 2; ++k) dst[n][k] = *(const PG8_LAS bf16x8*)(lds + PG8_SB(b, h) + boff + n * 2048 + k * 1024); } while (0)
#define PG8_MMA(ai, bj, At, Bt) do { __builtin_amdgcn_s_setprio(1); _Pragma("unroll") for (int m = 0; m < 4; ++m) _Pragma("unroll") for (int n = 0; n < 2; ++n) _Pragma("unroll") for (int k = 0; k < 2; ++k) \
        acc[ai][bj][m][n] = __builtin_amdgcn_mfma_f32_16x16x32_bf16(Bt[n][k], At[m][k], acc[ai][bj][m][n], 0, 0, 0); __builtin_amdgcn_s_setprio(0); } while (0)
#define PG8_WAIT_V(n) asm volatile("s_waitcnt vmcnt(" #n ")" ::: "memory")
#define PG8_WAIT_L(n) asm volatile("s_waitcnt lgkmcnt(" #n ")" ::: "memory")
#define PG8_BAR __builtin_amdgcn_s_barrier()
#define PG8_SCHED __builtin_amdgcn_sched_barrier(0)
    Unit cur, nxt; int ui = 0;
    if (!S.next(0, cur)) return;
    f32x4 acc[2][2][4][2];
#pragma unroll
    for (int a = 0; a < 2; ++a)
#pragma unroll
        for (int b = 0; b < 2; ++b)
#pragma unroll
            for (int m = 0; m < 4; ++m)
#pragma unroll
                for (int n = 0; n < 2; ++n) acc[a][b][m][n] = (f32x4){0.f, 0.f, 0.f, 0.f};
    bf16x8 At[4][2], B0[2][2], B1[2][2];
    const char* cA = (const char*)g.A + (size_t)cur.pm * tstepA + (size_t)cur.kh * K * 2; const char* cB = (const char*)g.Bt + (size_t)cur.pn * tstep + (size_t)cur.kh * K * 2;
    S.a_ready(cur);
    if constexpr (SP2) {
        PG8_STAGE(PG8_SB(0, 0), cB, voffB); PG8_STAGE(PG8_SB(0, 1), cB + hstep, voffB); PG8_STAGE(PG8_SA(0, 0), cA, voffA); PG8_STAGE(PG8_SA(0, 1), cA + hstepA, voffA);
        if (wr == 1) PG8_BAR;
        PG8_WAIT_V(2); PG8_BAR;
        PG8_STAGE(PG8_SB(1, 0), cB + kstep, voffB); PG8_STAGE(PG8_SA(1, 0), cA + kstep, voffA); PG8_STAGE(PG8_SB(1, 1), cB + hstep + kstep, voffB);
        PG8_WAIT_V(6); PG8_BAR;
    } else {
        PG8_STAGE(PG8_SB(0, 0), cB, voffB); PG8_STAGE(PG8_SA(0, 0), cA, voffA); PG8_STAGE(PG8_SB(0, 1), cB + hstep, voffB); PG8_STAGE(PG8_SA(0, 1), cA + hstepA, voffA);
        if (wr == 1) PG8_BAR;
        PG8_WAIT_V(4); PG8_BAR;
        PG8_STAGE(PG8_SB(1, 0), cB + kstep, voffB); PG8_STAGE(PG8_SA(1, 0), cA + kstep, voffA); PG8_STAGE(PG8_SB(1, 1), cB + hstep + kstep, voffB);
        PG8_WAIT_V(6); PG8_BAR;
    }
    for (;;) {
        const bool has_next = S.next(ui + 1, nxt);
        const char* nA = has_next ? (const char*)g.A + (size_t)nxt.pm * tstepA + (size_t)nxt.kh * K * 2 : cA; const char* nB = has_next ? (const char*)g.Bt + (size_t)nxt.pn * tstep + (size_t)nxt.kh * K * 2 : cB;
        for (int t = 0; t < nt; t += 2) {
            const bool last = (t == nt - 2);
            const char* a1 = cA + (size_t)(t + 1) * kstep;
            const char* a2 = last ? nA : cA + (size_t)(t + 2) * kstep; const char* b2 = last ? nB : cB + (size_t)(t + 2) * kstep;
            const char* a3 = a2 + kstep; const char* b3 = b2 + kstep;
            if (last && has_next) S.a_ready(nxt);
            if constexpr (SP2) {
            PG8_LDB(B0, 0, 0); PG8_LDB(B1, 0, 1); PG8_SCHED; PG8_LDA(At, 0, 0); PG8_STAGE(PG8_SA(1, 1), a1 + hstepA, voffA);
            PG8_WAIT_V(8); PG8_WAIT_L(0); PG8_BAR; PG8_MMA(0, 0, At, B0); PG8_MMA(0, 1, At, B1); PG8_BAR; PG8_SCHED;
            PG8_LDA(At, 0, 1); PG8_STAGE(PG8_SB(0, 0), b2, voffB); PG8_STAGE(PG8_SB(0, 1), b2 + hstep, voffB); PG8_STAGE(PG8_SA(0, 0), a2, voffA);
            PG8_WAIT_V(8); PG8_WAIT_L(0); PG8_BAR; PG8_MMA(1, 0, At, B0); PG8_MMA(1, 1, At, B1); PG8_BAR; PG8_SCHED;
            PG8_LDB(B0, 1, 0); PG8_LDB(B1, 1, 1); PG8_SCHED; PG8_LDA(At, 1, 0); PG8_STAGE(PG8_SA(0, 1), a2 + hstepA, voffA);
            PG8_WAIT_V(8); PG8_WAIT_L(0); PG8_BAR; PG8_MMA(0, 0, At, B0); PG8_MMA(0, 1, At, B1); PG8_BAR; PG8_SCHED;
            PG8_LDA(At, 1, 1); PG8_STAGE(PG8_SB(1, 0), b3, voffB); PG8_STAGE(PG8_SB(1, 1), b3 + hstep, voffB); PG8_STAGE(PG8_SA(1, 0), a3, voffA);
            PG8_WAIT_V(8); PG8_WAIT_L(0); PG8_BAR; PG8_MMA(1, 0, At, B0); PG8_MMA(1, 1, At, B1); PG8_BAR; PG8_SCHED;
            } else {
            PG8_LDB(B0, 0, 0); PG8_SCHED; PG8_LDA(At, 0, 0); PG8_STAGE(PG8_SA(1, 1), a1 + hstepA, voffA);
            PG8_WAIT_L(8); PG8_BAR; PG8_WAIT_L(0); PG8_MMA(0, 0, At, B0); PG8_BAR; PG8_SCHED;
            PG8_LDB(B1, 0, 1); PG8_STAGE(PG8_SB(0, 0), b2, voffB);
            PG8_BAR; PG8_WAIT_L(0); PG8_MMA(0, 1, At, B1); PG8_BAR;
            PG8_LDA(At, 0, 1); PG8_STAGE(PG8_SA(0, 0), a2, voffA);
            PG8_BAR; PG8_WAIT_L(0); PG8_MMA(1, 0, At, B0); PG8_BAR; PG8_SCHED;
            PG8_STAGE(PG8_SB(0, 1), b2 + hstep, voffB);
            PG8_WAIT_V(6); PG8_BAR; PG8_MMA(1, 1, At, B1); PG8_BAR;
            PG8_LDB(B0, 1, 0); PG8_SCHED; PG8_LDA(At, 1, 0); PG8_STAGE(PG8_SA(0, 1), a2 + hstepA, voffA);
            PG8_WAIT_L(8); PG8_BAR; PG8_WAIT_L(0); PG8_MMA(0, 0, At, B0); PG8_BAR; PG8_SCHED;
            PG8_LDB(B1, 1, 1); PG8_STAGE(PG8_SB(1, 0), b3, voffB);
            PG8_BAR; PG8_WAIT_L(0); PG8_MMA(0, 1, At, B1); PG8_BAR;
            PG8_LDA(At, 1, 1); PG8_STAGE(PG8_SA(1, 0), a3, voffA);
            PG8_BAR; PG8_WAIT_L(0); PG8_MMA(1, 0, At, B0); PG8_BAR; PG8_SCHED;
            PG8_STAGE(PG8_SB(1, 1), b3 + hstep, voffB);
            PG8_WAIT_V(6); PG8_BAR; PG8_MMA(1, 1, At, B1); PG8_BAR;
            }
        }
        if constexpr (ALIGN_EPI) { if (wr == 0) PG8_BAR; }
        bool keep_acc = false;
        if constexpr (Epi::MID) { if (cur.kh == 0) { E.mid(acc, cur, wr, wc, fr, fq); keep_acc = true; } }
        if constexpr (!Epi::AFTER_DRAIN) { if (!keep_acc) { E(acc, cur, wr, wc, fr, fq); S.done(cur); } }
        if (!has_next) break;
        if (!keep_acc)
#pragma unroll
        for (int a = 0; a < 2; ++a)
#pragma unroll
            for (int b = 0; b < 2; ++b)
#pragma unroll
                for (int m = 0; m < 4; ++m)
#pragma unroll
                    for (int n = 0; n < 2; ++n) acc[a][b][m][n] = (f32x4){0.f, 0.f, 0.f, 0.f};
        cur = nxt; cA = nA; cB = nB; ++ui;
        if constexpr (ALIGN_EPI) { if (wr == 1) PG8_BAR; }
    }
    PG8_WAIT_V(0);
    if constexpr (!ALIGN_EPI) { if (wr == 0) PG8_BAR; }
    PG8_BAR;
    if constexpr (Epi::AFTER_DRAIN) { E.fused(acc, cur, wr, wc, fr, fq, lds, wid, lane); S.done(cur); }
#undef PG8_SA
#undef PG8_SB
#undef PG8_STAGE
#undef PG8_LDA
#undef PG8_LDB
#undef PG8_MMA
#undef PG8_WAIT_V
#undef PG8_WAIT_L
#undef PG8_BAR
#undef PG8_SCHED
}
}
#define LAS __attribute__((address_space(3)))
typedef unsigned short bf16;
typedef short bf16x8 __attribute__((ext_vector_type(8)));
typedef short s16x4 __attribute__((ext_vector_type(4)));
typedef float f32x4 __attribute__((ext_vector_type(4)));
typedef float f32x16 __attribute__((ext_vector_type(16)));
typedef unsigned u32x4 __attribute__((ext_vector_type(4)));
typedef unsigned u32x2 __attribute__((ext_vector_type(2)));
typedef float f32x2_t __attribute__((ext_vector_type(2))); typedef __bf16 bf16x2_t __attribute__((ext_vector_type(2)));

constexpr int T = 16384, DM = 1024, SEQ = 2048;
constexpr int NWAVES = 8, NTHR = 512;
constexpr int LDS_BYTES = 147456;
constexpr float EPS = 1e-6f;
constexpr float ESCALE = 64.f;
constexpr float C2 = 0.125f * 1.4426950408889634f;
constexpr size_t MiB = 1u << 20;
constexpr size_t WS_WIN = 0, WS_WAC = 16 * MiB, WS_WOUT = 20 * MiB, WS_WQ = 22 * MiB, WS_SUBK = 26 * MiB, WS_SSQ = 27 * MiB;
constexpr size_t WS_EU = 28 * MiB, WS_EV = 44 * MiB, WS_BIG = 60 * MiB, WS_END = 252 * MiB;
constexpr size_t B_QKV = 0, B_GG = 96 * MiB, B_PR = 160 * MiB, B_MG = 0, B_H2B = 32 * MiB, B_QP = 96 * MiB, B_SEL = 64 * MiB, B_GATE = 72 * MiB;

__device__ __forceinline__ unsigned cvtpk(float lo, float hi) { f32x2_t v = {lo, hi}; bf16x2_t b = __builtin_convertvector(v, bf16x2_t); return __builtin_bit_cast(unsigned, b); }
__device__ __forceinline__ float wave_sum(float v) {
#pragma unroll
    for (int o = 1; o < 64; o <<= 1) v += __shfl_xor(v, o);
    return v;
}
#define LDS_WAIT() asm volatile("s_waitcnt lgkmcnt(0)" ::: "memory")

struct Params {
    const float* x; const float* norm1_g; const float* w_in; const float* lambda_qk; const float* subln_g; const float* conv_w;
    const float* w_attn_o; const float* w_conv_o; const float* w_out; const float* norm2_g; const float* w_query; const float* sub_keys;
    const float* expert_u; const float* expert_v; const float* final_g;
    float* out; unsigned char* ws; int lo, hi;
};

__device__ __forceinline__ void transpose_item(const float* W, int K, int N, bf16* WT, int remap, int dpitch, int koff, const float* kscale, LAS float* scr, int item, int lane) {
    const int nblk = N / 32, kb = item / nblk, nb = item % nblk, k0 = 64 * kb, n0 = 32 * nb;
    int d0 = n0, dstr = 1;
    if (remap) { if (n0 < 3072) d0 = n0; else if (n0 < 4096) d0 = n0 + 2048; else if (n0 < 5120) { d0 = 6144 + 2 * (n0 - 4096); dstr = 2; } else if (n0 < 6144) { d0 = 6144 + 2 * (n0 - 5120) + 1; dstr = 2; } else d0 = n0 - 3072; }
#pragma unroll 8
    for (int i = 0; i < 32; ++i) { const int kk = 2 * i + (lane >> 5); float v = W[(size_t)(k0 + kk) * N + n0 + (lane & 31)]; if (kscale) v *= kscale[k0 + kk]; scr[kk * 33 + (lane & 31)] = v; }
    LDS_WAIT(); asm volatile("" ::: "memory");
    const int c = lane & 7;
#pragma unroll
    for (int j = 0; j < 4; ++j) { const int n = (lane >> 3) + 8 * j; const LAS float* sp = scr + (8 * c) * 33 + n;
        u32x4 o; o.x = cvtpk(sp[0 * 33], sp[1 * 33]); o.y = cvtpk(sp[2 * 33], sp[3 * 33]); o.z = cvtpk(sp[4 * 33], sp[5 * 33]); o.w = cvtpk(sp[6 * 33], sp[7 * 33]);
        *(u32x4*)(WT + (size_t)(d0 + n * dstr) * dpitch + koff + k0 + 8 * c) = o; }
    LDS_WAIT(); asm volatile("" ::: "memory");
}
__device__ __forceinline__ void cvt_flat(const float* src, bf16* dst, size_t n8, size_t gtid, size_t nthr) {
    for (size_t i = gtid; i < n8; i += nthr) { const f32x4 a = *(const f32x4*)(src + i * 8), b = *(const f32x4*)(src + i * 8 + 4);
        u32x4 o; o.x = cvtpk(a[0], a[1]); o.y = cvtpk(a[2], a[3]); o.z = cvtpk(b[0], b[1]); o.w = cvtpk(b[2], b[3]); *(u32x4*)(dst + i * 8) = o; }
}
__device__ __forceinline__ void cvt_flat_fp8(const float* src, unsigned char* dst, size_t n16, float sc, size_t gtid, size_t nthr) {
    for (size_t i = gtid; i < n16; i += nthr) { u32x4 o;
#pragma unroll
        for (int q = 0; q < 4; ++q) { const f32x4 a = *(const f32x4*)(src + i * 16 + 4 * q) * sc; int w = 0;
            w = __builtin_amdgcn_cvt_pk_fp8_f32(a[0], a[1], w, false); w = __builtin_amdgcn_cvt_pk_fp8_f32(a[2], a[3], w, true); o[q] = (unsigned)w; }
        *(u32x4*)(dst + i * 16) = o; }
}
__device__ __forceinline__ void phase0(const Params& p, LAS unsigned char* lds, int G, int bid, int wave, int lane) {
    unsigned char* ws = p.ws;
    LAS float* scr = (LAS float*)(lds + wave * 16384);
    const int gw = bid * NWAVES + wave, NGW = G * NWAVES;
    constexpr int I_IN = 16 * 256, I_SQ = 16 * 32, I_Q = 16 * 64, NITEMS = I_IN + 3 * I_SQ + I_Q;
    for (int it = gw; it < NITEMS; it += NGW) {
        int r = it;
        if (r < I_IN) { transpose_item(p.w_in, 1024, 8192, (bf16*)(ws + WS_WIN), 1, 1024, 0, nullptr, scr, r, lane); continue; } r -= I_IN;
        if (r < I_SQ) { transpose_item(p.w_attn_o, 1024, 1024, (bf16*)(ws + WS_WAC), 0, 2048, 0, nullptr, scr, r, lane); continue; } r -= I_SQ;
        if (r < I_SQ) { transpose_item(p.w_conv_o, 1024, 1024, (bf16*)(ws + WS_WAC), 0, 2048, 1024, nullptr, scr, r, lane); continue; } r -= I_SQ;
        if (r < I_SQ) { transpose_item(p.w_out, 1024, 1024, (bf16*)(ws + WS_WOUT), 0, 1024, 0, nullptr, scr, r, lane); continue; } r -= I_SQ;
        transpose_item(p.w_query, 1024, 2048, (bf16*)(ws + WS_WQ), 0, 1024, 0, p.norm2_g, scr, r, lane);
    }
    const size_t gtid = (size_t)bid * NTHR + wave * 64 + lane, nthr = (size_t)G * NTHR;
    cvt_flat(p.sub_keys, (bf16*)(ws + WS_SUBK), (size_t)(8 * 2 * 128 * 128) / 8, gtid, nthr);
    bf16* N1 = (bf16*)p.out;
    f32x4 gv[4];
#pragma unroll
    for (int j = 0; j < 4; ++j) gv[j] = *((const f32x4*)p.norm1_g + lane + 64 * j);
    for (int m = gw; m < T; m += NGW) {
        const f32x4* xr = (const f32x4*)(p.x + (size_t)m * DM) + lane; f32x4 v[4]; float s = 0.f;
#pragma unroll
        for (int j = 0; j < 4; ++j) { v[j] = xr[64 * j]; s += (v[j][0] * v[j][0] + v[j][1] * v[j][1]) + (v[j][2] * v[j][2] + v[j][3] * v[j][3]); }
        const float r = rsqrtf(wave_sum(s) * (1.f / DM) + EPS);
        u32x2* o8 = (u32x2*)(N1 + (size_t)m * 2048) + lane;
#pragma unroll
        for (int j = 0; j < 4; ++j) { u32x2 o; o.x = cvtpk(v[j][0] * r * gv[j][0], v[j][1] * r * gv[j][1]); o.y = cvtpk(v[j][2] * r * gv[j][2], v[j][3] * r * gv[j][3]); o8[64 * j] = o; }
    }
}

__device__ __forceinline__ void up8(const bf16* p, float (&f)[8]) { const u32x4 w = *(const u32x4*)p; pg8::unpack8(w, f); }
__device__ __forceinline__ void phase_conv(const Params& p, int G, int bid, int tid) {
    const bf16* PR = (const bf16*)(p.ws + WS_BIG + B_PR); bf16* CBU = (bf16*)p.out + 1024;
    const size_t nthr = (size_t)G * NTHR;
    for (size_t it = (size_t)bid * NTHR + tid; it < (size_t)T * 128; it += nthr) {
        const int t = (int)(it >> 7), c8 = (int)(it & 127) * 8, s = t & (SEQ - 1);
        const bf16* row = PR + (size_t)t * 1024 + c8;
        float cb[8], a[8], acc[8];
        up8(CBU + (size_t)t * 2048 + c8, cb); up8(row, a);
        const f32x4 w2a = *(const f32x4*)(p.conv_w + 2048 + c8), w2b = *(const f32x4*)(p.conv_w + 2048 + c8 + 4);
#pragma unroll
        for (int i = 0; i < 8; ++i) acc[i] = (i < 4 ? w2a[i] : w2b[i - 4]) * a[i];
        if (s >= 1) { up8(row - 1024, a);
            const f32x4 w1a = *(const f32x4*)(p.conv_w + 1024 + c8), w1b = *(const f32x4*)(p.conv_w + 1024 + c8 + 4);
#pragma unroll
            for (int i = 0; i < 8; ++i) acc[i] += (i < 4 ? w1a[i] : w1b[i - 4]) * a[i]; }
        if (s >= 2) { up8(row - 2048, a);
            const f32x4 w0a = *(const f32x4*)(p.conv_w + c8), w0b = *(const f32x4*)(p.conv_w + c8 + 4);
#pragma unroll
            for (int i = 0; i < 8; ++i) acc[i] += (i < 4 ? w0a[i] : w0b[i - 4]) * a[i]; }
        u32x4 o; o.x = cvtpk(cb[0] * acc[0], cb[1] * acc[1]); o.y = cvtpk(cb[2] * acc[2], cb[3] * acc[3]); o.z = cvtpk(cb[4] * acc[4], cb[5] * acc[5]); o.w = cvtpk(cb[6] * acc[6], cb[7] * acc[7]);
        *(u32x4*)(CBU + (size_t)t * 2048 + c8) = o;
    }
}

constexpr int KPITCH = 272, VPITCH = 320, KBYTES = 64 * KPITCH, STAGEB = KBYTES + 64 * VPITCH;
constexpr int XOFF = 0, OSTOFF = 65536, OSTPITCH = 272, OSTB = 32 * OSTPITCH;
__device__ __forceinline__ s16x4 vtr(const LAS unsigned char* p) { return __builtin_amdgcn_ds_read_tr16_b64_v4i16((LAS s16x4*)p); }

__device__ __forceinline__ void attn_unit(LAS unsigned char* lds, const bf16* QKV, bf16* ON, const float* subg, float lam, int b, int h, int qb, int tid) {
    const int w = __builtin_amdgcn_readfirstlane(tid >> 6), lane = tid & 63, map = w >> 2, wq = w & 3, l31 = lane & 31, half = lane >> 5;
    const size_t trow0 = (size_t)b * SEQ;
    const int q0 = qb * 128 + wq * 32;
    bf16x8 qf[4];
    { const bf16* qp = QKV + (trow0 + q0 + l31) * 3072 + h * 128 + map * 64 + 8 * half;
#pragma unroll
      for (int s = 0; s < 4; ++s) qf[s] = *(const bf16x8*)(qp + 16 * s); }
    f32x16 O[4];
#pragma unroll
    for (int e = 0; e < 4; ++e)
#pragma unroll
        for (int r = 0; r < 16; ++r) O[e][r] = 0.f;
    float m_run = 0.f, l_run = 0.f;
    const int ntile = 2 * (qb + 1);
    const int skey = tid >> 4, sch = tid & 15;
    const bf16* gk = QKV + (trow0 + skey) * 3072 + 1024 + h * 128 + sch * 8;
    const int dk = skey * KPITCH + sch * 16, dv = KBYTES + skey * VPITCH + sch * 16;
    u32x4 stg[4];
#define GLOAD(j) do { const bf16* g_ = gk + (size_t)(j) * 64 * 3072; stg[0] = *(const u32x4*)g_; stg[1] = *(const u32x4*)(g_ + 32 * 3072); stg[2] = *(const u32x4*)(g_ + 1024); stg[3] = *(const u32x4*)(g_ + 32 * 3072 + 1024); } while (0)
#define LSTORE(st) do { LAS unsigned char* b_ = lds + (st) * STAGEB; *(LAS u32x4*)(b_ + dk) = stg[0]; *(LAS u32x4*)(b_ + dk + 32 * KPITCH) = stg[1]; *(LAS u32x4*)(b_ + dv) = stg[2]; *(LAS u32x4*)(b_ + dv + 32 * VPITCH) = stg[3]; } while (0)
    GLOAD(0); LSTORE(0); __syncthreads();
    const int koff = l31 * KPITCH + map * 128 + half * 16;
    const int voff = KBYTES + (4 * half + ((lane & 15) >> 2)) * VPITCH + (((lane >> 4) & 1) * 16 + (lane & 3) * 4) * 2;
    const int qi = q0 + l31;
    for (int j = 0; j < ntile; ++j) {
        if (j + 1 < ntile) GLOAD(j + 1);
        const int kbase = 64 * j;
        if (kbase <= q0 + 31) {
            const LAS unsigned char* sb = lds + (j & 1) * STAGEB;
            f32x16 s0, s1;
            const float negm = -m_run;
#pragma unroll
            for (int r = 0; r < 16; ++r) { s0[r] = negm; s1[r] = negm; }
#pragma unroll
            for (int s = 0; s < 4; ++s) { const bf16x8 k0 = *(const LAS bf16x8*)(sb + koff + s * 32), k1 = *(const LAS bf16x8*)(sb + koff + 32 * KPITCH + s * 32);
                s0 = __builtin_amdgcn_mfma_f32_32x32x16_bf16(k0, qf[s], s0, 0, 0, 0); s1 = __builtin_amdgcn_mfma_f32_32x32x16_bf16(k1, qf[s], s1, 0, 0, 0); }
            const LAS unsigned char* vb = sb + voff;
            s16x4 vlo[4][4], vhi[4][4];
            if (kbase + 63 > q0) {
#pragma unroll
                for (int r = 0; r < 16; ++r) { const int key = kbase + (r & 3) + 8 * (r >> 2) + 4 * half;
                    s0[r] = (key <= qi) ? s0[r] : -1e30f; s1[r] = (key + 32 <= qi) ? s1[r] : -1e30f; }
            }
            float mx = fmaxf(s0[0], s1[0]);
#pragma unroll
            for (int r = 1; r < 16; ++r) mx = fmaxf(mx, fmaxf(s0[r], s1[r]));
            mx = fmaxf(mx, __shfl_xor(mx, 32));
            float ps = 0.f;
            const bool first = (j == 0), move = first || (__ballot(mx > 8.f) != 0ull);
            const float delta = move ? (first ? mx : fmaxf(mx, 0.f)) : 0.f;
#pragma unroll
            for (int r = 0; r < 16; ++r) { s0[r] = __builtin_amdgcn_exp2f(s0[r] - delta); s1[r] = __builtin_amdgcn_exp2f(s1[r] - delta); ps += s0[r] + s1[r]; }
            if (move) {
                const float alpha = first ? 0.f : __builtin_amdgcn_exp2f(-delta); m_run += delta;
                l_run = l_run * alpha + ps;
                if (!first) {
#pragma unroll
                    for (int e = 0; e < 4; ++e) O[e] = O[e] * alpha;
                }
            } else l_run += ps;
            bf16x8 pf[4];
#pragma unroll
            for (int kk = 0; kk < 4; ++kk) { u32x4 wv;
                if (kk < 2) { wv.x = cvtpk(s0[8 * kk + 0], s0[8 * kk + 1]); wv.y = cvtpk(s0[8 * kk + 2], s0[8 * kk + 3]); wv.z = cvtpk(s0[8 * kk + 4], s0[8 * kk + 5]); wv.w = cvtpk(s0[8 * kk + 6], s0[8 * kk + 7]); }
                else { const int k2 = kk - 2; wv.x = cvtpk(s1[8 * k2 + 0], s1[8 * k2 + 1]); wv.y = cvtpk(s1[8 * k2 + 2], s1[8 * k2 + 3]); wv.z = cvtpk(s1[8 * k2 + 4], s1[8 * k2 + 5]); wv.w = cvtpk(s1[8 * k2 + 6], s1[8 * k2 + 7]); }
                pf[kk] = __builtin_bit_cast(bf16x8, wv); }
#pragma unroll
            for (int e = 0; e < 4; ++e) { vlo[0][e] = vtr(vb + e * 64); vhi[0][e] = vtr(vb + 8 * VPITCH + e * 64); }
#pragma unroll
            for (int kk = 0; kk < 4; ++kk)
#pragma unroll
                for (int e = 0; e < 4; ++e) {
                    if (e == 0 && kk < 3) {
#pragma unroll
                        for (int e2 = 0; e2 < 4; ++e2) { vlo[kk + 1][e2] = vtr(vb + (kk + 1) * 16 * VPITCH + e2 * 64); vhi[kk + 1][e2] = vtr(vb + ((kk + 1) * 16 + 8) * VPITCH + e2 * 64); }
                        __builtin_amdgcn_sched_barrier(0);
                    }
                    const s16x4 lo = vlo[kk][e], hi = vhi[kk][e];
                    bf16x8 a; a[0] = lo[0]; a[1] = lo[1]; a[2] = lo[2]; a[3] = lo[3]; a[4] = hi[0]; a[5] = hi[1]; a[6] = hi[2]; a[7] = hi[3];
                    O[e] = __builtin_amdgcn_mfma_f32_32x32x16_bf16(a, pf[kk], O[e], 0, 0, 0); }
        }
        if (j + 1 < ntile) LSTORE((j + 1) & 1);
        __syncthreads();
    }
#undef GLOAD
#undef LSTORE
    const float ltot = l_run + __shfl_xor(l_run, 32), inv = 1.f / ltot;
    LAS float* X = (LAS float*)(lds + XOFF) + wq * 4096 + lane;
    if (map == 1) {
        const float sc = inv * lam;
#pragma unroll
        for (int e = 0; e < 4; ++e)
#pragma unroll
            for (int r = 0; r < 16; ++r) X[(e * 16 + r) * 64] = O[e][r] * sc;
    }
    __syncthreads();
    if (map == 0) {
        float ssq = 0.f;
#pragma unroll
        for (int e = 0; e < 4; ++e)
#pragma unroll
            for (int r = 0; r < 16; ++r) { const float o = O[e][r] * inv - X[(e * 16 + r) * 64]; O[e][r] = o; ssq += o * o; }
        ssq += __shfl_xor(ssq, 32);
        const float rms = rsqrtf(ssq * (1.f / 128.f) + EPS) * 0.8f;
        LAS unsigned char* ost = lds + OSTOFF + wq * OSTB;
#pragma unroll
        for (int e = 0; e < 4; ++e)
#pragma unroll
            for (int rq = 0; rq < 4; ++rq) { const int e0 = 32 * e + 8 * rq + 4 * half; const f32x4 g = *(const f32x4*)(subg + e0);
                u32x2 o; o.x = cvtpk(O[e][4 * rq + 0] * rms * g[0], O[e][4 * rq + 1] * rms * g[1]); o.y = cvtpk(O[e][4 * rq + 2] * rms * g[2], O[e][4 * rq + 3] * rms * g[3]);
                *(LAS u32x2*)(ost + l31 * OSTPITCH + e0 * 2) = o; }
        LDS_WAIT(); __builtin_amdgcn_wave_barrier();
#pragma unroll
        for (int jj = 0; jj < 8; ++jj) { const int c = lane + 64 * jj, row = c >> 4, ch = c & 15;
            const u32x4 v = *(const LAS u32x4*)(ost + row * OSTPITCH + ch * 16);
            *(u32x4*)(ON + (trow0 + q0 + row) * 2048 + h * 128 + ch * 8) = v; }
    }
    __syncthreads();
}

__device__ __forceinline__ void phase_attn(const Params& p, LAS unsigned char* lds, int G, int bid, int tid) {
    const bf16* QKV = (const bf16*)(p.ws + WS_BIG); bf16* ON = (bf16*)p.out;
    const int lane = tid & 63;
    const float a = p.lambda_qk[lane] * p.lambda_qk[64 + lane], b = p.lambda_qk[128 + lane] * p.lambda_qk[192 + lane];
    const float lam = expf(wave_sum(a)) - expf(wave_sum(b)) + 0.2f;
    for (int c = bid; c < 256; c += G) {
        const int bh = c >> 2, quad = c & 3, b_ = bh >> 3, h = bh & 7;
        attn_unit(lds, QKV, ON, p.subln_g, lam, b_, h, 15 - 2 * quad, tid);
        attn_unit(lds, QKV, ON, p.subln_g, lam, b_, h, 2 * quad, tid);
        attn_unit(lds, QKV, ON, p.subln_g, lam, b_, h, 14 - 2 * quad, tid);
        attn_unit(lds, QKV, ON, p.subln_g, lam, b_, h, 2 * quad + 1, tid);
    }
}

__device__ __forceinline__ unsigned mono(float v) { const unsigned u = __builtin_bit_cast(unsigned, v); return (u & 0x80000000u) ? ~u : (u | 0x80000000u); }
__device__ __forceinline__ float unmono(unsigned k) { const unsigned u = (k & 0x80000000u) ? (k ^ 0x80000000u) : ~k; return __builtin_bit_cast(float, u); }
#define CE_(x, y) do { const unsigned t_ = max(x, y); y = min(x, y); x = t_; } while (0)
__device__ __forceinline__ void sort16(unsigned (&a)[16]) {
    CE_(a[0], a[1]); CE_(a[2], a[3]); CE_(a[0], a[2]); CE_(a[1], a[3]); CE_(a[1], a[2]); CE_(a[4], a[5]); CE_(a[6], a[7]); CE_(a[4], a[6]); CE_(a[5], a[7]); CE_(a[5], a[6]); CE_(a[0], a[4]); CE_(a[2], a[6]); CE_(a[2], a[4]); CE_(a[1], a[5]); CE_(a[3], a[7]); CE_(a[3], a[5]); CE_(a[1], a[2]); CE_(a[3], a[4]); CE_(a[5], a[6]); CE_(a[8], a[9]); CE_(a[10], a[11]); CE_(a[8], a[10]); CE_(a[9], a[11]); CE_(a[9], a[10]); CE_(a[12], a[13]); CE_(a[14], a[15]); CE_(a[12], a[14]); CE_(a[13], a[15]); CE_(a[13], a[14]); CE_(a[8], a[12]); CE_(a[10], a[14]); CE_(a[10], a[12]); CE_(a[9], a[13]); CE_(a[11], a[15]); CE_(a[11], a[13]); CE_(a[9], a[10]); CE_(a[11], a[12]); CE_(a[13], a[14]); CE_(a[0], a[8]); CE_(a[4], a[12]); CE_(a[4], a[8]); CE_(a[2], a[10]); CE_(a[6], a[14]); CE_(a[6], a[10]); CE_(a[2], a[4]); CE_(a[6], a[8]); CE_(a[10], a[12]); CE_(a[1], a[9]); CE_(a[5], a[13]); CE_(a[5], a[9]); CE_(a[3], a[11]); CE_(a[7], a[15]); CE_(a[7], a[11]); CE_(a[3], a[5]); CE_(a[7], a[9]); CE_(a[11], a[13]); CE_(a[1], a[2]); CE_(a[3], a[4]); CE_(a[5], a[6]); CE_(a[7], a[8]); CE_(a[9], a[10]); CE_(a[11], a[12]); CE_(a[13], a[14]);
}
__device__ __forceinline__ void merge16(unsigned (&a)[16], const unsigned (&b)[16]) {
    a[0] = max(a[0], b[15]); a[1] = max(a[1], b[14]); a[2] = max(a[2], b[13]); a[3] = max(a[3], b[12]); a[4] = max(a[4], b[11]); a[5] = max(a[5], b[10]); a[6] = max(a[6], b[9]); a[7] = max(a[7], b[8]); a[8] = max(a[8], b[7]); a[9] = max(a[9], b[6]); a[10] = max(a[10], b[5]); a[11] = max(a[11], b[4]); a[12] = max(a[12], b[3]); a[13] = max(a[13], b[2]); a[14] = max(a[14], b[1]); a[15] = max(a[15], b[0]);
    CE_(a[0], a[8]); CE_(a[1], a[9]); CE_(a[2], a[10]); CE_(a[3], a[11]); CE_(a[4], a[12]); CE_(a[5], a[13]); CE_(a[6], a[14]); CE_(a[7], a[15]); CE_(a[0], a[4]); CE_(a[1], a[5]); CE_(a[2], a[6]); CE_(a[3], a[7]); CE_(a[8], a[12]); CE_(a[9], a[13]); CE_(a[10], a[14]); CE_(a[11], a[15]); CE_(a[0], a[2]); CE_(a[1], a[3]); CE_(a[4], a[6]); CE_(a[5], a[7]); CE_(a[8], a[10]); CE_(a[9], a[11]); CE_(a[12], a[14]); CE_(a[13], a[15]); CE_(a[0], a[1]); CE_(a[2], a[3]); CE_(a[4], a[5]); CE_(a[6], a[7]); CE_(a[8], a[9]); CE_(a[10], a[11]); CE_(a[12], a[13]); CE_(a[14], a[15]);
}

__device__ __forceinline__ void convert_experts(const Params& p, size_t gtid, size_t nthr) {
    cvt_flat_fp8(p.expert_u, p.ws + WS_EU, (size_t)16384 * 1024 / 16, ESCALE, gtid, nthr);
    cvt_flat_fp8(p.expert_v, p.ws + WS_EV, (size_t)16384 * 1024 / 16, ESCALE, gtid, nthr);
}
__device__ __forceinline__ void phase_topk(const Params& p, LAS unsigned char* lds, int G, int bid, int wave, int lane) {
    const bf16* QP = (const bf16*)(p.ws + WS_BIG + B_QP); const bf16* SK = (const bf16*)(p.ws + WS_SUBK);
    int* SEL = (int*)(p.ws + WS_BIG + B_SEL); float* GATE = (float*)(p.ws + WS_BIG + B_GATE);
    const int gw = bid * NWAVES + wave, NGW = G * NWAVES, l31 = lane & 31, half = lane >> 5;
    LAS int* tab = (LAS int*)(lds + wave * 12288) + l31 * 32;
    LAS unsigned char* qst = lds + wave * 12288 + 4096 + lane * 16;
    const size_t cg_tid = (size_t)bid * 256 + (wave & 3) * 64 + lane, cg_n = (size_t)G * 256;
    if (wave < 4) cvt_flat_fp8(p.expert_u, p.ws + WS_EU, (size_t)16384 * 1024 / 16, ESCALE, cg_tid, cg_n);
    for (int task = gw; task < 512 * 8; task += NGW) {
        const int tg = task >> 3, h = task & 7, t = tg * 32 + l31;
        unsigned lists[2][16];
#pragma unroll
        for (int m = 0; m < 2; ++m) {
            f32x16 acc[4];
#pragma unroll
            for (int kb = 0; kb < 4; ++kb)
#pragma unroll
                for (int r = 0; r < 16; ++r) acc[kb][r] = 0.f;
            const bf16* qp = QP + (size_t)t * 2048 + h * 256 + m * 128 + 8 * half;
            const bf16* kp = SK + ((size_t)(h * 2 + m) * 128 + l31) * 128 + 8 * half;
            { u32x4 tq[8];
#pragma unroll
              for (int s = 0; s < 8; ++s) tq[s] = *(const u32x4*)(qp + 16 * s);
#pragma unroll
              for (int s = 0; s < 8; ++s) *(LAS u32x4*)(qst + s * 1024) = tq[s]; }
            bf16x8 akn[4];
#pragma unroll
            for (int kb = 0; kb < 4; ++kb) akn[kb] = *(const bf16x8*)(kp + kb * 32 * 128);
#pragma unroll 1
            for (int s = 0; s < 8; ++s) {
                const bf16x8 bq = *(const LAS bf16x8*)(qst + s * 1024);
                bf16x8 ak[4];
#pragma unroll
                for (int kb = 0; kb < 4; ++kb) ak[kb] = akn[kb];
                const int sn = (s < 7) ? s + 1 : 7;
#pragma unroll
                for (int kb = 0; kb < 4; ++kb) akn[kb] = *(const bf16x8*)(kp + kb * 32 * 128 + 16 * sn);
#pragma unroll
                for (int kb = 0; kb < 4; ++kb) acc[kb] = __builtin_amdgcn_mfma_f32_32x32x16_bf16(ak[kb], bq, acc[kb], 0, 0, 0);
            }
            unsigned top[16], oth[16];
#pragma unroll
            for (int kb = 0; kb < 4; ++kb) {
#pragma unroll
                for (int r = 0; r < 16; ++r) { const int kidx = 32 * kb + (r & 3) + 8 * (r >> 2) + 4 * half; oth[r] = (mono(acc[kb][r]) & ~127u) | (unsigned)(127 - kidx); }
                sort16(oth);
                if (kb == 0) {
#pragma unroll
                    for (int i = 0; i < 16; ++i) top[i] = oth[i];
                } else merge16(top, oth);
            }
#pragma unroll
            for (int i = 0; i < 16; ++i) oth[i] = (unsigned)__shfl_xor((int)top[i], 32);
            merge16(top, oth);
#pragma unroll
            for (int i = 0; i < 16; ++i) lists[m][i] = top[i];
        }
        float va[16], vb[16];
#pragma unroll
        for (int i = 0; i < 16; ++i) { va[i] = unmono(lists[0][i] & ~127u); vb[i] = unmono(lists[1][i] & ~127u);
            tab[i] = 127 - (int)(lists[0][i] & 127u); tab[16 + i] = 127 - (int)(lists[1][i] & 127u); }
#define CKEY(i, j) ((mono(va[i] + vb[j]) & ~255u) | (unsigned)(255 - ((i) * 16 + (j))))
        unsigned ct[16], l1[16], l2[16], l3[16];
#pragma unroll
        for (int j = 0; j < 16; ++j) ct[j] = CKEY(0, j);
#pragma unroll
        for (int j = 0; j < 8; ++j) l1[j] = CKEY(1, j);
#pragma unroll
        for (int j = 0; j < 5; ++j) l1[8 + j] = CKEY(2, j);
        l1[13] = 0u; l1[14] = 0u; l1[15] = 0u;
#pragma unroll
        for (int j = 0; j < 4; ++j) l2[j] = CKEY(3, j);
#pragma unroll
        for (int j = 0; j < 3; ++j) l2[4 + j] = CKEY(4, j);
#pragma unroll
        for (int j = 0; j < 2; ++j) { l2[7 + j] = CKEY(5, j); l2[9 + j] = CKEY(6, j); l2[11 + j] = CKEY(7, j); }
        l2[13] = 0u; l2[14] = 0u; l2[15] = 0u;
#pragma unroll
        for (int i = 0; i < 8; ++i) { l3[i] = CKEY(8 + i, 0); l3[8 + i] = 0u; }
#undef CKEY
        sort16(l1); sort16(l2); sort16(l3);
        merge16(ct, l1); merge16(l2, l3); merge16(ct, l2);
        LDS_WAIT(); __builtin_amdgcn_wave_barrier();
        const float s0 = unmono(ct[0] & ~255u);
        float ev[16], es = 0.f; int ex[16];
#pragma unroll
        for (int r = 0; r < 16; ++r) { const int pos = 255 - (int)(ct[r] & 255u); ev[r] = __expf(unmono(ct[r] & ~255u) - s0); es += ev[r];
            ex[r] = tab[pos >> 4] * 128 + tab[16 + (pos & 15)]; }
        const float ie = 1.f / es;
        int* so = SEL + (size_t)t * 128 + h * 16; float* go = GATE + (size_t)t * 128 + h * 16;
        if (half == 0) {
#pragma unroll
            for (int r = 0; r < 8; ++r) { so[r] = ex[r]; go[r] = ev[r] * ie; }
        } else {
#pragma unroll
            for (int r = 8; r < 16; ++r) { so[r] = ex[r]; go[r] = ev[r] * ie; }
        }
        LDS_WAIT(); __builtin_amdgcn_wave_barrier();
    }
    if (wave >= 4) cvt_flat_fp8(p.expert_v, p.ws + WS_EV, (size_t)16384 * 1024 / 16, ESCALE, cg_tid, cg_n);
}

__device__ __forceinline__ float gelu_as(float v) {
    const float av = fabsf(v), t = __builtin_amdgcn_rcpf(av * 0.2316418882f + 1.0f);
    float q = t * 0.5307027145f + (-0.7265760135f); q = q * t + 0.7107068705f; q = q * t + (-0.142248368f); q = q * t + 0.127414796f; q = q * t;
    const float e = __builtin_amdgcn_exp2f((v * v) * (-0.72134752044f)), m = v * (q * e);
    return v < 0.f ? m : v - m;
}
constexpr int KT = 4;
constexpr int GW_LDS = 17152;
constexpr int UPITCH = 272, USTG = 16 * UPITCH;
static_assert(KT == 4, "LDS map of the gather phase is laid out for 4 tokens per wave");
__device__ __forceinline__ void phase_gather(const Params& p, LAS unsigned char* lds, int G, int bid, int wave, int lane) {
    const int* SEL = (const int*)(p.ws + WS_BIG + B_SEL); const float* GATE = (const float*)(p.ws + WS_BIG + B_GATE);
    const unsigned char* EU = p.ws + WS_EU; const unsigned char* EV = p.ws + WS_EV;
    float* H2 = p.out;
    const int gw = bid * NWAVES + wave, NGW = G * NWAVES, l15 = lane & 15, g4 = lane >> 4;
    LAS unsigned char* wl = lds + wave * GW_LDS;
    LAS unsigned char* xnb = wl; LAS int* selb = (LAS int*)(wl + 4096); LAS float* gateb = (LAS float*)(wl + 6144); LAS float* hb = (LAS float*)(wl + 8192); LAS unsigned char* ustg = wl + 8448;
    for (int tb = gw * KT; tb < T; tb += NGW * KT) {
#pragma unroll 1
        for (int k = 0; k < KT; ++k) {
            const int t = tb + k;
            const float* hrow = H2 + (size_t)t * DM + 16 * lane;
            f32x4 hv[4];
#pragma unroll
            for (int j = 0; j < 4; ++j) hv[j] = *(const f32x4*)(hrow + 4 * j);
            const int selA = SEL[(size_t)t * 128 + lane], selB = SEL[(size_t)t * 128 + 64 + lane];
            const float gtA = GATE[(size_t)t * 128 + lane], gtB = GATE[(size_t)t * 128 + 64 + lane];
            float ssq = 0.f;
#pragma unroll
            for (int j = 0; j < 4; ++j) ssq += (hv[j][0] * hv[j][0] + hv[j][1] * hv[j][1]) + (hv[j][2] * hv[j][2] + hv[j][3] * hv[j][3]);
            const float r2 = rsqrtf(wave_sum(ssq) * (1.f / DM) + EPS);
            { u32x4 o;
#pragma unroll
              for (int j = 0; j < 4; ++j) { const f32x4 a = hv[j] * r2 * *(const f32x4*)(p.norm2_g + 16 * lane + 4 * j); int w = 0;
                  w = __builtin_amdgcn_cvt_pk_fp8_f32(a[0], a[1], w, false); w = __builtin_amdgcn_cvt_pk_fp8_f32(a[2], a[3], w, true); o[j] = (unsigned)w; }
              *(LAS u32x4*)(xnb + k * 1024 + 16 * lane) = o; }
            const int bA = selA >> 10, bB = selB >> 10; int posA = 0, posB = 0, off = 0;
#pragma unroll
            for (int b = 0; b < 16; ++b) {
                const unsigned long long mA = __ballot(bA == b), mB = __ballot(bB == b);
                const int cA = __popcll(mA), cB = __popcll(mB);
                const int rA = (int)__builtin_amdgcn_mbcnt_hi((unsigned)(mA >> 32), __builtin_amdgcn_mbcnt_lo((unsigned)mA, 0u));
                const int rB = (int)__builtin_amdgcn_mbcnt_hi((unsigned)(mB >> 32), __builtin_amdgcn_mbcnt_lo((unsigned)mB, 0u));
                if (bA == b) posA = off + rA;
                if (bB == b) posB = off + cA + rB;
                off += cA + cB;
            }
            selb[k * 128 + posA] = selA; gateb[k * 128 + posA] = gtA; selb[k * 128 + posB] = selB; gateb[k * 128 + posB] = gtB;
        }
        LDS_WAIT(); __builtin_amdgcn_wave_barrier();
        f32x2_t y[KT][8];
#pragma unroll
        for (int k = 0; k < KT; ++k)
#pragma unroll
            for (int i = 0; i < 8; ++i) y[k][i] = (f32x2_t){0.f, 0.f};
#pragma unroll 1
        for (int g = 0; g < 8; ++g) {
#pragma unroll
            for (int k = 0; k < KT; ++k) {
                asm volatile("" ::: "memory");
                f32x4 acc = (f32x4){0.f, 0.f, 0.f, 0.f};
                const int rr = lane >> 4, cc = lane & 15;
                const unsigned char* rp[4];
#pragma unroll
                for (int i = 0; i < 4; ++i) rp[i] = EU + (size_t)selb[k * 128 + 16 * g + 4 * i + rr] * DM + 16 * cc;
                u32x4 ld[4];
#pragma unroll
                for (int i = 0; i < 4; ++i) ld[i] = *(const u32x4*)(rp[i]);
#pragma unroll
                for (int qd = 0; qd < 4; ++qd) {
                    LAS unsigned char* sb = ustg + (qd & 1) * USTG;
#pragma unroll
                    for (int i = 0; i < 4; ++i) *(LAS u32x4*)(sb + (4 * i + rr) * UPITCH + 16 * cc) = ld[i];
                    if (qd < 3) {
#pragma unroll
                        for (int i = 0; i < 4; ++i) ld[i] = *(const u32x4*)(rp[i] + 256 * (qd + 1));
                    }
                    LDS_WAIT(); __builtin_amdgcn_wave_barrier();
                    const LAS unsigned char* ar = sb + l15 * UPITCH + 64 * g4;
                    const LAS unsigned char* xk = xnb + k * 1024 + 256 * qd + 64 * g4;
#pragma unroll
                    for (int i = 0; i < 4; ++i) { const u32x4 a = *(const LAS u32x4*)(ar + 16 * i); const u32x4 bx = *(const LAS u32x4*)(xk + 16 * i);
                        const long a0 = (long)(((unsigned long long)a.y << 32) | a.x), a1 = (long)(((unsigned long long)a.w << 32) | a.z);
                        const long b0 = (long)(((unsigned long long)bx.y << 32) | bx.x), b1 = (long)(((unsigned long long)bx.w << 32) | bx.z);
                        acc = __builtin_amdgcn_mfma_f32_16x16x32_fp8_fp8(a0, b0, acc, 0, 0, 0);
                        acc = __builtin_amdgcn_mfma_f32_16x16x32_fp8_fp8(a1, b1, acc, 0, 0, 0); }
                }
                if (l15 == 0) {
#pragma unroll
                    for (int j = 0; j < 4; ++j) { const float a = acc[j] * (1.f / ESCALE);
                        hb[k * 16 + 4 * g4 + j] = gelu_as(a) * gateb[k * 128 + 16 * g + 4 * g4 + j] * (1.f / ESCALE); }
                }
            }
            LDS_WAIT(); __builtin_amdgcn_wave_barrier();
#pragma unroll
            for (int k = 0; k < KT; ++k) {
                asm volatile("" ::: "memory");
                u32x4 vr[2][4];
#pragma unroll
                for (int i = 0; i < 4; ++i) vr[0][i] = *(const u32x4*)(EV + (size_t)selb[k * 128 + 16 * g + i] * DM + 16 * lane);
#pragma unroll
                for (int bt = 0; bt < 4; ++bt) {
                    if (bt < 3) {
#pragma unroll
                        for (int i = 0; i < 4; ++i) vr[(bt + 1) & 1][i] = *(const u32x4*)(EV + (size_t)selb[k * 128 + 16 * g + 4 * (bt + 1) + i] * DM + 16 * lane);
                    }
                    asm volatile("" ::: "memory");
#pragma unroll
                    for (int i = 0; i < 4; ++i) { const float hs = hb[k * 16 + 4 * bt + i]; const u32x4 v = vr[bt & 1][i];
#pragma unroll
                        for (int q = 0; q < 4; ++q) { const f32x2_t lo = __builtin_amdgcn_cvt_pk_f32_fp8((int)v[q], false), hi = __builtin_amdgcn_cvt_pk_f32_fp8((int)v[q], true);
                            y[k][2 * q] += lo * hs; y[k][2 * q + 1] += hi * hs; } }
                }
            }
            LDS_WAIT(); __builtin_amdgcn_wave_barrier();
        }
#pragma unroll
        for (int k = 0; k < KT; ++k) {
            float* hrow = H2 + (size_t)(tb + k) * DM + 16 * lane;
            f32x4 h3[4]; float s3 = 0.f;
#pragma unroll
            for (int j = 0; j < 4; ++j) { const f32x4 hv = *(const f32x4*)(hrow + 4 * j);
                h3[j][0] = hv[0] + y[k][2 * j][0]; h3[j][1] = hv[1] + y[k][2 * j][1]; h3[j][2] = hv[2] + y[k][2 * j + 1][0]; h3[j][3] = hv[3] + y[k][2 * j + 1][1];
                s3 += (h3[j][0] * h3[j][0] + h3[j][1] * h3[j][1]) + (h3[j][2] * h3[j][2] + h3[j][3] * h3[j][3]); }
            const float r3 = rsqrtf(wave_sum(s3) * (1.f / DM) + EPS);
#pragma unroll
            for (int j = 0; j < 4; ++j) *(f32x4*)(hrow + 4 * j) = h3[j] * r3 * *(const f32x4*)(p.final_g + 16 * lane + 4 * j);
        }
        LDS_WAIT(); __builtin_amdgcn_wave_barrier();
    }
}

#define XB_TMO      128
#define XB_XCNT(j)  (256  + 64 * (j))
#define XB_XSUB(j)  (1280 + 64 * (j))
#define XB_XGEN(j)  (2304 + 64 * (j))
#define XB_TOP      3328
#define XB_TOPGEN   3392
#define XCD_BAR_WORDS 3456
#define XB_SPIN_CAP (1u << 18)

__device__ __forceinline__ unsigned xb_ld(unsigned* p)              { return __hip_atomic_load(p, __ATOMIC_RELAXED, __HIP_MEMORY_SCOPE_AGENT); }
__device__ __forceinline__ unsigned xb_add(unsigned* p, unsigned v) { return __hip_atomic_fetch_add(p, v, __ATOMIC_RELAXED, __HIP_MEMORY_SCOPE_AGENT); }
__device__ __forceinline__ unsigned xb_xcc_id() { return (unsigned)__builtin_amdgcn_s_getreg((3 << 11) | 20) & 0xFu; }
#define XB_SPIN(cond, bar) do { unsigned _sp = 0; while (cond) { __builtin_amdgcn_s_sleep(1); \
    if ((++_sp & 255u) == 0u) { if (xb_ld(&(bar)[XB_TMO])) break; if (_sp > XB_SPIN_CAP) { atomicAdd(&(bar)[XB_TMO], 1u); break; } } } } while (0)

struct XcdBarrier {
    unsigned* bar; unsigned x;
    volatile LAS unsigned* st;
};

__device__ __forceinline__ XcdBarrier xcd_barrier_post(unsigned* bar, volatile LAS unsigned* st) {
    XcdBarrier b; b.bar = bar; b.x = xb_xcc_id(); b.st = st;
    if (threadIdx.x == 0) (void)xb_add(&bar[XB_XCNT(b.x)], 1u);
    return b;
}
__device__ __forceinline__ void xcd_barrier_complete(unsigned* bar, unsigned x, unsigned& nloc, unsigned& nx) {
    const unsigned G = gridDim.x * gridDim.y * gridDim.z;
    unsigned sum, cnt, mine, sp = 0u;
    for (;;) {
        sum = 0u; cnt = 0u; mine = 0u;
#pragma unroll
        for (unsigned j = 0; j < 16; ++j) { const unsigned c = xb_ld(&bar[XB_XCNT(j)]); sum += c; cnt += (c > 0u) ? 1u : 0u; mine = (j == x) ? c : mine; }
        if (sum == G) break;
        __builtin_amdgcn_s_sleep(1);
        if ((++sp & 255u) == 0u) { if (xb_ld(&bar[XB_TMO])) break; if (sp > XB_SPIN_CAP) { atomicAdd(&bar[XB_TMO], 1u); break; } }
    }
    nloc = mine > 0u ? mine : 1u; nx = cnt > 0u ? cnt : 1u;
}

__device__ __forceinline__ void xcd_barrier(const XcdBarrier& b) {
    asm volatile("s_waitcnt vmcnt(0)" ::: "memory");
    __syncthreads();
    if (threadIdx.x == 0) {
        unsigned* bar = b.bar;
        __builtin_amdgcn_s_waitcnt(0);
        unsigned nloc = b.st[0], nx = b.st[1];
        if (nloc == 0u) { xcd_barrier_complete(bar, b.x, nloc, nx); b.st[0] = nloc; b.st[1] = nx; }
        const unsigned old = xb_add(&bar[XB_XSUB(b.x)], 1u);
        const unsigned gen = old / nloc;
        if (old + 1u == (gen + 1u) * nloc) {
            __builtin_amdgcn_fence(__ATOMIC_RELEASE, "agent");
            asm volatile("s_waitcnt vmcnt(0)" ::: "memory");
            const unsigned og = xb_add(&bar[XB_TOP], 1u);
            const unsigned tg = og / nx;
            if (og + 1u == (tg + 1u) * nx) xb_add(&bar[XB_TOPGEN], 1u);
            else XB_SPIN(xb_ld(&bar[XB_TOPGEN]) == tg, bar);
            __builtin_amdgcn_fence(__ATOMIC_ACQUIRE, "agent");
            xb_add(&bar[XB_XGEN(b.x)], 1u);
            asm volatile("s_waitcnt vmcnt(0)" ::: "memory");
        } else {
            XB_SPIN(xb_ld(&bar[XB_XGEN(b.x)]) == gen, bar);
            __builtin_amdgcn_fence(__ATOMIC_ACQUIRE, "agent");
            asm volatile("s_waitcnt vmcnt(0)" ::: "memory");
        }
    }
    __syncthreads();
}

#ifndef ONE_LAUNCH
#define ONE_LAUNCH 1
#endif
constexpr int NPHASE = 8;
__global__ void __launch_bounds__(NTHR, 2) hybrid_fwd(Params p) {
    extern __shared__ __attribute__((aligned(16))) unsigned char lds_raw[];
    LAS unsigned char* lds = (LAS unsigned char*)lds_raw;
    const int tid = threadIdx.x, lane = tid & 63, wave = __builtin_amdgcn_readfirstlane(tid >> 6), G = gridDim.x, bid = blockIdx.x;
    unsigned char* ws = p.ws;
    volatile LAS unsigned* xst = (volatile LAS unsigned*)(lds + 139264);
    if (tid < 2) xst[tid] = 0u;
    __syncthreads();
    XcdBarrier xbar; xbar.bar = (unsigned*)(ws + WS_END); xbar.x = 0; xbar.st = xst;
    if (ONE_LAUNCH && p.hi - p.lo > 1) { xbar = xcd_barrier_post((unsigned*)(ws + WS_END), xst); cg::this_grid().sync(); }
    const pg8::bf16_t* N1 = (const pg8::bf16_t*)p.out;
#ifdef ONLY
#define PH(k) if ((k) == ONLY && p.lo <= (k) && (k) < p.hi)
#else
#define PH(k) if (p.lo <= (k) && (k) < p.hi)
#endif
#define SEAM(k) do { if (ONE_LAUNCH && p.lo <= (k) && (k) + 1 < p.hi) { xcd_barrier(xbar); } } while (0)
#define FRESH_IDS int tid = threadIdx.x; asm volatile("" : "+v"(tid)); const int lane = tid & 63, wave = __builtin_amdgcn_readfirstlane(tid >> 6); (void)lane; (void)wave
    unsigned char* big = ws + WS_BIG;
    PH(0) { FRESH_IDS; phase0(p, lds, G, bid, wave, lane); SEAM(0); }
    PH(1) { FRESH_IDS; pg8::Gemm g{N1, (const pg8::bf16_t*)(ws + WS_WIN), T, 8192, 1024, 2048, 1024}; pg8::StaticOrder S; S.init(T, 8192, G, bid);
        pg8::EpiG1 E{(pg8::bf16_t*)(big + B_QKV), (pg8::bf16_t*)(big + B_GG), (pg8::bf16_t*)p.out + 1024, (pg8::bf16_t*)(big + B_PR), C2};
        pg8::gemm_phase<pg8::EpiG1, pg8::StaticOrder, true, true>(lds, g, S, E); SEAM(1); }
    PH(2) { FRESH_IDS; phase_attn(p, lds, G, bid, tid); phase_conv(p, G, bid, tid); SEAM(2); }
    PH(3) { FRESH_IDS; pg8::Gemm g{(const pg8::bf16_t*)p.out, (const pg8::bf16_t*)(ws + WS_WAC), T, 1024, 1024, 2048, 2048}; pg8::SplitKOrder S; S.base.init(T, 1024, G, bid);
        pg8::EpiMerged E{(const pg8::bf16_t*)(big + B_GG), (pg8::bf16_t*)(big + B_MG)};
        pg8::gemm_phase<pg8::EpiMerged, pg8::SplitKOrder, false, true>(lds, g, S, E); SEAM(3); }
    PH(4) { FRESH_IDS; pg8::Gemm g{(const pg8::bf16_t*)(big + B_MG), (const pg8::bf16_t*)(ws + WS_WOUT), T, 1024, 1024, 1024, 1024}; pg8::StaticOrder S; S.init(T, 1024, G, bid);
        pg8::EpiResid E{p.x, p.out, (pg8::bf16_t*)(big + B_H2B), (float*)(ws + WS_SSQ)};
        pg8::gemm_phase<pg8::EpiResid, pg8::StaticOrder, false, true>(lds, g, S, E); SEAM(4); }
    PH(5) { FRESH_IDS; pg8::Gemm g{(const pg8::bf16_t*)(big + B_H2B), (const pg8::bf16_t*)(ws + WS_WQ), T, 2048, 1024, 1024, 1024}; pg8::StaticOrder S; S.init(T, 2048, G, bid);
        pg8::EpiRowScale E{(const float*)(ws + WS_SSQ), (pg8::bf16_t*)(big + B_QP)};
        pg8::gemm_phase<pg8::EpiRowScale, pg8::StaticOrder, true, true>(lds, g, S, E); SEAM(5); }
    PH(6) { FRESH_IDS; phase_topk(p, lds, G, bid, wave, lane); SEAM(6); }
    PH(7) { FRESH_IDS; phase_gather(p, lds, G, bid, wave, lane); }
#undef PH
#undef SEAM
}

extern "C" void kernel_launch(void* const* d_in, const int* in_sizes, int n_in, void* d_out, int out_size, void* d_ws, size_t ws_size, hipStream_t stream) {
    static int grid = 0;
    if (grid == 0) {
        if (n_in != 15 || out_size != T * DM || ws_size < WS_END) { fprintf(stderr, "kernel_launch: unexpected problem (n_in %d out %d ws %zu)\n", n_in, out_size, ws_size); grid = -1; return; }
        int dev = 0, cus = 0, per_cu = 0;
        hipGetDevice(&dev); hipDeviceGetAttribute(&cus, hipDeviceAttributeMultiprocessorCount, dev);
        if (hipFuncSetAttribute((const void*)hybrid_fwd, hipFuncAttributeMaxDynamicSharedMemorySize, LDS_BYTES) != hipSuccess) { fprintf(stderr, "kernel_launch: hipFuncSetAttribute failed\n"); grid = -1; return; }
        if (hipOccupancyMaxActiveBlocksPerMultiprocessor(&per_cu, (const void*)hybrid_fwd, NTHR, LDS_BYTES) != hipSuccess || per_cu < 1) { fprintf(stderr, "kernel_launch: occupancy query says %d\n", per_cu); per_cu = 1; }
        (void)hipGetLastError();
        grid = cus * per_cu;
    }
    if (grid < 0) return;
    Params p{};
    p.x = (const float*)d_in[0]; p.norm1_g = (const float*)d_in[1]; p.w_in = (const float*)d_in[2]; p.lambda_qk = (const float*)d_in[3]; p.subln_g = (const float*)d_in[4];
    p.conv_w = (const float*)d_in[5]; p.w_attn_o = (const float*)d_in[6]; p.w_conv_o = (const float*)d_in[7]; p.w_out = (const float*)d_in[8]; p.norm2_g = (const float*)d_in[9];
    p.w_query = (const float*)d_in[10]; p.sub_keys = (const float*)d_in[11]; p.expert_u = (const float*)d_in[12]; p.expert_v = (const float*)d_in[13]; p.final_g = (const float*)d_in[14];
    p.out = (float*)d_out; p.ws = (unsigned char*)d_ws;
#if ONE_LAUNCH
    p.lo = 0; p.hi = NPHASE;
    (void)hipMemsetAsync((char*)d_ws + WS_END, 0, 16384, stream);
    void* args[] = {&p};
    hipError_t e = hipLaunchCooperativeKernel((const void*)hybrid_fwd, dim3(grid), dim3(NTHR), args, LDS_BYTES, stream);
    if (e != hipSuccess) fprintf(stderr, "cooperative launch failed: %s (grid %d)\n", hipGetErrorString(e), grid);
#else
    for (int k = 0; k < NPHASE; ++k) {
        p.lo = k; p.hi = k + 1; hipLaunchKernelGGL(hybrid_fwd, dim3(grid), dim3(NTHR), LDS_BYTES, stream, p); }
#endif
}
```

```cpp
#include <hip/hip_runtime.h>
#include <hip/hip_cooperative_groups.h>
#include <cstdio>
#include <cstdint>
namespace cg = cooperative_groups;
namespace pg8 {
#define PG8_LAS __attribute__((address_space(3)))
typedef unsigned short bf16_t;
typedef short bf16x8 __attribute__((ext_vector_type(8)));
typedef float f32x4 __attribute__((ext_vector_type(4)));
typedef unsigned u32x4 __attribute__((ext_vector_type(4)));
constexpr int BM = 256, BK = 64, HALF = 128, HTB = HALF * BK * 2  , STAGE_BYTES = 8 * HTB, NXCD = 8, WGM = 8;

__host__ __device__ __forceinline__ int lds_byte(int r, int c) { const int st = (r >> 4) * 2 + (c >> 5), rr = r & 15, cc = c & 31, ob = rr * 64 + cc * 2; return st * 1024 + (ob ^ (((ob >> 9) & 1) << 5)); }
__host__ __device__ __forceinline__ void stage_rc(int b, int& R, int& C) { const int st = b / 1024, sb = b % 1024, swz = sb ^ (((sb >> 9) & 1) << 5); R = (st >> 1) * 16 + swz / 64; C = (st & 1) * 32 + (swz % 64) / 2; }
__host__ __device__ __forceinline__ int perm32(int rho) { const int n = rho >> 4, i = rho & 15; return 8 * (i >> 2) + 4 * n + (i & 3); }

struct Unit { int pm, pn, kh; };
struct Gemm { const bf16_t* A; const bf16_t* Bt; int M, N, K, lda, ldb; };
struct StaticOrder {
    int nM, nN, nwg, G, c;
    __host__ __device__ void init(int M, int N, int G_, int c_) { nM = M / BM; nN = N / BM; nwg = nM * nN; G = G_; c = c_; }
    __host__ __device__ bool next(int i, Unit& u) const {
        const long L = (long)i * G + c; if (L >= nwg) return false;
        int wgid = (int)L; { const int q = nwg / NXCD, r = nwg % NXCD, xcd = wgid % NXCD, off = wgid / NXCD; wgid = (xcd < r ? xcd * (q + 1) : r * (q + 1) + (xcd - r) * q) + off; }
        const int nig = WGM * nN, gid = wgid / nig, fm = gid * WGM, gsz = (nM - fm) < WGM ? (nM - fm) : WGM;
        u.pm = fm + ((wgid % nig) % gsz); u.pn = (wgid % nig) / gsz; u.kh = 0; return true;
    }
    __device__ __forceinline__ void a_ready(const Unit&) const {}
    __device__ __forceinline__ void done(const Unit&) const {}
};
struct SplitKOrder {
    StaticOrder base;
    __host__ __device__ bool next(int i, Unit& u) const { if (!base.next(i >> 1, u)) return false; u.kh = i & 1; return true; }
    __device__ __forceinline__ void a_ready(const Unit&) const {}
    __device__ __forceinline__ void done(const Unit&) const {}
};
__device__ __forceinline__ unsigned cvt_pk_bf16(float lo, float hi) { unsigned r; asm volatile("v_cvt_pk_bf16_f32 %0, %1, %2" : "=v"(r) : "v"(lo), "v"(hi)); return r; }
typedef float f32x2 __attribute__((ext_vector_type(2)));
typedef float f32x2 __attribute__((ext_vector_type(2)));
typedef unsigned u32x2 __attribute__((ext_vector_type(2)));
__device__ __forceinline__ void unpack8(const u32x4 w, float (&f)[8]) {
    f[0] = __builtin_bit_cast(float, w.x << 16); f[1] = __builtin_bit_cast(float, w.x & 0xffff0000u);
    f[2] = __builtin_bit_cast(float, w.y << 16); f[3] = __builtin_bit_cast(float, w.y & 0xffff0000u);
    f[4] = __builtin_bit_cast(float, w.z << 16); f[5] = __builtin_bit_cast(float, w.z & 0xffff0000u);
    f[6] = __builtin_bit_cast(float, w.w << 16); f[7] = __builtin_bit_cast(float, w.w & 0xffff0000u);
}
__device__ __forceinline__ u32x4 pack8(const f32x4 v0, const f32x4 v1) { u32x4 w; w.x = cvt_pk_bf16(v0[0], v0[1]); w.y = cvt_pk_bf16(v0[2], v0[3]); w.z = cvt_pk_bf16(v1[0], v1[1]); w.w = cvt_pk_bf16(v1[2], v1[3]); return w; }
struct EpiPlain {
    static constexpr bool PERM = true, AFTER_DRAIN = false, MID = false;
    bf16_t* O; int ldc;
    __device__ __forceinline__ void operator()(const f32x4 (&acc)[2][2][4][2], const Unit& u, int wr, int wc, int fr, int fq) const {
        const int row0 = u.pm * BM + wr * 64 + fr, col0 = u.pn * BM + wc * 32 + 8 * fq;
#pragma unroll
        for (int ai = 0; ai < 2; ++ai)
#pragma unroll
            for (int m = 0; m < 4; ++m) { bf16_t* rowp = O + (size_t)(row0 + ai * HALF + m * 16) * ldc + col0;
#pragma unroll
                for (int bj = 0; bj < 2; ++bj) *(u32x4*)(rowp + bj * HALF) = pack8(acc[ai][bj][m][0], acc[ai][bj][m][1]); }
    }
};
struct EpiQKVG {
    static constexpr bool PERM = true, AFTER_DRAIN = false, MID = false;
    bf16_t* QKV; bf16_t* GG; float c2;
    __device__ __forceinline__ void operator()(const f32x4 (&acc)[2][2][4][2], const Unit& u, int wr, int wc, int fr, int fq) const {
        int colt = u.pn * BM; bf16_t* base = QKV; int ldc = 3072; float sc = 1.f; bool sig = false;
        if (colt < 1024) sc = c2; else if (colt >= 3072) { base = GG; ldc = 2048; colt -= 3072; sig = true; }
        const int row0 = u.pm * BM + wr * 64 + fr, col0 = colt + wc * 32 + 8 * fq;
#pragma unroll
        for (int ai = 0; ai < 2; ++ai)
#pragma unroll
            for (int m = 0; m < 4; ++m) { bf16_t* rowp = base + (size_t)(row0 + ai * HALF + m * 16) * ldc + col0;
#pragma unroll
                for (int bj = 0; bj < 2; ++bj) { f32x4 v0 = acc[ai][bj][m][0], v1 = acc[ai][bj][m][1];
                    if (sig) {
#pragma unroll
                        for (int i = 0; i < 4; ++i) { v0[i] = __builtin_amdgcn_rcpf(1.f + __expf(-v0[i])); v1[i] = __builtin_amdgcn_rcpf(1.f + __expf(-v1[i])); }
                    } else { v0 = v0 * sc; v1 = v1 * sc; }
                    *(u32x4*)(rowp + bj * HALF) = pack8(v0, v1); } }
    }
};
struct EpiGateA {
    static constexpr bool PERM = true, AFTER_DRAIN = false, MID = false;
    const bf16_t* GG; float* TMP;
    __device__ __forceinline__ void operator()(const f32x4 (&acc)[2][2][4][2], const Unit& u, int wr, int wc, int fr, int fq) const {
        const int row0 = u.pm * BM + wr * 64 + fr, col0 = u.pn * BM + wc * 32 + 8 * fq;
#pragma unroll
        for (int ai = 0; ai < 2; ++ai)
#pragma unroll
            for (int m = 0; m < 4; ++m) { const size_t row = (size_t)(row0 + ai * HALF + m * 16);
#pragma unroll
                for (int bj = 0; bj < 2; ++bj) { const int col = col0 + bj * HALF; float g[8]; unpack8(*(const u32x4*)(GG + row * 2048 + col), g);
                    f32x4 v0 = acc[ai][bj][m][0], v1 = acc[ai][bj][m][1];
                    v0[0] *= g[0]; v0[1] *= g[1]; v0[2] *= g[2]; v0[3] *= g[3]; v1[0] *= g[4]; v1[1] *= g[5]; v1[2] *= g[6]; v1[3] *= g[7];
                    *(f32x4*)(TMP + row * 1024 + col) = v0; *(f32x4*)(TMP + row * 1024 + col + 4) = v1; } }
    }
};
struct EpiGateC {
    static constexpr bool PERM = true, AFTER_DRAIN = false, MID = false;
    const bf16_t* GG; const float* TMP; bf16_t* MG;
    __device__ __forceinline__ void operator()(const f32x4 (&acc)[2][2][4][2], const Unit& u, int wr, int wc, int fr, int fq) const {
        const int row0 = u.pm * BM + wr * 64 + fr, col0 = u.pn * BM + wc * 32 + 8 * fq;
#pragma unroll
        for (int ai = 0; ai < 2; ++ai)
#pragma unroll
            for (int m = 0; m < 4; ++m) { const size_t row = (size_t)(row0 + ai * HALF + m * 16);
#pragma unroll
                for (int bj = 0; bj < 2; ++bj) { const int col = col0 + bj * HALF; float g[8]; unpack8(*(const u32x4*)(GG + row * 2048 + 1024 + col), g);
                    const f32x4 t0 = *(const f32x4*)(TMP + row * 1024 + col), t1 = *(const f32x4*)(TMP + row * 1024 + col + 4);
                    f32x4 v0 = acc[ai][bj][m][0], v1 = acc[ai][bj][m][1];
                    v0[0] = t0[0] + v0[0] * g[0]; v0[1] = t0[1] + v0[1] * g[1]; v0[2] = t0[2] + v0[2] * g[2]; v0[3] = t0[3] + v0[3] * g[3];
                    v1[0] = t1[0] + v1[0] * g[4]; v1[1] = t1[1] + v1[1] * g[5]; v1[2] = t1[2] + v1[2] * g[6]; v1[3] = t1[3] + v1[3] * g[7];
                    *(u32x4*)(MG + row * 1024 + col) = pack8(v0, v1); } }
    }
};
struct EpiG1 {
    static constexpr bool PERM = true, AFTER_DRAIN = false, MID = false;
    bf16_t* QKV; bf16_t* GG; bf16_t* CB; bf16_t* PR; float c2;
    __device__ __forceinline__ void operator()(const f32x4 (&acc)[2][2][4][2], const Unit& u, int wr, int wc, int fr, int fq) const {
        int colt = u.pn * BM; const int row0 = u.pm * BM + wr * 64 + fr;
        if (colt >= 6144) {
            const int ch0 = (colt - 6144) / 2 + wc * 16 + 4 * fq;
#pragma unroll
            for (int ai = 0; ai < 2; ++ai)
#pragma unroll
                for (int m = 0; m < 4; ++m) { bf16_t* rowp = PR + (size_t)(row0 + ai * HALF + m * 16) * 1024 + ch0;
#pragma unroll
                    for (int bj = 0; bj < 2; ++bj) { const f32x4 v0 = acc[ai][bj][m][0], v1 = acc[ai][bj][m][1];
                        u32x2 w; w.x = cvt_pk_bf16(v0[0] * v0[1], v0[2] * v0[3]); w.y = cvt_pk_bf16(v1[0] * v1[1], v1[2] * v1[3]);
                        *(u32x2*)(rowp + bj * (HALF / 2)) = w; } }
            return;
        }
        bf16_t* base = QKV; int ldc = 3072; float sc = 1.f; bool sig = false;
        if (colt < 1024) sc = c2; else if (colt >= 5120) { base = CB; ldc = 2048; colt -= 5120; } else if (colt >= 3072) { base = GG; ldc = 2048; colt -= 3072; sig = true; }
        const int col0 = colt + wc * 32 + 8 * fq;
#pragma unroll
        for (int ai = 0; ai < 2; ++ai)
#pragma unroll
            for (int m = 0; m < 4; ++m) { bf16_t* rowp = base + (size_t)(row0 + ai * HALF + m * 16) * ldc + col0;
#pragma unroll
                for (int bj = 0; bj < 2; ++bj) { f32x4 v0 = acc[ai][bj][m][0], v1 = acc[ai][bj][m][1];
                    if (sig) {
#pragma unroll
                        for (int i = 0; i < 4; ++i) { v0[i] = __builtin_amdgcn_rcpf(1.f + __expf(-v0[i])); v1[i] = __builtin_amdgcn_rcpf(1.f + __expf(-v1[i])); }
                    } else { v0 = v0 * sc; v1 = v1 * sc; }
                    *(u32x4*)(rowp + bj * HALF) = pack8(v0, v1); } }
    }
};
struct EpiMerged {
    static constexpr bool PERM = true, AFTER_DRAIN = false, MID = true;
    const bf16_t* GG; bf16_t* MG;
    __device__ __forceinline__ void mid(f32x4 (&acc)[2][2][4][2], const Unit& u, int wr, int wc, int fr, int fq) const {
        const int row0 = u.pm * BM + wr * 64 + fr, col0 = u.pn * BM + wc * 32 + 8 * fq;
#pragma unroll
        for (int ai = 0; ai < 2; ++ai)
#pragma unroll
            for (int m = 0; m < 4; ++m) { const size_t row = (size_t)(row0 + ai * HALF + m * 16);
#pragma unroll
                for (int bj = 0; bj < 2; ++bj) { const int col = col0 + bj * HALF; float ga[8], gc[8];
                    unpack8(*(const u32x4*)(GG + row * 2048 + col), ga); unpack8(*(const u32x4*)(GG + row * 2048 + 1024 + col), gc);
#pragma unroll
                    for (int i = 0; i < 4; ++i) { acc[ai][bj][m][0][i] *= ga[i] * __builtin_amdgcn_rcpf(gc[i]); acc[ai][bj][m][1][i] *= ga[4 + i] * __builtin_amdgcn_rcpf(gc[4 + i]); }
                    asm volatile("" ::: "memory"); } }
    }
    __device__ __forceinline__ void operator()(const f32x4 (&acc)[2][2][4][2], const Unit& u, int wr, int wc, int fr, int fq) const {
        const int row0 = u.pm * BM + wr * 64 + fr, col0 = u.pn * BM + wc * 32 + 8 * fq;
#pragma unroll
        for (int ai = 0; ai < 2; ++ai)
#pragma unroll
            for (int m = 0; m < 4; ++m) { const size_t row = (size_t)(row0 + ai * HALF + m * 16);
#pragma unroll
                for (int bj = 0; bj < 2; ++bj) { const int col = col0 + bj * HALF; float gc[8]; unpack8(*(const u32x4*)(GG + row * 2048 + 1024 + col), gc);
                    f32x4 v0 = acc[ai][bj][m][0], v1 = acc[ai][bj][m][1];
#pragma unroll
                    for (int i = 0; i < 4; ++i) { v0[i] *= gc[i]; v1[i] *= gc[4 + i]; }
                    *(u32x4*)(MG + row * 1024 + col) = pack8(v0, v1); } }
    }
};
struct EpiResid {
    static constexpr bool PERM = true, AFTER_DRAIN = false, MID = false;
    const float* X; float* H2; bf16_t* H2B; float* SSQ;
    __device__ __forceinline__ void operator()(const f32x4 (&acc)[2][2][4][2], const Unit& u, int wr, int wc, int fr, int fq) const {
        const int row0 = u.pm * BM + wr * 64 + fr, col0 = u.pn * BM + wc * 32 + 8 * fq;
#pragma unroll
        for (int ai = 0; ai < 2; ++ai)
#pragma unroll
            for (int m = 0; m < 4; ++m) { const size_t row = (size_t)(row0 + ai * HALF + m * 16); float s = 0.f;
#pragma unroll
                for (int bj = 0; bj < 2; ++bj) { const size_t o = row * 1024 + col0 + bj * HALF;
                    const f32x4 v0 = acc[ai][bj][m][0] + *(const f32x4*)(X + o), v1 = acc[ai][bj][m][1] + *(const f32x4*)(X + o + 4);
                    *(f32x4*)(H2 + o) = v0; *(f32x4*)(H2 + o + 4) = v1; *(u32x4*)(H2B + o) = pack8(v0, v1);
                    s += (v0[0] * v0[0] + v0[1] * v0[1]) + (v0[2] * v0[2] + v0[3] * v0[3]) + (v1[0] * v1[0] + v1[1] * v1[1]) + (v1[2] * v1[2] + v1[3] * v1[3]); }
                s += __shfl_xor(s, 16); s += __shfl_xor(s, 32);
                if (fq == 0) SSQ[row * 16 + u.pn * 4 + wc] = s; }
    }
};
struct EpiRowScale {
    static constexpr bool PERM = true, AFTER_DRAIN = false, MID = false;
    const float* SSQ; bf16_t* O;
    __device__ __forceinline__ void operator()(const f32x4 (&acc)[2][2][4][2], const Unit& u, int wr, int wc, int fr, int fq) const {
        const int row0 = u.pm * BM + wr * 64 + fr, col0 = u.pn * BM + wc * 32 + 8 * fq;
#pragma unroll
        for (int ai = 0; ai < 2; ++ai)
#pragma unroll
            for (int m = 0; m < 4; ++m) { const size_t row = (size_t)(row0 + ai * HALF + m * 16);
                const f32x4* sp = (const f32x4*)(SSQ + row * 16); const f32x4 a = sp[0] + sp[1], b = sp[2] + sp[3], c = a + b;
                const float rs = rsqrtf(((c[0] + c[1]) + (c[2] + c[3])) * (1.f / 1024.f) + 1e-6f);
#pragma unroll
                for (int bj = 0; bj < 2; ++bj) *(u32x4*)(O + row * 2048 + col0 + bj * HALF) = pack8(acc[ai][bj][m][0] * rs, acc[ai][bj][m][1] * rs); }
    }
};
template <class Epi, class Sched, bool ALIGN_EPI = false, bool SP2 = false>
__device__ __forceinline__ void gemm_phase(PG8_LAS unsigned char* lds, const Gemm g, const Sched& S, const Epi& E) {
    const int tid = threadIdx.x, wid = __builtin_amdgcn_readfirstlane(tid >> 6), lane = tid & 63, wr = wid >> 2, wc = wid & 3, fr = lane & 15, fq = lane >> 4;
    const int K = g.K, nt = K / BK;
    unsigned voffA[2], voffB[2];
#pragma unroll
    for (int i = 0; i < 2; ++i) { int R, C; stage_rc(tid * 16 + i * 8192, R, C); const int Rb = Epi::PERM ? ((R & ~31) + perm32(R & 31)) : R;
        voffA[i] = (unsigned)(R * g.lda + C) * 2u; voffB[i] = (unsigned)(Rb * g.ldb + C) * 2u; }
    const size_t kstep = (size_t)(BK * 2);
    const size_t hstep = (size_t)HALF * g.ldb * 2;
    const size_t tstep = 2 * hstep;
    const size_t hstepA = (size_t)HALF * g.lda * 2, tstepA = 2 * hstepA;
    const unsigned ldsw = (unsigned)wid * 1024u;
    const int aoff = lds_byte(wr * 64 + fr, fq * 8), boff = lds_byte(wc * 32 + fr, fq * 8);
#define PG8_SA(b, h) (((b) * 2 + (h)) * HTB)
#define PG8_SB(b, h) ((4 + (b) * 2 + (h)) * HTB)
#define PG8_STAGE(bufoff, gbase, voff) do { _Pragma("unroll") for (int _i = 0; _i < 2; ++_i) \
        __builtin_amdgcn_global_load_lds((const unsigned*)((const char*)(gbase) + (voff)[_i]), (PG8_LAS unsigned*)(lds + (bufoff) + ldsw + _i * 8192), 16, 0, 0); } while (0)
#define PG8_LDA(dst, b, h) do { _Pragma("unroll") for (int m = 0; m < 4; ++m) _Pragma("unroll") for (int k = 0; k < 2; ++k) dst[m][k] = *(const PG8_LAS bf16x8*)(lds + PG8_SA(b, h) + aoff + m * 2048 + k * 1024); } while (0)
#define PG8_LDB(dst, b, h) do { _Pragma("unroll") for (int n = 0; n < 2; ++n) _Pragma("unroll") for (int k = 0; k < 2; ++k) dst[n][k] = *(const PG8_LAS bf16x8*)(lds + PG8_SB(b, h) + boff + n * 2048 + k * 1024); } while (0)
#define PG8_MMA(ai, bj, At, Bt) do { __builtin_amdgcn_s_setprio(1); _Pragma("unroll") for (int m = 0; m < 4; ++m) _Pragma("unroll") for (int n = 0; n < 2; ++n) _Pragma("unroll") for (int k = 0; k < 2; ++k) \
        acc[ai][bj][m][n] = __builtin_amdgcn_mfma_f32_16x16x32_bf16(Bt[n][k], At[m][k], acc[ai][bj][m][n], 0, 0, 0); __builtin_amdgcn_s_setprio(0); } while (0)
#define PG8_WAIT_V(n) asm volatile("s_waitcnt vmcnt(" #n ")" ::: "memory")
#define PG8_WAIT_L(n) asm volatile("s_waitcnt lgkmcnt(" #n ")" ::: "memory")
#define PG8_BAR __builtin_amdgcn_s_barrier()
#define PG8_SCHED __builtin_amdgcn_sched_barrier(0)
    Unit cur, nxt; int ui = 0;
    if (!S.next(0, cur)) return;
    f32x4 acc[2][2][4][2];
#pragma unroll
    for (int a = 0; a < 2; ++a)
#pragma unroll
        for (int b = 0; b < 2; ++b)
#pragma unroll
            for (int m = 0; m < 4; ++m)
#pragma unroll
                for (int n = 0; n < 2; ++n) acc[a][b][m][n] = (f32x4){0.f, 0.f, 0.f, 0.f};
    bf16x8 At[4][2], B0[2][2], B1[2][2];
    const char* cA = (const char*)g.A + (size_t)cur.pm * tstepA + (size_t)cur.kh * K * 2; const char* cB = (const char*)g.Bt + (size_t)cur.pn * tstep + (size_t)cur.kh * K * 2;
    S.a_ready(cur);
    if constexpr (SP2) {
        PG8_STAGE(PG8_SB(0, 0), cB, voffB); PG8_STAGE(PG8_SB(0, 1), cB + hstep, voffB); PG8_STAGE(PG8_SA(0, 0), cA, voffA); PG8_STAGE(PG8_SA(0, 1), cA + hstepA, voffA);
        if (wr == 1) PG8_BAR;
        PG8_WAIT_V(2); PG8_BAR;
        PG8_STAGE(PG8_SB(1, 0), cB + kstep, voffB); PG8_STAGE(PG8_SA(1, 0), cA + kstep, voffA); PG8_STAGE(PG8_SB(1, 1), cB + hstep + kstep, voffB);
        PG8_WAIT_V(6); PG8_BAR;
    } else {
        PG8_STAGE(PG8_SB(0, 0), cB, voffB); PG8_STAGE(PG8_SA(0, 0), cA, voffA); PG8_STAGE(PG8_SB(0, 1), cB + hstep, voffB); PG8_STAGE(PG8_SA(0, 1), cA + hstepA, voffA);
        if (wr == 1) PG8_BAR;
        PG8_WAIT_V(4); PG8_BAR;
        PG8_STAGE(PG8_SB(1, 0), cB + kstep, voffB); PG8_STAGE(PG8_SA(1, 0), cA + kstep, voffA); PG8_STAGE(PG8_SB(1, 1), cB + hstep + kstep, voffB);
        PG8_WAIT_V(6); PG8_BAR;
    }
    for (;;) {
        const bool has_next = S.next(ui + 1, nxt);
        const char* nA = has_next ? (const char*)g.A + (size_t)nxt.pm * tstepA + (size_t)nxt.kh * K * 2 : cA; const char* nB = has_next ? (const char*)g.Bt + (size_t)nxt.pn * tstep + (size_t)nxt.kh * K * 2 : cB;
        for (int t = 0; t < nt; t += 2) {
            const bool last = (t == nt - 2);
            const char* a1 = cA + (size_t)(t + 1) * kstep;
            const char* a2 = last ? nA : cA + (size_t)(t + 2) * kstep; const char* b2 = last ? nB : cB + (size_t)(t + 2) * kstep;
            const char* a3 = a2 + kstep; const char* b3 = b2 + kstep;
            if (last && has_next) S.a_ready(nxt);
            if constexpr (SP2) {
            PG8_LDB(B0, 0, 0); PG8_LDB(B1, 0, 1); PG8_SCHED; PG8_LDA(At, 0, 0); PG8_STAGE(PG8_SA(1, 1), a1 + hstepA, voffA);
            PG8_WAIT_V(8); PG8_WAIT_L(0); PG8_BAR; PG8_MMA(0, 0, At, B0); PG8_MMA(0, 1, At, B1); PG8_BAR; PG8_SCHED;
            PG8_LDA(At, 0, 1); PG8_STAGE(PG8_SB(0, 0), b2, voffB); PG8_STAGE(PG8_SB(0, 1), b2 + hstep, voffB); PG8_STAGE(PG8_SA(0, 0), a2, voffA);
            PG8_WAIT_V(8); PG8_WAIT_L(0); PG8_BAR; PG8_MMA(1, 0, At, B0); PG8_MMA(1, 1, At, B1); PG8_BAR; PG8_SCHED;
            PG8_LDB(B0, 1, 0); PG8_LDB(B1, 1, 1); PG8_SCHED; PG8_LDA(At, 1, 0); PG8_STAGE(PG8_SA(0, 1), a2 + hstepA, voffA);
            PG8_WAIT_V(8); PG8_WAIT_L(0); PG8_BAR; PG8_MMA(0, 0, At, B0); PG8_MMA(0, 1, At, B1); PG8_BAR; PG8_SCHED;
            PG8_LDA(At, 1, 1); PG8_STAGE(PG8_SB(1, 0), b3, voffB); PG8_STAGE(PG8_SB(1, 1), b3 + hstep, voffB); PG8_STAGE(PG8_SA(1, 0), a3, voffA);
            PG8_WAIT_V(8); PG8_WAIT_L(0); PG8_BAR; PG8_MMA(1, 0, At, B0); PG8_MMA(1, 1, At, B1); PG8_BAR; PG8_SCHED;
            } else {
            PG8_LDB(B0, 0, 0); PG8_SCHED; PG8_LDA(At, 0, 0); PG8_STAGE(PG8_SA(1, 1), a1 + hstepA, voffA);
            PG8_WAIT_L(8); PG8_BAR; PG8_WAIT_L(0); PG8_MMA(0, 0, At, B0); PG8_BAR; PG8_SCHED;
            PG8_LDB(B1, 0, 1); PG8_STAGE(PG8_SB(0, 0), b2, voffB);
            PG8_BAR; PG8_WAIT_L(0); PG8_MMA(0, 1, At, B1); PG8_BAR;
            PG8_LDA(At, 0, 1); PG8_STAGE(PG8_SA(0, 0), a2, voffA);
            PG8_BAR; PG8_WAIT_L(0); PG8_MMA(1, 0, At, B0); PG8_BAR; PG8_SCHED;
            PG8_STAGE(PG8_SB(0, 1), b2 + hstep, voffB);
            PG8_WAIT_V(6); PG8_BAR; PG8_MMA(1, 1, At, B1); PG8_BAR;
            PG8_LDB(B0, 1, 0); PG8_SCHED; PG8_LDA(At, 1, 0); PG8_STAGE(PG8_SA(0, 1), a2 + hstepA, voffA);
            PG8_WAIT_L(8); PG8_BAR; PG8_WAIT_L(0); PG8_MMA(0, 0, At, B0); PG8_BAR; PG8_SCHED;
            PG8_LDB(B1, 1, 1); PG8_STAGE(PG8_SB(1, 0), b3, voffB);
            PG8_BAR; PG8_WAIT_L(0); PG8_MMA(0, 1, At, B1); PG8_BAR;
            PG8_LDA(At, 1, 1); PG8_STAGE(PG8_SA(1, 0), a3, voffA);
            PG8_BAR; PG8_WAIT_L(0); PG8_MMA(1, 0, At, B0); PG8_BAR; PG8_SCHED;
            PG8_STAGE(PG8_SB(1, 1), b3 + hstep, voffB);
            PG8_WAIT_V(6); PG8_BAR; PG8_MMA(1, 1, At, B1); PG8_BAR;
            }
        }
        if constexpr (ALIGN_EPI) { if (wr == 0) PG8_BAR; }
        bool keep_acc = false;
        if constexpr (Epi::MID) { if (cur.kh == 0) { E.mid(acc, cur, wr, wc, fr, fq); keep_acc = true; } }
        if constexpr (!Epi::AFTER_DRAIN) { if (!keep_acc) { E(acc, cur, wr, wc, fr, fq); S.done(cur); } }
        if (!has_next) break;
        if (!keep_acc)
#pragma unroll
        for (int a = 0; a < 2; ++a)
#pragma unroll
            for (int b = 0; b < 2; ++b)
#pragma unroll
                for (int m = 0; m < 4; ++m)
#pragma unroll
                    for (int n = 0; n < 2; ++n) acc[a][b][m][n] = (f32x4){0.f, 0.f, 0.f, 0.f};
        cur = nxt; cA = nA; cB = nB; ++ui;
        if constexpr (ALIGN_EPI) { if (wr == 1) PG8_BAR; }
    }
    PG8_WAIT_V(0);
    if constexpr (!ALIGN_EPI) { if (wr == 0) PG8_BAR; }
    PG8_BAR;
    if constexpr (Epi::AFTER_DRAIN) { E.fused(acc, cur, wr, wc, fr, fq, lds, wid, lane); S.done(cur); }
#undef PG8_SA
#undef PG8_SB
#undef PG8_STAGE
#undef PG8_LDA
#undef PG8_LDB
#undef PG8_MMA
#undef PG8_WAIT_V
#undef PG8_WAIT_L
#undef PG8_BAR
#undef PG8_SCHED
}
}
#define LAS __attribute__((address_space(3)))
typedef unsigned short bf16;
typedef short bf16x8 __attribute__((ext_vector_type(8)));
typedef short s16x4 __attribute__((ext_vector_type(4)));
typedef float f32x4 __attribute__((ext_vector_type(4)));
typedef float f32x16 __attribute__((ext_vector_type(16)));
typedef unsigned u32x4 __attribute__((ext_vector_type(4)));
typedef unsigned u32x2 __attribute__((ext_vector_type(2)));
typedef float f32x2_t __attribute__((ext_vector_type(2))); typedef __bf16 bf16x2_t __attribute__((ext_vector_type(2)));

constexpr int T = 16384, DM = 1024, SEQ = 2048;
constexpr int NWAVES = 8, NTHR = 512;
constexpr int LDS_BYTES = 147456;
constexpr float EPS = 1e-6f;
constexpr float ESCALE = 64.f;
constexpr float C2 = 0.125f * 1.4426950408889634f;
constexpr size_t MiB = 1u << 20;
constexpr size_t WS_WIN = 0, WS_WAC = 16 * MiB, WS_WOUT = 20 * MiB, WS_WQ = 22 * MiB, WS_SUBK = 26 * MiB, WS_SSQ = 27 * MiB;
constexpr size_t WS_EU = 28 * MiB, WS_EV = 44 * MiB, WS_BIG = 60 * MiB, WS_END = 252 * MiB;
constexpr size_t B_QKV = 0, B_GG = 96 * MiB, B_PR = 160 * MiB, B_MG = 0, B_H2B = 32 * MiB, B_QP = 96 * MiB, B_SEL = 64 * MiB, B_GATE = 72 * MiB;

__device__ __forceinline__ unsigned cvtpk(float lo, float hi) { f32x2_t v = {lo, hi}; bf16x2_t b = __builtin_convertvector(v, bf16x2_t); return __builtin_bit_cast(unsigned, b); }
__device__ __forceinline__ float wave_sum(float v) {
#pragma unroll
    for (int o = 1; o < 64; o <<= 1) v += __shfl_xor(v, o);
    return v;
}
#define LDS_WAIT() asm volatile("s_waitcnt lgkmcnt(0)" ::: "memory")

struct Params {
    const float* x; const float* norm1_g; const float* w_in; const float* lambda_qk; const float* subln_g; const float* conv_w;
    const float* w_attn_o; const float* w_conv_o; const float* w_out; const float* norm2_g; const float* w_query; const float* sub_keys;
    const float* expert_u; const float* expert_v; const float* final_g;
    float* out; unsigned char* ws; int lo, hi;
};

__device__ __forceinline__ void transpose_item(const float* W, int K, int N, bf16* WT, int remap, int dpitch, int koff, const float* kscale, LAS float* scr, int item, int lane) {
    const int nblk = N / 32, kb = item / nblk, nb = item % nblk, k0 = 64 * kb, n0 = 32 * nb;
    int d0 = n0, dstr = 1;
    if (remap) { if (n0 < 3072) d0 = n0; else if (n0 < 4096) d0 = n0 + 2048; else if (n0 < 5120) { d0 = 6144 + 2 * (n0 - 4096); dstr = 2; } else if (n0 < 6144) { d0 = 6144 + 2 * (n0 - 5120) + 1; dstr = 2; } else d0 = n0 - 3072; }
#pragma unroll 8
    for (int i = 0; i < 32; ++i) { const int kk = 2 * i + (lane >> 5); float v = W[(size_t)(k0 + kk) * N + n0 + (lane & 31)]; if (kscale) v *= kscale[k0 + kk]; scr[kk * 33 + (lane & 31)] = v; }
    LDS_WAIT(); asm volatile("" ::: "memory");
    const int c = lane & 7;
#pragma unroll
    for (int j = 0; j < 4; ++j) { const int n = (lane >> 3) + 8 * j; const LAS float* sp = scr + (8 * c) * 33 + n;
        u32x4 o; o.x = cvtpk(sp[0 * 33], sp[1 * 33]); o.y = cvtpk(sp[2 * 33], sp[3 * 33]); o.z = cvtpk(sp[4 * 33], sp[5 * 33]); o.w = cvtpk(sp[6 * 33], sp[7 * 33]);
        *(u32x4*)(WT + (size_t)(d0 + n * dstr) * dpitch + koff + k0 + 8 * c) = o; }
    LDS_WAIT(); asm volatile("" ::: "memory");
}
__device__ __forceinline__ void cvt_flat(const float* src, bf16* dst, size_t n8, size_t gtid, size_t nthr) {
    for (size_t i = gtid; i < n8; i += nthr) { const f32x4 a = *(const f32x4*)(src + i * 8), b = *(const f32x4*)(src + i * 8 + 4);
        u32x4 o; o.x = cvtpk(a[0], a[1]); o.y = cvtpk(a[2], a[3]); o.z = cvtpk(b[0], b[1]); o.w = cvtpk(b[2], b[3]); *(u32x4*)(dst + i * 8) = o; }
}
__device__ __forceinline__ void cvt_flat_fp8(const float* src, unsigned char* dst, size_t n16, float sc, size_t gtid, size_t nthr) {
    for (size_t i = gtid; i < n16; i += nthr) { u32x4 o;
#pragma unroll
        for (int q = 0; q < 4; ++q) { const f32x4 a = *(const f32x4*)(src + i * 16 + 4 * q) * sc; int w = 0;
            w = __builtin_amdgcn_cvt_pk_fp8_f32(a[0], a[1], w, false); w = __builtin_amdgcn_cvt_pk_fp8_f32(a[2], a[3], w, true); o[q] = (unsigned)w; }
        *(u32x4*)(dst + i * 16) = o; }
}
__device__ __forceinline__ void phase0(const Params& p, LAS unsigned char* lds, int G, int bid, int wave, int lane) {
    unsigned char* ws = p.ws;
    LAS float* scr = (LAS float*)(lds + wave * 16384);
    const int gw = bid * NWAVES + wave, NGW = G * NWAVES;
    constexpr int I_IN = 16 * 256, I_SQ = 16 * 32, I_Q = 16 * 64, NITEMS = I_IN + 3 * I_SQ + I_Q;
    for (int it = gw; it < NITEMS; it += NGW) {
        int r = it;
        if (r < I_IN) { transpose_item(p.w_in, 1024, 8192, (bf16*)(ws + WS_WIN), 1, 1024, 0, nullptr, scr, r, lane); continue; } r -= I_IN;
        if (r < I_SQ) { transpose_item(p.w_attn_o, 1024, 1024, (bf16*)(ws + WS_WAC), 0, 2048, 0, nullptr, scr, r, lane); continue; } r -= I_SQ;
        if (r < I_SQ) { transpose_item(p.w_conv_o, 1024, 1024, (bf16*)(ws + WS_WAC), 0, 2048, 1024, nullptr, scr, r, lane); continue; } r -= I_SQ;
        if (r < I_SQ) { transpose_item(p.w_out, 1024, 1024, (bf16*)(ws + WS_WOUT), 0, 1024, 0, nullptr, scr, r, lane); continue; } r -= I_SQ;
        transpose_item(p.w_query, 1024, 2048, (bf16*)(ws + WS_WQ), 0, 1024, 0, p.norm2_g, scr, r, lane);
    }
    const size_t gtid = (size_t)bid * NTHR + wave * 64 + lane, nthr = (size_t)G * NTHR;
    cvt_flat(p.sub_keys, (bf16*)(ws + WS_SUBK), (size_t)(8 * 2 * 128 * 128) / 8, gtid, nthr);
    bf16* N1 = (bf16*)p.out;
    f32x4 gv[4];
#pragma unroll
    for (int j = 0; j < 4; ++j) gv[j] = *((const f32x4*)p.norm1_g + lane + 64 * j);
    for (int m = gw; m < T; m += NGW) {
        const f32x4* xr = (const f32x4*)(p.x + (size_t)m * DM) + lane; f32x4 v[4]; float s = 0.f;
#pragma unroll
        for (int j = 0; j < 4; ++j) { v[j] = xr[64 * j]; s += (v[j][0] * v[j][0] + v[j][1] * v[j][1]) + (v[j][2] * v[j][2] + v[j][3] * v[j][3]); }
        const float r = rsqrtf(wave_sum(s) * (1.f / DM) + EPS);
        u32x2* o8 = (u32x2*)(N1 + (size_t)m * 2048) + lane;
#pragma unroll
        for (int j = 0; j < 4; ++j) { u32x2 o; o.x = cvtpk(v[j][0] * r * gv[j][0], v[j][1] * r * gv[j][1]); o.y = cvtpk(v[j][2] * r * gv[j][2], v[j][3] * r * gv[j][3]); o8[64 * j] = o; }
    }
}

__device__ __forceinline__ void up8(const bf16* p, float (&f)[8]) { const u32x4 w = *(const u32x4*)p; pg8::unpack8(w, f); }
__device__ __forceinline__ void phase_conv(const Params& p, int G, int bid, int tid) {
    const bf16* PR = (const bf16*)(p.ws + WS_BIG + B_PR); bf16* CBU = (bf16*)p.out + 1024;
    const size_t nthr = (size_t)G * NTHR;
    for (size_t it = (size_t)bid * NTHR + tid; it < (size_t)T * 128; it += nthr) {
        const int t = (int)(it >> 7), c8 = (int)(it & 127) * 8, s = t & (SEQ - 1);
        const bf16* row = PR + (size_t)t * 1024 + c8;
        float cb[8], a[8], acc[8];
        up8(CBU + (size_t)t * 2048 + c8, cb); up8(row, a);
        const f32x4 w2a = *(const f32x4*)(p.conv_w + 2048 + c8), w2b = *(const f32x4*)(p.conv_w + 2048 + c8 + 4);
#pragma unroll
        for (int i = 0; i < 8; ++i) acc[i] = (i < 4 ? w2a[i] : w2b[i - 4]) * a[i];
        if (s >= 1) { up8(row - 1024, a);
            const f32x4 w1a = *(const f32x4*)(p.conv_w + 1024 + c8), w1b = *(const f32x4*)(p.conv_w + 1024 + c8 + 4);
#pragma unroll
            for (int i = 0; i < 8; ++i) acc[i] += (i < 4 ? w1a[i] : w1b[i - 4]) * a[i]; }
        if (s >= 2) { up8(row - 2048, a);
            const f32x4 w0a = *(const f32x4*)(p.conv_w + c8), w0b = *(const f32x4*)(p.conv_w + c8 + 4);
#pragma unroll
            for (int i = 0; i < 8; ++i) acc[i] += (i < 4 ? w0a[i] : w0b[i - 4]) * a[i]; }
        u32x4 o; o.x = cvtpk(cb[0] * acc[0], cb[1] * acc[1]); o.y = cvtpk(cb[2] * acc[2], cb[3] * acc[3]); o.z = cvtpk(cb[4] * acc[4], cb[5] * acc[5]); o.w = cvtpk(cb[6] * acc[6], cb[7] * acc[7]);
        *(u32x4*)(CBU + (size_t)t * 2048 + c8) = o;
    }
}

constexpr int KPITCH = 272, VPITCH = 320, KBYTES = 64 * KPITCH, STAGEB = KBYTES + 64 * VPITCH;
constexpr int XOFF = 0, OSTOFF = 65536, OSTPITCH = 272, OSTB = 32 * OSTPITCH;
__device__ __forceinline__ s16x4 vtr(const LAS unsigned char* p) { return __builtin_amdgcn_ds_read_tr16_b64_v4i16((LAS s16x4*)p); }

__device__ __forceinline__ void attn_unit(LAS unsigned char* lds, const bf16* QKV, bf16* ON, const float* subg, float lam, int b, int h, int qb, int tid) {
    const int w = __builtin_amdgcn_readfirstlane(tid >> 6), lane = tid & 63, map = w >> 2, wq = w & 3, l31 = lane & 31, half = lane >> 5;
    const size_t trow0 = (size_t)b * SEQ;
    const int q0 = qb * 128 + wq * 32;
    bf16x8 qf[4];
    { const bf16* qp = QKV + (trow0 + q0 + l31) * 3072 + h * 128 + map * 64 + 8 * half;
#pragma unroll
      for (int s = 0; s < 4; ++s) qf[s] = *(const bf16x8*)(qp + 16 * s); }
    f32x16 O[4];
#pragma unroll
    for (int e = 0; e < 4; ++e)
#pragma unroll
        for (int r = 0; r < 16; ++r) O[e][r] = 0.f;
    float m_run = 0.f, l_run = 0.f;
    const int ntile = 2 * (qb + 1);
    const int skey = tid >> 4, sch = tid & 15;
    const bf16* gk = QKV + (trow0 + skey) * 3072 + 1024 + h * 128 + sch * 8;
    const int dk = skey * KPITCH + sch * 16, dv = KBYTES + skey * VPITCH + sch * 16;
    u32x4 stg[4];
#define GLOAD(j) do { const bf16* g_ = gk + (size_t)(j) * 64 * 3072; stg[0] = *(const u32x4*)g_; stg[1] = *(const u32x4*)(g_ + 32 * 3072); stg[2] = *(const u32x4*)(g_ + 1024); stg[3] = *(const u32x4*)(g_ + 32 * 3072 + 1024); } while (0)
#define LSTORE(st) do { LAS unsigned char* b_ = lds + (st) * STAGEB; *(LAS u32x4*)(b_ + dk) = stg[0]; *(LAS u32x4*)(b_ + dk + 32 * KPITCH) = stg[1]; *(LAS u32x4*)(b_ + dv) = stg[2]; *(LAS u32x4*)(b_ + dv + 32 * VPITCH) = stg[3]; } while (0)
    GLOAD(0); LSTORE(0); __syncthreads();
    const int koff = l31 * KPITCH + map * 128 + half * 16;
    const int voff = KBYTES + (4 * half + ((lane & 15) >> 2)) * VPITCH + (((lane >> 4) & 1) * 16 + (lane & 3) * 4) * 2;
    const int qi = q0 + l31;
    for (int j = 0; j < ntile; ++j) {
        if (j + 1 < ntile) GLOAD(j + 1);
        const int kbase = 64 * j;
        if (kbase <= q0 + 31) {
            const LAS unsigned char* sb = lds + (j & 1) * STAGEB;
            f32x16 s0, s1;
            const float negm = -m_run;
#pragma unroll
            for (int r = 0; r < 16; ++r) { s0[r] = negm; s1[r] = negm; }
#pragma unroll
            for (int s = 0; s < 4; ++s) { const bf16x8 k0 = *(const LAS bf16x8*)(sb + koff + s * 32), k1 = *(const LAS bf16x8*)(sb + koff + 32 * KPITCH + s * 32);
                s0 = __builtin_amdgcn_mfma_f32_32x32x16_bf16(k0, qf[s], s0, 0, 0, 0); s1 = __builtin_amdgcn_mfma_f32_32x32x16_bf16(k1, qf[s], s1, 0, 0, 0); }
            const LAS unsigned char* vb = sb + voff;
            s16x4 vlo[4][4], vhi[4][4];
            if (kbase + 63 > q0) {
#pragma unroll
                for (int r = 0; r < 16; ++r) { const int key = kbase + (r & 3) + 8 * (r >> 2) + 4 * half;
                    s0[r] = (key <= qi) ? s0[r] : -1e30f; s1[r] = (key + 32 <= qi) ? s1[r] : -1e30f; }
            }
            float mx = fmaxf(s0[0], s1[0]);
#pragma unroll
            for (int r = 1; r < 16; ++r) mx = fmaxf(mx, fmaxf(s0[r], s1[r]));
            mx = fmaxf(mx, __shfl_xor(mx, 32));
            float ps = 0.f;
            const bool first = (j == 0), move = first || (__ballot(mx > 8.f) != 0ull);
            const float delta = move ? (first ? mx : fmaxf(mx, 0.f)) : 0.f;
#pragma unroll
            for (int r = 0; r < 16; ++r) { s0[r] = __builtin_amdgcn_exp2f(s0[r] - delta); s1[r] = __builtin_amdgcn_exp2f(s1[r] - delta); ps += s0[r] + s1[r]; }
            if (move) {
                const float alpha = first ? 0.f : __builtin_amdgcn_exp2f(-delta); m_run += delta;
                l_run = l_run * alpha + ps;
                if (!first) {
#pragma unroll
                    for (int e = 0; e < 4; ++e) O[e] = O[e] * alpha;
                }
            } else l_run += ps;
            bf16x8 pf[4];
#pragma unroll
            for (int kk = 0; kk < 4; ++kk) { u32x4 wv;
                if (kk < 2) { wv.x = cvtpk(s0[8 * kk + 0], s0[8 * kk + 1]); wv.y = cvtpk(s0[8 * kk + 2], s0[8 * kk + 3]); wv.z = cvtpk(s0[8 * kk + 4], s0[8 * kk + 5]); wv.w = cvtpk(s0[8 * kk + 6], s0[8 * kk + 7]); }
                else { const int k2 = kk - 2; wv.x = cvtpk(s1[8 * k2 + 0], s1[8 * k2 + 1]); wv.y = cvtpk(s1[8 * k2 + 2], s1[8 * k2 + 3]); wv.z = cvtpk(s1[8 * k2 + 4], s1[8 * k2 + 5]); wv.w = cvtpk(s1[8 * k2 + 6], s1[8 * k2 + 7]); }
                pf[kk] = __builtin_bit_cast(bf16x8, wv); }
#pragma unroll
            for (int e = 0; e < 4; ++e) { vlo[0][e] = vtr(vb + e * 64); vhi[0][e] = vtr(vb + 8 * VPITCH + e * 64); }
#pragma unroll
            for (int kk = 0; kk < 4; ++kk)
#pragma unroll
                for (int e = 0; e < 4; ++e) {
                    if (e == 0 && kk < 3) {
#pragma unroll
                        for (int e2 = 0; e2 < 4; ++e2) { vlo[kk + 1][e2] = vtr(vb + (kk + 1) * 16 * VPITCH + e2 * 64); vhi[kk + 1][e2] = vtr(vb + ((kk + 1) * 16 + 8) * VPITCH + e2 * 64); }
                        __builtin_amdgcn_sched_barrier(0);
                    }
                    const s16x4 lo = vlo[kk][e], hi = vhi[kk][e];
                    bf16x8 a; a[0] = lo[0]; a[1] = lo[1]; a[2] = lo[2]; a[3] = lo[3]; a[4] = hi[0]; a[5] = hi[1]; a[6] = hi[2]; a[7] = hi[3];
                    O[e] = __builtin_amdgcn_mfma_f32_32x32x16_bf16(a, pf[kk], O[e], 0, 0, 0); }
        }
        if (j + 1 < ntile) LSTORE((j + 1) & 1);
        __syncthreads();
    }
#undef GLOAD
#undef LSTORE
    const float ltot = l_run + __shfl_xor(l_run, 32), inv = 1.f / ltot;
    LAS float* X = (LAS float*)(lds + XOFF) + wq * 4096 + lane;
    if (map == 1) {
        const float sc = inv * lam;
#pragma unroll
        for (int e = 0; e < 4; ++e)
#pragma unroll
            for (int r = 0; r < 16; ++r) X[(e * 16 + r) * 64] = O[e][r] * sc;
    }
    __syncthreads();
    if (map == 0) {
        float ssq = 0.f;
#pragma unroll
        for (int e = 0; e < 4; ++e)
#pragma unroll
            for (int r = 0; r < 16; ++r) { const float o = O[e][r] * inv - X[(e * 16 + r) * 64]; O[e][r] = o; ssq += o * o; }
        ssq += __shfl_xor(ssq, 32);
        const float rms = rsqrtf(ssq * (1.f / 128.f) + EPS) * 0.8f;
        LAS unsigned char* ost = lds + OSTOFF + wq * OSTB;
#pragma unroll
        for (int e = 0; e < 4; ++e)
#pragma unroll
            for (int rq = 0; rq < 4; ++rq) { const int e0 = 32 * e + 8 * rq + 4 * half; const f32x4 g = *(const f32x4*)(subg + e0);
                u32x2 o; o.x = cvtpk(O[e][4 * rq + 0] * rms * g[0], O[e][4 * rq + 1] * rms * g[1]); o.y = cvtpk(O[e][4 * rq + 2] * rms * g[2], O[e][4 * rq + 3] * rms * g[3]);
                *(LAS u32x2*)(ost + l31 * OSTPITCH + e0 * 2) = o; }
        LDS_WAIT(); __builtin_amdgcn_wave_barrier();
#pragma unroll
        for (int jj = 0; jj < 8; ++jj) { const int c = lane + 64 * jj, row = c >> 4, ch = c & 15;
            const u32x4 v = *(const LAS u32x4*)(ost + row * OSTPITCH + ch * 16);
            *(u32x4*)(ON + (trow0 + q0 + row) * 2048 + h * 128 + ch * 8) = v; }
    }
    __syncthreads();
}

__device__ __forceinline__ void phase_attn(const Params& p, LAS unsigned char* lds, int G, int bid, int tid) {
    const bf16* QKV = (const bf16*)(p.ws + WS_BIG); bf16* ON = (bf16*)p.out;
    const int lane = tid & 63;
    const float a = p.lambda_qk[lane] * p.lambda_qk[64 + lane], b = p.lambda_qk[128 + lane] * p.lambda_qk[192 + lane];
    const float lam = expf(wave_sum(a)) - expf(wave_sum(b)) + 0.2f;
    for (int c = bid; c < 256; c += G) {
        const int bh = c >> 2, quad = c & 3, b_ = bh >> 3, h = bh & 7;
        attn_unit(lds, QKV, ON, p.subln_g, lam, b_, h, 15 - 2 * quad, tid);
        attn_unit(lds, QKV, ON, p.subln_g, lam, b_, h, 2 * quad, tid);
        attn_unit(lds, QKV, ON, p.subln_g, lam, b_, h, 14 - 2 * quad, tid);
        attn_unit(lds, QKV, ON, p.subln_g, lam, b_, h, 2 * quad + 1, tid);
    }
}

__device__ __forceinline__ unsigned mono(float v) { const unsigned u = __builtin_bit_cast(unsigned, v); return (u & 0x80000000u) ? ~u : (u | 0x80000000u); }
__device__ __forceinline__ float unmono(unsigned k) { const unsigned u = (k & 0x80000000u) ? (k ^ 0x80000000u) : ~k; return __builtin_bit_cast(float, u); }
#define CE_(x, y) do { const unsigned t_ = max(x, y); y = min(x, y); x = t_; } while (0)
__device__ __forceinline__ void sort16(unsigned (&a)[16]) {
    CE_(a[0], a[1]); CE_(a[2], a[3]); CE_(a[0], a[2]); CE_(a[1], a[3]); CE_(a[1], a[2]); CE_(a[4], a[5]); CE_(a[6], a[7]); CE_(a[4], a[6]); CE_(a[5], a[7]); CE_(a[5], a[6]); CE_(a[0], a[4]); CE_(a[2], a[6]); CE_(a[2], a[4]); CE_(a[1], a[5]); CE_(a[3], a[7]); CE_(a[3], a[5]); CE_(a[1], a[2]); CE_(a[3], a[4]); CE_(a[5], a[6]); CE_(a[8], a[9]); CE_(a[10], a[11]); CE_(a[8], a[10]); CE_(a[9], a[11]); CE_(a[9], a[10]); CE_(a[12], a[13]); CE_(a[14], a[15]); CE_(a[12], a[14]); CE_(a[13], a[15]); CE_(a[13], a[14]); CE_(a[8], a[12]); CE_(a[10], a[14]); CE_(a[10], a[12]); CE_(a[9], a[13]); CE_(a[11], a[15]); CE_(a[11], a[13]); CE_(a[9], a[10]); CE_(a[11], a[12]); CE_(a[13], a[14]); CE_(a[0], a[8]); CE_(a[4], a[12]); CE_(a[4], a[8]); CE_(a[2], a[10]); CE_(a[6], a[14]); CE_(a[6], a[10]); CE_(a[2], a[4]); CE_(a[6], a[8]); CE_(a[10], a[12]); CE_(a[1], a[9]); CE_(a[5], a[13]); CE_(a[5], a[9]); CE_(a[3], a[11]); CE_(a[7], a[15]); CE_(a[7], a[11]); CE_(a[3], a[5]); CE_(a[7], a[9]); CE_(a[11], a[13]); CE_(a[1], a[2]); CE_(a[3], a[4]); CE_(a[5], a[6]); CE_(a[7], a[8]); CE_(a[9], a[10]); CE_(a[11], a[12]); CE_(a[13], a[14]);
}
__device__ __forceinline__ void merge16(unsigned (&a)[16], const unsigned (&b)[16]) {
    a[0] = max(a[0], b[15]); a[1] = max(a[1], b[14]); a[2] = max(a[2], b[13]); a[3] = max(a[3], b[12]); a[4] = max(a[4], b[11]); a[5] = max(a[5], b[10]); a[6] = max(a[6], b[9]); a[7] = max(a[7], b[8]); a[8] = max(a[8], b[7]); a[9] = max(a[9], b[6]); a[10] = max(a[10], b[5]); a[11] = max(a[11], b[4]); a[12] = max(a[12], b[3]); a[13] = max(a[13], b[2]); a[14] = max(a[14], b[1]); a[15] = max(a[15], b[0]);
    CE_(a[0], a[8]); CE_(a[1], a[9]); CE_(a[2], a[10]); CE_(a[3], a[11]); CE_(a[4], a[12]); CE_(a[5], a[13]); CE_(a[6], a[14]); CE_(a[7], a[15]); CE_(a[0], a[4]); CE_(a[1], a[5]); CE_(a[2], a[6]); CE_(a[3], a[7]); CE_(a[8], a[12]); CE_(a[9], a[13]); CE_(a[10], a[14]); CE_(a[11], a[15]); CE_(a[0], a[2]); CE_(a[1], a[3]); CE_(a[4], a[6]); CE_(a[5], a[7]); CE_(a[8], a[10]); CE_(a[9], a[11]); CE_(a[12], a[14]); CE_(a[13], a[15]); CE_(a[0], a[1]); CE_(a[2], a[3]); CE_(a[4], a[5]); CE_(a[6], a[7]); CE_(a[8], a[9]); CE_(a[10], a[11]); CE_(a[12], a[13]); CE_(a[14], a[15]);
}

__device__ __forceinline__ void convert_experts(const Params& p, size_t gtid, size_t nthr) {
    cvt_flat_fp8(p.expert_u, p.ws + WS_EU, (size_t)16384 * 1024 / 16, ESCALE, gtid, nthr);
    cvt_flat_fp8(p.expert_v, p.ws + WS_EV, (size_t)16384 * 1024 / 16, ESCALE, gtid, nthr);
}
__device__ __forceinline__ void phase_topk(const Params& p, LAS unsigned char* lds, int G, int bid, int wave, int lane) {
    const bf16* QP = (const bf16*)(p.ws + WS_BIG + B_QP); const bf16* SK = (const bf16*)(p.ws + WS_SUBK);
    int* SEL = (int*)(p.ws + WS_BIG + B_SEL); float* GATE = (float*)(p.ws + WS_BIG + B_GATE);
    const int gw = bid * NWAVES + wave, NGW = G * NWAVES, l31 = lane & 31, half = lane >> 5;
    LAS int* tab = (LAS int*)(lds + wave * 12288) + l31 * 32;
    LAS unsigned char* qst = lds + wave * 12288 + 4096 + lane * 16;
    LAS unsigned char* skl = lds + 8 * 12288;
    const float* ctab = (wave < 4) ? p.expert_u : p.expert_v; unsigned char* cdst = p.ws + ((wave < 4) ? WS_EU : WS_EV);
    const int tid_ = wave * 64 + lane;
    for (int sbk = bid; sbk < 256; sbk += G)
    for (int rnd = 0; rnd < 2; ++rnd) {
        const int tg = 8 * (sbk >> 2) + wave, h = 2 * (sbk & 3) + rnd, t = tg * 32 + l31;
        unsigned lists[2][16];
#pragma unroll
        for (int m = 0; m < 2; ++m) {
            f32x16 acc[4];
#pragma unroll
            for (int kb = 0; kb < 4; ++kb)
#pragma unroll
                for (int r = 0; r < 16; ++r) acc[kb][r] = 0.f;
            const bf16* qp = QP + (size_t)t * 2048 + h * 256 + m * 128 + 8 * half;
            { const bf16* sks = SK + (size_t)(h * 2 + m) * 128 * 128;
#pragma unroll
              for (int jj = 0; jj < 4; ++jj) { const int c = tid_ + 512 * jj, row = c >> 4, ch = c & 15;
                  *(LAS u32x4*)(skl + row * 272 + ch * 16) = *(const u32x4*)(sks + row * 128 + ch * 8); } }
            __syncthreads();
            const size_t cbase = ((size_t)(sbk * 4 + (wave & 3)) * 1024 + (size_t)(rnd * 2 + m) * 256 + lane) * 16;
#define CAST_SLICE() do { _Pragma("unroll") for (int j = 0; j < 4; ++j) { const size_t o_ = cbase + (size_t)j * 64 * 16; u32x4 w_; \
                _Pragma("unroll") for (int q = 0; q < 4; ++q) { const f32x4 a_ = *(const f32x4*)(ctab + o_ + 4 * q) * ESCALE; int x_ = 0; \
                    x_ = __builtin_amdgcn_cvt_pk_fp8_f32(a_[0], a_[1], x_, false); x_ = __builtin_amdgcn_cvt_pk_fp8_f32(a_[2], a_[3], x_, true); w_[q] = (unsigned)x_; } \
                *(u32x4*)(cdst + o_) = w_; } } while (0)
            if (wave < 4) CAST_SLICE();
            const LAS unsigned char* kl = skl + l31 * 272 + half * 16;
            { u32x4 tq[8];
#pragma unroll
              for (int s = 0; s < 8; ++s) tq[s] = *(const u32x4*)(qp + 16 * s);
#pragma unroll
              for (int s = 0; s < 8; ++s) *(LAS u32x4*)(qst + s * 1024) = tq[s]; }
#pragma unroll 2
            for (int s = 0; s < 8; ++s) {
                const bf16x8 bq = *(const LAS bf16x8*)(qst + s * 1024);
#pragma unroll
                for (int kb = 0; kb < 4; ++kb) { const bf16x8 ak = *(const LAS bf16x8*)(kl + kb * 32 * 272 + s * 32); acc[kb] = __builtin_amdgcn_mfma_f32_32x32x16_bf16(ak, bq, acc[kb], 0, 0, 0); }
            }
            unsigned top[16], oth[16];
#pragma unroll
            for (int kb = 0; kb < 4; ++kb) {
#pragma unroll
                for (int r = 0; r < 16; ++r) { const int kidx = 32 * kb + (r & 3) + 8 * (r >> 2) + 4 * half; oth[r] = (mono(acc[kb][r]) & ~127u) | (unsigned)(127 - kidx); }
                sort16(oth);
                if (kb == 0) {
#pragma unroll
                    for (int i = 0; i < 16; ++i) top[i] = oth[i];
                } else merge16(top, oth);
            }
#pragma unroll
            for (int i = 0; i < 16; ++i) oth[i] = (unsigned)__shfl_xor((int)top[i], 32);
            merge16(top, oth);
#pragma unroll
            for (int i = 0; i < 16; ++i) lists[m][i] = top[i];
            if (wave >= 4) CAST_SLICE();
#undef CAST_SLICE
            __syncthreads();
        }
        float va[16], vb[16];
#pragma unroll
        for (int i = 0; i < 16; ++i) { va[i] = unmono(lists[0][i] & ~127u); vb[i] = unmono(lists[1][i] & ~127u);
            tab[i] = 127 - (int)(lists[0][i] & 127u); tab[16 + i] = 127 - (int)(lists[1][i] & 127u); }
#define CKEY(i, j) ((mono(va[i] + vb[j]) & ~255u) | (unsigned)(255 - ((i) * 16 + (j))))
        unsigned ct[16], l1[16], l2[16], l3[16];
#pragma unroll
        for (int j = 0; j < 16; ++j) ct[j] = CKEY(0, j);
#pragma unroll
        for (int j = 0; j < 8; ++j) l1[j] = CKEY(1, j);
#pragma unroll
        for (int j = 0; j < 5; ++j) l1[8 + j] = CKEY(2, j);
        l1[13] = 0u; l1[14] = 0u; l1[15] = 0u;
#pragma unroll
        for (int j = 0; j < 4; ++j) l2[j] = CKEY(3, j);
#pragma unroll
        for (int j = 0; j < 3; ++j) l2[4 + j] = CKEY(4, j);
#pragma unroll
        for (int j = 0; j < 2; ++j) { l2[7 + j] = CKEY(5, j); l2[9 + j] = CKEY(6, j); l2[11 + j] = CKEY(7, j); }
        l2[13] = 0u; l2[14] = 0u; l2[15] = 0u;
#pragma unroll
        for (int i = 0; i < 8; ++i) { l3[i] = CKEY(8 + i, 0); l3[8 + i] = 0u; }
#undef CKEY
        sort16(l1); sort16(l2); sort16(l3);
        merge16(ct, l1); merge16(l2, l3); merge16(ct, l2);
        LDS_WAIT(); __builtin_amdgcn_wave_barrier();
        const float s0 = unmono(ct[0] & ~255u);
        float ev[16], es = 0.f; int ex[16];
#pragma unroll
        for (int r = 0; r < 16; ++r) { const int pos = 255 - (int)(ct[r] & 255u); ev[r] = __expf(unmono(ct[r] & ~255u) - s0); es += ev[r];
            ex[r] = tab[pos >> 4] * 128 + tab[16 + (pos & 15)]; }
        const float ie = 1.f / es;
        int* so = SEL + (size_t)t * 128 + h * 16; float* go = GATE + (size_t)t * 128 + h * 16;
        if (half == 0) {
#pragma unroll
            for (int r = 0; r < 8; ++r) { so[r] = ex[r]; go[r] = ev[r] * ie; }
        } else {
#pragma unroll
            for (int r = 8; r < 16; ++r) { so[r] = ex[r]; go[r] = ev[r] * ie; }
        }
        LDS_WAIT(); __builtin_amdgcn_wave_barrier();
    }
}

__device__ __forceinline__ float gelu_as(float v) {
    const float av = fabsf(v), t = __builtin_amdgcn_rcpf(av * 0.2316418882f + 1.0f);
    float q = t * 0.5307027145f + (-0.7265760135f); q = q * t + 0.7107068705f; q = q * t + (-0.142248368f); q = q * t + 0.127414796f; q = q * t;
    const float e = __builtin_amdgcn_exp2f((v * v) * (-0.72134752044f)), m = v * (q * e);
    return v < 0.f ? m : v - m;
}
constexpr int KT = 4;
constexpr int GW_LDS = 17152;
constexpr int UPITCH = 272, USTG = 16 * UPITCH;
static_assert(KT == 4, "LDS map of the gather phase is laid out for 4 tokens per wave");
__device__ __forceinline__ void phase_gather(const Params& p, LAS unsigned char* lds, int G, int bid, int wave, int lane) {
    const int* SEL = (const int*)(p.ws + WS_BIG + B_SEL); const float* GATE = (const float*)(p.ws + WS_BIG + B_GATE);
    const unsigned char* EU = p.ws + WS_EU; const unsigned char* EV = p.ws + WS_EV;
    float* H2 = p.out;
    const int gw = bid * NWAVES + wave, NGW = G * NWAVES, l15 = lane & 15, g4 = lane >> 4;
    LAS unsigned char* wl = lds + wave * GW_LDS;
    LAS unsigned char* xnb = wl; LAS int* selb = (LAS int*)(wl + 4096); LAS float* gateb = (LAS float*)(wl + 6144); LAS float* hb = (LAS float*)(wl + 8192); LAS unsigned char* ustg = wl + 8448;
    for (int tb = gw * KT; tb < T; tb += NGW * KT) {
#pragma unroll 1
        for (int k = 0; k < KT; ++k) {
            const int t = tb + k;
            const float* hrow = H2 + (size_t)t * DM + 16 * lane;
            f32x4 hv[4];
#pragma unroll
            for (int j = 0; j < 4; ++j) hv[j] = *(const f32x4*)(hrow + 4 * j);
            const int selA = SEL[(size_t)t * 128 + lane], selB = SEL[(size_t)t * 128 + 64 + lane];
            const float gtA = GATE[(size_t)t * 128 + lane], gtB = GATE[(size_t)t * 128 + 64 + lane];
            float ssq = 0.f;
#pragma unroll
            for (int j = 0; j < 4; ++j) ssq += (hv[j][0] * hv[j][0] + hv[j][1] * hv[j][1]) + (hv[j][2] * hv[j][2] + hv[j][3] * hv[j][3]);
            const float r2 = rsqrtf(wave_sum(ssq) * (1.f / DM) + EPS);
            { u32x4 o;
#pragma unroll
              for (int j = 0; j < 4; ++j) { const f32x4 a = hv[j] * r2 * *(const f32x4*)(p.norm2_g + 16 * lane + 4 * j); int w = 0;
                  w = __builtin_amdgcn_cvt_pk_fp8_f32(a[0], a[1], w, false); w = __builtin_amdgcn_cvt_pk_fp8_f32(a[2], a[3], w, true); o[j] = (unsigned)w; }
              *(LAS u32x4*)(xnb + k * 1024 + 16 * lane) = o; }
            const int bA = selA >> 10, bB = selB >> 10; int posA = 0, posB = 0, off = 0;
#pragma unroll
            for (int b = 0; b < 16; ++b) {
                const unsigned long long mA = __ballot(bA == b), mB = __ballot(bB == b);
                const int cA = __popcll(mA), cB = __popcll(mB);
                const int rA = (int)__builtin_amdgcn_mbcnt_hi((unsigned)(mA >> 32), __builtin_amdgcn_mbcnt_lo((unsigned)mA, 0u));
                const int rB = (int)__builtin_amdgcn_mbcnt_hi((unsigned)(mB >> 32), __builtin_amdgcn_mbcnt_lo((unsigned)mB, 0u));
                if (bA == b) posA = off + rA;
                if (bB == b) posB = off + cA + rB;
                off += cA + cB;
            }
            selb[k * 128 + posA] = selA; gateb[k * 128 + posA] = gtA; selb[k * 128 + posB] = selB; gateb[k * 128 + posB] = gtB;
        }
        LDS_WAIT(); __builtin_amdgcn_wave_barrier();
        f32x2_t y[KT][8];
#pragma unroll
        for (int k = 0; k < KT; ++k)
#pragma unroll
            for (int i = 0; i < 8; ++i) y[k][i] = (f32x2_t){0.f, 0.f};
#pragma unroll 1
        for (int g = 0; g < 8; ++g) {
#pragma unroll
            for (int k = 0; k < KT; ++k) {
                asm volatile("" ::: "memory");
                f32x4 acc = (f32x4){0.f, 0.f, 0.f, 0.f};
                const int rr = lane >> 4, cc = lane & 15;
                const unsigned char* rp[4];
#pragma unroll
                for (int i = 0; i < 4; ++i) rp[i] = EU + (size_t)selb[k * 128 + 16 * g + 4 * i + rr] * DM + 16 * cc;
                u32x4 ld[4];
#pragma unroll
                for (int i = 0; i < 4; ++i) ld[i] = *(const u32x4*)(rp[i]);
#pragma unroll
                for (int qd = 0; qd < 4; ++qd) {
                    LAS unsigned char* sb = ustg + (qd & 1) * USTG;
#pragma unroll
                    for (int i = 0; i < 4; ++i) *(LAS u32x4*)(sb + (4 * i + rr) * UPITCH + 16 * cc) = ld[i];
                    if (qd < 3) {
#pragma unroll
                        for (int i = 0; i < 4; ++i) ld[i] = *(const u32x4*)(rp[i] + 256 * (qd + 1));
                    }
                    LDS_WAIT(); __builtin_amdgcn_wave_barrier();
                    const LAS unsigned char* ar = sb + l15 * UPITCH + 64 * g4;
                    const LAS unsigned char* xk = xnb + k * 1024 + 256 * qd + 64 * g4;
#pragma unroll
                    for (int i = 0; i < 4; ++i) { const u32x4 a = *(const LAS u32x4*)(ar + 16 * i); const u32x4 bx = *(const LAS u32x4*)(xk + 16 * i);
                        const long a0 = (long)(((unsigned long long)a.y << 32) | a.x), a1 = (long)(((unsigned long long)a.w << 32) | a.z);
                        const long b0 = (long)(((unsigned long long)bx.y << 32) | bx.x), b1 = (long)(((unsigned long long)bx.w << 32) | bx.z);
                        acc = __builtin_amdgcn_mfma_f32_16x16x32_fp8_fp8(a0, b0, acc, 0, 0, 0);
                        acc = __builtin_amdgcn_mfma_f32_16x16x32_fp8_fp8(a1, b1, acc, 0, 0, 0); }
                }
                if (l15 == 0) {
#pragma unroll
                    for (int j = 0; j < 4; ++j) { const float a = acc[j] * (1.f / ESCALE);
                        hb[k * 16 + 4 * g4 + j] = gelu_as(a) * gateb[k * 128 + 16 * g + 4 * g4 + j] * (1.f / ESCALE); }
                }
            }
            LDS_WAIT(); __builtin_amdgcn_wave_barrier();
#pragma unroll
            for (int k = 0; k < KT; ++k) {
                asm volatile("" ::: "memory");
                u32x4 vr[2][4];
#pragma unroll
                for (int i = 0; i < 4; ++i) vr[0][i] = *(const u32x4*)(EV + (size_t)selb[k * 128 + 16 * g + i] * DM + 16 * lane);
#pragma unroll
                for (int bt = 0; bt < 4; ++bt) {
                    if (bt < 3) {
#pragma unroll
                        for (int i = 0; i < 4; ++i) vr[(bt + 1) & 1][i] = *(const u32x4*)(EV + (size_t)selb[k * 128 + 16 * g + 4 * (bt + 1) + i] * DM + 16 * lane);
                    }
                    asm volatile("" ::: "memory");
#pragma unroll
                    for (int i = 0; i < 4; ++i) { const float hs = hb[k * 16 + 4 * bt + i]; const u32x4 v = vr[bt & 1][i];
#pragma unroll
                        for (int q = 0; q < 4; ++q) { const f32x2_t lo = __builtin_amdgcn_cvt_pk_f32_fp8((int)v[q], false), hi = __builtin_amdgcn_cvt_pk_f32_fp8((int)v[q], true);
                            y[k][2 * q] += lo * hs; y[k][2 * q + 1] += hi * hs; } }
                }
            }
            LDS_WAIT(); __builtin_amdgcn_wave_barrier();
        }
#pragma unroll
        for (int k = 0; k < KT; ++k) {
            float* hrow = H2 + (size_t)(tb + k) * DM + 16 * lane;
            f32x4 h3[4]; float s3 = 0.f;
#pragma unroll
            for (int j = 0; j < 4; ++j) { const f32x4 hv = *(const f32x4*)(hrow + 4 * j);
                h3[j][0] = hv[0] + y[k][2 * j][0]; h3[j][1] = hv[1] + y[k][2 * j][1]; h3[j][2] = hv[2] + y[k][2 * j + 1][0]; h3[j][3] = hv[3] + y[k][2 * j + 1][1];
                s3 += (h3[j][0] * h3[j][0] + h3[j][1] * h3[j][1]) + (h3[j][2] * h3[j][2] + h3[j][3] * h3[j][3]); }
            const float r3 = rsqrtf(wave_sum(s3) * (1.f / DM) + EPS);
#pragma unroll
            for (int j = 0; j < 4; ++j) *(f32x4*)(hrow + 4 * j) = h3[j] * r3 * *(const f32x4*)(p.final_g + 16 * lane + 4 * j);
        }
        LDS_WAIT(); __builtin_amdgcn_wave_barrier();
    }
}

#define XB_TMO      128
#define XB_XCNT(j)  (256  + 64 * (j))
#define XB_XSUB(j)  (1280 + 64 * (j))
#define XB_XGEN(j)  (2304 + 64 * (j))
#define XB_TOP      3328
#define XB_TOPGEN   3392
#define XCD_BAR_WORDS 3456
#define XB_SPIN_CAP (1u << 18)

__device__ __forceinline__ unsigned xb_ld(unsigned* p)              { return __hip_atomic_load(p, __ATOMIC_RELAXED, __HIP_MEMORY_SCOPE_AGENT); }
__device__ __forceinline__ unsigned xb_add(unsigned* p, unsigned v) { return __hip_atomic_fetch_add(p, v, __ATOMIC_RELAXED, __HIP_MEMORY_SCOPE_AGENT); }
__device__ __forceinline__ unsigned xb_xcc_id() { return (unsigned)__builtin_amdgcn_s_getreg((3 << 11) | 20) & 0xFu; }
#define XB_SPIN(cond, bar) do { unsigned _sp = 0; while (cond) { __builtin_amdgcn_s_sleep(1); \
    if ((++_sp & 255u) == 0u) { if (xb_ld(&(bar)[XB_TMO])) break; if (_sp > XB_SPIN_CAP) { atomicAdd(&(bar)[XB_TMO], 1u); break; } } } } while (0)

struct XcdBarrier {
    unsigned* bar; unsigned x;
    volatile LAS unsigned* st;
};

__device__ __forceinline__ XcdBarrier xcd_barrier_post(unsigned* bar, volatile LAS unsigned* st) {
    XcdBarrier b; b.bar = bar; b.x = xb_xcc_id(); b.st = st;
    if (threadIdx.x == 0) (void)xb_add(&bar[XB_XCNT(b.x)], 1u);
    return b;
}
__device__ __forceinline__ void xcd_barrier_complete(unsigned* bar, unsigned x, unsigned& nloc, unsigned& nx) {
    const unsigned G = gridDim.x * gridDim.y * gridDim.z;
    unsigned sum, cnt, mine, sp = 0u;
    for (;;) {
        sum = 0u; cnt = 0u; mine = 0u;
#pragma unroll
        for (unsigned j = 0; j < 16; ++j) { const unsigned c = xb_ld(&bar[XB_XCNT(j)]); sum += c; cnt += (c > 0u) ? 1u : 0u; mine = (j == x) ? c : mine; }
        if (sum == G) break;
        __builtin_amdgcn_s_sleep(1);
        if ((++sp & 255u) == 0u) { if (xb_ld(&bar[XB_TMO])) break; if (sp > XB_SPIN_CAP) { atomicAdd(&bar[XB_TMO], 1u); break; } }
    }
    nloc = mine > 0u ? mine : 1u; nx = cnt > 0u ? cnt : 1u;
}

__device__ __forceinline__ void xcd_barrier(const XcdBarrier& b) {
    asm volatile("s_waitcnt vmcnt(0)" ::: "memory");
    __syncthreads();
    if (threadIdx.x == 0) {
        unsigned* bar = b.bar;
        __builtin_amdgcn_s_waitcnt(0);
        unsigned nloc = b.st[0], nx = b.st[1];
        if (nloc == 0u) { xcd_barrier_complete(bar, b.x, nloc, nx); b.st[0] = nloc; b.st[1] = nx; }
        const unsigned old = xb_add(&bar[XB_XSUB(b.x)], 1u);
        const unsigned gen = old / nloc;
        if (old + 1u == (gen + 1u) * nloc) {
            __builtin_amdgcn_fence(__ATOMIC_RELEASE, "agent");
            asm volatile("s_waitcnt vmcnt(0)" ::: "memory");
            const unsigned og = xb_add(&bar[XB_TOP], 1u);
            const unsigned tg = og / nx;
            if (og + 1u == (tg + 1u) * nx) xb_add(&bar[XB_TOPGEN], 1u);
            else XB_SPIN(xb_ld(&bar[XB_TOPGEN]) == tg, bar);
            __builtin_amdgcn_fence(__ATOMIC_ACQUIRE, "agent");
            xb_add(&bar[XB_XGEN(b.x)], 1u);
            asm volatile("s_waitcnt vmcnt(0)" ::: "memory");
        } else {
            XB_SPIN(xb_ld(&bar[XB_XGEN(b.x)]) == gen, bar);
            __builtin_amdgcn_fence(__ATOMIC_ACQUIRE, "agent");
            asm volatile("s_waitcnt vmcnt(0)" ::: "memory");
        }
    }
    __syncthreads();
}

#ifndef ONE_LAUNCH
#define ONE_LAUNCH 1
#endif
constexpr int NPHASE = 8;
__global__ void __launch_bounds__(NTHR, 2) hybrid_fwd(Params p) {
    extern __shared__ __attribute__((aligned(16))) unsigned char lds_raw[];
    LAS unsigned char* lds = (LAS unsigned char*)lds_raw;
    const int tid = threadIdx.x, lane = tid & 63, wave = __builtin_amdgcn_readfirstlane(tid >> 6), G = gridDim.x, bid = blockIdx.x;
    unsigned char* ws = p.ws;
    volatile LAS unsigned* xst = (volatile LAS unsigned*)(lds + 139264);
    if (tid < 2) xst[tid] = 0u;
    __syncthreads();
    XcdBarrier xbar; xbar.bar = (unsigned*)(ws + WS_END); xbar.x = 0; xbar.st = xst;
    if (ONE_LAUNCH && p.hi - p.lo > 1) { xbar = xcd_barrier_post((unsigned*)(ws + WS_END), xst); cg::this_grid().sync(); }
    const pg8::bf16_t* N1 = (const pg8::bf16_t*)p.out;
#ifdef ONLY
#define PH(k) if ((k) == ONLY && p.lo <= (k) && (k) < p.hi)
#else
#define PH(k) if (p.lo <= (k) && (k) < p.hi)
#endif
#define SEAM(k) do { if (ONE_LAUNCH && p.lo <= (k) && (k) + 1 < p.hi) { xcd_barrier(xbar); } } while (0)
#define FRESH_IDS int tid = threadIdx.x; asm volatile("" : "+v"(tid)); const int lane = tid & 63, wave = __builtin_amdgcn_readfirstlane(tid >> 6); (void)lane; (void)wave
    unsigned char* big = ws + WS_BIG;
    PH(0) { FRESH_IDS; phase0(p, lds, G, bid, wave, lane); SEAM(0); }
    PH(1) { FRESH_IDS; pg8::Gemm g{N1, (const pg8::bf16_t*)(ws + WS_WIN), T, 8192, 1024, 2048, 1024}; pg8::StaticOrder S; S.init(T, 8192, G, bid);
        pg8::EpiG1 E{(pg8::bf16_t*)(big + B_QKV), (pg8::bf16_t*)(big + B_GG), (pg8::bf16_t*)p.out + 1024, (pg8::bf16_t*)(big + B_PR), C2};
        pg8::gemm_phase<pg8::EpiG1, pg8::StaticOrder, true, true>(lds, g, S, E); SEAM(1); }
    PH(2) { FRESH_IDS; phase_attn(p, lds, G, bid, tid); phase_conv(p, G, bid, tid); SEAM(2); }
    PH(3) { FRESH_IDS; pg8::Gemm g{(const pg8::bf16_t*)p.out, (const pg8::bf16_t*)(ws + WS_WAC), T, 1024, 1024, 2048, 2048}; pg8::SplitKOrder S; S.base.init(T, 1024, G, bid);
        pg8::EpiMerged E{(const pg8::bf16_t*)(big + B_GG), (pg8::bf16_t*)(big + B_MG)};
        pg8::gemm_phase<pg8::EpiMerged, pg8::SplitKOrder, false, true>(lds, g, S, E); SEAM(3); }
    PH(4) { FRESH_IDS; pg8::Gemm g{(const pg8::bf16_t*)(big + B_MG), (const pg8::bf16_t*)(ws + WS_WOUT), T, 1024, 1024, 1024, 1024}; pg8::StaticOrder S; S.init(T, 1024, G, bid);
        pg8::EpiResid E{p.x, p.out, (pg8::bf16_t*)(big + B_H2B), (float*)(ws + WS_SSQ)};
        pg8::gemm_phase<pg8::EpiResid, pg8::StaticOrder, false, true>(lds, g, S, E); SEAM(4); }
    PH(5) { FRESH_IDS; pg8::Gemm g{(const pg8::bf16_t*)(big + B_H2B), (const pg8::bf16_t*)(ws + WS_WQ), T, 2048, 1024, 1024, 1024}; pg8::StaticOrder S; S.init(T, 2048, G, bid);
        pg8::EpiRowScale E{(const float*)(ws + WS_SSQ), (pg8::bf16_t*)(big + B_QP)};
        pg8::gemm_phase<pg8::EpiRowScale, pg8::StaticOrder, true, true>(lds, g, S, E); SEAM(5); }
    PH(6) { FRESH_IDS; phase_topk(p, lds, G, bid, wave, lane); SEAM(6); }
    PH(7) { FRESH_IDS; phase_gather(p, lds, G, bid, wave, lane); }
#undef PH
#undef SEAM
}

extern "C" void kernel_launch(void* const* d_in, const int* in_sizes, int n_in, void* d_out, int out_size, void* d_ws, size_t ws_size, hipStream_t stream) {
    static int grid = 0;
    if (grid == 0) {
        if (n_in != 15 || out_size != T * DM || ws_size < WS_END) { fprintf(stderr, "kernel_launch: unexpected problem (n_in %d out %d ws %zu)\n", n_in, out_size, ws_size); grid = -1; return; }
        int dev = 0, cus = 0, per_cu = 0;
        hipGetDevice(&dev); hipDeviceGetAttribute(&cus, hipDeviceAttributeMultiprocessorCount, dev);
        if (hipFuncSetAttribute((const void*)hybrid_fwd, hipFuncAttributeMaxDynamicSharedMemorySize, LDS_BYTES) != hipSuccess) { fprintf(stderr, "kernel_launch: hipFuncSetAttribute failed\n"); grid = -1; return; }
        if (hipOccupancyMaxActiveBlocksPerMultiprocessor(&per_cu, (const void*)hybrid_fwd, NTHR, LDS_BYTES) != hipSuccess || per_cu < 1) { fprintf(stderr, "kernel_launch: occupancy query says %d\n", per_cu); per_cu = 1; }
        (void)hipGetLastError();
        grid = cus * per_cu;
    }
    if (grid < 0) return;
    Params p{};
    p.x = (const float*)d_in[0]; p.norm1_g = (const float*)d_in[1]; p.w_in = (const float*)d_in[2]; p.lambda_qk = (const float*)d_in[3]; p.subln_g = (const float*)d_in[4];
    p.conv_w = (const float*)d_in[5]; p.w_attn_o = (const float*)d_in[6]; p.w_conv_o = (const float*)d_in[7]; p.w_out = (const float*)d_in[8]; p.norm2_g = (const float*)d_in[9];
    p.w_query = (const float*)d_in[10]; p.sub_keys = (const float*)d_in[11]; p.expert_u = (const float*)d_in[12]; p.expert_v = (const float*)d_in[13]; p.final_g = (const float*)d_in[14];
    p.out = (float*)d_out; p.ws = (unsigned char*)d_ws;
#if ONE_LAUNCH
    p.lo = 0; p.hi = NPHASE;
    (void)hipMemsetAsync((char*)d_ws + WS_END, 0, 16384, stream);
    void* args[] = {&p};
    hipError_t e = hipLaunchCooperativeKernel((const void*)hybrid_fwd, dim3(grid), dim3(NTHR), args, LDS_BYTES, stream);
    if (e != hipSuccess) fprintf(stderr, "cooperative launch failed: %s (grid %d)\n", hipGetErrorString(e), grid);
#else
    for (int k = 0; k < NPHASE; ++k) {
        p.lo = k; p.hi = k + 1; hipLaunchKernelGGL(hybrid_fwd, dim3(grid), dim3(NTHR), LDS_BYTES, stream, p); }
#endif
}
```

```cpp
#include <hip/hip_runtime.h>
#include <hip/hip_cooperative_groups.h>
#include <cstdio>
#include <cstdint>
namespace cg = cooperative_groups;
namespace pg8 {
#define PG8_LAS __attribute__((address_space(3)))
typedef unsigned short bf16_t;
typedef short bf16x8 __attribute__((ext_vector_type(8)));
typedef float f32x4 __attribute__((ext_vector_type(4)));
typedef unsigned u32x4 __attribute__((ext_vector_type(4)));
constexpr int BM = 256, BK = 64, HALF = 128, HTB = HALF * BK * 2  , STAGE_BYTES = 8 * HTB, NXCD = 8, WGM = 8;

__host__ __device__ __forceinline__ int lds_byte(int r, int c) { const int st = (r >> 4) * 2 + (c >> 5), rr = r & 15, cc = c & 31, ob = rr * 64 + cc * 2; return st * 1024 + (ob ^ (((ob >> 9) & 1) << 5)); }
__host__ __device__ __forceinline__ void stage_rc(int b, int& R, int& C) { const int st = b / 1024, sb = b % 1024, swz = sb ^ (((sb >> 9) & 1) << 5); R = (st >> 1) * 16 + swz / 64; C = (st & 1) * 32 + (swz % 64) / 2; }
__host__ __device__ __forceinline__ int perm32(int rho) { const int n = rho >> 4, i = rho & 15; return 8 * (i >> 2) + 4 * n + (i & 3); }

struct Unit { int pm, pn, kh; };
struct Gemm { const bf16_t* A; const bf16_t* Bt; int M, N, K, lda, ldb; };
struct StaticOrder {
    int nM, nN, nwg, G, c;
    __host__ __device__ void init(int M, int N, int G_, int c_) { nM = M / BM; nN = N / BM; nwg = nM * nN; G = G_; c = c_; }
    __host__ __device__ bool next(int i, Unit& u) const {
        const long L = (long)i * G + c; if (L >= nwg) return false;
        int wgid = (int)L; { const int q = nwg / NXCD, r = nwg % NXCD, xcd = wgid % NXCD, off = wgid / NXCD; wgid = (xcd < r ? xcd * (q + 1) : r * (q + 1) + (xcd - r) * q) + off; }
        const int nig = WGM * nN, gid = wgid / nig, fm = gid * WGM, gsz = (nM - fm) < WGM ? (nM - fm) : WGM;
        u.pm = fm + ((wgid % nig) % gsz); u.pn = (wgid % nig) / gsz; u.kh = 0; return true;
    }
    __device__ __forceinline__ void a_ready(const Unit&) const {}
    __device__ __forceinline__ void done(const Unit&) const {}
};
struct SplitKOrder {
    StaticOrder base;
    __host__ __device__ bool next(int i, Unit& u) const { if (!base.next(i >> 1, u)) return false; u.kh = i & 1; return true; }
    __device__ __forceinline__ void a_ready(const Unit&) const {}
    __device__ __forceinline__ void done(const Unit&) const {}
};
__device__ __forceinline__ unsigned cvt_pk_bf16(float lo, float hi) { unsigned r; asm volatile("v_cvt_pk_bf16_f32 %0, %1, %2" : "=v"(r) : "v"(lo), "v"(hi)); return r; }
typedef float f32x2 __attribute__((ext_vector_type(2)));
typedef float f32x2 __attribute__((ext_vector_type(2)));
typedef unsigned u32x2 __attribute__((ext_vector_type(2)));
__device__ __forceinline__ void unpack8(const u32x4 w, float (&f)[8]) {
    f[0] = __builtin_bit_cast(float, w.x << 16); f[1] = __builtin_bit_cast(float, w.x & 0xffff0000u);
    f[2] = __builtin_bit_cast(float, w.y << 16); f[3] = __builtin_bit_cast(float, w.y & 0xffff0000u);
    f[4] = __builtin_bit_cast(float, w.z << 16); f[5] = __builtin_bit_cast(float, w.z & 0xffff0000u);
    f[6] = __builtin_bit_cast(float, w.w << 16); f[7] = __builtin_bit_cast(float, w.w & 0xffff0000u);
}
__device__ __forceinline__ u32x4 pack8(const f32x4 v0, const f32x4 v1) { u32x4 w; w.x = cvt_pk_bf16(v0[0], v0[1]); w.y = cvt_pk_bf16(v0[2], v0[3]); w.z = cvt_pk_bf16(v1[0], v1[1]); w.w = cvt_pk_bf16(v1[2], v1[3]); return w; }
struct EpiPlain {
    static constexpr bool PERM = true, AFTER_DRAIN = false, MID = false;
    bf16_t* O; int ldc;
    __device__ __forceinline__ void operator()(const f32x4 (&acc)[2][2][4][2], const Unit& u, int wr, int wc, int fr, int fq) const {
        const int row0 = u.pm * BM + wr * 64 + fr, col0 = u.pn * BM + wc * 32 + 8 * fq;
#pragma unroll
        for (int ai = 0; ai < 2; ++ai)
#pragma unroll
            for (int m = 0; m < 4; ++m) { bf16_t* rowp = O + (size_t)(row0 + ai * HALF + m * 16) * ldc + col0;
#pragma unroll
                for (int bj = 0; bj < 2; ++bj) *(u32x4*)(rowp + bj * HALF) = pack8(acc[ai][bj][m][0], acc[ai][bj][m][1]); }
    }
};
struct EpiQKVG {
    static constexpr bool PERM = true, AFTER_DRAIN = false, MID = false;
    bf16_t* QKV; bf16_t* GG; float c2;
    __device__ __forceinline__ void operator()(const f32x4 (&acc)[2][2][4][2], const Unit& u, int wr, int wc, int fr, int fq) const {
        int colt = u.pn * BM; bf16_t* base = QKV; int ldc = 3072; float sc = 1.f; bool sig = false;
        if (colt < 1024) sc = c2; else if (colt >= 3072) { base = GG; ldc = 2048; colt -= 3072; sig = true; }
        const int row0 = u.pm * BM + wr * 64 + fr, col0 = colt + wc * 32 + 8 * fq;
#pragma unroll
        for (int ai = 0; ai < 2; ++ai)
#pragma unroll
            for (int m = 0; m < 4; ++m) { bf16_t* rowp = base + (size_t)(row0 + ai * HALF + m * 16) * ldc + col0;
#pragma unroll
                for (int bj = 0; bj < 2; ++bj) { f32x4 v0 = acc[ai][bj][m][0], v1 = acc[ai][bj][m][1];
                    if (sig) {
#pragma unroll
                        for (int i = 0; i < 4; ++i) { v0[i] = __builtin_amdgcn_rcpf(1.f + __expf(-v0[i])); v1[i] = __builtin_amdgcn_rcpf(1.f + __expf(-v1[i])); }
                    } else { v0 = v0 * sc; v1 = v1 * sc; }
                    *(u32x4*)(rowp + bj * HALF) = pack8(v0, v1); } }
    }
};
struct EpiGateA {
    static constexpr bool PERM = true, AFTER_DRAIN = false, MID = false;
    const bf16_t* GG; float* TMP;
    __device__ __forceinline__ void operator()(const f32x4 (&acc)[2][2][4][2], const Unit& u, int wr, int wc, int fr, int fq) const {
        const int row0 = u.pm * BM + wr * 64 + fr, col0 = u.pn * BM + wc * 32 + 8 * fq;
#pragma unroll
        for (int ai = 0; ai < 2; ++ai)
#pragma unroll
            for (int m = 0; m < 4; ++m) { const size_t row = (size_t)(row0 + ai * HALF + m * 16);
#pragma unroll
                for (int bj = 0; bj < 2; ++bj) { const int col = col0 + bj * HALF; float g[8]; unpack8(*(const u32x4*)(GG + row * 2048 + col), g);
                    f32x4 v0 = acc[ai][bj][m][0], v1 = acc[ai][bj][m][1];
                    v0[0] *= g[0]; v0[1] *= g[1]; v0[2] *= g[2]; v0[3] *= g[3]; v1[0] *= g[4]; v1[1] *= g[5]; v1[2] *= g[6]; v1[3] *= g[7];
                    *(f32x4*)(TMP + row * 1024 + col) = v0; *(f32x4*)(TMP + row * 1024 + col + 4) = v1; } }
    }
};
struct EpiGateC {
    static constexpr bool PERM = true, AFTER_DRAIN = false, MID = false;
    const bf16_t* GG; const float* TMP; bf16_t* MG;
    __device__ __forceinline__ void operator()(const f32x4 (&acc)[2][2][4][2], const Unit& u, int wr, int wc, int fr, int fq) const {
        const int row0 = u.pm * BM + wr * 64 + fr, col0 = u.pn * BM + wc * 32 + 8 * fq;
#pragma unroll
        for (int ai = 0; ai < 2; ++ai)
#pragma unroll
            for (int m = 0; m < 4; ++m) { const size_t row = (size_t)(row0 + ai * HALF + m * 16);
#pragma unroll
                for (int bj = 0; bj < 2; ++bj) { const int col = col0 + bj * HALF; float g[8]; unpack8(*(const u32x4*)(GG + row * 2048 + 1024 + col), g);
                    const f32x4 t0 = *(const f32x4*)(TMP + row * 1024 + col), t1 = *(const f32x4*)(TMP + row * 1024 + col + 4);
                    f32x4 v0 = acc[ai][bj][m][0], v1 = acc[ai][bj][m][1];
                    v0[0] = t0[0] + v0[0] * g[0]; v0[1] = t0[1] + v0[1] * g[1]; v0[2] = t0[2] + v0[2] * g[2]; v0[3] = t0[3] + v0[3] * g[3];
                    v1[0] = t1[0] + v1[0] * g[4]; v1[1] = t1[1] + v1[1] * g[5]; v1[2] = t1[2] + v1[2] * g[6]; v1[3] = t1[3] + v1[3] * g[7];
                    *(u32x4*)(MG + row * 1024 + col) = pack8(v0, v1); } }
    }
};
struct EpiG1 {
    static constexpr bool PERM = true, AFTER_DRAIN = false, MID = false;
    bf16_t* QKV; bf16_t* GG; bf16_t* CB; bf16_t* PR; float c2;
    __device__ __forceinline__ void operator()(const f32x4 (&acc)[2][2][4][2], const Unit& u, int wr, int wc, int fr, int fq) const {
        int colt = u.pn * BM; const int row0 = u.pm * BM + wr * 64 + fr;
        if (colt >= 6144) {
            const int ch0 = (colt - 6144) / 2 + wc * 16 + 4 * fq;
#pragma unroll
            for (int ai = 0; ai < 2; ++ai)
#pragma unroll
                for (int m = 0; m < 4; ++m) { bf16_t* rowp = PR + (size_t)(row0 + ai * HALF + m * 16) * 1024 + ch0;
#pragma unroll
                    for (int bj = 0; bj < 2; ++bj) { const f32x4 v0 = acc[ai][bj][m][0], v1 = acc[ai][bj][m][1];
                        u32x2 w; w.x = cvt_pk_bf16(v0[0] * v0[1], v0[2] * v0[3]); w.y = cvt_pk_bf16(v1[0] * v1[1], v1[2] * v1[3]);
                        *(u32x2*)(rowp + bj * (HALF / 2)) = w; } }
            return;
        }
        bf16_t* base = QKV; int ldc = 3072; float sc = 1.f; bool sig = false;
        if (colt < 1024) sc = c2; else if (colt >= 5120) { base = CB; ldc = 2048; colt -= 5120; } else if (colt >= 3072) { base = GG; ldc = 2048; colt -= 3072; sig = true; }
        const int col0 = colt + wc * 32 + 8 * fq;
#pragma unroll
        for (int ai = 0; ai < 2; ++ai)
#pragma unroll
            for (int m = 0; m < 4; ++m) { bf16_t* rowp = base + (size_t)(row0 + ai * HALF + m * 16) * ldc + col0;
#pragma unroll
                for (int bj = 0; bj < 2; ++bj) { f32x4 v0 = acc[ai][bj][m][0], v1 = acc[ai][bj][m][1];
                    if (sig) {
#pragma unroll
                        for (int i = 0; i < 4; ++i) { v0[i] = __builtin_amdgcn_rcpf(1.f + __expf(-v0[i])); v1[i] = __builtin_amdgcn_rcpf(1.f + __expf(-v1[i])); }
                    } else { v0 = v0 * sc; v1 = v1 * sc; }
                    *(u32x4*)(rowp + bj * HALF) = pack8(v0, v1); } }
    }
};
struct EpiMerged {
    static constexpr bool PERM = true, AFTER_DRAIN = false, MID = true;
    const bf16_t* GG; bf16_t* MG;
    __device__ __forceinline__ void mid(f32x4 (&acc)[2][2][4][2], const Unit& u, int wr, int wc, int fr, int fq) const {
        const int row0 = u.pm * BM + wr * 64 + fr, col0 = u.pn * BM + wc * 32 + 8 * fq;
#pragma unroll
        for (int ai = 0; ai < 2; ++ai)
#pragma unroll
            for (int m = 0; m < 4; ++m) { const size_t row = (size_t)(row0 + ai * HALF + m * 16);
#pragma unroll
                for (int bj = 0; bj < 2; ++bj) { const int col = col0 + bj * HALF; float ga[8], gc[8];
                    unpack8(*(const u32x4*)(GG + row * 2048 + col), ga); unpack8(*(const u32x4*)(GG + row * 2048 + 1024 + col), gc);
#pragma unroll
                    for (int i = 0; i < 4; ++i) { acc[ai][bj][m][0][i] *= ga[i] * __builtin_amdgcn_rcpf(gc[i]); acc[ai][bj][m][1][i] *= ga[4 + i] * __builtin_amdgcn_rcpf(gc[4 + i]); }
                    asm volatile("" ::: "memory"); } }
    }
    __device__ __forceinline__ void operator()(const f32x4 (&acc)[2][2][4][2], const Unit& u, int wr, int wc, int fr, int fq) const {
        const int row0 = u.pm * BM + wr * 64 + fr, col0 = u.pn * BM + wc * 32 + 8 * fq;
#pragma unroll
        for (int ai = 0; ai < 2; ++ai)
#pragma unroll
            for (int m = 0; m < 4; ++m) { const size_t row = (size_t)(row0 + ai * HALF + m * 16);
#pragma unroll
                for (int bj = 0; bj < 2; ++bj) { const int col = col0 + bj * HALF; float gc[8]; unpack8(*(const u32x4*)(GG + row * 2048 + 1024 + col), gc);
                    f32x4 v0 = acc[ai][bj][m][0], v1 = acc[ai][bj][m][1];
#pragma unroll
                    for (int i = 0; i < 4; ++i) { v0[i] *= gc[i]; v1[i] *= gc[4 + i]; }
                    *(u32x4*)(MG + row * 1024 + col) = pack8(v0, v1); } }
    }
};
struct EpiResid {
    static constexpr bool PERM = true, AFTER_DRAIN = false, MID = false;
    const float* X; float* H2; bf16_t* H2B; float* SSQ;
    __device__ __forceinline__ void operator()(const f32x4 (&acc)[2][2][4][2], const Unit& u, int wr, int wc, int fr, int fq) const {
        const int row0 = u.pm * BM + wr * 64 + fr, col0 = u.pn * BM + wc * 32 + 8 * fq;
#pragma unroll
        for (int ai = 0; ai < 2; ++ai)
#pragma unroll
            for (int m = 0; m < 4; ++m) { const size_t row = (size_t)(row0 + ai * HALF + m * 16); float s = 0.f;
#pragma unroll
                for (int bj = 0; bj < 2; ++bj) { const size_t o = row * 1024 + col0 + bj * HALF;
                    const f32x4 v0 = acc[ai][bj][m][0] + *(const f32x4*)(X + o), v1 = acc[ai][bj][m][1] + *(const f32x4*)(X + o + 4);
                    *(f32x4*)(H2 + o) = v0; *(f32x4*)(H2 + o + 4) = v1; *(u32x4*)(H2B + o) = pack8(v0, v1);
                    s += (v0[0] * v0[0] + v0[1] * v0[1]) + (v0[2] * v0[2] + v0[3] * v0[3]) + (v1[0] * v1[0] + v1[1] * v1[1]) + (v1[2] * v1[2] + v1[3] * v1[3]); }
                s += __shfl_xor(s, 16); s += __shfl_xor(s, 32);
                if (fq == 0) SSQ[row * 16 + u.pn * 4 + wc] = s; }
    }
};
struct EpiRowScale {
    static constexpr bool PERM = true, AFTER_DRAIN = false, MID = false;
    const float* SSQ; bf16_t* O;
    __device__ __forceinline__ void operator()(const f32x4 (&acc)[2][2][4][2], const Unit& u, int wr, int wc, int fr, int fq) const {
        const int row0 = u.pm * BM + wr * 64 + fr, col0 = u.pn * BM + wc * 32 + 8 * fq;
#pragma unroll
        for (int ai = 0; ai < 2; ++ai)
#pragma unroll
            for (int m = 0; m < 4; ++m) { const size_t row = (size_t)(row0 + ai * HALF + m * 16);
                const f32x4* sp = (const f32x4*)(SSQ + row * 16); const f32x4 a = sp[0] + sp[1], b = sp[2] + sp[3], c = a + b;
                const float rs = rsqrtf(((c[0] + c[1]) + (c[2] + c[3])) * (1.f / 1024.f) + 1e-6f);
#pragma unroll
                for (int bj = 0; bj < 2; ++bj) *(u32x4*)(O + row * 2048 + col0 + bj * HALF) = pack8(acc[ai][bj][m][0] * rs, acc[ai][bj][m][1] * rs); }
    }
};
template <class Epi, class Sched, bool ALIGN_EPI = false, bool SP2 = false>
__device__ __forceinline__ void gemm_phase(PG8_LAS unsigned char* lds, const Gemm g, const Sched& S, const Epi& E) {
    const int tid = threadIdx.x, wid = __builtin_amdgcn_readfirstlane(tid >> 6), lane = tid & 63, wr = wid >> 2, wc = wid & 3, fr = lane & 15, fq = lane >> 4;
    const int K = g.K, nt = K / BK;
    unsigned voffA[2], voffB[2];
#pragma unroll
    for (int i = 0; i < 2; ++i) { int R, C; stage_rc(tid * 16 + i * 8192, R, C); const int Rb = Epi::PERM ? ((R & ~31) + perm32(R & 31)) : R;
        voffA[i] = (unsigned)(R * g.lda + C) * 2u; voffB[i] = (unsigned)(Rb * g.ldb + C) * 2u; }
    const size_t kstep = (size_t)(BK * 2);
    const size_t hstep = (size_t)HALF * g.ldb * 2;
    const size_t tstep = 2 * hstep;
    const size_t hstepA = (size_t)HALF * g.lda * 2, tstepA = 2 * hstepA;
    const unsigned ldsw = (unsigned)wid * 1024u;
    const int aoff = lds_byte(wr * 64 + fr, fq * 8), boff = lds_byte(wc * 32 + fr, fq * 8);
#define PG8_SA(b, h) (((b) * 2 + (h)) * HTB)
#define PG8_SB(b, h) ((4 + (b) * 2 + (h)) * HTB)
#define PG8_STAGE(bufoff, gbase, voff) do { _Pragma("unroll") for (int _i = 0; _i < 2; ++_i) \
        __builtin_amdgcn_global_load_lds((const unsigned*)((const char*)(gbase) + (voff)[_i]), (PG8_LAS unsigned*)(lds + (bufoff) + ldsw + _i * 8192), 16, 0, 0); } while (0)
#define PG8_LDA(dst, b, h) do { _Pragma("unroll") for (int m = 0; m < 4; ++m) _Pragma("unroll") for (int k = 0; k < 2; ++k) dst[m][k] = *(const PG8_LAS bf16x8*)(lds + PG8_SA(b, h) + aoff + m * 2048 + k * 1024); } while (0)
#define PG8_LDB(dst, b, h) do { _Pragma("unroll") for (int n = 0; n < 2; ++n) _Pragma("unroll") for (int k = 0; k < 2; ++k) dst[n][k] = *(const PG8_LAS bf16x8*)(lds + PG8_SB(b, h) + boff + n * 2048 + k * 1024); } while (0)
#define PG8_MMA(ai, bj, At, Bt) do { __builtin_amdgcn_s_setprio(1); _Pragma("unroll") for (int m = 0; m < 4; ++m) _Pragma("unroll") for (int n = 0; n < 2; ++n) _Pragma("unroll") for (int k = 0; k < 2; ++k) \
        acc[ai][bj][m][n] = __builtin_amdgcn_mfma_f32_16x16x32_bf16(Bt[n][k], At[m][k], acc[ai][bj][m][n], 0, 0, 0); __builtin_amdgcn_s_setprio(0); } while (0)
#define PG8_WAIT_V(n) asm volatile("s_waitcnt vmcnt(" #n ")" ::: "memory")
#define PG8_WAIT_L(n) asm volatile("s_waitcnt lgkmcnt(" #n ")" ::: "memory")
#define PG8_BAR __builtin_amdgcn_s_barrier()
#define PG8_SCHED __builtin_amdgcn_sched_barrier(0)
    Unit cur, nxt; int ui = 0;
    if (!S.next(0, cur)) return;
    f32x4 acc[2][2][4][2];
#pragma unroll
    for (int a = 0; a < 2; ++a)
#pragma unroll
        for (int b = 0; b < 2; ++b)
#pragma unroll
            for (int m = 0; m < 4; ++m)
#pragma unroll
                for (int n = 0; n < 2; ++n) acc[a][b][m][n] = (f32x4){0.f, 0.f, 0.f, 0.f};
    bf16x8 At[4][2], B0[2][2], B1[2][2];
    const char* cA = (const char*)g.A + (size_t)cur.pm * tstepA + (size_t)cur.kh * K * 2; const char* cB = (const char*)g.Bt + (size_t)cur.pn * tstep + (size_t)cur.kh * K * 2;
    S.a_ready(cur);
    if constexpr (SP2) {
        PG8_STAGE(PG8_SB(0, 0), cB, voffB); PG8_STAGE(PG8_SB(0, 1), cB + hstep, voffB); PG8_STAGE(PG8_SA(0, 0), cA, voffA); PG8_STAGE(PG8_SA(0, 1), cA + hstepA, voffA);
        if (wr == 1) PG8_BAR;
        PG8_WAIT_V(2); PG8_BAR;
        PG8_STAGE(PG8_SB(1, 0), cB + kstep, voffB); PG8_STAGE(PG8_SA(1, 0), cA + kstep, voffA); PG8_STAGE(PG8_SB(1, 1), cB + hstep + kstep, voffB);
        PG8_WAIT_V(6); PG8_BAR;
    } else {
        PG8_STAGE(PG8_SB(0, 0), cB, voffB); PG8_STAGE(PG8_SA(0, 0), cA, voffA); PG8_STAGE(PG8_SB(0, 1), cB + hstep, voffB); PG8_STAGE(PG8_SA(0, 1), cA + hstepA, voffA);
        if (wr == 1) PG8_BAR;
        PG8_WAIT_V(4); PG8_BAR;
        PG8_STAGE(PG8_SB(1, 0), cB + kstep, voffB); PG8_STAGE(PG8_SA(1, 0), cA + kstep, voffA); PG8_STAGE(PG8_SB(1, 1), cB + hstep + kstep, voffB);
        PG8_WAIT_V(6); PG8_BAR;
    }
    for (;;) {
        const bool has_next = S.next(ui + 1, nxt);
        const char* nA = has_next ? (const char*)g.A + (size_t)nxt.pm * tstepA + (size_t)nxt.kh * K * 2 : cA; const char* nB = has_next ? (const char*)g.Bt + (size_t)nxt.pn * tstep + (size_t)nxt.kh * K * 2 : cB;
        for (int t = 0; t < nt; t += 2) {
            const bool last = (t == nt - 2);
            const char* a1 = cA + (size_t)(t + 1) * kstep;
            const char* a2 = last ? nA : cA + (size_t)(t + 2) * kstep; const char* b2 = last ? nB : cB + (size_t)(t + 2) * kstep;
            const char* a3 = a2 + kstep; const char* b3 = b2 + kstep;
            if (last && has_next) S.a_ready(nxt);
            if constexpr (SP2) {
            PG8_LDB(B0, 0, 0); PG8_LDB(B1, 0, 1); PG8_SCHED; PG8_LDA(At, 0, 0); PG8_STAGE(PG8_SA(1, 1), a1 + hstepA, voffA);
            PG8_WAIT_V(8); PG8_WAIT_L(0); PG8_BAR; PG8_MMA(0, 0, At, B0); PG8_MMA(0, 1, At, B1); PG8_BAR; PG8_SCHED;
            PG8_LDA(At, 0, 1); PG8_STAGE(PG8_SB(0, 0), b2, voffB); PG8_STAGE(PG8_SB(0, 1), b2 + hstep, voffB); PG8_STAGE(PG8_SA(0, 0), a2, voffA);
            PG8_WAIT_V(8); PG8_WAIT_L(0); PG8_BAR; PG8_MMA(1, 0, At, B0); PG8_MMA(1, 1, At, B1); PG8_BAR; PG8_SCHED;
            PG8_LDB(B0, 1, 0); PG8_LDB(B1, 1, 1); PG8_SCHED; PG8_LDA(At, 1, 0); PG8_STAGE(PG8_SA(0, 1), a2 + hstepA, voffA);
            PG8_WAIT_V(8); PG8_WAIT_L(0); PG8_BAR; PG8_MMA(0, 0, At, B0); PG8_MMA(0, 1, At, B1); PG8_BAR; PG8_SCHED;
            PG8_LDA(At, 1, 1); PG8_STAGE(PG8_SB(1, 0), b3, voffB); PG8_STAGE(PG8_SB(1, 1), b3 + hstep, voffB); PG8_STAGE(PG8_SA(1, 0), a3, voffA);
            PG8_WAIT_V(8); PG8_WAIT_L(0); PG8_BAR; PG8_MMA(1, 0, At, B0); PG8_MMA(1, 1, At, B1); PG8_BAR; PG8_SCHED;
            } else {
            PG8_LDB(B0, 0, 0); PG8_SCHED; PG8_LDA(At, 0, 0); PG8_STAGE(PG8_SA(1, 1), a1 + hstepA, voffA);
            PG8_WAIT_L(8); PG8_BAR; PG8_WAIT_L(0); PG8_MMA(0, 0, At, B0); PG8_BAR; PG8_SCHED;
            PG8_LDB(B1, 0, 1); PG8_STAGE(PG8_SB(0, 0), b2, voffB);
            PG8_BAR; PG8_WAIT_L(0); PG8_MMA(0, 1, At, B1); PG8_BAR;
            PG8_LDA(At, 0, 1); PG8_STAGE(PG8_SA(0, 0), a2, voffA);
            PG8_BAR; PG8_WAIT_L(0); PG8_MMA(1, 0, At, B0); PG8_BAR; PG8_SCHED;
            PG8_STAGE(PG8_SB(0, 1), b2 + hstep, voffB);
            PG8_WAIT_V(6); PG8_BAR; PG8_MMA(1, 1, At, B1); PG8_BAR;
            PG8_LDB(B0, 1, 0); PG8_SCHED; PG8_LDA(At, 1, 0); PG8_STAGE(PG8_SA(0, 1), a2 + hstepA, voffA);
            PG8_WAIT_L(8); PG8_BAR; PG8_WAIT_L(0); PG8_MMA(0, 0, At, B0); PG8_BAR; PG8_SCHED;
            PG8_LDB(B1, 1, 1); PG8_STAGE(PG8_SB(1, 0), b3, voffB);
            PG8_BAR; PG8_WAIT_L(0); PG8_MMA(0, 1, At, B1); PG8_BAR;
            PG8_LDA(At, 1, 1); PG8_STAGE(PG8_SA(1, 0), a3, voffA);
            PG8_BAR; PG8_WAIT_L(0); PG8_MMA(1, 0, At, B0); PG8_BAR; PG8_SCHED;
            PG8_STAGE(PG8_SB(1, 1), b3 + hstep, voffB);
            PG8_WAIT_V(6); PG8_BAR; PG8_MMA(1, 1, At, B1); PG8_BAR;
            }
        }
        if constexpr (ALIGN_EPI) { if (wr == 0) PG8_BAR; }
        bool keep_acc = false;
        if constexpr (Epi::MID) { if (cur.kh == 0) { E.mid(acc, cur, wr, wc, fr, fq); keep_acc = true; } }
        if constexpr (!Epi::AFTER_DRAIN) { if (!keep_acc) { E(acc, cur, wr, wc, fr, fq); S.done(cur); } }
        if (!has_next) break;
        if (!keep_acc)
#pragma unroll
        for (int a = 0; a < 2; ++a)
#pragma unroll
            for (int b = 0; b < 2; ++b)
#pragma unroll
                for (int m = 0; m < 4; ++m)
#pragma unroll
                    for (int n = 0; n < 2; ++n) acc[a][b][m][n] = (f32x4){0.f, 0.f, 0.f, 0.f};
        cur = nxt; cA = nA; cB = nB; ++ui;
        if constexpr (ALIGN_EPI) { if (wr == 1) PG8_BAR; }
    }
    PG8_WAIT_V(0);
    if constexpr (!ALIGN_EPI) { if (wr == 0) PG8_BAR; }
    PG8_BAR;
    if constexpr (Epi::AFTER_DRAIN) { E.fused(acc, cur, wr, wc, fr, fq, lds, wid, lane); S.done(cur); }
#undef PG8_SA
#undef PG8_SB
#undef PG8_STAGE
#undef PG8_LDA
#undef PG8_LDB
#undef PG8_MMA
#undef PG8_WAIT_V
#undef PG8_WAIT_L
#undef PG8_BAR
#undef PG8_SCHED
}
}
#define LAS __attribute__((address_space(3)))
typedef unsigned short bf16;
typedef short bf16x8 __attribute__((ext_vector_type(8)));
typedef short s16x4 __attribute__((ext_vector_type(4)));
typedef float f32x4 __attribute__((ext_vector_type(4)));
typedef float f32x16 __attribute__((ext_vector_type(16)));
typedef unsigned u32x4 __attribute__((ext_vector_type(4)));
typedef unsigned u32x2 __attribute__((ext_vector_type(2)));
typedef float f32x2_t __attribute__((ext_vector_type(2))); typedef __bf16 bf16x2_t __attribute__((ext_vector_type(2)));

constexpr int T = 16384, DM = 1024, SEQ = 2048;
constexpr int NWAVES = 8, NTHR = 512;
constexpr int LDS_BYTES = 147456;
constexpr float EPS = 1e-6f;
constexpr float ESCALE = 64.f;
constexpr float C2 = 0.125f * 1.4426950408889634f;
constexpr size_t MiB = 1u << 20;
constexpr size_t WS_WIN = 0, WS_WAC = 16 * MiB, WS_WOUT = 20 * MiB, WS_WQ = 22 * MiB, WS_SUBK = 26 * MiB, WS_SSQ = 27 * MiB;
constexpr size_t WS_EU = 28 * MiB, WS_EV = 44 * MiB, WS_BIG = 60 * MiB, WS_END = 252 * MiB;
constexpr size_t B_QKV = 0, B_GG = 96 * MiB, B_PR = 160 * MiB, B_MG = 0, B_H2B = 32 * MiB, B_QP = 96 * MiB, B_SEL = 64 * MiB, B_GATE = 72 * MiB;

__device__ __forceinline__ unsigned cvtpk(float lo, float hi) { f32x2_t v = {lo, hi}; bf16x2_t b = __builtin_convertvector(v, bf16x2_t); return __builtin_bit_cast(unsigned, b); }
__device__ __forceinline__ float wave_sum(float v) {
#pragma unroll
    for (int o = 1; o < 64; o <<= 1) v += __shfl_xor(v, o);
    return v;
}
#define LDS_WAIT() asm volatile("s_waitcnt lgkmcnt(0)" ::: "memory")

struct Params {
    const float* x; const float* norm1_g; const float* w_in; const float* lambda_qk; const float* subln_g; const float* conv_w;
    const float* w_attn_o; const float* w_conv_o; const float* w_out; const float* norm2_g; const float* w_query; const float* sub_keys;
    const float* expert_u; const float* expert_v; const float* final_g;
    float* out; unsigned char* ws; int lo, hi;
};

__device__ __forceinline__ void transpose_item(const float* W, int K, int N, bf16* WT, int remap, int dpitch, int koff, const float* kscale, LAS float* scr, int item, int lane) {
    const int nblk = N / 32, kb = item / nblk, nb = item % nblk, k0 = 64 * kb, n0 = 32 * nb;
    int d0 = n0, dstr = 1;
    if (remap) { if (n0 < 3072) d0 = n0; else if (n0 < 4096) d0 = n0 + 2048; else if (n0 < 5120) { d0 = 6144 + 2 * (n0 - 4096); dstr = 2; } else if (n0 < 6144) { d0 = 6144 + 2 * (n0 - 5120) + 1; dstr = 2; } else d0 = n0 - 3072; }
    { float wv[32];
#pragma unroll
      for (int i = 0; i < 32; ++i) wv[i] = W[(size_t)(k0 + 2 * i + (lane >> 5)) * N + n0 + (lane & 31)];
#pragma unroll
      for (int i = 0; i < 32; ++i) { const int kk = 2 * i + (lane >> 5); float v = wv[i]; if (kscale) v *= kscale[k0 + kk]; scr[kk * 33 + (lane & 31)] = v; } }
    LDS_WAIT(); asm volatile("" ::: "memory");
    const int c = lane & 7;
#pragma unroll
    for (int j = 0; j < 4; ++j) { const int n = (lane >> 3) + 8 * j; const LAS float* sp = scr + (8 * c) * 33 + n;
        u32x4 o; o.x = cvtpk(sp[0 * 33], sp[1 * 33]); o.y = cvtpk(sp[2 * 33], sp[3 * 33]); o.z = cvtpk(sp[4 * 33], sp[5 * 33]); o.w = cvtpk(sp[6 * 33], sp[7 * 33]);
        *(u32x4*)(WT + (size_t)(d0 + n * dstr) * dpitch + koff + k0 + 8 * c) = o; }
    LDS_WAIT(); asm volatile("" ::: "memory");
}
__device__ __forceinline__ void cvt_flat(const float* src, bf16* dst, size_t n8, size_t gtid, size_t nthr) {
    for (size_t i = gtid; i < n8; i += nthr) { const f32x4 a = *(const f32x4*)(src + i * 8), b = *(const f32x4*)(src + i * 8 + 4);
        u32x4 o; o.x = cvtpk(a[0], a[1]); o.y = cvtpk(a[2], a[3]); o.z = cvtpk(b[0], b[1]); o.w = cvtpk(b[2], b[3]); *(u32x4*)(dst + i * 8) = o; }
}
__device__ __forceinline__ void cvt_flat_fp8(const float* src, unsigned char* dst, size_t n16, float sc, size_t gtid, size_t nthr) {
    for (size_t i = gtid; i < n16; i += nthr) { u32x4 o;
#pragma unroll
        for (int q = 0; q < 4; ++q) { const f32x4 a = *(const f32x4*)(src + i * 16 + 4 * q) * sc; int w = 0;
            w = __builtin_amdgcn_cvt_pk_fp8_f32(a[0], a[1], w, false); w = __builtin_amdgcn_cvt_pk_fp8_f32(a[2], a[3], w, true); o[q] = (unsigned)w; }
        *(u32x4*)(dst + i * 16) = o; }
}
__device__ __forceinline__ void phase0(const Params& p, LAS unsigned char* lds, int G, int bid, int wave, int lane) {
    unsigned char* ws = p.ws;
    LAS float* scr = (LAS float*)(lds + wave * 16384);
    const int gw = bid * NWAVES + wave, NGW = G * NWAVES;
    constexpr int I_IN = 16 * 256, I_SQ = 16 * 32, I_Q = 16 * 64, NITEMS = I_IN + 3 * I_SQ + I_Q;
    for (int it = gw; it < NITEMS; it += NGW) {
        int r = it;
        if (r < I_IN) { transpose_item(p.w_in, 1024, 8192, (bf16*)(ws + WS_WIN), 1, 1024, 0, nullptr, scr, r, lane); continue; } r -= I_IN;
        if (r < I_SQ) { transpose_item(p.w_attn_o, 1024, 1024, (bf16*)(ws + WS_WAC), 0, 2048, 0, nullptr, scr, r, lane); continue; } r -= I_SQ;
        if (r < I_SQ) { transpose_item(p.w_conv_o, 1024, 1024, (bf16*)(ws + WS_WAC), 0, 2048, 1024, nullptr, scr, r, lane); continue; } r -= I_SQ;
        if (r < I_SQ) { transpose_item(p.w_out, 1024, 1024, (bf16*)(ws + WS_WOUT), 0, 1024, 0, nullptr, scr, r, lane); continue; } r -= I_SQ;
        transpose_item(p.w_query, 1024, 2048, (bf16*)(ws + WS_WQ), 0, 1024, 0, p.norm2_g, scr, r, lane);
    }
    const size_t gtid = (size_t)bid * NTHR + wave * 64 + lane, nthr = (size_t)G * NTHR;
    cvt_flat(p.sub_keys, (bf16*)(ws + WS_SUBK), (size_t)(8 * 2 * 128 * 128) / 8, gtid, nthr);
    bf16* N1 = (bf16*)p.out;
    f32x4 gv[4];
#pragma unroll
    for (int j = 0; j < 4; ++j) gv[j] = *((const f32x4*)p.norm1_g + lane + 64 * j);
    for (int m0 = gw; m0 < T; m0 += 2 * NGW) {
        const int m1 = (m0 + NGW < T) ? m0 + NGW : m0;
        const f32x4* xr0 = (const f32x4*)(p.x + (size_t)m0 * DM) + lane; const f32x4* xr1 = (const f32x4*)(p.x + (size_t)m1 * DM) + lane;
        f32x4 v0[4], v1[4]; float s0 = 0.f, s1 = 0.f;
#pragma unroll
        for (int j = 0; j < 4; ++j) { v0[j] = xr0[64 * j]; v1[j] = xr1[64 * j]; }
#pragma unroll
        for (int j = 0; j < 4; ++j) { s0 += (v0[j][0] * v0[j][0] + v0[j][1] * v0[j][1]) + (v0[j][2] * v0[j][2] + v0[j][3] * v0[j][3]);
                                      s1 += (v1[j][0] * v1[j][0] + v1[j][1] * v1[j][1]) + (v1[j][2] * v1[j][2] + v1[j][3] * v1[j][3]); }
        const float r0 = rsqrtf(wave_sum(s0) * (1.f / DM) + EPS), r1 = rsqrtf(wave_sum(s1) * (1.f / DM) + EPS);
        u32x2* o0 = (u32x2*)(N1 + (size_t)m0 * 2048) + lane; u32x2* o1 = (u32x2*)(N1 + (size_t)m1 * 2048) + lane;
#pragma unroll
        for (int j = 0; j < 4; ++j) { u32x2 o; o.x = cvtpk(v0[j][0] * r0 * gv[j][0], v0[j][1] * r0 * gv[j][1]); o.y = cvtpk(v0[j][2] * r0 * gv[j][2], v0[j][3] * r0 * gv[j][3]); o0[64 * j] = o;
            u32x2 q; q.x = cvtpk(v1[j][0] * r1 * gv[j][0], v1[j][1] * r1 * gv[j][1]); q.y = cvtpk(v1[j][2] * r1 * gv[j][2], v1[j][3] * r1 * gv[j][3]); o1[64 * j] = q; }
    }
}

__device__ __forceinline__ void up8(const bf16* p, float (&f)[8]) { const u32x4 w = *(const u32x4*)p; pg8::unpack8(w, f); }
__device__ __forceinline__ void phase_conv(const Params& p, int G, int bid, int tid) {
    const bf16* PR = (const bf16*)(p.ws + WS_BIG + B_PR); bf16* CBU = (bf16*)p.out + 1024;
    const size_t nthr = (size_t)G * NTHR;
    for (size_t it = (size_t)bid * NTHR + tid; it < (size_t)T * 128; it += nthr) {
        const int t = (int)(it >> 7), c8 = (int)(it & 127) * 8, s = t & (SEQ - 1);
        const bf16* row = PR + (size_t)t * 1024 + c8;
        float cb[8], a[8], acc[8];
        up8(CBU + (size_t)t * 2048 + c8, cb); up8(row, a);
        const f32x4 w2a = *(const f32x4*)(p.conv_w + 2048 + c8), w2b = *(const f32x4*)(p.conv_w + 2048 + c8 + 4);
#pragma unroll
        for (int i = 0; i < 8; ++i) acc[i] = (i < 4 ? w2a[i] : w2b[i - 4]) * a[i];
        if (s >= 1) { up8(row - 1024, a);
            const f32x4 w1a = *(const f32x4*)(p.conv_w + 1024 + c8), w1b = *(const f32x4*)(p.conv_w + 1024 + c8 + 4);
#pragma unroll
            for (int i = 0; i < 8; ++i) acc[i] += (i < 4 ? w1a[i] : w1b[i - 4]) * a[i]; }
        if (s >= 2) { up8(row - 2048, a);
            const f32x4 w0a = *(const f32x4*)(p.conv_w + c8), w0b = *(const f32x4*)(p.conv_w + c8 + 4);
#pragma unroll
            for (int i = 0; i < 8; ++i) acc[i] += (i < 4 ? w0a[i] : w0b[i - 4]) * a[i]; }
        u32x4 o; o.x = cvtpk(cb[0] * acc[0], cb[1] * acc[1]); o.y = cvtpk(cb[2] * acc[2], cb[3] * acc[3]); o.z = cvtpk(cb[4] * acc[4], cb[5] * acc[5]); o.w = cvtpk(cb[6] * acc[6], cb[7] * acc[7]);
        *(u32x4*)(CBU + (size_t)t * 2048 + c8) = o;
    }
}

constexpr int KPITCH = 272, VPITCH = 320, KBYTES = 64 * KPITCH, STAGEB = KBYTES + 64 * VPITCH;
constexpr int XOFF = 0, OSTOFF = 65536, OSTPITCH = 272, OSTB = 32 * OSTPITCH;
__device__ __forceinline__ s16x4 vtr(const LAS unsigned char* p) { return __builtin_amdgcn_ds_read_tr16_b64_v4i16((LAS s16x4*)p); }

__device__ __forceinline__ void attn_unit(LAS unsigned char* lds, const bf16* QKV, bf16* ON, const float* subg, float lam, int b, int h, int qb, int tid) {
    const int w = __builtin_amdgcn_readfirstlane(tid >> 6), lane = tid & 63, map = w >> 2, wq = w & 3, l31 = lane & 31, half = lane >> 5;
    const size_t trow0 = (size_t)b * SEQ;
    const int q0 = qb * 128 + wq * 32;
    bf16x8 qf[4];
    { const bf16* qp = QKV + (trow0 + q0 + l31) * 3072 + h * 128 + map * 64 + 8 * half;
#pragma unroll
      for (int s = 0; s < 4; ++s) qf[s] = *(const bf16x8*)(qp + 16 * s); }
    f32x16 O[4];
#pragma unroll
    for (int e = 0; e < 4; ++e)
#pragma unroll
        for (int r = 0; r < 16; ++r) O[e][r] = 0.f;
    float m_run = 0.f, l_run = 0.f;
    const int ntile = 2 * (qb + 1);
    const int skey = tid >> 4, sch = tid & 15;
    const bf16* gk = QKV + (trow0 + skey) * 3072 + 1024 + h * 128 + sch * 8;
    const int dk = skey * KPITCH + sch * 16, dv = KBYTES + skey * VPITCH + sch * 16;
    u32x4 stg[4];
#define GLOAD(j) do { const bf16* g_ = gk + (size_t)(j) * 64 * 3072; stg[0] = *(const u32x4*)g_; stg[1] = *(const u32x4*)(g_ + 32 * 3072); stg[2] = *(const u32x4*)(g_ + 1024); stg[3] = *(const u32x4*)(g_ + 32 * 3072 + 1024); } while (0)
#define LSTORE(st) do { LAS unsigned char* b_ = lds + (st) * STAGEB; *(LAS u32x4*)(b_ + dk) = stg[0]; *(LAS u32x4*)(b_ + dk + 32 * KPITCH) = stg[1]; *(LAS u32x4*)(b_ + dv) = stg[2]; *(LAS u32x4*)(b_ + dv + 32 * VPITCH) = stg[3]; } while (0)
    GLOAD(0); LSTORE(0); __syncthreads();
    const int koff = l31 * KPITCH + map * 128 + half * 16;
    const int voff = KBYTES + (4 * half + ((lane & 15) >> 2)) * VPITCH + (((lane >> 4) & 1) * 16 + (lane & 3) * 4) * 2;
    const int qi = q0 + l31;
    for (int j = 0; j < ntile; ++j) {
        if (j + 1 < ntile) GLOAD(j + 1);
        const int kbase = 64 * j;
        if (kbase <= q0 + 31) {
            const LAS unsigned char* sb = lds + (j & 1) * STAGEB;
            f32x16 s0, s1;
            const float negm = -m_run;
#pragma unroll
            for (int r = 0; r < 16; ++r) { s0[r] = negm; s1[r] = negm; }
#pragma unroll
            for (int s = 0; s < 4; ++s) { const bf16x8 k0 = *(const LAS bf16x8*)(sb + koff + s * 32), k1 = *(const LAS bf16x8*)(sb + koff + 32 * KPITCH + s * 32);
                s0 = __builtin_amdgcn_mfma_f32_32x32x16_bf16(k0, qf[s], s0, 0, 0, 0); s1 = __builtin_amdgcn_mfma_f32_32x32x16_bf16(k1, qf[s], s1, 0, 0, 0); }
            const LAS unsigned char* vb = sb + voff;
            s16x4 vlo[4][4], vhi[4][4];
            if (kbase + 63 > q0) {
#pragma unroll
                for (int r = 0; r < 16; ++r) { const int key = kbase + (r & 3) + 8 * (r >> 2) + 4 * half;
                    s0[r] = (key <= qi) ? s0[r] : -1e30f; s1[r] = (key + 32 <= qi) ? s1[r] : -1e30f; }
            }
            float mx = fmaxf(s0[0], s1[0]);
#pragma unroll
            for (int r = 1; r < 16; ++r) mx = fmaxf(mx, fmaxf(s0[r], s1[r]));
            mx = fmaxf(mx, __shfl_xor(mx, 32));
            float ps = 0.f;
            const bool first = (j == 0), move = first || (__ballot(mx > 8.f) != 0ull);
            const float delta = move ? (first ? mx : fmaxf(mx, 0.f)) : 0.f;
#pragma unroll
            for (int r = 0; r < 16; ++r) { s0[r] = __builtin_amdgcn_exp2f(s0[r] - delta); s1[r] = __builtin_amdgcn_exp2f(s1[r] - delta); ps += s0[r] + s1[r]; }
            if (move) {
                const float alpha = first ? 0.f : __builtin_amdgcn_exp2f(-delta); m_run += delta;
                l_run = l_run * alpha + ps;
                if (!first) {
#pragma unroll
                    for (int e = 0; e < 4; ++e) O[e] = O[e] * alpha;
                }
            } else l_run += ps;
            bf16x8 pf[4];
#pragma unroll
            for (int kk = 0; kk < 4; ++kk) { u32x4 wv;
                if (kk < 2) { wv.x = cvtpk(s0[8 * kk + 0], s0[8 * kk + 1]); wv.y = cvtpk(s0[8 * kk + 2], s0[8 * kk + 3]); wv.z = cvtpk(s0[8 * kk + 4], s0[8 * kk + 5]); wv.w = cvtpk(s0[8 * kk + 6], s0[8 * kk + 7]); }
                else { const int k2 = kk - 2; wv.x = cvtpk(s1[8 * k2 + 0], s1[8 * k2 + 1]); wv.y = cvtpk(s1[8 * k2 + 2], s1[8 * k2 + 3]); wv.z = cvtpk(s1[8 * k2 + 4], s1[8 * k2 + 5]); wv.w = cvtpk(s1[8 * k2 + 6], s1[8 * k2 + 7]); }
                pf[kk] = __builtin_bit_cast(bf16x8, wv); }
#pragma unroll
            for (int e = 0; e < 4; ++e) { vlo[0][e] = vtr(vb + e * 64); vhi[0][e] = vtr(vb + 8 * VPITCH + e * 64); }
#pragma unroll
            for (int kk = 0; kk < 4; ++kk)
#pragma unroll
                for (int e = 0; e < 4; ++e) {
                    if (e == 0 && kk < 3) {
#pragma unroll
                        for (int e2 = 0; e2 < 4; ++e2) { vlo[kk + 1][e2] = vtr(vb + (kk + 1) * 16 * VPITCH + e2 * 64); vhi[kk + 1][e2] = vtr(vb + ((kk + 1) * 16 + 8) * VPITCH + e2 * 64); }
                        __builtin_amdgcn_sched_barrier(0);
                    }
                    const s16x4 lo = vlo[kk][e], hi = vhi[kk][e];
                    bf16x8 a; a[0] = lo[0]; a[1] = lo[1]; a[2] = lo[2]; a[3] = lo[3]; a[4] = hi[0]; a[5] = hi[1]; a[6] = hi[2]; a[7] = hi[3];
                    O[e] = __builtin_amdgcn_mfma_f32_32x32x16_bf16(a, pf[kk], O[e], 0, 0, 0); }
        }
        if (j + 1 < ntile) LSTORE((j + 1) & 1);
        __syncthreads();
    }
#undef GLOAD
#undef LSTORE
    const float ltot = l_run + __shfl_xor(l_run, 32), inv = 1.f / ltot;
    LAS float* X = (LAS float*)(lds + XOFF) + wq * 4096 + lane;
    if (map == 1) {
        const float sc = inv * lam;
#pragma unroll
        for (int e = 0; e < 4; ++e)
#pragma unroll
            for (int r = 0; r < 16; ++r) X[(e * 16 + r) * 64] = O[e][r] * sc;
    }
    __syncthreads();
    if (map == 0) {
        float ssq = 0.f;
#pragma unroll
        for (int e = 0; e < 4; ++e)
#pragma unroll
            for (int r = 0; r < 16; ++r) { const float o = O[e][r] * inv - X[(e * 16 + r) * 64]; O[e][r] = o; ssq += o * o; }
        ssq += __shfl_xor(ssq, 32);
        const float rms = rsqrtf(ssq * (1.f / 128.f) + EPS) * 0.8f;
        LAS unsigned char* ost = lds + OSTOFF + wq * OSTB;
#pragma unroll
        for (int e = 0; e < 4; ++e)
#pragma unroll
            for (int rq = 0; rq < 4; ++rq) { const int e0 = 32 * e + 8 * rq + 4 * half; const f32x4 g = *(const f32x4*)(subg + e0);
                u32x2 o; o.x = cvtpk(O[e][4 * rq + 0] * rms * g[0], O[e][4 * rq + 1] * rms * g[1]); o.y = cvtpk(O[e][4 * rq + 2] * rms * g[2], O[e][4 * rq + 3] * rms * g[3]);
                *(LAS u32x2*)(ost + l31 * OSTPITCH + e0 * 2) = o; }
        LDS_WAIT(); __builtin_amdgcn_wave_barrier();
#pragma unroll
        for (int jj = 0; jj < 8; ++jj) { const int c = lane + 64 * jj, row = c >> 4, ch = c & 15;
            const u32x4 v = *(const LAS u32x4*)(ost + row * OSTPITCH + ch * 16);
            *(u32x4*)(ON + (trow0 + q0 + row) * 2048 + h * 128 + ch * 8) = v; }
    }
    __syncthreads();
}

__device__ __forceinline__ void phase_attn(const Params& p, LAS unsigned char* lds, int G, int bid, int tid) {
    const bf16* QKV = (const bf16*)(p.ws + WS_BIG); bf16* ON = (bf16*)p.out;
    const int lane = tid & 63;
    const float a = p.lambda_qk[lane] * p.lambda_qk[64 + lane], b = p.lambda_qk[128 + lane] * p.lambda_qk[192 + lane];
    const float lam = expf(wave_sum(a)) - expf(wave_sum(b)) + 0.2f;
    for (int c = bid; c < 256; c += G) {
        const int bh = c >> 2, quad = c & 3, b_ = bh >> 3, h = bh & 7;
        attn_unit(lds, QKV, ON, p.subln_g, lam, b_, h, 15 - 2 * quad, tid);
        attn_unit(lds, QKV, ON, p.subln_g, lam, b_, h, 2 * quad, tid);
        attn_unit(lds, QKV, ON, p.subln_g, lam, b_, h, 14 - 2 * quad, tid);
        attn_unit(lds, QKV, ON, p.subln_g, lam, b_, h, 2 * quad + 1, tid);
    }
}

__device__ __forceinline__ unsigned mono(float v) { const unsigned u = __builtin_bit_cast(unsigned, v); return (u & 0x80000000u) ? ~u : (u | 0x80000000u); }
__device__ __forceinline__ float unmono(unsigned k) { const unsigned u = (k & 0x80000000u) ? (k ^ 0x80000000u) : ~k; return __builtin_bit_cast(float, u); }
#define CE_(x, y) do { const unsigned t_ = max(x, y); y = min(x, y); x = t_; } while (0)
__device__ __forceinline__ void sort16(unsigned (&a)[16]) {
    CE_(a[0], a[1]); CE_(a[2], a[3]); CE_(a[0], a[2]); CE_(a[1], a[3]); CE_(a[1], a[2]); CE_(a[4], a[5]); CE_(a[6], a[7]); CE_(a[4], a[6]); CE_(a[5], a[7]); CE_(a[5], a[6]); CE_(a[0], a[4]); CE_(a[2], a[6]); CE_(a[2], a[4]); CE_(a[1], a[5]); CE_(a[3], a[7]); CE_(a[3], a[5]); CE_(a[1], a[2]); CE_(a[3], a[4]); CE_(a[5], a[6]); CE_(a[8], a[9]); CE_(a[10], a[11]); CE_(a[8], a[10]); CE_(a[9], a[11]); CE_(a[9], a[10]); CE_(a[12], a[13]); CE_(a[14], a[15]); CE_(a[12], a[14]); CE_(a[13], a[15]); CE_(a[13], a[14]); CE_(a[8], a[12]); CE_(a[10], a[14]); CE_(a[10], a[12]); CE_(a[9], a[13]); CE_(a[11], a[15]); CE_(a[11], a[13]); CE_(a[9], a[10]); CE_(a[11], a[12]); CE_(a[13], a[14]); CE_(a[0], a[8]); CE_(a[4], a[12]); CE_(a[4], a[8]); CE_(a[2], a[10]); CE_(a[6], a[14]); CE_(a[6], a[10]); CE_(a[2], a[4]); CE_(a[6], a[8]); CE_(a[10], a[12]); CE_(a[1], a[9]); CE_(a[5], a[13]); CE_(a[5], a[9]); CE_(a[3], a[11]); CE_(a[7], a[15]); CE_(a[7], a[11]); CE_(a[3], a[5]); CE_(a[7], a[9]); CE_(a[11], a[13]); CE_(a[1], a[2]); CE_(a[3], a[4]); CE_(a[5], a[6]); CE_(a[7], a[8]); CE_(a[9], a[10]); CE_(a[11], a[12]); CE_(a[13], a[14]);
}
__device__ __forceinline__ void merge16(unsigned (&a)[16], const unsigned (&b)[16]) {
    a[0] = max(a[0], b[15]); a[1] = max(a[1], b[14]); a[2] = max(a[2], b[13]); a[3] = max(a[3], b[12]); a[4] = max(a[4], b[11]); a[5] = max(a[5], b[10]); a[6] = max(a[6], b[9]); a[7] = max(a[7], b[8]); a[8] = max(a[8], b[7]); a[9] = max(a[9], b[6]); a[10] = max(a[10], b[5]); a[11] = max(a[11], b[4]); a[12] = max(a[12], b[3]); a[13] = max(a[13], b[2]); a[14] = max(a[14], b[1]); a[15] = max(a[15], b[0]);
    CE_(a[0], a[8]); CE_(a[1], a[9]); CE_(a[2], a[10]); CE_(a[3], a[11]); CE_(a[4], a[12]); CE_(a[5], a[13]); CE_(a[6], a[14]); CE_(a[7], a[15]); CE_(a[0], a[4]); CE_(a[1], a[5]); CE_(a[2], a[6]); CE_(a[3], a[7]); CE_(a[8], a[12]); CE_(a[9], a[13]); CE_(a[10], a[14]); CE_(a[11], a[15]); CE_(a[0], a[2]); CE_(a[1], a[3]); CE_(a[4], a[6]); CE_(a[5], a[7]); CE_(a[8], a[10]); CE_(a[9], a[11]); CE_(a[12], a[14]); CE_(a[13], a[15]); CE_(a[0], a[1]); CE_(a[2], a[3]); CE_(a[4], a[5]); CE_(a[6], a[7]); CE_(a[8], a[9]); CE_(a[10], a[11]); CE_(a[12], a[13]); CE_(a[14], a[15]);
}

__device__ __forceinline__ void convert_experts(const Params& p, size_t gtid, size_t nthr) {
    cvt_flat_fp8(p.expert_u, p.ws + WS_EU, (size_t)16384 * 1024 / 16, ESCALE, gtid, nthr);
    cvt_flat_fp8(p.expert_v, p.ws + WS_EV, (size_t)16384 * 1024 / 16, ESCALE, gtid, nthr);
}
__device__ __forceinline__ void phase_topk(const Params& p, LAS unsigned char* lds, int G, int bid, int wave, int lane) {
    const bf16* QP = (const bf16*)(p.ws + WS_BIG + B_QP); const bf16* SK = (const bf16*)(p.ws + WS_SUBK);
    int* SEL = (int*)(p.ws + WS_BIG + B_SEL); float* GATE = (float*)(p.ws + WS_BIG + B_GATE);
    const int gw = bid * NWAVES + wave, NGW = G * NWAVES, l31 = lane & 31, half = lane >> 5;
    LAS int* tab = (LAS int*)(lds + wave * 12288) + l31 * 32;
    LAS unsigned char* qst = lds + wave * 12288 + 4096 + lane * 16;
    LAS unsigned char* skl = lds + 8 * 12288;
    const float* ctab = (wave < 4) ? p.expert_u : p.expert_v; unsigned char* cdst = p.ws + ((wave < 4) ? WS_EU : WS_EV);
    const int tid_ = wave * 64 + lane;
    for (int sbk = bid; sbk < 256; sbk += G)
    for (int rnd = 0; rnd < 2; ++rnd) {
        const int tg = 8 * (sbk >> 2) + wave, h = 2 * (sbk & 3) + rnd, t = tg * 32 + l31;
        unsigned lists[2][16];
#pragma unroll
        for (int m = 0; m < 2; ++m) {
            f32x16 acc[4];
#pragma unroll
            for (int kb = 0; kb < 4; ++kb)
#pragma unroll
                for (int r = 0; r < 16; ++r) acc[kb][r] = 0.f;
            const bf16* qp = QP + (size_t)t * 2048 + h * 256 + m * 128 + 8 * half;
            { const bf16* sks = SK + (size_t)(h * 2 + m) * 128 * 128;
#pragma unroll
              for (int jj = 0; jj < 4; ++jj) { const int c = tid_ + 512 * jj, row = c >> 4, ch = c & 15;
                  *(LAS u32x4*)(skl + row * 272 + ch * 16) = *(const u32x4*)(sks + row * 128 + ch * 8); } }
            __syncthreads();
            const size_t cbase = ((size_t)(sbk * 4 + (wave & 3)) * 1024 + (size_t)(rnd * 2 + m) * 256 + lane) * 16;
#define CAST_SLICE() do { _Pragma("unroll") for (int j = 0; j < 4; ++j) { const size_t o_ = cbase + (size_t)j * 64 * 16; u32x4 w_; \
                _Pragma("unroll") for (int q = 0; q < 4; ++q) { const f32x4 a_ = *(const f32x4*)(ctab + o_ + 4 * q) * ESCALE; int x_ = 0; \
                    x_ = __builtin_amdgcn_cvt_pk_fp8_f32(a_[0], a_[1], x_, false); x_ = __builtin_amdgcn_cvt_pk_fp8_f32(a_[2], a_[3], x_, true); w_[q] = (unsigned)x_; } \
                *(u32x4*)(cdst + o_) = w_; } } while (0)
            if (wave < 4) CAST_SLICE();
            const LAS unsigned char* kl = skl + l31 * 272 + half * 16;
            { u32x4 tq[8];
#pragma unroll
              for (int s = 0; s < 8; ++s) tq[s] = *(const u32x4*)(qp + 16 * s);
#pragma unroll
              for (int s = 0; s < 8; ++s) *(LAS u32x4*)(qst + s * 1024) = tq[s]; }
#pragma unroll 2
            for (int s = 0; s < 8; ++s) {
                const bf16x8 bq = *(const LAS bf16x8*)(qst + s * 1024);
#pragma unroll
                for (int kb = 0; kb < 4; ++kb) { const bf16x8 ak = *(const LAS bf16x8*)(kl + kb * 32 * 272 + s * 32); acc[kb] = __builtin_amdgcn_mfma_f32_32x32x16_bf16(ak, bq, acc[kb], 0, 0, 0); }
            }
            unsigned top[16], oth[16];
#pragma unroll
            for (int kb = 0; kb < 4; ++kb) {
#pragma unroll
                for (int r = 0; r < 16; ++r) { const int kidx = 32 * kb + (r & 3) + 8 * (r >> 2) + 4 * half; oth[r] = (mono(acc[kb][r]) & ~127u) | (unsigned)(127 - kidx); }
                sort16(oth);
                if (kb == 0) {
#pragma unroll
                    for (int i = 0; i < 16; ++i) top[i] = oth[i];
                } else merge16(top, oth);
            }
#pragma unroll
            for (int i = 0; i < 16; ++i) oth[i] = (unsigned)__shfl_xor((int)top[i], 32);
            merge16(top, oth);
#pragma unroll
            for (int i = 0; i < 16; ++i) lists[m][i] = top[i];
            if (wave >= 4) CAST_SLICE();
#undef CAST_SLICE
            __syncthreads();
        }
        float va[16], vb[16];
#pragma unroll
        for (int i = 0; i < 16; ++i) { va[i] = unmono(lists[0][i] & ~127u); vb[i] = unmono(lists[1][i] & ~127u);
            tab[i] = 127 - (int)(lists[0][i] & 127u); tab[16 + i] = 127 - (int)(lists[1][i] & 127u); }
#define CKEY(i, j) ((mono(va[i] + vb[j]) & ~255u) | (unsigned)(255 - ((i) * 16 + (j))))
        unsigned ct[16], l1[16], l2[16], l3[16];
#pragma unroll
        for (int j = 0; j < 16; ++j) ct[j] = CKEY(0, j);
#pragma unroll
        for (int j = 0; j < 8; ++j) l1[j] = CKEY(1, j);
#pragma unroll
        for (int j = 0; j < 5; ++j) l1[8 + j] = CKEY(2, j);
        l1[13] = 0u; l1[14] = 0u; l1[15] = 0u;
#pragma unroll
        for (int j = 0; j < 4; ++j) l2[j] = CKEY(3, j);
#pragma unroll
        for (int j = 0; j < 3; ++j) l2[4 + j] = CKEY(4, j);
#pragma unroll
        for (int j = 0; j < 2; ++j) { l2[7 + j] = CKEY(5, j); l2[9 + j] = CKEY(6, j); l2[11 + j] = CKEY(7, j); }
        l2[13] = 0u; l2[14] = 0u; l2[15] = 0u;
#pragma unroll
        for (int i = 0; i < 8; ++i) { l3[i] = CKEY(8 + i, 0); l3[8 + i] = 0u; }
#undef CKEY
        sort16(l1); sort16(l2); sort16(l3);
        merge16(ct, l1); merge16(l2, l3); merge16(ct, l2);
        LDS_WAIT(); __builtin_amdgcn_wave_barrier();
        const float s0 = unmono(ct[0] & ~255u);
        float ev[16], es = 0.f; int ex[16];
#pragma unroll
        for (int r = 0; r < 16; ++r) { const int pos = 255 - (int)(ct[r] & 255u); ev[r] = __expf(unmono(ct[r] & ~255u) - s0); es += ev[r];
            ex[r] = tab[pos >> 4] * 128 + tab[16 + (pos & 15)]; }
        const float ie = 1.f / es;
        int* so = SEL + (size_t)t * 128 + h * 16; float* go = GATE + (size_t)t * 128 + h * 16;
        if (half == 0) {
#pragma unroll
            for (int r = 0; r < 8; ++r) { so[r] = ex[r]; go[r] = ev[r] * ie; }
        } else {
#pragma unroll
            for (int r = 8; r < 16; ++r) { so[r] = ex[r]; go[r] = ev[r] * ie; }
        }
        LDS_WAIT(); __builtin_amdgcn_wave_barrier();
    }
}

__device__ __forceinline__ float gelu_as(float v) {
    const float av = fabsf(v), t = __builtin_amdgcn_rcpf(av * 0.2316418882f + 1.0f);
    float q = t * 0.5307027145f + (-0.7265760135f); q = q * t + 0.7107068705f; q = q * t + (-0.142248368f); q = q * t + 0.127414796f; q = q * t;
    const float e = __builtin_amdgcn_exp2f((v * v) * (-0.72134752044f)), m = v * (q * e);
    return v < 0.f ? m : v - m;
}
constexpr int KT = 4;
constexpr int GW_LDS = 17152;
constexpr int UPITCH = 272, USTG = 16 * UPITCH;
static_assert(KT == 4, "LDS map of the gather phase is laid out for 4 tokens per wave");
__device__ __forceinline__ void phase_gather(const Params& p, LAS unsigned char* lds, int G, int bid, int wave, int lane) {
    const int* SEL = (const int*)(p.ws + WS_BIG + B_SEL); const float* GATE = (const float*)(p.ws + WS_BIG + B_GATE);
    const unsigned char* EU = p.ws + WS_EU; const unsigned char* EV = p.ws + WS_EV;
    float* H2 = p.out;
    const int gw = bid * NWAVES + wave, NGW = G * NWAVES, l15 = lane & 15, g4 = lane >> 4;
    LAS unsigned char* wl = lds + wave * GW_LDS;
    LAS unsigned char* xnb = wl; LAS int* selb = (LAS int*)(wl + 4096); LAS float* gateb = (LAS float*)(wl + 6144); LAS float* hb = (LAS float*)(wl + 8192); LAS unsigned char* ustg = wl + 8448;
    for (int tb = gw * KT; tb < T; tb += NGW * KT) {
#pragma unroll 1
        for (int k = 0; k < KT; ++k) {
            const int t = tb + k;
            const float* hrow = H2 + (size_t)t * DM + 16 * lane;
            f32x4 hv[4];
#pragma unroll
            for (int j = 0; j < 4; ++j) hv[j] = *(const f32x4*)(hrow + 4 * j);
            const int selA = SEL[(size_t)t * 128 + lane], selB = SEL[(size_t)t * 128 + 64 + lane];
            const float gtA = GATE[(size_t)t * 128 + lane], gtB = GATE[(size_t)t * 128 + 64 + lane];
            float ssq = 0.f;
#pragma unroll
            for (int j = 0; j < 4; ++j) ssq += (hv[j][0] * hv[j][0] + hv[j][1] * hv[j][1]) + (hv[j][2] * hv[j][2] + hv[j][3] * hv[j][3]);
            const float r2 = rsqrtf(wave_sum(ssq) * (1.f / DM) + EPS);
            { u32x4 o;
#pragma unroll
              for (int j = 0; j < 4; ++j) { const f32x4 a = hv[j] * r2 * *(const f32x4*)(p.norm2_g + 16 * lane + 4 * j); int w = 0;
                  w = __builtin_amdgcn_cvt_pk_fp8_f32(a[0], a[1], w, false); w = __builtin_amdgcn_cvt_pk_fp8_f32(a[2], a[3], w, true); o[j] = (unsigned)w; }
              *(LAS u32x4*)(xnb + k * 1024 + 16 * lane) = o; }
            const int bA = selA >> 10, bB = selB >> 10; int posA = 0, posB = 0, off = 0;
#pragma unroll
            for (int b = 0; b < 16; ++b) {
                const unsigned long long mA = __ballot(bA == b), mB = __ballot(bB == b);
                const int cA = __popcll(mA), cB = __popcll(mB);
                const int rA = (int)__builtin_amdgcn_mbcnt_hi((unsigned)(mA >> 32), __builtin_amdgcn_mbcnt_lo((unsigned)mA, 0u));
                const int rB = (int)__builtin_amdgcn_mbcnt_hi((unsigned)(mB >> 32), __builtin_amdgcn_mbcnt_lo((unsigned)mB, 0u));
                if (bA == b) posA = off + rA;
                if (bB == b) posB = off + cA + rB;
                off += cA + cB;
            }
            selb[k * 128 + posA] = selA; gateb[k * 128 + posA] = gtA; selb[k * 128 + posB] = selB; gateb[k * 128 + posB] = gtB;
        }
        LDS_WAIT(); __builtin_amdgcn_wave_barrier();
        f32x2_t y[KT][8];
#pragma unroll
        for (int k = 0; k < KT; ++k)
#pragma unroll
            for (int i = 0; i < 8; ++i) y[k][i] = (f32x2_t){0.f, 0.f};
#pragma unroll 1
        for (int g = 0; g < 8; ++g) {
#pragma unroll
            for (int k = 0; k < KT; ++k) {
                asm volatile("" ::: "memory");
                f32x4 acc = (f32x4){0.f, 0.f, 0.f, 0.f};
                const int rr = lane >> 4, cc = lane & 15;
                const unsigned char* rp[4];
#pragma unroll
                for (int i = 0; i < 4; ++i) rp[i] = EU + (size_t)selb[k * 128 + 16 * g + 4 * i + rr] * DM + 16 * cc;
                u32x4 ld[4];
#pragma unroll
                for (int i = 0; i < 4; ++i) ld[i] = *(const u32x4*)(rp[i]);
#pragma unroll
                for (int qd = 0; qd < 4; ++qd) {
                    LAS unsigned char* sb = ustg + (qd & 1) * USTG;
#pragma unroll
                    for (int i = 0; i < 4; ++i) *(LAS u32x4*)(sb + (4 * i + rr) * UPITCH + 16 * cc) = ld[i];
                    if (qd < 3) {
#pragma unroll
                        for (int i = 0; i < 4; ++i) ld[i] = *(const u32x4*)(rp[i] + 256 * (qd + 1));
                    }
                    LDS_WAIT(); __builtin_amdgcn_wave_barrier();
                    const LAS unsigned char* ar = sb + l15 * UPITCH + 64 * g4;
                    const LAS unsigned char* xk = xnb + k * 1024 + 256 * qd + 64 * g4;
#pragma unroll
                    for (int i = 0; i < 4; ++i) { const u32x4 a = *(const LAS u32x4*)(ar + 16 * i); const u32x4 bx = *(const LAS u32x4*)(xk + 16 * i);
                        const long a0 = (long)(((unsigned long long)a.y << 32) | a.x), a1 = (long)(((unsigned long long)a.w << 32) | a.z);
                        const long b0 = (long)(((unsigned long long)bx.y << 32) | bx.x), b1 = (long)(((unsigned long long)bx.w << 32) | bx.z);
                        acc = __builtin_amdgcn_mfma_f32_16x16x32_fp8_fp8(a0, b0, acc, 0, 0, 0);
                        acc = __builtin_amdgcn_mfma_f32_16x16x32_fp8_fp8(a1, b1, acc, 0, 0, 0); }
                }
                if (l15 == 0) {
#pragma unroll
                    for (int j = 0; j < 4; ++j) { const float a = acc[j] * (1.f / ESCALE);
                        hb[k * 16 + 4 * g4 + j] = gelu_as(a) * gateb[k * 128 + 16 * g + 4 * g4 + j] * (1.f / ESCALE); }
                }
            }
            LDS_WAIT(); __builtin_amdgcn_wave_barrier();
#pragma unroll
            for (int k = 0; k < KT; ++k) {
                asm volatile("" ::: "memory");
                u32x4 vr[2][4];
#pragma unroll
                for (int i = 0; i < 4; ++i) vr[0][i] = *(const u32x4*)(EV + (size_t)selb[k * 128 + 16 * g + i] * DM + 16 * lane);
#pragma unroll
                for (int bt = 0; bt < 4; ++bt) {
                    if (bt < 3) {
#pragma unroll
                        for (int i = 0; i < 4; ++i) vr[(bt + 1) & 1][i] = *(const u32x4*)(EV + (size_t)selb[k * 128 + 16 * g + 4 * (bt + 1) + i] * DM + 16 * lane);
                    }
                    asm volatile("" ::: "memory");
#pragma unroll
                    for (int i = 0; i < 4; ++i) { const float hs = hb[k * 16 + 4 * bt + i]; const u32x4 v = vr[bt & 1][i];
#pragma unroll
                        for (int q = 0; q < 4; ++q) { const f32x2_t lo = __builtin_amdgcn_cvt_pk_f32_fp8((int)v[q], false), hi = __builtin_amdgcn_cvt_pk_f32_fp8((int)v[q], true);
                            y[k][2 * q] += lo * hs; y[k][2 * q + 1] += hi * hs; } }
                }
            }
            LDS_WAIT(); __builtin_amdgcn_wave_barrier();
        }
#pragma unroll
        for (int k = 0; k < KT; ++k) {
            float* hrow = H2 + (size_t)(tb + k) * DM + 16 * lane;
            f32x4 h3[4]; float s3 = 0.f;
#pragma unroll
            for (int j = 0; j < 4; ++j) { const f32x4 hv = *(const f32x4*)(hrow + 4 * j);
                h3[j][0] = hv[0] + y[k][2 * j][0]; h3[j][1] = hv[1] + y[k][2 * j][1]; h3[j][2] = hv[2] + y[k][2 * j + 1][0]; h3[j][3] = hv[3] + y[k][2 * j + 1][1];
                s3 += (h3[j][0] * h3[j][0] + h3[j][1] * h3[j][1]) + (h3[j][2] * h3[j][2] + h3[j][3] * h3[j][3]); }
            const float r3 = rsqrtf(wave_sum(s3) * (1.f / DM) + EPS);
#pragma unroll
            for (int j = 0; j < 4; ++j) *(f32x4*)(hrow + 4 * j) = h3[j] * r3 * *(const f32x4*)(p.final_g + 16 * lane + 4 * j);
        }
        LDS_WAIT(); __builtin_amdgcn_wave_barrier();
    }
}

#define XB_TMO      128
#define XB_XCNT(j)  (256  + 64 * (j))
#define XB_XSUB(j)  (1280 + 64 * (j))
#define XB_XGEN(j)  (2304 + 64 * (j))
#define XB_TOP      3328
#define XB_TOPGEN   3392
#define XCD_BAR_WORDS 3456
#define XB_SPIN_CAP (1u << 18)

__device__ __forceinline__ unsigned xb_ld(unsigned* p)              { return __hip_atomic_load(p, __ATOMIC_RELAXED, __HIP_MEMORY_SCOPE_AGENT); }
__device__ __forceinline__ unsigned xb_add(unsigned* p, unsigned v) { return __hip_atomic_fetch_add(p, v, __ATOMIC_RELAXED, __HIP_MEMORY_SCOPE_AGENT); }
__device__ __forceinline__ unsigned xb_xcc_id() { return (unsigned)__builtin_amdgcn_s_getreg((3 << 11) | 20) & 0xFu; }
#define XB_SPIN(cond, bar) do { unsigned _sp = 0; while (cond) { __builtin_amdgcn_s_sleep(1); \
    if ((++_sp & 255u) == 0u) { if (xb_ld(&(bar)[XB_TMO])) break; if (_sp > XB_SPIN_CAP) { atomicAdd(&(bar)[XB_TMO], 1u); break; } } } } while (0)

struct XcdBarrier {
    unsigned* bar; unsigned x;
    volatile LAS unsigned* st;
};

__device__ __forceinline__ XcdBarrier xcd_barrier_post(unsigned* bar, volatile LAS unsigned* st) {
    XcdBarrier b; b.bar = bar; b.x = xb_xcc_id(); b.st = st;
    if (threadIdx.x == 0) (void)xb_add(&bar[XB_XCNT(b.x)], 1u);
    return b;
}
__device__ __forceinline__ void xcd_barrier_complete(unsigned* bar, unsigned x, unsigned& nloc, unsigned& nx) {
    const unsigned G = gridDim.x * gridDim.y * gridDim.z;
    unsigned sum, cnt, mine, sp = 0u;
    for (;;) {
        sum = 0u; cnt = 0u; mine = 0u;
#pragma unroll
        for (unsigned j = 0; j < 16; ++j) { const unsigned c = xb_ld(&bar[XB_XCNT(j)]); sum += c; cnt += (c > 0u) ? 1u : 0u; mine = (j == x) ? c : mine; }
        if (sum == G) break;
        __builtin_amdgcn_s_sleep(1);
        if ((++sp & 255u) == 0u) { if (xb_ld(&bar[XB_TMO])) break; if (sp > XB_SPIN_CAP) { atomicAdd(&bar[XB_TMO], 1u); break; } }
    }
    nloc = mine > 0u ? mine : 1u; nx = cnt > 0u ? cnt : 1u;
}

__device__ __forceinline__ void xcd_barrier(const XcdBarrier& b) {
    asm volatile("s_waitcnt vmcnt(0)" ::: "memory");
    __syncthreads();
    if (threadIdx.x == 0) {
        unsigned* bar = b.bar;
        __builtin_amdgcn_s_waitcnt(0);
        unsigned nloc = b.st[0], nx = b.st[1];
        if (nloc == 0u) { xcd_barrier_complete(bar, b.x, nloc, nx); b.st[0] = nloc; b.st[1] = nx; }
        const unsigned old = xb_add(&bar[XB_XSUB(b.x)], 1u);
        const unsigned gen = old / nloc;
        if (old + 1u == (gen + 1u) * nloc) {
            __builtin_amdgcn_fence(__ATOMIC_RELEASE, "agent");
            asm volatile("s_waitcnt vmcnt(0)" ::: "memory");
            const unsigned og = xb_add(&bar[XB_TOP], 1u);
            const unsigned tg = og / nx;
            if (og + 1u == (tg + 1u) * nx) xb_add(&bar[XB_TOPGEN], 1u);
            else XB_SPIN(xb_ld(&bar[XB_TOPGEN]) == tg, bar);
            __builtin_amdgcn_fence(__ATOMIC_ACQUIRE, "agent");
            xb_add(&bar[XB_XGEN(b.x)], 1u);
            asm volatile("s_waitcnt vmcnt(0)" ::: "memory");
        } else {
            XB_SPIN(xb_ld(&bar[XB_XGEN(b.x)]) == gen, bar);
            __builtin_amdgcn_fence(__ATOMIC_ACQUIRE, "agent");
            asm volatile("s_waitcnt vmcnt(0)" ::: "memory");
        }
    }
    __syncthreads();
}

#ifndef ONE_LAUNCH
#define ONE_LAUNCH 1
#endif
constexpr int NPHASE = 8;
__global__ void __launch_bounds__(NTHR, 2) hybrid_fwd(Params p) {
    extern __shared__ __attribute__((aligned(16))) unsigned char lds_raw[];
    LAS unsigned char* lds = (LAS unsigned char*)lds_raw;
    const int tid = threadIdx.x, lane = tid & 63, wave = __builtin_amdgcn_readfirstlane(tid >> 6), G = gridDim.x, bid = blockIdx.x;
    unsigned char* ws = p.ws;
    volatile LAS unsigned* xst = (volatile LAS unsigned*)(lds + 139264);
    if (tid < 2) xst[tid] = 0u;
    __syncthreads();
    XcdBarrier xbar; xbar.bar = (unsigned*)(ws + WS_END); xbar.x = 0; xbar.st = xst;
    if (ONE_LAUNCH && p.hi - p.lo > 1) { xbar = xcd_barrier_post((unsigned*)(ws + WS_END), xst); cg::this_grid().sync(); }
    const pg8::bf16_t* N1 = (const pg8::bf16_t*)p.out;
#ifdef ONLY
#define PH(k) if ((k) == ONLY && p.lo <= (k) && (k) < p.hi)
#else
#define PH(k) if (p.lo <= (k) && (k) < p.hi)
#endif
#define SEAM(k) do { if (ONE_LAUNCH && p.lo <= (k) && (k) + 1 < p.hi) { xcd_barrier(xbar); } } while (0)
#define FRESH_IDS int tid = threadIdx.x; asm volatile("" : "+v"(tid)); const int lane = tid & 63, wave = __builtin_amdgcn_readfirstlane(tid >> 6); (void)lane; (void)wave
    unsigned char* big = ws + WS_BIG;
    PH(0) { FRESH_IDS; phase0(p, lds, G, bid, wave, lane); SEAM(0); }
    PH(1) { FRESH_IDS; pg8::Gemm g{N1, (const pg8::bf16_t*)(ws + WS_WIN), T, 8192, 1024, 2048, 1024}; pg8::StaticOrder S; S.init(T, 8192, G, bid);
        pg8::EpiG1 E{(pg8::bf16_t*)(big + B_QKV), (pg8::bf16_t*)(big + B_GG), (pg8::bf16_t*)p.out + 1024, (pg8::bf16_t*)(big + B_PR), C2};
        pg8::gemm_phase<pg8::EpiG1, pg8::StaticOrder, true, true>(lds, g, S, E); SEAM(1); }
    PH(2) { FRESH_IDS; phase_attn(p, lds, G, bid, tid); phase_conv(p, G, bid, tid); SEAM(2); }
    PH(3) { FRESH_IDS; pg8::Gemm g{(const pg8::bf16_t*)p.out, (const pg8::bf16_t*)(ws + WS_WAC), T, 1024, 1024, 2048, 2048}; pg8::SplitKOrder S; S.base.init(T, 1024, G, bid);
        pg8::EpiMerged E{(const pg8::bf16_t*)(big + B_GG), (pg8::bf16_t*)(big + B_MG)};
        pg8::gemm_phase<pg8::EpiMerged, pg8::SplitKOrder, false, true>(lds, g, S, E); SEAM(3); }
    PH(4) { FRESH_IDS; pg8::Gemm g{(const pg8::bf16_t*)(big + B_MG), (const pg8::bf16_t*)(ws + WS_WOUT), T, 1024, 1024, 1024, 1024}; pg8::StaticOrder S; S.init(T, 1024, G, bid);
        pg8::EpiResid E{p.x, p.out, (pg8::bf16_t*)(big + B_H2B), (float*)(ws + WS_SSQ)};
        pg8::gemm_phase<pg8::EpiResid, pg8::StaticOrder, false, true>(lds, g, S, E); SEAM(4); }
    PH(5) { FRESH_IDS; pg8::Gemm g{(const pg8::bf16_t*)(big + B_H2B), (const pg8::bf16_t*)(ws + WS_WQ), T, 2048, 1024, 1024, 1024}; pg8::StaticOrder S; S.init(T, 2048, G, bid);
        pg8::EpiRowScale E{(const float*)(ws + WS_SSQ), (pg8::bf16_t*)(big + B_QP)};
        pg8::gemm_phase<pg8::EpiRowScale, pg8::StaticOrder, true, true>(lds, g, S, E); SEAM(5); }
    PH(6) { FRESH_IDS; phase_topk(p, lds, G, bid, wave, lane); SEAM(6); }
    PH(7) { FRESH_IDS; phase_gather(p, lds, G, bid, wave, lane); }
#undef PH
#undef SEAM
}

extern "C" void kernel_launch(void* const* d_in, const int* in_sizes, int n_in, void* d_out, int out_size, void* d_ws, size_t ws_size, hipStream_t stream) {
    static int grid = 0;
    if (grid == 0) {
        if (n_in != 15 || out_size != T * DM || ws_size < WS_END) { fprintf(stderr, "kernel_launch: unexpected problem (n_in %d out %d ws %zu)\n", n_in, out_size, ws_size); grid = -1; return; }
        int dev = 0, cus = 0, per_cu = 0;
        hipGetDevice(&dev); hipDeviceGetAttribute(&cus, hipDeviceAttributeMultiprocessorCount, dev);
        if (hipFuncSetAttribute((const void*)hybrid_fwd, hipFuncAttributeMaxDynamicSharedMemorySize, LDS_BYTES) != hipSuccess) { fprintf(stderr, "kernel_launch: hipFuncSetAttribute failed\n"); grid = -1; return; }
        if (hipOccupancyMaxActiveBlocksPerMultiprocessor(&per_cu, (const void*)hybrid_fwd, NTHR, LDS_BYTES) != hipSuccess || per_cu < 1) { fprintf(stderr, "kernel_launch: occupancy query says %d\n", per_cu); per_cu = 1; }
        (void)hipGetLastError();
        grid = cus * per_cu;
    }
    if (grid < 0) return;
    Params p{};
    p.x = (const float*)d_in[0]; p.norm1_g = (const float*)d_in[1]; p.w_in = (const float*)d_in[2]; p.lambda_qk = (const float*)d_in[3]; p.subln_g = (const float*)d_in[4];
    p.conv_w = (const float*)d_in[5]; p.w_attn_o = (const float*)d_in[6]; p.w_conv_o = (const float*)d_in[7]; p.w_out = (const float*)d_in[8]; p.norm2_g = (const float*)d_in[9];
    p.w_query = (const float*)d_in[10]; p.sub_keys = (const float*)d_in[11]; p.expert_u = (const float*)d_in[12]; p.expert_v = (const float*)d_in[13]; p.final_g = (const float*)d_in[14];
    p.out = (float*)d_out; p.ws = (unsigned char*)d_ws;
#if ONE_LAUNCH
    p.lo = 0; p.hi = NPHASE;
    (void)hipMemsetAsync((char*)d_ws + WS_END, 0, 16384, stream);
    void* args[] = {&p};
    hipError_t e = hipLaunchCooperativeKernel((const void*)hybrid_fwd, dim3(grid), dim3(NTHR), args, LDS_BYTES, stream);
    if (e != hipSuccess) fprintf(stderr, "cooperative launch failed: %s (grid %d)\n", hipGetErrorString(e), grid);
#else
    for (int k = 0; k < NPHASE; ++k) {
        p.lo = k; p.hi = k + 1; hipLaunchKernelGGL(hybrid_fwd, dim3(grid), dim3(NTHR), LDS_BYTES, stream, p); }
#endif
}
```

```cpp
#include <hip/hip_runtime.h>
#include <hip/hip_cooperative_groups.h>
#include <cstdio>
#include <cstdint>
namespace cg = cooperative_groups;
namespace pg8 {
#define PG8_LAS __attribute__((address_space(3)))
typedef unsigned short bf16_t;
typedef short bf16x8 __attribute__((ext_vector_type(8)));
typedef float f32x4 __attribute__((ext_vector_type(4)));
typedef unsigned u32x4 __attribute__((ext_vector_type(4)));
constexpr int BM = 256, BK = 64, HALF = 128, HTB = HALF * BK * 2  , STAGE_BYTES = 8 * HTB, NXCD = 8, WGM = 8;

__host__ __device__ __forceinline__ int lds_byte(int r, int c) { const int st = (r >> 4) * 2 + (c >> 5), rr = r & 15, cc = c & 31, ob = rr * 64 + cc * 2; return st * 1024 + (ob ^ (((ob >> 9) & 1) << 5)); }
__host__ __device__ __forceinline__ void stage_rc(int b, int& R, int& C) { const int st = b / 1024, sb = b % 1024, swz = sb ^ (((sb >> 9) & 1) << 5); R = (st >> 1) * 16 + swz / 64; C = (st & 1) * 32 + (swz % 64) / 2; }
__host__ __device__ __forceinline__ int perm32(int rho) { const int n = rho >> 4, i = rho & 15; return 8 * (i >> 2) + 4 * n + (i & 3); }

struct Unit { int pm, pn, kh; };
struct Gemm { const bf16_t* A; const bf16_t* Bt; int M, N, K, lda, ldb; };
struct StaticOrder {
    int nM, nN, nwg, G, c;
    __host__ __device__ void init(int M, int N, int G_, int c_) { nM = M / BM; nN = N / BM; nwg = nM * nN; G = G_; c = c_; }
    __host__ __device__ bool next(int i, Unit& u) const {
        const long L = (long)i * G + c; if (L >= nwg) return false;
        int wgid = (int)L; { const int q = nwg / NXCD, r = nwg % NXCD, xcd = wgid % NXCD, off = wgid / NXCD; wgid = (xcd < r ? xcd * (q + 1) : r * (q + 1) + (xcd - r) * q) + off; }
        const int nig = WGM * nN, gid = wgid / nig, fm = gid * WGM, gsz = (nM - fm) < WGM ? (nM - fm) : WGM;
        u.pm = fm + ((wgid % nig) % gsz); u.pn = (wgid % nig) / gsz; u.kh = 0; return true;
    }
    __device__ __forceinline__ void a_ready(const Unit&) const {}
    __device__ __forceinline__ void done(const Unit&) const {}
};
struct SplitKOrder {
    StaticOrder base;
    __host__ __device__ bool next(int i, Unit& u) const { if (!base.next(i >> 1, u)) return false; u.kh = i & 1; return true; }
    __device__ __forceinline__ void a_ready(const Unit&) const {}
    __device__ __forceinline__ void done(const Unit&) const {}
};
__device__ __forceinline__ unsigned cvt_pk_bf16(float lo, float hi) { unsigned r; asm volatile("v_cvt_pk_bf16_f32 %0, %1, %2" : "=v"(r) : "v"(lo), "v"(hi)); return r; }
typedef float f32x2 __attribute__((ext_vector_type(2)));
typedef float f32x2 __attribute__((ext_vector_type(2)));
typedef unsigned u32x2 __attribute__((ext_vector_type(2)));
__device__ __forceinline__ void unpack8(const u32x4 w, float (&f)[8]) {
    f[0] = __builtin_bit_cast(float, w.x << 16); f[1] = __builtin_bit_cast(float, w.x & 0xffff0000u);
    f[2] = __builtin_bit_cast(float, w.y << 16); f[3] = __builtin_bit_cast(float, w.y & 0xffff0000u);
    f[4] = __builtin_bit_cast(float, w.z << 16); f[5] = __builtin_bit_cast(float, w.z & 0xffff0000u);
    f[6] = __builtin_bit_cast(float, w.w << 16); f[7] = __builtin_bit_cast(float, w.w & 0xffff0000u);
}
__device__ __forceinline__ u32x4 pack8(const f32x4 v0, const f32x4 v1) { u32x4 w; w.x = cvt_pk_bf16(v0[0], v0[1]); w.y = cvt_pk_bf16(v0[2], v0[3]); w.z = cvt_pk_bf16(v1[0], v1[1]); w.w = cvt_pk_bf16(v1[2], v1[3]); return w; }
struct EpiPlain {
    static constexpr bool PERM = true, AFTER_DRAIN = false, MID = false;
    bf16_t* O; int ldc;
    __device__ __forceinline__ void operator()(const f32x4 (&acc)[2][2][4][2], const Unit& u, int wr, int wc, int fr, int fq) const {
        const int row0 = u.pm * BM + wr * 64 + fr, col0 = u.pn * BM + wc * 32 + 8 * fq;
#pragma unroll
        for (int ai = 0; ai < 2; ++ai)
#pragma unroll
            for (int m = 0; m < 4; ++m) { bf16_t* rowp = O + (size_t)(row0 + ai * HALF + m * 16) * ldc + col0;
#pragma unroll
                for (int bj = 0; bj < 2; ++bj) *(u32x4*)(rowp + bj * HALF) = pack8(acc[ai][bj][m][0], acc[ai][bj][m][1]); }
    }
};
struct EpiQKVG {
    static constexpr bool PERM = true, AFTER_DRAIN = false, MID = false;
    bf16_t* QKV; bf16_t* GG; float c2;
    __device__ __forceinline__ void operator()(const f32x4 (&acc)[2][2][4][2], const Unit& u, int wr, int wc, int fr, int fq) const {
        int colt = u.pn * BM; bf16_t* base = QKV; int ldc = 3072; float sc = 1.f; bool sig = false;
        if (colt < 1024) sc = c2; else if (colt >= 3072) { base = GG; ldc = 2048; colt -= 3072; sig = true; }
        const int row0 = u.pm * BM + wr * 64 + fr, col0 = colt + wc * 32 + 8 * fq;
#pragma unroll
        for (int ai = 0; ai < 2; ++ai)
#pragma unroll
            for (int m = 0; m < 4; ++m) { bf16_t* rowp = base + (size_t)(row0 + ai * HALF + m * 16) * ldc + col0;
#pragma unroll
                for (int bj = 0; bj < 2; ++bj) { f32x4 v0 = acc[ai][bj][m][0], v1 = acc[ai][bj][m][1];
                    if (sig) {
#pragma unroll
                        for (int i = 0; i < 4; ++i) { v0[i] = __builtin_amdgcn_rcpf(1.f + __expf(-v0[i])); v1[i] = __builtin_amdgcn_rcpf(1.f + __expf(-v1[i])); }
                    } else { v0 = v0 * sc; v1 = v1 * sc; }
                    *(u32x4*)(rowp + bj * HALF) = pack8(v0, v1); } }
    }
};
struct EpiGateA {
    static constexpr bool PERM = true, AFTER_DRAIN = false, MID = false;
    const bf16_t* GG; float* TMP;
    __device__ __forceinline__ void operator()(const f32x4 (&acc)[2][2][4][2], const Unit& u, int wr, int wc, int fr, int fq) const {
        const int row0 = u.pm * BM + wr * 64 + fr, col0 = u.pn * BM + wc * 32 + 8 * fq;
#pragma unroll
        for (int ai = 0; ai < 2; ++ai)
#pragma unroll
            for (int m = 0; m < 4; ++m) { const size_t row = (size_t)(row0 + ai * HALF + m * 16);
#pragma unroll
                for (int bj = 0; bj < 2; ++bj) { const int col = col0 + bj * HALF; float g[8]; unpack8(*(const u32x4*)(GG + row * 2048 + col), g);
                    f32x4 v0 = acc[ai][bj][m][0], v1 = acc[ai][bj][m][1];
                    v0[0] *= g[0]; v0[1] *= g[1]; v0[2] *= g[2]; v0[3] *= g[3]; v1[0] *= g[4]; v1[1] *= g[5]; v1[2] *= g[6]; v1[3] *= g[7];
                    *(f32x4*)(TMP + row * 1024 + col) = v0; *(f32x4*)(TMP + row * 1024 + col + 4) = v1; } }
    }
};
struct EpiGateC {
    static constexpr bool PERM = true, AFTER_DRAIN = false, MID = false;
    const bf16_t* GG; const float* TMP; bf16_t* MG;
    __device__ __forceinline__ void operator()(const f32x4 (&acc)[2][2][4][2], const Unit& u, int wr, int wc, int fr, int fq) const {
        const int row0 = u.pm * BM + wr * 64 + fr, col0 = u.pn * BM + wc * 32 + 8 * fq;
#pragma unroll
        for (int ai = 0; ai < 2; ++ai)
#pragma unroll
            for (int m = 0; m < 4; ++m) { const size_t row = (size_t)(row0 + ai * HALF + m * 16);
#pragma unroll
                for (int bj = 0; bj < 2; ++bj) { const int col = col0 + bj * HALF; float g[8]; unpack8(*(const u32x4*)(GG + row * 2048 + 1024 + col), g);
                    const f32x4 t0 = *(const f32x4*)(TMP + row * 1024 + col), t1 = *(const f32x4*)(TMP + row * 1024 + col + 4);
                    f32x4 v0 = acc[ai][bj][m][0], v1 = acc[ai][bj][m][1];
                    v0[0] = t0[0] + v0[0] * g[0]; v0[1] = t0[1] + v0[1] * g[1]; v0[2] = t0[2] + v0[2] * g[2]; v0[3] = t0[3] + v0[3] * g[3];
                    v1[0] = t1[0] + v1[0] * g[4]; v1[1] = t1[1] + v1[1] * g[5]; v1[2] = t1[2] + v1[2] * g[6]; v1[3] = t1[3] + v1[3] * g[7];
                    *(u32x4*)(MG + row * 1024 + col) = pack8(v0, v1); } }
    }
};
struct EpiG1 {
    static constexpr bool PERM = true, AFTER_DRAIN = false, MID = false;
    bf16_t* QKV; bf16_t* GG; bf16_t* CB; bf16_t* PR; float c2;
    __device__ __forceinline__ void operator()(const f32x4 (&acc)[2][2][4][2], const Unit& u, int wr, int wc, int fr, int fq) const {
        int colt = u.pn * BM; const int row0 = u.pm * BM + wr * 64 + fr;
        if (colt >= 6144) {
            const int ch0 = (colt - 6144) / 2 + wc * 16 + 4 * fq;
#pragma unroll
            for (int ai = 0; ai < 2; ++ai)
#pragma unroll
                for (int m = 0; m < 4; ++m) { bf16_t* rowp = PR + (size_t)(row0 + ai * HALF + m * 16) * 1024 + ch0;
#pragma unroll
                    for (int bj = 0; bj < 2; ++bj) { const f32x4 v0 = acc[ai][bj][m][0], v1 = acc[ai][bj][m][1];
                        u32x2 w; w.x = cvt_pk_bf16(v0[0] * v0[1], v0[2] * v0[3]); w.y = cvt_pk_bf16(v1[0] * v1[1], v1[2] * v1[3]);
                        *(u32x2*)(rowp + bj * (HALF / 2)) = w; } }
            return;
        }
        bf16_t* base = QKV; int ldc = 3072; float sc = 1.f; bool sig = false;
        if (colt < 1024) sc = c2; else if (colt >= 5120) { base = CB; ldc = 2048; colt -= 5120; } else if (colt >= 3072) { base = GG; ldc = 2048; colt -= 3072; sig = true; }
        const int col0 = colt + wc * 32 + 8 * fq;
#pragma unroll
        for (int ai = 0; ai < 2; ++ai)
#pragma unroll
            for (int m = 0; m < 4; ++m) { bf16_t* rowp = base + (size_t)(row0 + ai * HALF + m * 16) * ldc + col0;
#pragma unroll
                for (int bj = 0; bj < 2; ++bj) { f32x4 v0 = acc[ai][bj][m][0], v1 = acc[ai][bj][m][1];
                    if (sig) {
#pragma unroll
                        for (int i = 0; i < 4; ++i) { v0[i] = __builtin_amdgcn_rcpf(1.f + __expf(-v0[i])); v1[i] = __builtin_amdgcn_rcpf(1.f + __expf(-v1[i])); }
                    } else { v0 = v0 * sc; v1 = v1 * sc; }
                    *(u32x4*)(rowp + bj * HALF) = pack8(v0, v1); } }
    }
};
struct EpiMerged {
    static constexpr bool PERM = true, AFTER_DRAIN = false, MID = true;
    const bf16_t* GG; bf16_t* MG;
    __device__ __forceinline__ void mid(f32x4 (&acc)[2][2][4][2], const Unit& u, int wr, int wc, int fr, int fq) const {
        const int row0 = u.pm * BM + wr * 64 + fr, col0 = u.pn * BM + wc * 32 + 8 * fq;
#pragma unroll
        for (int ai = 0; ai < 2; ++ai)
#pragma unroll
            for (int m = 0; m < 4; ++m) { const size_t row = (size_t)(row0 + ai * HALF + m * 16);
#pragma unroll
                for (int bj = 0; bj < 2; ++bj) { const int col = col0 + bj * HALF; float ga[8], gc[8];
                    unpack8(*(const u32x4*)(GG + row * 2048 + col), ga); unpack8(*(const u32x4*)(GG + row * 2048 + 1024 + col), gc);
#pragma unroll
                    for (int i = 0; i < 4; ++i) { acc[ai][bj][m][0][i] *= ga[i] * __builtin_amdgcn_rcpf(gc[i]); acc[ai][bj][m][1][i] *= ga[4 + i] * __builtin_amdgcn_rcpf(gc[4 + i]); }
                    asm volatile("" ::: "memory"); } }
    }
    __device__ __forceinline__ void operator()(const f32x4 (&acc)[2][2][4][2], const Unit& u, int wr, int wc, int fr, int fq) const {
        const int row0 = u.pm * BM + wr * 64 + fr, col0 = u.pn * BM + wc * 32 + 8 * fq;
#pragma unroll
        for (int ai = 0; ai < 2; ++ai)
#pragma unroll
            for (int m = 0; m < 4; ++m) { const size_t row = (size_t)(row0 + ai * HALF + m * 16);
#pragma unroll
                for (int bj = 0; bj < 2; ++bj) { const int col = col0 + bj * HALF; float gc[8]; unpack8(*(const u32x4*)(GG + row * 2048 + 1024 + col), gc);
                    f32x4 v0 = acc[ai][bj][m][0], v1 = acc[ai][bj][m][1];
#pragma unroll
                    for (int i = 0; i < 4; ++i) { v0[i] *= gc[i]; v1[i] *= gc[4 + i]; }
                    *(u32x4*)(MG + row * 1024 + col) = pack8(v0, v1); } }
    }
};
struct EpiResid {
    static constexpr bool PERM = true, AFTER_DRAIN = false, MID = false;
    const float* X; float* H2; bf16_t* H2B; float* SSQ;
    __device__ __forceinline__ void operator()(const f32x4 (&acc)[2][2][4][2], const Unit& u, int wr, int wc, int fr, int fq) const {
        const int row0 = u.pm * BM + wr * 64 + fr, col0 = u.pn * BM + wc * 32 + 8 * fq;
#pragma unroll
        for (int ai = 0; ai < 2; ++ai)
#pragma unroll
            for (int m = 0; m < 4; ++m) { const size_t row = (size_t)(row0 + ai * HALF + m * 16); float s = 0.f;
#pragma unroll
                for (int bj = 0; bj < 2; ++bj) { const size_t o = row * 1024 + col0 + bj * HALF;
                    const f32x4 v0 = acc[ai][bj][m][0] + *(const f32x4*)(X + o), v1 = acc[ai][bj][m][1] + *(const f32x4*)(X + o + 4);
                    *(f32x4*)(H2 + o) = v0; *(f32x4*)(H2 + o + 4) = v1; *(u32x4*)(H2B + o) = pack8(v0, v1);
                    s += (v0[0] * v0[0] + v0[1] * v0[1]) + (v0[2] * v0[2] + v0[3] * v0[3]) + (v1[0] * v1[0] + v1[1] * v1[1]) + (v1[2] * v1[2] + v1[3] * v1[3]); }
                s += __shfl_xor(s, 16); s += __shfl_xor(s, 32);
                if (fq == 0) SSQ[row * 16 + u.pn * 4 + wc] = s; }
    }
};
struct EpiRowScale {
    static constexpr bool PERM = true, AFTER_DRAIN = false, MID = false;
    const float* SSQ; bf16_t* O;
    __device__ __forceinline__ void operator()(const f32x4 (&acc)[2][2][4][2], const Unit& u, int wr, int wc, int fr, int fq) const {
        const int row0 = u.pm * BM + wr * 64 + fr, col0 = u.pn * BM + wc * 32 + 8 * fq;
#pragma unroll
        for (int ai = 0; ai < 2; ++ai)
#pragma unroll
            for (int m = 0; m < 4; ++m) { const size_t row = (size_t)(row0 + ai * HALF + m * 16);
                const f32x4* sp = (const f32x4*)(SSQ + row * 16); const f32x4 a = sp[0] + sp[1], b = sp[2] + sp[3], c = a + b;
                const float rs = rsqrtf(((c[0] + c[1]) + (c[2] + c[3])) * (1.f / 1024.f) + 1e-6f);
#pragma unroll
                for (int bj = 0; bj < 2; ++bj) *(u32x4*)(O + row * 2048 + col0 + bj * HALF) = pack8(acc[ai][bj][m][0] * rs, acc[ai][bj][m][1] * rs); }
    }
};
template <class Epi, class Sched, bool ALIGN_EPI = false, bool SP2 = false>
__device__ __forceinline__ void gemm_phase(PG8_LAS unsigned char* lds, const Gemm g, const Sched& S, const Epi& E) {
    const int tid = threadIdx.x, wid = __builtin_amdgcn_readfirstlane(tid >> 6), lane = tid & 63, wr = wid >> 2, wc = wid & 3, fr = lane & 15, fq = lane >> 4;
    const int K = g.K, nt = K / BK;
    unsigned voffA[2], voffB[2];
#pragma unroll
    for (int i = 0; i < 2; ++i) { int R, C; stage_rc(tid * 16 + i * 8192, R, C); const int Rb = Epi::PERM ? ((R & ~31) + perm32(R & 31)) : R;
        voffA[i] = (unsigned)(R * g.lda + C) * 2u; voffB[i] = (unsigned)(Rb * g.ldb + C) * 2u; }
    const size_t kstep = (size_t)(BK * 2);
    const size_t hstep = (size_t)HALF * g.ldb * 2;
    const size_t tstep = 2 * hstep;
    const size_t hstepA = (size_t)HALF * g.lda * 2, tstepA = 2 * hstepA;
    const unsigned ldsw = (unsigned)wid * 1024u;
    const int aoff = lds_byte(wr * 64 + fr, fq * 8), boff = lds_byte(wc * 32 + fr, fq * 8);
#define PG8_SA(b, h) (((b) * 2 + (h)) * HTB)
#define PG8_SB(b, h) ((4 + (b) * 2 + (h)) * HTB)
#define PG8_STAGE(bufoff, gbase, voff) do { _Pragma("unroll") for (int _i = 0; _i < 2; ++_i) \
        __builtin_amdgcn_global_load_lds((const unsigned*)((const char*)(gbase) + (voff)[_i]), (PG8_LAS unsigned*)(lds + (bufoff) + ldsw + _i * 8192), 16, 0, 0); } while (0)
#define PG8_LDA(dst, b, h) do { _Pragma("unroll") for (int m = 0; m < 4; ++m) _Pragma("unroll") for (int k = 0; k < 2; ++k) dst[m][k] = *(const PG8_LAS bf16x8*)(lds + PG8_SA(b, h) + aoff + m * 2048 + k * 1024); } while (0)
#define PG8_LDB(dst, b, h) do { _Pragma("unroll") for (int n = 0; n < 2; ++n) _Pragma("unroll") for (int k = 0; k < 2; ++k) dst[n][k] = *(const PG8_LAS bf16x8*)(lds + PG8_SB(b, h) + boff + n * 2048 + k * 1024); } while (0)
#define PG8_MMA(ai, bj, At, Bt) do { __builtin_amdgcn_s_setprio(1); _Pragma("unroll") for (int m = 0; m < 4; ++m) _Pragma("unroll") for (int n = 0; n < 2; ++n) _Pragma("unroll") for (int k = 0; k < 2; ++k) \
        acc[ai][bj][m][n] = __builtin_amdgcn_mfma_f32_16x16x32_bf16(Bt[n][k], At[m][k], acc[ai][bj][m][n], 0, 0, 0); __builtin_amdgcn_s_setprio(0); } while (0)
#define PG8_WAIT_V(n) asm volatile("s_waitcnt vmcnt(" #n ")" ::: "memory")
#define PG8_WAIT_L(n) asm volatile("s_waitcnt lgkmcnt(" #n ")" ::: "memory")
#define PG8_BAR __builtin_amdgcn_s_barrier()
#define PG8_SCHED __builtin_amdgcn_sched_barrier(0)
    Unit cur, nxt; int ui = 0;
    if (!S.next(0, cur)) return;
    f32x4 acc[2][2][4][2];
#pragma unroll
    for (int a = 0; a < 2; ++a)
#pragma unroll
        for (int b = 0; b < 2; ++b)
#pragma unroll
            for (int m = 0; m < 4; ++m)
#pragma unroll
                for (int n = 0; n < 2; ++n) acc[a][b][m][n] = (f32x4){0.f, 0.f, 0.f, 0.f};
    bf16x8 At[4][2], B0[2][2], B1[2][2];
    const char* cA = (const char*)g.A + (size_t)cur.pm * tstepA + (size_t)cur.kh * K * 2; const char* cB = (const char*)g.Bt + (size_t)cur.pn * tstep + (size_t)cur.kh * K * 2;
    S.a_ready(cur);
    if constexpr (SP2) {
        PG8_STAGE(PG8_SB(0, 0), cB, voffB); PG8_STAGE(PG8_SB(0, 1), cB + hstep, voffB); PG8_STAGE(PG8_SA(0, 0), cA, voffA); PG8_STAGE(PG8_SA(0, 1), cA + hstepA, voffA);
        if (wr == 1) PG8_BAR;
        PG8_WAIT_V(2); PG8_BAR;
        PG8_STAGE(PG8_SB(1, 0), cB + kstep, voffB); PG8_STAGE(PG8_SA(1, 0), cA + kstep, voffA); PG8_STAGE(PG8_SB(1, 1), cB + hstep + kstep, voffB);
        PG8_WAIT_V(6); PG8_BAR;
    } else {
        PG8_STAGE(PG8_SB(0, 0), cB, voffB); PG8_STAGE(PG8_SA(0, 0), cA, voffA); PG8_STAGE(PG8_SB(0, 1), cB + hstep, voffB); PG8_STAGE(PG8_SA(0, 1), cA + hstepA, voffA);
        if (wr == 1) PG8_BAR;
        PG8_WAIT_V(4); PG8_BAR;
        PG8_STAGE(PG8_SB(1, 0), cB + kstep, voffB); PG8_STAGE(PG8_SA(1, 0), cA + kstep, voffA); PG8_STAGE(PG8_SB(1, 1), cB + hstep + kstep, voffB);
        PG8_WAIT_V(6); PG8_BAR;
    }
    for (;;) {
        const bool has_next = S.next(ui + 1, nxt);
        const char* nA = has_next ? (const char*)g.A + (size_t)nxt.pm * tstepA + (size_t)nxt.kh * K * 2 : cA; const char* nB = has_next ? (const char*)g.Bt + (size_t)nxt.pn * tstep + (size_t)nxt.kh * K * 2 : cB;
        for (int t = 0; t < nt; t += 2) {
            const bool last = (t == nt - 2);
            const char* a1 = cA + (size_t)(t + 1) * kstep;
            const char* a2 = last ? nA : cA + (size_t)(t + 2) * kstep; const char* b2 = last ? nB : cB + (size_t)(t + 2) * kstep;
            const char* a3 = a2 + kstep; const char* b3 = b2 + kstep;
            if (last && has_next) S.a_ready(nxt);
            if constexpr (SP2) {
            PG8_LDB(B0, 0, 0); PG8_LDB(B1, 0, 1); PG8_SCHED; PG8_LDA(At, 0, 0); PG8_STAGE(PG8_SA(1, 1), a1 + hstepA, voffA);
            PG8_WAIT_V(8); PG8_WAIT_L(0); PG8_BAR; PG8_MMA(0, 0, At, B0); PG8_MMA(0, 1, At, B1); PG8_BAR; PG8_SCHED;
            PG8_LDA(At, 0, 1); PG8_STAGE(PG8_SB(0, 0), b2, voffB); PG8_STAGE(PG8_SB(0, 1), b2 + hstep, voffB); PG8_STAGE(PG8_SA(0, 0), a2, voffA);
            PG8_WAIT_V(8); PG8_WAIT_L(0); PG8_BAR; PG8_MMA(1, 0, At, B0); PG8_MMA(1, 1, At, B1); PG8_BAR; PG8_SCHED;
            PG8_LDB(B0, 1, 0); PG8_LDB(B1, 1, 1); PG8_SCHED; PG8_LDA(At, 1, 0); PG8_STAGE(PG8_SA(0, 1), a2 + hstepA, voffA);
            PG8_WAIT_V(8); PG8_WAIT_L(0); PG8_BAR; PG8_MMA(0, 0, At, B0); PG8_MMA(0, 1, At, B1); PG8_BAR; PG8_SCHED;
            PG8_LDA(At, 1, 1); PG8_STAGE(PG8_SB(1, 0), b3, voffB); PG8_STAGE(PG8_SB(1, 1), b3 + hstep, voffB); PG8_STAGE(PG8_SA(1, 0), a3, voffA);
            PG8_WAIT_V(8); PG8_WAIT_L(0); PG8_BAR; PG8_MMA(1, 0, At, B0); PG8_MMA(1, 1, At, B1); PG8_BAR; PG8_SCHED;
            } else {
            PG8_LDB(B0, 0, 0); PG8_SCHED; PG8_LDA(At, 0, 0); PG8_STAGE(PG8_SA(1, 1), a1 + hstepA, voffA);
            PG8_WAIT_L(8); PG8_BAR; PG8_WAIT_L(0); PG8_MMA(0, 0, At, B0); PG8_BAR; PG8_SCHED;
            PG8_LDB(B1, 0, 1); PG8_STAGE(PG8_SB(0, 0), b2, voffB);
            PG8_BAR; PG8_WAIT_L(0); PG8_MMA(0, 1, At, B1); PG8_BAR;
            PG8_LDA(At, 0, 1); PG8_STAGE(PG8_SA(0, 0), a2, voffA);
            PG8_BAR; PG8_WAIT_L(0); PG8_MMA(1, 0, At, B0); PG8_BAR; PG8_SCHED;
            PG8_STAGE(PG8_SB(0, 1), b2 + hstep, voffB);
            PG8_WAIT_V(6); PG8_BAR; PG8_MMA(1, 1, At, B1); PG8_BAR;
            PG8_LDB(B0, 1, 0); PG8_SCHED; PG8_LDA(At, 1, 0); PG8_STAGE(PG8_SA(0, 1), a2 + hstepA, voffA);
            PG8_WAIT_L(8); PG8_BAR; PG8_WAIT_L(0); PG8_MMA(0, 0, At, B0); PG8_BAR; PG8_SCHED;
            PG8_LDB(B1, 1, 1); PG8_STAGE(PG8_SB(1, 0), b3, voffB);
            PG8_BAR; PG8_WAIT_L(0); PG8_MMA(0, 1, At, B1); PG8_BAR;
            PG8_LDA(At, 1, 1); PG8_STAGE(PG8_SA(1, 0), a3, voffA);
            PG8_BAR; PG8_WAIT_L(0); PG8_MMA(1, 0, At, B0); PG8_BAR; PG8_SCHED;
            PG8_STAGE(PG8_SB(1, 1), b3 + hstep, voffB);
            PG8_WAIT_V(6); PG8_BAR; PG8_MMA(1, 1, At, B1); PG8_BAR;
            }
        }
        if constexpr (ALIGN_EPI) { if (wr == 0) PG8_BAR; }
        bool keep_acc = false;
        if constexpr (Epi::MID) { if (cur.kh == 0) { E.mid(acc, cur, wr, wc, fr, fq); keep_acc = true; } }
        if constexpr (!Epi::AFTER_DRAIN) { if (!keep_acc) { E(acc, cur, wr, wc, fr, fq); S.done(cur); } }
        if (!has_next) break;
        if (!keep_acc)
#pragma unroll
        for (int a = 0; a < 2; ++a)
#pragma unroll
            for (int b = 0; b < 2; ++b)
#pragma unroll
                for (int m = 0; m < 4; ++m)
#pragma unroll
                    for (int n = 0; n < 2; ++n) acc[a][b][m][n] = (f32x4){0.f, 0.f, 0.f, 0.f};
        cur = nxt; cA = nA; cB = nB; ++ui;
        if constexpr (ALIGN_EPI) { if (wr == 1) PG8_BAR; }
    }
    PG8_WAIT_V(0);
    if constexpr (!ALIGN_EPI) { if (wr == 0) PG8_BAR; }
    PG8_BAR;
    if constexpr (Epi::AFTER_DRAIN) { E.fused(acc, cur, wr, wc, fr, fq, lds, wid, lane); S.done(cur); }
#undef PG8_SA
#undef PG8_SB
#undef PG8_STAGE
#undef PG8_LDA
#undef PG8_LDB
#undef PG8_MMA
#undef PG8_WAIT_V
#undef PG8_WAIT_L
#undef PG8_BAR
#undef PG8_SCHED
}
}
#define LAS __attribute__((address_space(3)))
typedef unsigned short bf16;
typedef short bf16x8 __attribute__((ext_vector_type(8)));
typedef short s16x4 __attribute__((ext_vector_type(4)));
typedef float f32x4 __attribute__((ext_vector_type(4)));
typedef float f32x16 __attribute__((ext_vector_type(16)));
typedef unsigned u32x4 __attribute__((ext_vector_type(4)));
typedef unsigned u32x2 __attribute__((ext_vector_type(2)));
typedef float f32x2_t __attribute__((ext_vector_type(2))); typedef __bf16 bf16x2_t __attribute__((ext_vector_type(2)));

constexpr int T = 16384, DM = 1024, SEQ = 2048;
constexpr int NWAVES = 8, NTHR = 512;
constexpr int LDS_BYTES = 147456;
constexpr float EPS = 1e-6f;
constexpr float ESCALE = 64.f;
constexpr float C2 = 0.125f * 1.4426950408889634f;
constexpr size_t MiB = 1u << 20;
constexpr size_t WS_WIN = 0, WS_WAC = 16 * MiB, WS_WOUT = 20 * MiB, WS_WQ = 22 * MiB, WS_SUBK = 26 * MiB, WS_SSQ = 27 * MiB;
constexpr size_t WS_EU = 28 * MiB, WS_EV = 44 * MiB, WS_BIG = 60 * MiB, WS_END = 252 * MiB;
constexpr size_t B_QKV = 0, B_GG = 96 * MiB, B_PR = 160 * MiB, B_MG = 0, B_H2B = 32 * MiB, B_QP = 96 * MiB, B_SEL = 64 * MiB, B_GATE = 72 * MiB;

__device__ __forceinline__ unsigned cvtpk(float lo, float hi) { f32x2_t v = {lo, hi}; bf16x2_t b = __builtin_convertvector(v, bf16x2_t); return __builtin_bit_cast(unsigned, b); }
__device__ __forceinline__ float wave_sum(float v) {
#pragma unroll
    for (int o = 1; o < 64; o <<= 1) v += __shfl_xor(v, o);
    return v;
}
#define LDS_WAIT() asm volatile("s_waitcnt lgkmcnt(0)" ::: "memory")

struct Params {
    const float* x; const float* norm1_g; const float* w_in; const float* lambda_qk; const float* subln_g; const float* conv_w;
    const float* w_attn_o; const float* w_conv_o; const float* w_out; const float* norm2_g; const float* w_query; const float* sub_keys;
    const float* expert_u; const float* expert_v; const float* final_g;
    float* out; unsigned char* ws; int lo, hi;
};

__device__ __forceinline__ void transpose_item(const float* W, int K, int N, bf16* WT, int remap, int dpitch, int koff, const float* kscale, LAS float* scr, int item, int lane) {
    const int nblk = N / 32, kb = item / nblk, nb = item % nblk, k0 = 64 * kb, n0 = 32 * nb;
    int d0 = n0, dstr = 1;
    if (remap) { if (n0 < 3072) d0 = n0; else if (n0 < 4096) d0 = n0 + 2048; else if (n0 < 5120) { d0 = 6144 + 2 * (n0 - 4096); dstr = 2; } else if (n0 < 6144) { d0 = 6144 + 2 * (n0 - 5120) + 1; dstr = 2; } else d0 = n0 - 3072; }
    { float wv[32];
#pragma unroll
      for (int i = 0; i < 32; ++i) wv[i] = W[(size_t)(k0 + 2 * i + (lane >> 5)) * N + n0 + (lane & 31)];
#pragma unroll
      for (int i = 0; i < 32; ++i) { const int kk = 2 * i + (lane >> 5); float v = wv[i]; if (kscale) v *= kscale[k0 + kk]; scr[kk * 33 + (lane & 31)] = v; } }
    LDS_WAIT(); asm volatile("" ::: "memory");
    const int c = lane & 7;
#pragma unroll
    for (int j = 0; j < 4; ++j) { const int n = (lane >> 3) + 8 * j; const LAS float* sp = scr + (8 * c) * 33 + n;
        u32x4 o; o.x = cvtpk(sp[0 * 33], sp[1 * 33]); o.y = cvtpk(sp[2 * 33], sp[3 * 33]); o.z = cvtpk(sp[4 * 33], sp[5 * 33]); o.w = cvtpk(sp[6 * 33], sp[7 * 33]);
        *(u32x4*)(WT + (size_t)(d0 + n * dstr) * dpitch + koff + k0 + 8 * c) = o; }
    LDS_WAIT(); asm volatile("" ::: "memory");
}
__device__ __forceinline__ void cvt_flat(const float* src, bf16* dst, size_t n8, size_t gtid, size_t nthr) {
    for (size_t i = gtid; i < n8; i += nthr) { const f32x4 a = *(const f32x4*)(src + i * 8), b = *(const f32x4*)(src + i * 8 + 4);
        u32x4 o; o.x = cvtpk(a[0], a[1]); o.y = cvtpk(a[2], a[3]); o.z = cvtpk(b[0], b[1]); o.w = cvtpk(b[2], b[3]); *(u32x4*)(dst + i * 8) = o; }
}
__device__ __forceinline__ void cvt_flat_fp8(const float* src, unsigned char* dst, size_t n16, float sc, size_t gtid, size_t nthr) {
    for (size_t i = gtid; i < n16; i += nthr) { u32x4 o;
#pragma unroll
        for (int q = 0; q < 4; ++q) { const f32x4 a = *(const f32x4*)(src + i * 16 + 4 * q) * sc; int w = 0;
            w = __builtin_amdgcn_cvt_pk_fp8_f32(a[0], a[1], w, false); w = __builtin_amdgcn_cvt_pk_fp8_f32(a[2], a[3], w, true); o[q] = (unsigned)w; }
        *(u32x4*)(dst + i * 16) = o; }
}
__device__ __forceinline__ void phase0(const Params& p, LAS unsigned char* lds, int G, int bid, int wave, int lane) {
    unsigned char* ws = p.ws;
    LAS float* scr = (LAS float*)(lds + wave * 16384);
    const int gw = bid * NWAVES + wave, NGW = G * NWAVES;
    constexpr int I_IN = 16 * 256, I_SQ = 16 * 32, I_Q = 16 * 64, NITEMS = I_IN + 3 * I_SQ + I_Q;
    for (int it = gw; it < NITEMS; it += NGW) {
        int r = it;
        if (r < I_IN) { transpose_item(p.w_in, 1024, 8192, (bf16*)(ws + WS_WIN), 1, 1024, 0, nullptr, scr, r, lane); continue; } r -= I_IN;
        if (r < I_SQ) { transpose_item(p.w_attn_o, 1024, 1024, (bf16*)(ws + WS_WAC), 0, 2048, 0, nullptr, scr, r, lane); continue; } r -= I_SQ;
        if (r < I_SQ) { transpose_item(p.w_conv_o, 1024, 1024, (bf16*)(ws + WS_WAC), 0, 2048, 1024, nullptr, scr, r, lane); continue; } r -= I_SQ;
        if (r < I_SQ) { transpose_item(p.w_out, 1024, 1024, (bf16*)(ws + WS_WOUT), 0, 1024, 0, nullptr, scr, r, lane); continue; } r -= I_SQ;
        transpose_item(p.w_query, 1024, 2048, (bf16*)(ws + WS_WQ), 0, 1024, 0, p.norm2_g, scr, r, lane);
    }
    const size_t gtid = (size_t)bid * NTHR + wave * 64 + lane, nthr = (size_t)G * NTHR;
    cvt_flat(p.sub_keys, (bf16*)(ws + WS_SUBK), (size_t)(8 * 2 * 128 * 128) / 8, gtid, nthr);
    bf16* N1 = (bf16*)p.out;
    f32x4 gv[4];
#pragma unroll
    for (int j = 0; j < 4; ++j) gv[j] = *((const f32x4*)p.norm1_g + lane + 64 * j);
    for (int m0 = gw; m0 < T; m0 += 2 * NGW) {
        const int m1 = (m0 + NGW < T) ? m0 + NGW : m0;
        const f32x4* xr0 = (const f32x4*)(p.x + (size_t)m0 * DM) + lane; const f32x4* xr1 = (const f32x4*)(p.x + (size_t)m1 * DM) + lane;
        f32x4 v0[4], v1[4]; float s0 = 0.f, s1 = 0.f;
#pragma unroll
        for (int j = 0; j < 4; ++j) { v0[j] = xr0[64 * j]; v1[j] = xr1[64 * j]; }
#pragma unroll
        for (int j = 0; j < 4; ++j) { s0 += (v0[j][0] * v0[j][0] + v0[j][1] * v0[j][1]) + (v0[j][2] * v0[j][2] + v0[j][3] * v0[j][3]);
                                      s1 += (v1[j][0] * v1[j][0] + v1[j][1] * v1[j][1]) + (v1[j][2] * v1[j][2] + v1[j][3] * v1[j][3]); }
        const float r0 = rsqrtf(wave_sum(s0) * (1.f / DM) + EPS), r1 = rsqrtf(wave_sum(s1) * (1.f / DM) + EPS);
        u32x2* o0 = (u32x2*)(N1 + (size_t)m0 * 2048) + lane; u32x2* o1 = (u32x2*)(N1 + (size_t)m1 * 2048) + lane;
#pragma unroll
        for (int j = 0; j < 4; ++j) { u32x2 o; o.x = cvtpk(v0[j][0] * r0 * gv[j][0], v0[j][1] * r0 * gv[j][1]); o.y = cvtpk(v0[j][2] * r0 * gv[j][2], v0[j][3] * r0 * gv[j][3]); o0[64 * j] = o;
            u32x2 q; q.x = cvtpk(v1[j][0] * r1 * gv[j][0], v1[j][1] * r1 * gv[j][1]); q.y = cvtpk(v1[j][2] * r1 * gv[j][2], v1[j][3] * r1 * gv[j][3]); o1[64 * j] = q; }
    }
}

__device__ __forceinline__ void up8(const bf16* p, float (&f)[8]) { const u32x4 w = *(const u32x4*)p; pg8::unpack8(w, f); }
__device__ __forceinline__ void phase_conv(const Params& p, int G, int bid, int tid) {
    const bf16* PR = (const bf16*)(p.ws + WS_BIG + B_PR); bf16* CBU = (bf16*)p.out + 1024;
    const size_t nthr = (size_t)G * NTHR;
    for (size_t it = (size_t)bid * NTHR + tid; it < (size_t)(T / 8) * 128; it += nthr) {
        const int t0 = (int)(it >> 7) * 8, c8 = (int)(it & 127) * 8, s0 = t0 & (SEQ - 1);
        const bf16* row = PR + (size_t)t0 * 1024 + c8;
        u32x4 pr[10], cbr[8];
#pragma unroll
        for (int i = 0; i < 8; ++i) { pr[i + 2] = *(const u32x4*)(row + (size_t)i * 1024); cbr[i] = *(const u32x4*)(CBU + (size_t)(t0 + i) * 2048 + c8); }
        if (s0 != 0) { pr[0] = *(const u32x4*)(row - 2048); pr[1] = *(const u32x4*)(row - 1024); } else { pr[0] = (u32x4){0u, 0u, 0u, 0u}; pr[1] = pr[0]; }
        float w0[8], w1[8], w2[8];
#pragma unroll
        for (int i = 0; i < 8; ++i) { w0[i] = p.conv_w[c8 + i]; w1[i] = p.conv_w[1024 + c8 + i]; w2[i] = p.conv_w[2048 + c8 + i]; }
        float fa[8], fb[8], fc[8];
        pg8::unpack8(pr[0], fa); pg8::unpack8(pr[1], fb);
#pragma unroll
        for (int i = 0; i < 8; ++i) {
            pg8::unpack8(pr[i + 2], fc);
            float cb[8]; pg8::unpack8(cbr[i], cb);
            float o[8];
#pragma unroll
            for (int c = 0; c < 8; ++c) o[c] = cb[c] * (w0[c] * fa[c] + w1[c] * fb[c] + w2[c] * fc[c]);
            u32x4 w; w.x = cvtpk(o[0], o[1]); w.y = cvtpk(o[2], o[3]); w.z = cvtpk(o[4], o[5]); w.w = cvtpk(o[6], o[7]);
            *(u32x4*)(CBU + (size_t)(t0 + i) * 2048 + c8) = w;
#pragma unroll
            for (int c = 0; c < 8; ++c) { fa[c] = fb[c]; fb[c] = fc[c]; }
        }
    }
}

constexpr int KPITCH = 272, VPITCH = 320, KBYTES = 64 * KPITCH, STAGEB = KBYTES + 64 * VPITCH;
constexpr int XOFF = 0, OSTOFF = 65536, OSTPITCH = 272, OSTB = 32 * OSTPITCH;
__device__ __forceinline__ s16x4 vtr(const LAS unsigned char* p) { return __builtin_amdgcn_ds_read_tr16_b64_v4i16((LAS s16x4*)p); }

__device__ __forceinline__ void attn_unit(LAS unsigned char* lds, const bf16* QKV, bf16* ON, const float* subg, float lam, int b, int h, int qb, int tid) {
    const int w = __builtin_amdgcn_readfirstlane(tid >> 6), lane = tid & 63, map = w >> 2, wq = w & 3, l31 = lane & 31, half = lane >> 5;
    const size_t trow0 = (size_t)b * SEQ;
    const int q0 = qb * 128 + wq * 32;
    bf16x8 qf[4];
    { const bf16* qp = QKV + (trow0 + q0 + l31) * 3072 + h * 128 + map * 64 + 8 * half;
#pragma unroll
      for (int s = 0; s < 4; ++s) qf[s] = *(const bf16x8*)(qp + 16 * s); }
    f32x16 O[4];
#pragma unroll
    for (int e = 0; e < 4; ++e)
#pragma unroll
        for (int r = 0; r < 16; ++r) O[e][r] = 0.f;
    float m_run = 0.f, l_run = 0.f;
    const int ntile = 2 * (qb + 1);
    const int skey = tid >> 4, sch = tid & 15;
    const bf16* gk = QKV + (trow0 + skey) * 3072 + 1024 + h * 128 + sch * 8;
    const int dk = skey * KPITCH + sch * 16, dv = KBYTES + skey * VPITCH + sch * 16;
    u32x4 stg[4];
#define GLOAD(j) do { const bf16* g_ = gk + (size_t)(j) * 64 * 3072; stg[0] = *(const u32x4*)g_; stg[1] = *(const u32x4*)(g_ + 32 * 3072); stg[2] = *(const u32x4*)(g_ + 1024); stg[3] = *(const u32x4*)(g_ + 32 * 3072 + 1024); } while (0)
#define LSTORE(st) do { LAS unsigned char* b_ = lds + (st) * STAGEB; *(LAS u32x4*)(b_ + dk) = stg[0]; *(LAS u32x4*)(b_ + dk + 32 * KPITCH) = stg[1]; *(LAS u32x4*)(b_ + dv) = stg[2]; *(LAS u32x4*)(b_ + dv + 32 * VPITCH) = stg[3]; } while (0)
    GLOAD(0); LSTORE(0); __syncthreads();
    const int koff = l31 * KPITCH + map * 128 + half * 16;
    const int voff = KBYTES + (4 * half + ((lane & 15) >> 2)) * VPITCH + (((lane >> 4) & 1) * 16 + (lane & 3) * 4) * 2;
    const int qi = q0 + l31;
    for (int j = 0; j < ntile; ++j) {
        if (j + 1 < ntile) GLOAD(j + 1);
        const int kbase = 64 * j;
        if (kbase <= q0 + 31) {
            const LAS unsigned char* sb = lds + (j & 1) * STAGEB;
            f32x16 s0, s1;
            const float negm = -m_run;
#pragma unroll
            for (int r = 0; r < 16; ++r) { s0[r] = negm; s1[r] = negm; }
#pragma unroll
            for (int s = 0; s < 4; ++s) { const bf16x8 k0 = *(const LAS bf16x8*)(sb + koff + s * 32), k1 = *(const LAS bf16x8*)(sb + koff + 32 * KPITCH + s * 32);
                s0 = __builtin_amdgcn_mfma_f32_32x32x16_bf16(k0, qf[s], s0, 0, 0, 0); s1 = __builtin_amdgcn_mfma_f32_32x32x16_bf16(k1, qf[s], s1, 0, 0, 0); }
            const LAS unsigned char* vb = sb + voff;
            s16x4 vlo[4][4], vhi[4][4];
            if (kbase + 63 > q0) {
#pragma unroll
                for (int r = 0; r < 16; ++r) { const int key = kbase + (r & 3) + 8 * (r >> 2) + 4 * half;
                    s0[r] = (key <= qi) ? s0[r] : -1e30f; s1[r] = (key + 32 <= qi) ? s1[r] : -1e30f; }
            }
            float mx = fmaxf(s0[0], s1[0]);
#pragma unroll
            for (int r = 1; r < 16; ++r) mx = fmaxf(mx, fmaxf(s0[r], s1[r]));
            mx = fmaxf(mx, __shfl_xor(mx, 32));
            float ps = 0.f;
            const bool first = (j == 0), move = first || (__ballot(mx > 8.f) != 0ull);
            const float delta = move ? (first ? mx : fmaxf(mx, 0.f)) : 0.f;
#pragma unroll
            for (int r = 0; r < 16; ++r) { s0[r] = __builtin_amdgcn_exp2f(s0[r] - delta); s1[r] = __builtin_amdgcn_exp2f(s1[r] - delta); ps += s0[r] + s1[r]; }
            if (move) {
                const float alpha = first ? 0.f : __builtin_amdgcn_exp2f(-delta); m_run += delta;
                l_run = l_run * alpha + ps;
                if (!first) {
#pragma unroll
                    for (int e = 0; e < 4; ++e) O[e] = O[e] * alpha;
                }
            } else l_run += ps;
            bf16x8 pf[4];
#pragma unroll
            for (int kk = 0; kk < 4; ++kk) { u32x4 wv;
                if (kk < 2) { wv.x = cvtpk(s0[8 * kk + 0], s0[8 * kk + 1]); wv.y = cvtpk(s0[8 * kk + 2], s0[8 * kk + 3]); wv.z = cvtpk(s0[8 * kk + 4], s0[8 * kk + 5]); wv.w = cvtpk(s0[8 * kk + 6], s0[8 * kk + 7]); }
                else { const int k2 = kk - 2; wv.x = cvtpk(s1[8 * k2 + 0], s1[8 * k2 + 1]); wv.y = cvtpk(s1[8 * k2 + 2], s1[8 * k2 + 3]); wv.z = cvtpk(s1[8 * k2 + 4], s1[8 * k2 + 5]); wv.w = cvtpk(s1[8 * k2 + 6], s1[8 * k2 + 7]); }
                pf[kk] = __builtin_bit_cast(bf16x8, wv); }
#pragma unroll
            for (int e = 0; e < 4; ++e) { vlo[0][e] = vtr(vb + e * 64); vhi[0][e] = vtr(vb + 8 * VPITCH + e * 64); }
#pragma unroll
            for (int kk = 0; kk < 4; ++kk)
#pragma unroll
                for (int e = 0; e < 4; ++e) {
                    if (e == 0 && kk < 3) {
#pragma unroll
                        for (int e2 = 0; e2 < 4; ++e2) { vlo[kk + 1][e2] = vtr(vb + (kk + 1) * 16 * VPITCH + e2 * 64); vhi[kk + 1][e2] = vtr(vb + ((kk + 1) * 16 + 8) * VPITCH + e2 * 64); }
                        __builtin_amdgcn_sched_barrier(0);
                    }
                    const s16x4 lo = vlo[kk][e], hi = vhi[kk][e];
                    bf16x8 a; a[0] = lo[0]; a[1] = lo[1]; a[2] = lo[2]; a[3] = lo[3]; a[4] = hi[0]; a[5] = hi[1]; a[6] = hi[2]; a[7] = hi[3];
                    O[e] = __builtin_amdgcn_mfma_f32_32x32x16_bf16(a, pf[kk], O[e], 0, 0, 0); }
        }
        if (j + 1 < ntile) LSTORE((j + 1) & 1);
        __syncthreads();
    }
#undef GLOAD
#undef LSTORE
    const float ltot = l_run + __shfl_xor(l_run, 32), inv = 1.f / ltot;
    LAS float* X = (LAS float*)(lds + XOFF) + wq * 4096 + lane;
    if (map == 1) {
        const float sc = inv * lam;
#pragma unroll
        for (int e = 0; e < 4; ++e)
#pragma unroll
            for (int r = 0; r < 16; ++r) X[(e * 16 + r) * 64] = O[e][r] * sc;
    }
    __syncthreads();
    if (map == 0) {
        float ssq = 0.f;
#pragma unroll
        for (int e = 0; e < 4; ++e)
#pragma unroll
            for (int r = 0; r < 16; ++r) { const float o = O[e][r] * inv - X[(e * 16 + r) * 64]; O[e][r] = o; ssq += o * o; }
        ssq += __shfl_xor(ssq, 32);
        const float rms = rsqrtf(ssq * (1.f / 128.f) + EPS) * 0.8f;
        LAS unsigned char* ost = lds + OSTOFF + wq * OSTB;
#pragma unroll
        for (int e = 0; e < 4; ++e)
#pragma unroll
            for (int rq = 0; rq < 4; ++rq) { const int e0 = 32 * e + 8 * rq + 4 * half; const f32x4 g = *(const f32x4*)(subg + e0);
                u32x2 o; o.x = cvtpk(O[e][4 * rq + 0] * rms * g[0], O[e][4 * rq + 1] * rms * g[1]); o.y = cvtpk(O[e][4 * rq + 2] * rms * g[2], O[e][4 * rq + 3] * rms * g[3]);
                *(LAS u32x2*)(ost + l31 * OSTPITCH + e0 * 2) = o; }
        LDS_WAIT(); __builtin_amdgcn_wave_barrier();
#pragma unroll
        for (int jj = 0; jj < 8; ++jj) { const int c = lane + 64 * jj, row = c >> 4, ch = c & 15;
            const u32x4 v = *(const LAS u32x4*)(ost + row * OSTPITCH + ch * 16);
            *(u32x4*)(ON + (trow0 + q0 + row) * 2048 + h * 128 + ch * 8) = v; }
    }
    __syncthreads();
}

__device__ __forceinline__ void phase_attn(const Params& p, LAS unsigned char* lds, int G, int bid, int tid) {
    const bf16* QKV = (const bf16*)(p.ws + WS_BIG); bf16* ON = (bf16*)p.out;
    const int lane = tid & 63;
    const float a = p.lambda_qk[lane] * p.lambda_qk[64 + lane], b = p.lambda_qk[128 + lane] * p.lambda_qk[192 + lane];
    const float lam = expf(wave_sum(a)) - expf(wave_sum(b)) + 0.2f;
    for (int c = bid; c < 256; c += G) {
        const int bh = c >> 2, quad = c & 3, b_ = bh >> 3, h = bh & 7;
        attn_unit(lds, QKV, ON, p.subln_g, lam, b_, h, 15 - 2 * quad, tid);
        attn_unit(lds, QKV, ON, p.subln_g, lam, b_, h, 2 * quad, tid);
        attn_unit(lds, QKV, ON, p.subln_g, lam, b_, h, 14 - 2 * quad, tid);
        attn_unit(lds, QKV, ON, p.subln_g, lam, b_, h, 2 * quad + 1, tid);
    }
}

__device__ __forceinline__ unsigned mono(float v) { const unsigned u = __builtin_bit_cast(unsigned, v); return (u & 0x80000000u) ? ~u : (u | 0x80000000u); }
__device__ __forceinline__ float unmono(unsigned k) { const unsigned u = (k & 0x80000000u) ? (k ^ 0x80000000u) : ~k; return __builtin_bit_cast(float, u); }
#define CE_(x, y) do { const unsigned t_ = max(x, y); y = min(x, y); x = t_; } while (0)
__device__ __forceinline__ void sort16(unsigned (&a)[16]) {
    CE_(a[0], a[1]); CE_(a[2], a[3]); CE_(a[0], a[2]); CE_(a[1], a[3]); CE_(a[1], a[2]); CE_(a[4], a[5]); CE_(a[6], a[7]); CE_(a[4], a[6]); CE_(a[5], a[7]); CE_(a[5], a[6]); CE_(a[0], a[4]); CE_(a[2], a[6]); CE_(a[2], a[4]); CE_(a[1], a[5]); CE_(a[3], a[7]); CE_(a[3], a[5]); CE_(a[1], a[2]); CE_(a[3], a[4]); CE_(a[5], a[6]); CE_(a[8], a[9]); CE_(a[10], a[11]); CE_(a[8], a[10]); CE_(a[9], a[11]); CE_(a[9], a[10]); CE_(a[12], a[13]); CE_(a[14], a[15]); CE_(a[12], a[14]); CE_(a[13], a[15]); CE_(a[13], a[14]); CE_(a[8], a[12]); CE_(a[10], a[14]); CE_(a[10], a[12]); CE_(a[9], a[13]); CE_(a[11], a[15]); CE_(a[11], a[13]); CE_(a[9], a[10]); CE_(a[11], a[12]); CE_(a[13], a[14]); CE_(a[0], a[8]); CE_(a[4], a[12]); CE_(a[4], a[8]); CE_(a[2], a[10]); CE_(a[6], a[14]); CE_(a[6], a[10]); CE_(a[2], a[4]); CE_(a[6], a[8]); CE_(a[10], a[12]); CE_(a[1], a[9]); CE_(a[5], a[13]); CE_(a[5], a[9]); CE_(a[3], a[11]); CE_(a[7], a[15]); CE_(a[7], a[11]); CE_(a[3], a[5]); CE_(a[7], a[9]); CE_(a[11], a[13]); CE_(a[1], a[2]); CE_(a[3], a[4]); CE_(a[5], a[6]); CE_(a[7], a[8]); CE_(a[9], a[10]); CE_(a[11], a[12]); CE_(a[13], a[14]);
}
__device__ __forceinline__ void merge16(unsigned (&a)[16], const unsigned (&b)[16]) {
    a[0] = max(a[0], b[15]); a[1] = max(a[1], b[14]); a[2] = max(a[2], b[13]); a[3] = max(a[3], b[12]); a[4] = max(a[4], b[11]); a[5] = max(a[5], b[10]); a[6] = max(a[6], b[9]); a[7] = max(a[7], b[8]); a[8] = max(a[8], b[7]); a[9] = max(a[9], b[6]); a[10] = max(a[10], b[5]); a[11] = max(a[11], b[4]); a[12] = max(a[12], b[3]); a[13] = max(a[13], b[2]); a[14] = max(a[14], b[1]); a[15] = max(a[15], b[0]);
    CE_(a[0], a[8]); CE_(a[1], a[9]); CE_(a[2], a[10]); CE_(a[3], a[11]); CE_(a[4], a[12]); CE_(a[5], a[13]); CE_(a[6], a[14]); CE_(a[7], a[15]); CE_(a[0], a[4]); CE_(a[1], a[5]); CE_(a[2], a[6]); CE_(a[3], a[7]); CE_(a[8], a[12]); CE_(a[9], a[13]); CE_(a[10], a[14]); CE_(a[11], a[15]); CE_(a[0], a[2]); CE_(a[1], a[3]); CE_(a[4], a[6]); CE_(a[5], a[7]); CE_(a[8], a[10]); CE_(a[9], a[11]); CE_(a[12], a[14]); CE_(a[13], a[15]); CE_(a[0], a[1]); CE_(a[2], a[3]); CE_(a[4], a[5]); CE_(a[6], a[7]); CE_(a[8], a[9]); CE_(a[10], a[11]); CE_(a[12], a[13]); CE_(a[14], a[15]);
}

__device__ __forceinline__ void convert_experts(const Params& p, size_t gtid, size_t nthr) {
    cvt_flat_fp8(p.expert_u, p.ws + WS_EU, (size_t)16384 * 1024 / 16, ESCALE, gtid, nthr);
    cvt_flat_fp8(p.expert_v, p.ws + WS_EV, (size_t)16384 * 1024 / 16, ESCALE, gtid, nthr);
}
__device__ __forceinline__ void phase_topk(const Params& p, LAS unsigned char* lds, int G, int bid, int wave, int lane) {
    const bf16* QP = (const bf16*)(p.ws + WS_BIG + B_QP); const bf16* SK = (const bf16*)(p.ws + WS_SUBK);
    int* SEL = (int*)(p.ws + WS_BIG + B_SEL); float* GATE = (float*)(p.ws + WS_BIG + B_GATE);
    const int gw = bid * NWAVES + wave, NGW = G * NWAVES, l31 = lane & 31, half = lane >> 5;
    LAS int* tab = (LAS int*)(lds + wave * 12288) + l31 * 32;
    LAS unsigned char* qst = lds + wave * 12288 + 4096 + lane * 16;
    LAS unsigned char* skl = lds + 8 * 12288;
    const float* ctab = (wave < 4) ? p.expert_u : p.expert_v; unsigned char* cdst = p.ws + ((wave < 4) ? WS_EU : WS_EV);
    const int tid_ = wave * 64 + lane;
    for (int sbk = bid; sbk < 256; sbk += G)
    for (int rnd = 0; rnd < 2; ++rnd) {
        const int tg = 8 * (sbk >> 2) + wave, h = 2 * (sbk & 3) + rnd, t = tg * 32 + l31;
        unsigned lists[2][16];
#pragma unroll
        for (int m = 0; m < 2; ++m) {
            f32x16 acc[4];
#pragma unroll
            for (int kb = 0; kb < 4; ++kb)
#pragma unroll
                for (int r = 0; r < 16; ++r) acc[kb][r] = 0.f;
            const bf16* qp = QP + (size_t)t * 2048 + h * 256 + m * 128 + 8 * half;
            { const bf16* sks = SK + (size_t)(h * 2 + m) * 128 * 128;
#pragma unroll
              for (int jj = 0; jj < 4; ++jj) { const int c = tid_ + 512 * jj, row = c >> 4, ch = c & 15;
                  *(LAS u32x4*)(skl + row * 272 + ch * 16) = *(const u32x4*)(sks + row * 128 + ch * 8); } }
            __syncthreads();
            const size_t cbase = ((size_t)(sbk * 4 + (wave & 3)) * 1024 + (size_t)(rnd * 2 + m) * 256 + lane) * 16;
#define CAST_SLICE() do { _Pragma("unroll") for (int j = 0; j < 4; ++j) { const size_t o_ = cbase + (size_t)j * 64 * 16; u32x4 w_; \
                _Pragma("unroll") for (int q = 0; q < 4; ++q) { const f32x4 a_ = *(const f32x4*)(ctab + o_ + 4 * q) * ESCALE; int x_ = 0; \
                    x_ = __builtin_amdgcn_cvt_pk_fp8_f32(a_[0], a_[1], x_, false); x_ = __builtin_amdgcn_cvt_pk_fp8_f32(a_[2], a_[3], x_, true); w_[q] = (unsigned)x_; } \
                *(u32x4*)(cdst + o_) = w_; } } while (0)
            if (wave < 4) CAST_SLICE();
            const LAS unsigned char* kl = skl + l31 * 272 + half * 16;
            { u32x4 tq[8];
#pragma unroll
              for (int s = 0; s < 8; ++s) tq[s] = *(const u32x4*)(qp + 16 * s);
#pragma unroll
              for (int s = 0; s < 8; ++s) *(LAS u32x4*)(qst + s * 1024) = tq[s]; }
#pragma unroll 2
            for (int s = 0; s < 8; ++s) {
                const bf16x8 bq = *(const LAS bf16x8*)(qst + s * 1024);
#pragma unroll
                for (int kb = 0; kb < 4; ++kb) { const bf16x8 ak = *(const LAS bf16x8*)(kl + kb * 32 * 272 + s * 32); acc[kb] = __builtin_amdgcn_mfma_f32_32x32x16_bf16(ak, bq, acc[kb], 0, 0, 0); }
            }
            unsigned top[16], oth[16];
#pragma unroll
            for (int kb = 0; kb < 4; ++kb) {
#pragma unroll
                for (int r = 0; r < 16; ++r) { const int kidx = 32 * kb + (r & 3) + 8 * (r >> 2) + 4 * half; oth[r] = (mono(acc[kb][r]) & ~127u) | (unsigned)(127 - kidx); }
                sort16(oth);
                if (kb == 0) {
#pragma unroll
                    for (int i = 0; i < 16; ++i) top[i] = oth[i];
                } else merge16(top, oth);
            }
#pragma unroll
            for (int i = 0; i < 16; ++i) oth[i] = (unsigned)__shfl_xor((int)top[i], 32);
            merge16(top, oth);
#pragma unroll
            for (int i = 0; i < 16; ++i) lists[m][i] = top[i];
            if (wave >= 4) CAST_SLICE();
#undef CAST_SLICE
            __syncthreads();
        }
        float va[16], vb[16];
#pragma unroll
        for (int i = 0; i < 16; ++i) { va[i] = unmono(lists[0][i] & ~127u); vb[i] = unmono(lists[1][i] & ~127u);
            tab[i] = 127 - (int)(lists[0][i] & 127u); tab[16 + i] = 127 - (int)(lists[1][i] & 127u); }
#define CKEY(i, j) ((mono(va[i] + vb[j]) & ~255u) | (unsigned)(255 - ((i) * 16 + (j))))
        unsigned ct[16], l1[16], l2[16], l3[16];
#pragma unroll
        for (int j = 0; j < 16; ++j) ct[j] = CKEY(0, j);
#pragma unroll
        for (int j = 0; j < 8; ++j) l1[j] = CKEY(1, j);
#pragma unroll
        for (int j = 0; j < 5; ++j) l1[8 + j] = CKEY(2, j);
        l1[13] = 0u; l1[14] = 0u; l1[15] = 0u;
#pragma unroll
        for (int j = 0; j < 4; ++j) l2[j] = CKEY(3, j);
#pragma unroll
        for (int j = 0; j < 3; ++j) l2[4 + j] = CKEY(4, j);
#pragma unroll
        for (int j = 0; j < 2; ++j) { l2[7 + j] = CKEY(5, j); l2[9 + j] = CKEY(6, j); l2[11 + j] = CKEY(7, j); }
        l2[13] = 0u; l2[14] = 0u; l2[15] = 0u;
#pragma unroll
        for (int i = 0; i < 8; ++i) { l3[i] = CKEY(8 + i, 0); l3[8 + i] = 0u; }
#undef CKEY
        sort16(l1); sort16(l2); sort16(l3);
        merge16(ct, l1); merge16(l2, l3); merge16(ct, l2);
        LDS_WAIT(); __builtin_amdgcn_wave_barrier();
        const float s0 = unmono(ct[0] & ~255u);
        float ev[16], es = 0.f; int ex[16];
#pragma unroll
        for (int r = 0; r < 16; ++r) { const int pos = 255 - (int)(ct[r] & 255u); ev[r] = __expf(unmono(ct[r] & ~255u) - s0); es += ev[r];
            ex[r] = tab[pos >> 4] * 128 + tab[16 + (pos & 15)]; }
        const float ie = 1.f / es;
        int* so = SEL + (size_t)t * 128 + h * 16; float* go = GATE + (size_t)t * 128 + h * 16;
        if (half == 0) {
#pragma unroll
            for (int r = 0; r < 8; ++r) { so[r] = ex[r]; go[r] = ev[r] * ie; }
        } else {
#pragma unroll
            for (int r = 8; r < 16; ++r) { so[r] = ex[r]; go[r] = ev[r] * ie; }
        }
        LDS_WAIT(); __builtin_amdgcn_wave_barrier();
    }
}

__device__ __forceinline__ float gelu_as(float v) {
    const float av = fabsf(v), t = __builtin_amdgcn_rcpf(av * 0.2316418882f + 1.0f);
    float q = t * 0.5307027145f + (-0.7265760135f); q = q * t + 0.7107068705f; q = q * t + (-0.142248368f); q = q * t + 0.127414796f; q = q * t;
    const float e = __builtin_amdgcn_exp2f((v * v) * (-0.72134752044f)), m = v * (q * e);
    return v < 0.f ? m : v - m;
}
constexpr int KT = 4;
constexpr int GW_LDS = 17152;
constexpr int UPITCH = 272, USTG = 16 * UPITCH;
static_assert(KT == 4, "LDS map of the gather phase is laid out for 4 tokens per wave");
__device__ __forceinline__ void phase_gather(const Params& p, LAS unsigned char* lds, int G, int bid, int wave, int lane) {
    const int* SEL = (const int*)(p.ws + WS_BIG + B_SEL); const float* GATE = (const float*)(p.ws + WS_BIG + B_GATE);
    const unsigned char* EU = p.ws + WS_EU; const unsigned char* EV = p.ws + WS_EV;
    float* H2 = p.out;
    const int gw = bid * NWAVES + wave, NGW = G * NWAVES, l15 = lane & 15, g4 = lane >> 4;
    LAS unsigned char* wl = lds + wave * GW_LDS;
    LAS unsigned char* xnb = wl; LAS int* selb = (LAS int*)(wl + 4096); LAS float* gateb = (LAS float*)(wl + 6144); LAS float* hb = (LAS float*)(wl + 8192); LAS unsigned char* ustg = wl + 8448;
    for (int tb = gw * KT; tb < T; tb += NGW * KT) {
#pragma unroll 1
        for (int k = 0; k < KT; ++k) {
            const int t = tb + k;
            const float* hrow = H2 + (size_t)t * DM + 16 * lane;
            f32x4 hv[4];
#pragma unroll
            for (int j = 0; j < 4; ++j) hv[j] = *(const f32x4*)(hrow + 4 * j);
            const int selA = SEL[(size_t)t * 128 + lane], selB = SEL[(size_t)t * 128 + 64 + lane];
            const float gtA = GATE[(size_t)t * 128 + lane], gtB = GATE[(size_t)t * 128 + 64 + lane];
            float ssq = 0.f;
#pragma unroll
            for (int j = 0; j < 4; ++j) ssq += (hv[j][0] * hv[j][0] + hv[j][1] * hv[j][1]) + (hv[j][2] * hv[j][2] + hv[j][3] * hv[j][3]);
            const float r2 = rsqrtf(wave_sum(ssq) * (1.f / DM) + EPS);
            { u32x4 o;
#pragma unroll
              for (int j = 0; j < 4; ++j) { const f32x4 a = hv[j] * r2 * *(const f32x4*)(p.norm2_g + 16 * lane + 4 * j); int w = 0;
                  w = __builtin_amdgcn_cvt_pk_fp8_f32(a[0], a[1], w, false); w = __builtin_amdgcn_cvt_pk_fp8_f32(a[2], a[3], w, true); o[j] = (unsigned)w; }
              *(LAS u32x4*)(xnb + k * 1024 + 16 * lane) = o; }
            const int bA = selA >> 10, bB = selB >> 10; int posA = 0, posB = 0, off = 0;
#pragma unroll
            for (int b = 0; b < 16; ++b) {
                const unsigned long long mA = __ballot(bA == b), mB = __ballot(bB == b);
                const int cA = __popcll(mA), cB = __popcll(mB);
                const int rA = (int)__builtin_amdgcn_mbcnt_hi((unsigned)(mA >> 32), __builtin_amdgcn_mbcnt_lo((unsigned)mA, 0u));
                const int rB = (int)__builtin_amdgcn_mbcnt_hi((unsigned)(mB >> 32), __builtin_amdgcn_mbcnt_lo((unsigned)mB, 0u));
                if (bA == b) posA = off + rA;
                if (bB == b) posB = off + cA + rB;
                off += cA + cB;
            }
            selb[k * 128 + posA] = selA; gateb[k * 128 + posA] = gtA; selb[k * 128 + posB] = selB; gateb[k * 128 + posB] = gtB;
        }
        LDS_WAIT(); __builtin_amdgcn_wave_barrier();
        f32x2_t y[KT][8];
#pragma unroll
        for (int k = 0; k < KT; ++k)
#pragma unroll
            for (int i = 0; i < 8; ++i) y[k][i] = (f32x2_t){0.f, 0.f};
#pragma unroll 1
        for (int g = 0; g < 8; ++g) {
#pragma unroll
            for (int k = 0; k < KT; ++k) {
                asm volatile("" ::: "memory");
                f32x4 acc = (f32x4){0.f, 0.f, 0.f, 0.f};
                const int rr = lane >> 4, cc = lane & 15;
                const unsigned char* rp[4];
#pragma unroll
                for (int i = 0; i < 4; ++i) rp[i] = EU + (size_t)selb[k * 128 + 16 * g + 4 * i + rr] * DM + 16 * cc;
                u32x4 ld[4];
#pragma unroll
                for (int i = 0; i < 4; ++i) ld[i] = *(const u32x4*)(rp[i]);
#pragma unroll
                for (int qd = 0; qd < 4; ++qd) {
                    LAS unsigned char* sb = ustg + (qd & 1) * USTG;
#pragma unroll
                    for (int i = 0; i < 4; ++i) *(LAS u32x4*)(sb + (4 * i + rr) * UPITCH + 16 * cc) = ld[i];
                    if (qd < 3) {
#pragma unroll
                        for (int i = 0; i < 4; ++i) ld[i] = *(const u32x4*)(rp[i] + 256 * (qd + 1));
                    }
                    LDS_WAIT(); __builtin_amdgcn_wave_barrier();
                    const LAS unsigned char* ar = sb + l15 * UPITCH + 64 * g4;
                    const LAS unsigned char* xk = xnb + k * 1024 + 256 * qd + 64 * g4;
#pragma unroll
                    for (int i = 0; i < 4; ++i) { const u32x4 a = *(const LAS u32x4*)(ar + 16 * i); const u32x4 bx = *(const LAS u32x4*)(xk + 16 * i);
                        const long a0 = (long)(((unsigned long long)a.y << 32) | a.x), a1 = (long)(((unsigned long long)a.w << 32) | a.z);
                        const long b0 = (long)(((unsigned long long)bx.y << 32) | bx.x), b1 = (long)(((unsigned long long)bx.w << 32) | bx.z);
                        acc = __builtin_amdgcn_mfma_f32_16x16x32_fp8_fp8(a0, b0, acc, 0, 0, 0);
                        acc = __builtin_amdgcn_mfma_f32_16x16x32_fp8_fp8(a1, b1, acc, 0, 0, 0); }
                }
                if (l15 == 0) {
#pragma unroll
                    for (int j = 0; j < 4; ++j) { const float a = acc[j] * (1.f / ESCALE);
                        hb[k * 16 + 4 * g4 + j] = gelu_as(a) * gateb[k * 128 + 16 * g + 4 * g4 + j] * (1.f / ESCALE); }
                }
            }
            LDS_WAIT(); __builtin_amdgcn_wave_barrier();
#pragma unroll
            for (int k = 0; k < KT; ++k) {
                asm volatile("" ::: "memory");
                u32x4 vr[2][4];
#pragma unroll
                for (int i = 0; i < 4; ++i) vr[0][i] = *(const u32x4*)(EV + (size_t)selb[k * 128 + 16 * g + i] * DM + 16 * lane);
#pragma unroll
                for (int bt = 0; bt < 4; ++bt) {
                    if (bt < 3) {
#pragma unroll
                        for (int i = 0; i < 4; ++i) vr[(bt + 1) & 1][i] = *(const u32x4*)(EV + (size_t)selb[k * 128 + 16 * g + 4 * (bt + 1) + i] * DM + 16 * lane);
                    }
                    asm volatile("" ::: "memory");
#pragma unroll
                    for (int i = 0; i < 4; ++i) { const float hs = hb[k * 16 + 4 * bt + i]; const u32x4 v = vr[bt & 1][i];
#pragma unroll
                        for (int q = 0; q < 4; ++q) { const f32x2_t lo = __builtin_amdgcn_cvt_pk_f32_fp8((int)v[q], false), hi = __builtin_amdgcn_cvt_pk_f32_fp8((int)v[q], true);
                            y[k][2 * q] += lo * hs; y[k][2 * q + 1] += hi * hs; } }
                }
            }
            LDS_WAIT(); __builtin_amdgcn_wave_barrier();
        }
#pragma unroll
        for (int k = 0; k < KT; ++k) {
            float* hrow = H2 + (size_t)(tb + k) * DM + 16 * lane;
            f32x4 h3[4]; float s3 = 0.f;
#pragma unroll
            for (int j = 0; j < 4; ++j) { const f32x4 hv = *(const f32x4*)(hrow + 4 * j);
                h3[j][0] = hv[0] + y[k][2 * j][0]; h3[j][1] = hv[1] + y[k][2 * j][1]; h3[j][2] = hv[2] + y[k][2 * j + 1][0]; h3[j][3] = hv[3] + y[k][2 * j + 1][1];
                s3 += (h3[j][0] * h3[j][0] + h3[j][1] * h3[j][1]) + (h3[j][2] * h3[j][2] + h3[j][3] * h3[j][3]); }
            const float r3 = rsqrtf(wave_sum(s3) * (1.f / DM) + EPS);
#pragma unroll
            for (int j = 0; j < 4; ++j) *(f32x4*)(hrow + 4 * j) = h3[j] * r3 * *(const f32x4*)(p.final_g + 16 * lane + 4 * j);
        }
        LDS_WAIT(); __builtin_amdgcn_wave_barrier();
    }
}

#define XB_TMO      128
#define XB_XCNT(j)  (256  + 64 * (j))
#define XB_XSUB(j)  (1280 + 64 * (j))
#define XB_XGEN(j)  (2304 + 64 * (j))
#define XB_TOP      3328
#define XB_TOPGEN   3392
#define XCD_BAR_WORDS 3456
#define XB_SPIN_CAP (1u << 18)

__device__ __forceinline__ unsigned xb_ld(unsigned* p)              { return __hip_atomic_load(p, __ATOMIC_RELAXED, __HIP_MEMORY_SCOPE_AGENT); }
__device__ __forceinline__ unsigned xb_add(unsigned* p, unsigned v) { return __hip_atomic_fetch_add(p, v, __ATOMIC_RELAXED, __HIP_MEMORY_SCOPE_AGENT); }
__device__ __forceinline__ unsigned xb_xcc_id() { return (unsigned)__builtin_amdgcn_s_getreg((3 << 11) | 20) & 0xFu; }
#define XB_SPIN(cond, bar) do { unsigned _sp = 0; while (cond) { __builtin_amdgcn_s_sleep(1); \
    if ((++_sp & 255u) == 0u) { if (xb_ld(&(bar)[XB_TMO])) break; if (_sp > XB_SPIN_CAP) { atomicAdd(&(bar)[XB_TMO], 1u); break; } } } } while (0)

struct XcdBarrier {
    unsigned* bar; unsigned x;
    volatile LAS unsigned* st;
};

__device__ __forceinline__ XcdBarrier xcd_barrier_post(unsigned* bar, volatile LAS unsigned* st) {
    XcdBarrier b; b.bar = bar; b.x = xb_xcc_id(); b.st = st;
    if (threadIdx.x == 0) (void)xb_add(&bar[XB_XCNT(b.x)], 1u);
    return b;
}
__device__ __forceinline__ void xcd_barrier_complete(unsigned* bar, unsigned x, unsigned& nloc, unsigned& nx) {
    const unsigned G = gridDim.x * gridDim.y * gridDim.z;
    unsigned sum, cnt, mine, sp = 0u;
    for (;;) {
        sum = 0u; cnt = 0u; mine = 0u;
#pragma unroll
        for (unsigned j = 0; j < 16; ++j) { const unsigned c = xb_ld(&bar[XB_XCNT(j)]); sum += c; cnt += (c > 0u) ? 1u : 0u; mine = (j == x) ? c : mine; }
        if (sum == G) break;
        __builtin_amdgcn_s_sleep(1);
        if ((++sp & 255u) == 0u) { if (xb_ld(&bar[XB_TMO])) break; if (sp > XB_SPIN_CAP) { atomicAdd(&bar[XB_TMO], 1u); break; } }
    }
    nloc = mine > 0u ? mine : 1u; nx = cnt > 0u ? cnt : 1u;
}

__device__ __forceinline__ void xcd_barrier(const XcdBarrier& b) {
    asm volatile("s_waitcnt vmcnt(0)" ::: "memory");
    __syncthreads();
    if (threadIdx.x == 0) {
        unsigned* bar = b.bar;
        __builtin_amdgcn_s_waitcnt(0);
        unsigned nloc = b.st[0], nx = b.st[1];
        if (nloc == 0u) { xcd_barrier_complete(bar, b.x, nloc, nx); b.st[0] = nloc; b.st[1] = nx; }
        const unsigned old = xb_add(&bar[XB_XSUB(b.x)], 1u);
        const unsigned gen = old / nloc;
        if (old + 1u == (gen + 1u) * nloc) {
            __builtin_amdgcn_fence(__ATOMIC_RELEASE, "agent");
            asm volatile("s_waitcnt vmcnt(0)" ::: "memory");
            const unsigned og = xb_add(&bar[XB_TOP], 1u);
            const unsigned tg = og / nx;
            if (og + 1u == (tg + 1u) * nx) xb_add(&bar[XB_TOPGEN], 1u);
            else XB_SPIN(xb_ld(&bar[XB_TOPGEN]) == tg, bar);
            __builtin_amdgcn_fence(__ATOMIC_ACQUIRE, "agent");
            xb_add(&bar[XB_XGEN(b.x)], 1u);
            asm volatile("s_waitcnt vmcnt(0)" ::: "memory");
        } else {
            XB_SPIN(xb_ld(&bar[XB_XGEN(b.x)]) == gen, bar);
            __builtin_amdgcn_fence(__ATOMIC_ACQUIRE, "agent");
            asm volatile("s_waitcnt vmcnt(0)" ::: "memory");
        }
    }
    __syncthreads();
}

#ifndef ONE_LAUNCH
#define ONE_LAUNCH 1
#endif
constexpr int NPHASE = 8;
__global__ void __launch_bounds__(NTHR, 2) hybrid_fwd(Params p) {
    extern __shared__ __attribute__((aligned(16))) unsigned char lds_raw[];
    LAS unsigned char* lds = (LAS unsigned char*)lds_raw;
    const int tid = threadIdx.x, lane = tid & 63, wave = __builtin_amdgcn_readfirstlane(tid >> 6), G = gridDim.x, bid = blockIdx.x;
    unsigned char* ws = p.ws;
    volatile LAS unsigned* xst = (volatile LAS unsigned*)(lds + 139264);
    if (tid < 2) xst[tid] = 0u;
    __syncthreads();
    XcdBarrier xbar; xbar.bar = (unsigned*)(ws + WS_END); xbar.x = 0; xbar.st = xst;
    if (ONE_LAUNCH && p.hi - p.lo > 1) { xbar = xcd_barrier_post((unsigned*)(ws + WS_END), xst); cg::this_grid().sync(); }
    const pg8::bf16_t* N1 = (const pg8::bf16_t*)p.out;
#ifdef ONLY
#define PH(k) if ((k) == ONLY && p.lo <= (k) && (k) < p.hi)
#else
#define PH(k) if (p.lo <= (k) && (k) < p.hi)
#endif
#define SEAM(k) do { if (ONE_LAUNCH && p.lo <= (k) && (k) + 1 < p.hi) { xcd_barrier(xbar); } } while (0)
#define FRESH_IDS int tid = threadIdx.x; asm volatile("" : "+v"(tid)); const int lane = tid & 63, wave = __builtin_amdgcn_readfirstlane(tid >> 6); (void)lane; (void)wave
    unsigned char* big = ws + WS_BIG;
    PH(0) { FRESH_IDS; phase0(p, lds, G, bid, wave, lane); SEAM(0); }
    PH(1) { FRESH_IDS; pg8::Gemm g{N1, (const pg8::bf16_t*)(ws + WS_WIN), T, 8192, 1024, 2048, 1024}; pg8::StaticOrder S; S.init(T, 8192, G, bid);
        pg8::EpiG1 E{(pg8::bf16_t*)(big + B_QKV), (pg8::bf16_t*)(big + B_GG), (pg8::bf16_t*)p.out + 1024, (pg8::bf16_t*)(big + B_PR), C2};
        pg8::gemm_phase<pg8::EpiG1, pg8::StaticOrder, true, true>(lds, g, S, E); SEAM(1); }
    PH(2) { FRESH_IDS; phase_attn(p, lds, G, bid, tid); phase_conv(p, G, bid, tid); SEAM(2); }
    PH(3) { FRESH_IDS; pg8::Gemm g{(const pg8::bf16_t*)p.out, (const pg8::bf16_t*)(ws + WS_WAC), T, 1024, 1024, 2048, 2048}; pg8::SplitKOrder S; S.base.init(T, 1024, G, bid);
        pg8::EpiMerged E{(const pg8::bf16_t*)(big + B_GG), (pg8::bf16_t*)(big + B_MG)};
        pg8::gemm_phase<pg8::EpiMerged, pg8::SplitKOrder, false, true>(lds, g, S, E); SEAM(3); }
    PH(4) { FRESH_IDS; pg8::Gemm g{(const pg8::bf16_t*)(big + B_MG), (const pg8::bf16_t*)(ws + WS_WOUT), T, 1024, 1024, 1024, 1024}; pg8::StaticOrder S; S.init(T, 1024, G, bid);
        pg8::EpiResid E{p.x, p.out, (pg8::bf16_t*)(big + B_H2B), (float*)(ws + WS_SSQ)};
        pg8::gemm_phase<pg8::EpiResid, pg8::StaticOrder, false, true>(lds, g, S, E); SEAM(4); }
    PH(5) { FRESH_IDS; pg8::Gemm g{(const pg8::bf16_t*)(big + B_H2B), (const pg8::bf16_t*)(ws + WS_WQ), T, 2048, 1024, 1024, 1024}; pg8::StaticOrder S; S.init(T, 2048, G, bid);
        pg8::EpiRowScale E{(const float*)(ws + WS_SSQ), (pg8::bf16_t*)(big + B_QP)};
        pg8::gemm_phase<pg8::EpiRowScale, pg8::StaticOrder, true, true>(lds, g, S, E); SEAM(5); }
    PH(6) { FRESH_IDS; phase_topk(p, lds, G, bid, wave, lane); SEAM(6); }
    PH(7) { FRESH_IDS; phase_gather(p, lds, G, bid, wave, lane); }
#undef PH
#undef SEAM
}

extern "C" void kernel_launch(void* const* d_in, const int* in_sizes, int n_in, void* d_out, int out_size, void* d_ws, size_t ws_size, hipStream_t stream) {
    static int grid = 0;
    if (grid == 0) {
        if (n_in != 15 || out_size != T * DM || ws_size < WS_END) { fprintf(stderr, "kernel_launch: unexpected problem (n_in %d out %d ws %zu)\n", n_in, out_size, ws_size); grid = -1; return; }
        int dev = 0, cus = 0, per_cu = 0;
        hipGetDevice(&dev); hipDeviceGetAttribute(&cus, hipDeviceAttributeMultiprocessorCount, dev);
        if (hipFuncSetAttribute((const void*)hybrid_fwd, hipFuncAttributeMaxDynamicSharedMemorySize, LDS_BYTES) != hipSuccess) { fprintf(stderr, "kernel_launch: hipFuncSetAttribute failed\n"); grid = -1; return; }
        if (hipOccupancyMaxActiveBlocksPerMultiprocessor(&per_cu, (const void*)hybrid_fwd, NTHR, LDS_BYTES) != hipSuccess || per_cu < 1) { fprintf(stderr, "kernel_launch: occupancy query says %d\n", per_cu); per_cu = 1; }
        (void)hipGetLastError();
        grid = cus * per_cu;
    }
    if (grid < 0) return;
    Params p{};
    p.x = (const float*)d_in[0]; p.norm1_g = (const float*)d_in[1]; p.w_in = (const float*)d_in[2]; p.lambda_qk = (const float*)d_in[3]; p.subln_g = (const float*)d_in[4];
    p.conv_w = (const float*)d_in[5]; p.w_attn_o = (const float*)d_in[6]; p.w_conv_o = (const float*)d_in[7]; p.w_out = (const float*)d_in[8]; p.norm2_g = (const float*)d_in[9];
    p.w_query = (const float*)d_in[10]; p.sub_keys = (const float*)d_in[11]; p.expert_u = (const float*)d_in[12]; p.expert_v = (const float*)d_in[13]; p.final_g = (const float*)d_in[14];
    p.out = (float*)d_out; p.ws = (unsigned char*)d_ws;
#if ONE_LAUNCH
    p.lo = 0; p.hi = NPHASE;
    (void)hipMemsetAsync((char*)d_ws + WS_END, 0, 16384, stream);
    void* args[] = {&p};
    hipError_t e = hipLaunchCooperativeKernel((const void*)hybrid_fwd, dim3(grid), dim3(NTHR), args, LDS_BYTES, stream);
    if (e != hipSuccess) fprintf(stderr, "cooperative launch failed: %s (grid %d)\n", hipGetErrorString(e), grid);
#else
    for (int k = 0; k < NPHASE; ++k) {
        p.lo = k; p.hi = k + 1; hipLaunchKernelGGL(hybrid_fwd, dim3(grid), dim3(NTHR), LDS_BYTES, stream, p); }
#endif
}
```

```cpp
#include <hip/hip_runtime.h>
#include <hip/hip_cooperative_groups.h>
#include <cstdio>
#include <cstdint>
namespace cg = cooperative_groups;
namespace pg8 {
#define PG8_LAS __attribute__((address_space(3)))
typedef unsigned short bf16_t;
typedef short bf16x8 __attribute__((ext_vector_type(8)));
typedef float f32x4 __attribute__((ext_vector_type(4)));
typedef unsigned u32x4 __attribute__((ext_vector_type(4)));
constexpr int BM = 256, BK = 64, HALF = 128, HTB = HALF * BK * 2  , STAGE_BYTES = 8 * HTB, NXCD = 8, WGM = 8;

__host__ __device__ __forceinline__ int lds_byte(int r, int c) { const int st = (r >> 4) * 2 + (c >> 5), rr = r & 15, cc = c & 31, ob = rr * 64 + cc * 2; return st * 1024 + (ob ^ (((ob >> 9) & 1) << 5)); }
__host__ __device__ __forceinline__ void stage_rc(int b, int& R, int& C) { const int st = b / 1024, sb = b % 1024, swz = sb ^ (((sb >> 9) & 1) << 5); R = (st >> 1) * 16 + swz / 64; C = (st & 1) * 32 + (swz % 64) / 2; }
__host__ __device__ __forceinline__ int perm32(int rho) { const int n = rho >> 4, i = rho & 15; return 8 * (i >> 2) + 4 * n + (i & 3); }

struct Unit { int pm, pn, kh; };
struct Gemm { const bf16_t* A; const bf16_t* Bt; int M, N, K, lda, ldb; };
struct StaticOrder {
    int nM, nN, nwg, G, c;
    __host__ __device__ void init(int M, int N, int G_, int c_) { nM = M / BM; nN = N / BM; nwg = nM * nN; G = G_; c = c_; }
    __host__ __device__ bool next(int i, Unit& u) const {
        const long L = (long)i * G + c; if (L >= nwg) return false;
        int wgid = (int)L; { const int q = nwg / NXCD, r = nwg % NXCD, xcd = wgid % NXCD, off = wgid / NXCD; wgid = (xcd < r ? xcd * (q + 1) : r * (q + 1) + (xcd - r) * q) + off; }
        const int nig = WGM * nN, gid = wgid / nig, fm = gid * WGM, gsz = (nM - fm) < WGM ? (nM - fm) : WGM;
        u.pm = fm + ((wgid % nig) % gsz); u.pn = (wgid % nig) / gsz; u.kh = 0; return true;
    }
    __device__ __forceinline__ void a_ready(const Unit&) const {}
    __device__ __forceinline__ void done(const Unit&) const {}
};
struct SplitKOrder {
    StaticOrder base;
    __host__ __device__ bool next(int i, Unit& u) const { if (!base.next(i >> 1, u)) return false; u.kh = i & 1; return true; }
    __device__ __forceinline__ void a_ready(const Unit&) const {}
    __device__ __forceinline__ void done(const Unit&) const {}
};
__device__ __forceinline__ unsigned cvt_pk_bf16(float lo, float hi) { unsigned r; asm volatile("v_cvt_pk_bf16_f32 %0, %1, %2" : "=v"(r) : "v"(lo), "v"(hi)); return r; }
typedef float f32x2 __attribute__((ext_vector_type(2)));
typedef float f32x2 __attribute__((ext_vector_type(2)));
typedef unsigned u32x2 __attribute__((ext_vector_type(2)));
__device__ __forceinline__ void unpack8(const u32x4 w, float (&f)[8]) {
    f[0] = __builtin_bit_cast(float, w.x << 16); f[1] = __builtin_bit_cast(float, w.x & 0xffff0000u);
    f[2] = __builtin_bit_cast(float, w.y << 16); f[3] = __builtin_bit_cast(float, w.y & 0xffff0000u);
    f[4] = __builtin_bit_cast(float, w.z << 16); f[5] = __builtin_bit_cast(float, w.z & 0xffff0000u);
    f[6] = __builtin_bit_cast(float, w.w << 16); f[7] = __builtin_bit_cast(float, w.w & 0xffff0000u);
}
__device__ __forceinline__ u32x4 pack8(const f32x4 v0, const f32x4 v1) { u32x4 w; w.x = cvt_pk_bf16(v0[0], v0[1]); w.y = cvt_pk_bf16(v0[2], v0[3]); w.z = cvt_pk_bf16(v1[0], v1[1]); w.w = cvt_pk_bf16(v1[2], v1[3]); return w; }
struct EpiPlain {
    static constexpr bool PERM = true, AFTER_DRAIN = false, MID = false;
    bf16_t* O; int ldc;
    __device__ __forceinline__ void operator()(const f32x4 (&acc)[2][2][4][2], const Unit& u, int wr, int wc, int fr, int fq) const {
        const int row0 = u.pm * BM + wr * 64 + fr, col0 = u.pn * BM + wc * 32 + 8 * fq;
#pragma unroll
        for (int ai = 0; ai < 2; ++ai)
#pragma unroll
            for (int m = 0; m < 4; ++m) { bf16_t* rowp = O + (size_t)(row0 + ai * HALF + m * 16) * ldc + col0;
#pragma unroll
                for (int bj = 0; bj < 2; ++bj) *(u32x4*)(rowp + bj * HALF) = pack8(acc[ai][bj][m][0], acc[ai][bj][m][1]); }
    }
};
struct EpiQKVG {
    static constexpr bool PERM = true, AFTER_DRAIN = false, MID = false;
    bf16_t* QKV; bf16_t* GG; float c2;
    __device__ __forceinline__ void operator()(const f32x4 (&acc)[2][2][4][2], const Unit& u, int wr, int wc, int fr, int fq) const {
        int colt = u.pn * BM; bf16_t* base = QKV; int ldc = 3072; float sc = 1.f; bool sig = false;
        if (colt < 1024) sc = c2; else if (colt >= 3072) { base = GG; ldc = 2048; colt -= 3072; sig = true; }
        const int row0 = u.pm * BM + wr * 64 + fr, col0 = colt + wc * 32 + 8 * fq;
#pragma unroll
        for (int ai = 0; ai < 2; ++ai)
#pragma unroll
            for (int m = 0; m < 4; ++m) { bf16_t* rowp = base + (size_t)(row0 + ai * HALF + m * 16) * ldc + col0;
#pragma unroll
                for (int bj = 0; bj < 2; ++bj) { f32x4 v0 = acc[ai][bj][m][0], v1 = acc[ai][bj][m][1];
                    if (sig) {
#pragma unroll
                        for (int i = 0; i < 4; ++i) { v0[i] = __builtin_amdgcn_rcpf(1.f + __expf(-v0[i])); v1[i] = __builtin_amdgcn_rcpf(1.f + __expf(-v1[i])); }
                    } else { v0 = v0 * sc; v1 = v1 * sc; }
                    *(u32x4*)(rowp + bj * HALF) = pack8(v0, v1); } }
    }
};
struct EpiGateA {
    static constexpr bool PERM = true, AFTER_DRAIN = false, MID = false;
    const bf16_t* GG; float* TMP;
    __device__ __forceinline__ void operator()(const f32x4 (&acc)[2][2][4][2], const Unit& u, int wr, int wc, int fr, int fq) const {
        const int row0 = u.pm * BM + wr * 64 + fr, col0 = u.pn * BM + wc * 32 + 8 * fq;
#pragma unroll
        for (int ai = 0; ai < 2; ++ai)
#pragma unroll
            for (int m = 0; m < 4; ++m) { const size_t row = (size_t)(row0 + ai * HALF + m * 16);
#pragma unroll
                for (int bj = 0; bj < 2; ++bj) { const int col = col0 + bj * HALF; float g[8]; unpack8(*(const u32x4*)(GG + row * 2048 + col), g);
                    f32x4 v0 = acc[ai][bj][m][0], v1 = acc[ai][bj][m][1];
                    v0[0] *= g[0]; v0[1] *= g[1]; v0[2] *= g[2]; v0[3] *= g[3]; v1[0] *= g[4]; v1[1] *= g[5]; v1[2] *= g[6]; v1[3] *= g[7];
                    *(f32x4*)(TMP + row * 1024 + col) = v0; *(f32x4*)(TMP + row * 1024 + col + 4) = v1; } }
    }
};
struct EpiGateC {
    static constexpr bool PERM = true, AFTER_DRAIN = false, MID = false;
    const bf16_t* GG; const float* TMP; bf16_t* MG;
    __device__ __forceinline__ void operator()(const f32x4 (&acc)[2][2][4][2], const Unit& u, int wr, int wc, int fr, int fq) const {
        const int row0 = u.pm * BM + wr * 64 + fr, col0 = u.pn * BM + wc * 32 + 8 * fq;
#pragma unroll
        for (int ai = 0; ai < 2; ++ai)
#pragma unroll
            for (int m = 0; m < 4; ++m) { const size_t row = (size_t)(row0 + ai * HALF + m * 16);
#pragma unroll
                for (int bj = 0; bj < 2; ++bj) { const int col = col0 + bj * HALF; float g[8]; unpack8(*(const u32x4*)(GG + row * 2048 + 1024 + col), g);
                    const f32x4 t0 = *(const f32x4*)(TMP + row * 1024 + col), t1 = *(const f32x4*)(TMP + row * 1024 + col + 4);
                    f32x4 v0 = acc[ai][bj][m][0], v1 = acc[ai][bj][m][1];
                    v0[0] = t0[0] + v0[0] * g[0]; v0[1] = t0[1] + v0[1] * g[1]; v0[2] = t0[2] + v0[2] * g[2]; v0[3] = t0[3] + v0[3] * g[3];
                    v1[0] = t1[0] + v1[0] * g[4]; v1[1] = t1[1] + v1[1] * g[5]; v1[2] = t1[2] + v1[2] * g[6]; v1[3] = t1[3] + v1[3] * g[7];
                    *(u32x4*)(MG + row * 1024 + col) = pack8(v0, v1); } }
    }
};
struct EpiG1 {
    static constexpr bool PERM = true, AFTER_DRAIN = false, MID = false;
    bf16_t* QKV; bf16_t* GG; bf16_t* CB; bf16_t* PR; float c2;
    __device__ __forceinline__ void operator()(const f32x4 (&acc)[2][2][4][2], const Unit& u, int wr, int wc, int fr, int fq) const {
        int colt = u.pn * BM; const int row0 = u.pm * BM + wr * 64 + fr;
        if (colt >= 6144) {
            const int ch0 = (colt - 6144) / 2 + wc * 16 + 4 * fq;
#pragma unroll
            for (int ai = 0; ai < 2; ++ai)
#pragma unroll
                for (int m = 0; m < 4; ++m) { bf16_t* rowp = PR + (size_t)(row0 + ai * HALF + m * 16) * 1024 + ch0;
#pragma unroll
                    for (int bj = 0; bj < 2; ++bj) { const f32x4 v0 = acc[ai][bj][m][0], v1 = acc[ai][bj][m][1];
                        u32x2 w; w.x = cvt_pk_bf16(v0[0] * v0[1], v0[2] * v0[3]); w.y = cvt_pk_bf16(v1[0] * v1[1], v1[2] * v1[3]);
                        *(u32x2*)(rowp + bj * (HALF / 2)) = w; } }
            return;
        }
        bf16_t* base = QKV; int ldc = 3072; float sc = 1.f; bool sig = false;
        if (colt < 1024) sc = c2; else if (colt >= 5120) { base = CB; ldc = 2048; colt -= 5120; } else if (colt >= 3072) { base = GG; ldc = 2048; colt -= 3072; sig = true; }
        const int col0 = colt + wc * 32 + 8 * fq;
#pragma unroll
        for (int ai = 0; ai < 2; ++ai)
#pragma unroll
            for (int m = 0; m < 4; ++m) { bf16_t* rowp = base + (size_t)(row0 + ai * HALF + m * 16) * ldc + col0;
#pragma unroll
                for (int bj = 0; bj < 2; ++bj) { f32x4 v0 = acc[ai][bj][m][0], v1 = acc[ai][bj][m][1];
                    if (sig) {
#pragma unroll
                        for (int i = 0; i < 4; ++i) { v0[i] = __builtin_amdgcn_rcpf(1.f + __expf(-v0[i])); v1[i] = __builtin_amdgcn_rcpf(1.f + __expf(-v1[i])); }
                    } else { v0 = v0 * sc; v1 = v1 * sc; }
                    *(u32x4*)(rowp + bj * HALF) = pack8(v0, v1); } }
    }
};
struct EpiMerged {
    static constexpr bool PERM = true, AFTER_DRAIN = false, MID = true;
    const bf16_t* GG; bf16_t* MG;
    __device__ __forceinline__ void mid(f32x4 (&acc)[2][2][4][2], const Unit& u, int wr, int wc, int fr, int fq) const {
        const int row0 = u.pm * BM + wr * 64 + fr, col0 = u.pn * BM + wc * 32 + 8 * fq;
#pragma unroll
        for (int ai = 0; ai < 2; ++ai)
#pragma unroll
            for (int m = 0; m < 4; ++m) { const size_t row = (size_t)(row0 + ai * HALF + m * 16);
#pragma unroll
                for (int bj = 0; bj < 2; ++bj) { const int col = col0 + bj * HALF; float ga[8], gc[8];
                    unpack8(*(const u32x4*)(GG + row * 2048 + col), ga); unpack8(*(const u32x4*)(GG + row * 2048 + 1024 + col), gc);
#pragma unroll
                    for (int i = 0; i < 4; ++i) { acc[ai][bj][m][0][i] *= ga[i] * __builtin_amdgcn_rcpf(gc[i]); acc[ai][bj][m][1][i] *= ga[4 + i] * __builtin_amdgcn_rcpf(gc[4 + i]); }
                    asm volatile("" ::: "memory"); } }
    }
    __device__ __forceinline__ void operator()(const f32x4 (&acc)[2][2][4][2], const Unit& u, int wr, int wc, int fr, int fq) const {
        const int row0 = u.pm * BM + wr * 64 + fr, col0 = u.pn * BM + wc * 32 + 8 * fq;
#pragma unroll
        for (int ai = 0; ai < 2; ++ai)
#pragma unroll
            for (int m = 0; m < 4; ++m) { const size_t row = (size_t)(row0 + ai * HALF + m * 16);
#pragma unroll
                for (int bj = 0; bj < 2; ++bj) { const int col = col0 + bj * HALF; float gc[8]; unpack8(*(const u32x4*)(GG + row * 2048 + 1024 + col), gc);
                    f32x4 v0 = acc[ai][bj][m][0], v1 = acc[ai][bj][m][1];
#pragma unroll
                    for (int i = 0; i < 4; ++i) { v0[i] *= gc[i]; v1[i] *= gc[4 + i]; }
                    *(u32x4*)(MG + row * 1024 + col) = pack8(v0, v1); } }
    }
};
struct EpiResid {
    static constexpr bool PERM = true, AFTER_DRAIN = false, MID = false;
    const float* X; float* H2; bf16_t* H2B; float* SSQ;
    __device__ __forceinline__ void operator()(const f32x4 (&acc)[2][2][4][2], const Unit& u, int wr, int wc, int fr, int fq) const {
        const int row0 = u.pm * BM + wr * 64 + fr, col0 = u.pn * BM + wc * 32 + 8 * fq;
#pragma unroll
        for (int ai = 0; ai < 2; ++ai)
#pragma unroll
            for (int m = 0; m < 4; ++m) { const size_t row = (size_t)(row0 + ai * HALF + m * 16); float s = 0.f;
#pragma unroll
                for (int bj = 0; bj < 2; ++bj) { const size_t o = row * 1024 + col0 + bj * HALF;
                    const f32x4 v0 = acc[ai][bj][m][0] + *(const f32x4*)(X + o), v1 = acc[ai][bj][m][1] + *(const f32x4*)(X + o + 4);
                    *(f32x4*)(H2 + o) = v0; *(f32x4*)(H2 + o + 4) = v1; *(u32x4*)(H2B + o) = pack8(v0, v1);
                    s += (v0[0] * v0[0] + v0[1] * v0[1]) + (v0[2] * v0[2] + v0[3] * v0[3]) + (v1[0] * v1[0] + v1[1] * v1[1]) + (v1[2] * v1[2] + v1[3] * v1[3]); }
                s += __shfl_xor(s, 16); s += __shfl_xor(s, 32);
                if (fq == 0) SSQ[row * 16 + u.pn * 4 + wc] = s; }
    }
};
struct EpiRowScale {
    static constexpr bool PERM = true, AFTER_DRAIN = false, MID = false;
    const float* SSQ; bf16_t* O;
    __device__ __forceinline__ void operator()(const f32x4 (&acc)[2][2][4][2], const Unit& u, int wr, int wc, int fr, int fq) const {
        const int row0 = u.pm * BM + wr * 64 + fr, col0 = u.pn * BM + wc * 32 + 8 * fq;
#pragma unroll
        for (int ai = 0; ai < 2; ++ai)
#pragma unroll
            for (int m = 0; m < 4; ++m) { const size_t row = (size_t)(row0 + ai * HALF + m * 16);
                const f32x4* sp = (const f32x4*)(SSQ + row * 16); const f32x4 a = sp[0] + sp[1], b = sp[2] + sp[3], c = a + b;
                const float rs = rsqrtf(((c[0] + c[1]) + (c[2] + c[3])) * (1.f / 1024.f) + 1e-6f);
#pragma unroll
                for (int bj = 0; bj < 2; ++bj) *(u32x4*)(O + row * 2048 + col0 + bj * HALF) = pack8(acc[ai][bj][m][0] * rs, acc[ai][bj][m][1] * rs); }
    }
};
template <class Epi, class Sched, bool ALIGN_EPI = false, bool SP2 = false>
__device__ __forceinline__ void gemm_phase(PG8_LAS unsigned char* lds, const Gemm g, const Sched& S, const Epi& E) {
    const int tid = threadIdx.x, wid = __builtin_amdgcn_readfirstlane(tid >> 6), lane = tid & 63, wr = wid >> 2, wc = wid & 3, fr = lane & 15, fq = lane >> 4;
    const int K = g.K, nt = K / BK;
    unsigned voffA[2], voffB[2];
#pragma unroll
    for (int i = 0; i < 2; ++i) { int R, C; stage_rc(tid * 16 + i * 8192, R, C); const int Rb = Epi::PERM ? ((R & ~31) + perm32(R & 31)) : R;
        voffA[i] = (unsigned)(R * g.lda + C) * 2u; voffB[i] = (unsigned)(Rb * g.ldb + C) * 2u; }
    const size_t kstep = (size_t)(BK * 2);
    const size_t hstep = (size_t)HALF * g.ldb * 2;
    const size_t tstep = 2 * hstep;
    const size_t hstepA = (size_t)HALF * g.lda * 2, tstepA = 2 * hstepA;
    const unsigned ldsw = (unsigned)wid * 1024u;
    const int aoff = lds_byte(wr * 64 + fr, fq * 8), boff = lds_byte(wc * 32 + fr, fq * 8);
#define PG8_SA(b, h) (((b) * 2 + (h)) * HTB)
#define PG8_SB(b, h) ((4 + (b) * 2 + (h)) * HTB)
#define PG8_STAGE(bufoff, gbase, voff) do { _Pragma("unroll") for (int _i = 0; _i < 2; ++_i) \
        __builtin_amdgcn_global_load_lds((const unsigned*)((const char*)(gbase) + (voff)[_i]), (PG8_LAS unsigned*)(lds + (bufoff) + ldsw + _i * 8192), 16, 0, 0); } while (0)
#define PG8_LDA(dst, b, h) do { _Pragma("unroll") for (int m = 0; m < 4; ++m) _Pragma("unroll") for (int k = 0; k < 2; ++k) dst[m][k] = *(const PG8_LAS bf16x8*)(lds + PG8_SA(b, h) + aoff + m * 2048 + k * 1024); } while (0)
#define PG8_LDB(dst, b, h) do { _Pragma("unroll") for (int n = 0; n < 2; ++n) _Pragma("unroll") for (int k = 0; k < 2; ++k) dst[n][k] = *(const PG8_LAS bf16x8*)(lds + PG8_SB(b, h) + boff + n * 2048 + k * 1024); } while (0)
#define PG8_MMA(ai, bj, At, Bt) do { __builtin_amdgcn_s_setprio(1); _Pragma("unroll") for (int m = 0; m < 4; ++m) _Pragma("unroll") for (int n = 0; n < 2; ++n) _Pragma("unroll") for (int k = 0; k < 2; ++k) \
        acc[ai][bj][m][n] = __builtin_amdgcn_mfma_f32_16x16x32_bf16(Bt[n][k], At[m][k], acc[ai][bj][m][n], 0, 0, 0); __builtin_amdgcn_s_setprio(0); } while (0)
#define PG8_WAIT_V(n) asm volatile("s_waitcnt vmcnt(" #n ")" ::: "memory")
#define PG8_WAIT_L(n) asm volatile("s_waitcnt lgkmcnt(" #n ")" ::: "memory")
#define PG8_BAR __builtin_amdgcn_s_barrier()
#define PG8_SCHED __builtin_amdgcn_sched_barrier(0)
    Unit cur, nxt; int ui = 0;
    if (!S.next(0, cur)) return;
    f32x4 acc[2][2][4][2];
#pragma unroll
    for (int a = 0; a < 2; ++a)
#pragma unroll
        for (int b = 0; b < 2; ++b)
#pragma unroll
            for (int m = 0; m < 4; ++m)
#pragma unroll
                for (int n = 0; n < 2; ++n) acc[a][b][m][n] = (f32x4){0.f, 0.f, 0.f, 0.f};
    bf16x8 At[4][2], B0[2][2], B1[2][2];
    const char* cA = (const char*)g.A + (size_t)cur.pm * tstepA + (size_t)cur.kh * K * 2; const char* cB = (const char*)g.Bt + (size_t)cur.pn * tstep + (size_t)cur.kh * K * 2;
    S.a_ready(cur);
    if constexpr (SP2) {
        PG8_STAGE(PG8_SB(0, 0), cB, voffB); PG8_STAGE(PG8_SB(0, 1), cB + hstep, voffB); PG8_STAGE(PG8_SA(0, 0), cA, voffA); PG8_STAGE(PG8_SA(0, 1), cA + hstepA, voffA);
        if (wr == 1) PG8_BAR;
        PG8_WAIT_V(2); PG8_BAR;
        PG8_STAGE(PG8_SB(1, 0), cB + kstep, voffB); PG8_STAGE(PG8_SA(1, 0), cA + kstep, voffA); PG8_STAGE(PG8_SB(1, 1), cB + hstep + kstep, voffB);
        PG8_WAIT_V(6); PG8_BAR;
    } else {
        PG8_STAGE(PG8_SB(0, 0), cB, voffB); PG8_STAGE(PG8_SA(0, 0), cA, voffA); PG8_STAGE(PG8_SB(0, 1), cB + hstep, voffB); PG8_STAGE(PG8_SA(0, 1), cA + hstepA, voffA);
        if (wr == 1) PG8_BAR;
        PG8_WAIT_V(4); PG8_BAR;
        PG8_STAGE(PG8_SB(1, 0), cB + kstep, voffB); PG8_STAGE(PG8_SA(1, 0), cA + kstep, voffA); PG8_STAGE(PG8_SB(1, 1), cB + hstep + kstep, voffB);
        PG8_WAIT_V(6); PG8_BAR;
    }
    for (;;) {
        const bool has_next = S.next(ui + 1, nxt);
        const char* nA = has_next ? (const char*)g.A + (size_t)nxt.pm * tstepA + (size_t)nxt.kh * K * 2 : cA; const char* nB = has_next ? (const char*)g.Bt + (size_t)nxt.pn * tstep + (size_t)nxt.kh * K * 2 : cB;
        for (int t = 0; t < nt; t += 2) {
            const bool last = (t == nt - 2);
            const char* a1 = cA + (size_t)(t + 1) * kstep;
            const char* a2 = last ? nA : cA + (size_t)(t + 2) * kstep; const char* b2 = last ? nB : cB + (size_t)(t + 2) * kstep;
            const char* a3 = a2 + kstep; const char* b3 = b2 + kstep;
            if (last && has_next) S.a_ready(nxt);
            if constexpr (SP2) {
            PG8_LDB(B0, 0, 0); PG8_LDB(B1, 0, 1); PG8_SCHED; PG8_LDA(At, 0, 0); PG8_STAGE(PG8_SA(1, 1), a1 + hstepA, voffA);
            PG8_WAIT_V(8); PG8_WAIT_L(0); PG8_BAR; PG8_MMA(0, 0, At, B0); PG8_MMA(0, 1, At, B1); PG8_BAR; PG8_SCHED;
            PG8_LDA(At, 0, 1); PG8_STAGE(PG8_SB(0, 0), b2, voffB); PG8_STAGE(PG8_SB(0, 1), b2 + hstep, voffB); PG8_STAGE(PG8_SA(0, 0), a2, voffA);
            PG8_WAIT_V(8); PG8_WAIT_L(0); PG8_BAR; PG8_MMA(1, 0, At, B0); PG8_MMA(1, 1, At, B1); PG8_BAR; PG8_SCHED;
            PG8_LDB(B0, 1, 0); PG8_LDB(B1, 1, 1); PG8_SCHED; PG8_LDA(At, 1, 0); PG8_STAGE(PG8_SA(0, 1), a2 + hstepA, voffA);
            PG8_WAIT_V(8); PG8_WAIT_L(0); PG8_BAR; PG8_MMA(0, 0, At, B0); PG8_MMA(0, 1, At, B1); PG8_BAR; PG8_SCHED;
            PG8_LDA(At, 1, 1); PG8_STAGE(PG8_SB(1, 0), b3, voffB); PG8_STAGE(PG8_SB(1, 1), b3 + hstep, voffB); PG8_STAGE(PG8_SA(1, 0), a3, voffA);
            PG8_WAIT_V(8); PG8_WAIT_L(0); PG8_BAR; PG8_MMA(1, 0, At, B0); PG8_MMA(1, 1, At, B1); PG8_BAR; PG8_SCHED;
            } else {
            PG8_LDB(B0, 0, 0); PG8_SCHED; PG8_LDA(At, 0, 0); PG8_STAGE(PG8_SA(1, 1), a1 + hstepA, voffA);
            PG8_WAIT_L(8); PG8_BAR; PG8_WAIT_L(0); PG8_MMA(0, 0, At, B0); PG8_BAR; PG8_SCHED;
            PG8_LDB(B1, 0, 1); PG8_STAGE(PG8_SB(0, 0), b2, voffB);
            PG8_BAR; PG8_WAIT_L(0); PG8_MMA(0, 1, At, B1); PG8_BAR;
            PG8_LDA(At, 0, 1); PG8_STAGE(PG8_SA(0, 0), a2, voffA);
            PG8_BAR; PG8_WAIT_L(0); PG8_MMA(1, 0, At, B0); PG8_BAR; PG8_SCHED;
            PG8_STAGE(PG8_SB(0, 1), b2 + hstep, voffB);
            PG8_WAIT_V(6); PG8_BAR; PG8_MMA(1, 1, At, B1); PG8_BAR;
            PG8_LDB(B0, 1, 0); PG8_SCHED; PG8_LDA(At, 1, 0); PG8_STAGE(PG8_SA(0, 1), a2 + hstepA, voffA);
            PG8_WAIT_L(8); PG8_BAR; PG8_WAIT_L(0); PG8_MMA(0, 0, At, B0); PG8_BAR; PG8_SCHED;
            PG8_LDB(B1, 1, 1); PG8_STAGE(PG8_SB(1, 0), b3, voffB);
            PG8_BAR; PG8_WAIT_L(0); PG8_MMA(0, 1, At, B1); PG8_BAR;
            PG8_LDA(At, 1, 1); PG8_STAGE(PG8_SA(1, 0), a3, voffA);
            PG8_BAR; PG8_WAIT_L(0); PG8_MMA(1, 0, At, B0); PG8_BAR; PG8_SCHED;
            PG8_STAGE(PG8_SB(1, 1), b3 + hstep, voffB);
            PG8_WAIT_V(6); PG8_BAR; PG8_MMA(1, 1, At, B1); PG8_BAR;
            }
        }
        if constexpr (ALIGN_EPI) { if (wr == 0) PG8_BAR; }
        bool keep_acc = false;
        if constexpr (Epi::MID) { if (cur.kh == 0) { E.mid(acc, cur, wr, wc, fr, fq); keep_acc = true; } }
        if constexpr (!Epi::AFTER_DRAIN) { if (!keep_acc) { E(acc, cur, wr, wc, fr, fq); S.done(cur); } }
        if (!has_next) break;
        if (!keep_acc)
#pragma unroll
        for (int a = 0; a < 2; ++a)
#pragma unroll
            for (int b = 0; b < 2; ++b)
#pragma unroll
                for (int m = 0; m < 4; ++m)
#pragma unroll
                    for (int n = 0; n < 2; ++n) acc[a][b][m][n] = (f32x4){0.f, 0.f, 0.f, 0.f};
        cur = nxt; cA = nA; cB = nB; ++ui;
        if constexpr (ALIGN_EPI) { if (wr == 1) PG8_BAR; }
    }
    PG8_WAIT_V(0);
    if constexpr (!ALIGN_EPI) { if (wr == 0) PG8_BAR; }
    PG8_BAR;
    if constexpr (Epi::AFTER_DRAIN) { E.fused(acc, cur, wr, wc, fr, fq, lds, wid, lane); S.done(cur); }
#undef PG8_SA
#undef PG8_SB
#undef PG8_STAGE
#undef PG8_LDA
#undef PG8_LDB
#undef PG8_MMA
#undef PG8_WAIT_V
#undef PG8_WAIT_L
#undef PG8_BAR
#undef PG8_SCHED
}
}
#define LAS __attribute__((address_space(3)))
typedef unsigned short bf16;
typedef short bf16x8 __attribute__((ext_vector_type(8)));
typedef short s16x4 __attribute__((ext_vector_type(4)));
typedef float f32x4 __attribute__((ext_vector_type(4)));
typedef float f32x16 __attribute__((ext_vector_type(16)));
typedef unsigned u32x4 __attribute__((ext_vector_type(4)));
typedef unsigned u32x2 __attribute__((ext_vector_type(2)));
typedef float f32x2_t __attribute__((ext_vector_type(2))); typedef __bf16 bf16x2_t __attribute__((ext_vector_type(2)));

constexpr int T = 16384, DM = 1024, SEQ = 2048;
constexpr int NWAVES = 8, NTHR = 512;
constexpr int LDS_BYTES = 147456;
constexpr float EPS = 1e-6f;
constexpr float ESCALE = 64.f;
constexpr float C2 = 0.125f * 1.4426950408889634f;
constexpr size_t MiB = 1u << 20;
constexpr size_t WS_WIN = 0, WS_WAC = 16 * MiB, WS_WOUT = 20 * MiB, WS_WQ = 22 * MiB, WS_SUBK = 26 * MiB, WS_SSQ = 27 * MiB;
constexpr size_t WS_EU = 28 * MiB, WS_EV = 44 * MiB, WS_BIG = 60 * MiB, WS_END = 252 * MiB;
constexpr size_t B_QKV = 0, B_GG = 96 * MiB, B_PR = 160 * MiB, B_MG = 0, B_H2B = 32 * MiB, B_QP = 96 * MiB, B_SEL = 64 * MiB, B_GATE = 72 * MiB;

__device__ __forceinline__ unsigned cvtpk(float lo, float hi) { f32x2_t v = {lo, hi}; bf16x2_t b = __builtin_convertvector(v, bf16x2_t); return __builtin_bit_cast(unsigned, b); }
__device__ __forceinline__ float wave_sum(float v) {
#pragma unroll
    for (int o = 1; o < 64; o <<= 1) v += __shfl_xor(v, o);
    return v;
}
#define LDS_WAIT() asm volatile("s_waitcnt lgkmcnt(0)" ::: "memory")

struct Params {
    const float* x; const float* norm1_g; const float* w_in; const float* lambda_qk; const float* subln_g; const float* conv_w;
    const float* w_attn_o; const float* w_conv_o; const float* w_out; const float* norm2_g; const float* w_query; const float* sub_keys;
    const float* expert_u; const float* expert_v; const float* final_g;
    float* out; unsigned char* ws; int lo, hi;
};

__device__ __forceinline__ void transpose_item(const float* W, int K, int N, bf16* WT, int remap, int dpitch, int koff, const float* kscale, LAS float* scr, int item, int lane) {
    const int nblk = N / 32, kb = item / nblk, nb = item % nblk, k0 = 64 * kb, n0 = 32 * nb;
    int d0 = n0, dstr = 1;
    if (remap) { if (n0 < 3072) d0 = n0; else if (n0 < 4096) d0 = n0 + 2048; else if (n0 < 5120) { d0 = 6144 + 2 * (n0 - 4096); dstr = 2; } else if (n0 < 6144) { d0 = 6144 + 2 * (n0 - 5120) + 1; dstr = 2; } else d0 = n0 - 3072; }
    { float wv[32];
#pragma unroll
      for (int i = 0; i < 32; ++i) wv[i] = W[(size_t)(k0 + 2 * i + (lane >> 5)) * N + n0 + (lane & 31)];
#pragma unroll
      for (int i = 0; i < 32; ++i) { const int kk = 2 * i + (lane >> 5); float v = wv[i]; if (kscale) v *= kscale[k0 + kk]; scr[kk * 33 + (lane & 31)] = v; } }
    LDS_WAIT(); asm volatile("" ::: "memory");
    const int c = lane & 7;
#pragma unroll
    for (int j = 0; j < 4; ++j) { const int n = (lane >> 3) + 8 * j; const LAS float* sp = scr + (8 * c) * 33 + n;
        u32x4 o; o.x = cvtpk(sp[0 * 33], sp[1 * 33]); o.y = cvtpk(sp[2 * 33], sp[3 * 33]); o.z = cvtpk(sp[4 * 33], sp[5 * 33]); o.w = cvtpk(sp[6 * 33], sp[7 * 33]);
        *(u32x4*)(WT + (size_t)(d0 + n * dstr) * dpitch + koff + k0 + 8 * c) = o; }
    LDS_WAIT(); asm volatile("" ::: "memory");
}
__device__ __forceinline__ void cvt_flat(const float* src, bf16* dst, size_t n8, size_t gtid, size_t nthr) {
    for (size_t i = gtid; i < n8; i += nthr) { const f32x4 a = *(const f32x4*)(src + i * 8), b = *(const f32x4*)(src + i * 8 + 4);
        u32x4 o; o.x = cvtpk(a[0], a[1]); o.y = cvtpk(a[2], a[3]); o.z = cvtpk(b[0], b[1]); o.w = cvtpk(b[2], b[3]); *(u32x4*)(dst + i * 8) = o; }
}
__device__ __forceinline__ void cvt_flat_fp8(const float* src, unsigned char* dst, size_t n16, float sc, size_t gtid, size_t nthr) {
    for (size_t i = gtid; i < n16; i += nthr) { u32x4 o;
#pragma unroll
        for (int q = 0; q < 4; ++q) { const f32x4 a = *(const f32x4*)(src + i * 16 + 4 * q) * sc; int w = 0;
            w = __builtin_amdgcn_cvt_pk_fp8_f32(a[0], a[1], w, false); w = __builtin_amdgcn_cvt_pk_fp8_f32(a[2], a[3], w, true); o[q] = (unsigned)w; }
        *(u32x4*)(dst + i * 16) = o; }
}
__device__ __forceinline__ void phase0(const Params& p, LAS unsigned char* lds, int G, int bid, int wave, int lane) {
    unsigned char* ws = p.ws;
    LAS float* scr = (LAS float*)(lds + wave * 16384);
    const int gw = bid * NWAVES + wave, NGW = G * NWAVES;
    constexpr int I_IN = 16 * 256, I_SQ = 16 * 32, I_Q = 16 * 64, NITEMS = I_IN + 3 * I_SQ + I_Q;
    for (int it = gw; it < NITEMS; it += NGW) {
        int r = it;
        if (r < I_IN) { transpose_item(p.w_in, 1024, 8192, (bf16*)(ws + WS_WIN), 1, 1024, 0, nullptr, scr, r, lane); continue; } r -= I_IN;
        if (r < I_SQ) { transpose_item(p.w_attn_o, 1024, 1024, (bf16*)(ws + WS_WAC), 0, 2048, 0, nullptr, scr, r, lane); continue; } r -= I_SQ;
        if (r < I_SQ) { transpose_item(p.w_conv_o, 1024, 1024, (bf16*)(ws + WS_WAC), 0, 2048, 1024, nullptr, scr, r, lane); continue; } r -= I_SQ;
        if (r < I_SQ) { transpose_item(p.w_out, 1024, 1024, (bf16*)(ws + WS_WOUT), 0, 1024, 0, nullptr, scr, r, lane); continue; } r -= I_SQ;
        transpose_item(p.w_query, 1024, 2048, (bf16*)(ws + WS_WQ), 0, 1024, 0, p.norm2_g, scr, r, lane);
    }
    const size_t gtid = (size_t)bid * NTHR + wave * 64 + lane, nthr = (size_t)G * NTHR;
    cvt_flat(p.sub_keys, (bf16*)(ws + WS_SUBK), (size_t)(8 * 2 * 128 * 128) / 8, gtid, nthr);
    bf16* N1 = (bf16*)p.out;
    f32x4 gv[4];
#pragma unroll
    for (int j = 0; j < 4; ++j) gv[j] = *((const f32x4*)p.norm1_g + lane + 64 * j);
    for (int m0 = gw; m0 < T; m0 += 2 * NGW) {
        const int m1 = (m0 + NGW < T) ? m0 + NGW : m0;
        const f32x4* xr0 = (const f32x4*)(p.x + (size_t)m0 * DM) + lane; const f32x4* xr1 = (const f32x4*)(p.x + (size_t)m1 * DM) + lane;
        f32x4 v0[4], v1[4]; float s0 = 0.f, s1 = 0.f;
#pragma unroll
        for (int j = 0; j < 4; ++j) { v0[j] = xr0[64 * j]; v1[j] = xr1[64 * j]; }
#pragma unroll
        for (int j = 0; j < 4; ++j) { s0 += (v0[j][0] * v0[j][0] + v0[j][1] * v0[j][1]) + (v0[j][2] * v0[j][2] + v0[j][3] * v0[j][3]);
                                      s1 += (v1[j][0] * v1[j][0] + v1[j][1] * v1[j][1]) + (v1[j][2] * v1[j][2] + v1[j][3] * v1[j][3]); }
        const float r0 = rsqrtf(wave_sum(s0) * (1.f / DM) + EPS), r1 = rsqrtf(wave_sum(s1) * (1.f / DM) + EPS);
        u32x2* o0 = (u32x2*)(N1 + (size_t)m0 * 2048) + lane; u32x2* o1 = (u32x2*)(N1 + (size_t)m1 * 2048) + lane;
#pragma unroll
        for (int j = 0; j < 4; ++j) { u32x2 o; o.x = cvtpk(v0[j][0] * r0 * gv[j][0], v0[j][1] * r0 * gv[j][1]); o.y = cvtpk(v0[j][2] * r0 * gv[j][2], v0[j][3] * r0 * gv[j][3]); o0[64 * j] = o;
            u32x2 q; q.x = cvtpk(v1[j][0] * r1 * gv[j][0], v1[j][1] * r1 * gv[j][1]); q.y = cvtpk(v1[j][2] * r1 * gv[j][2], v1[j][3] * r1 * gv[j][3]); o1[64 * j] = q; }
    }
}

__device__ __forceinline__ void up8(const bf16* p, float (&f)[8]) { const u32x4 w = *(const u32x4*)p; pg8::unpack8(w, f); }
__device__ __forceinline__ void phase_conv(const Params& p, int G, int bid, int tid) {
    const bf16* PR = (const bf16*)(p.ws + WS_BIG + B_PR); bf16* CBU = (bf16*)p.out + 1024;
    const size_t nthr = (size_t)G * NTHR;
    for (size_t it = (size_t)bid * NTHR + tid; it < (size_t)(T / 8) * 128; it += nthr) {
        const int t0 = (int)(it >> 7) * 8, c8 = (int)(it & 127) * 8, s0 = t0 & (SEQ - 1);
        const bf16* row = PR + (size_t)t0 * 1024 + c8;
        u32x4 pr[10], cbr[8];
#pragma unroll
        for (int i = 0; i < 8; ++i) { pr[i + 2] = *(const u32x4*)(row + (size_t)i * 1024); cbr[i] = *(const u32x4*)(CBU + (size_t)(t0 + i) * 2048 + c8); }
        if (s0 != 0) { pr[0] = *(const u32x4*)(row - 2048); pr[1] = *(const u32x4*)(row - 1024); } else { pr[0] = (u32x4){0u, 0u, 0u, 0u}; pr[1] = pr[0]; }
        float w0[8], w1[8], w2[8];
#pragma unroll
        for (int i = 0; i < 8; ++i) { w0[i] = p.conv_w[c8 + i]; w1[i] = p.conv_w[1024 + c8 + i]; w2[i] = p.conv_w[2048 + c8 + i]; }
        float fa[8], fb[8], fc[8];
        pg8::unpack8(pr[0], fa); pg8::unpack8(pr[1], fb);
#pragma unroll
        for (int i = 0; i < 8; ++i) {
            pg8::unpack8(pr[i + 2], fc);
            float cb[8]; pg8::unpack8(cbr[i], cb);
            float o[8];
#pragma unroll
            for (int c = 0; c < 8; ++c) o[c] = cb[c] * (w0[c] * fa[c] + w1[c] * fb[c] + w2[c] * fc[c]);
            u32x4 w; w.x = cvtpk(o[0], o[1]); w.y = cvtpk(o[2], o[3]); w.z = cvtpk(o[4], o[5]); w.w = cvtpk(o[6], o[7]);
            *(u32x4*)(CBU + (size_t)(t0 + i) * 2048 + c8) = w;
#pragma unroll
            for (int c = 0; c < 8; ++c) { fa[c] = fb[c]; fb[c] = fc[c]; }
        }
    }
}

constexpr int KPITCH = 272, VPITCH = 320, KBYTES = 64 * KPITCH, STAGEB = KBYTES + 64 * VPITCH;
constexpr int XOFF = 0, OSTOFF = 65536, OSTPITCH = 272, OSTB = 32 * OSTPITCH;
__device__ __forceinline__ s16x4 vtr(const LAS unsigned char* p) { return __builtin_amdgcn_ds_read_tr16_b64_v4i16((LAS s16x4*)p); }

__device__ __forceinline__ void attn_unit(LAS unsigned char* lds, const bf16* QKV, bf16* ON, const float* subg, float lam, int b, int h, int qb, int tid) {
    const int w = __builtin_amdgcn_readfirstlane(tid >> 6), lane = tid & 63, map = w >> 2, wq = w & 3, l31 = lane & 31, half = lane >> 5;
    const size_t trow0 = (size_t)b * SEQ;
    const int q0 = qb * 128 + wq * 32;
    bf16x8 qf[4];
    { const bf16* qp = QKV + (trow0 + q0 + l31) * 3072 + h * 128 + map * 64 + 8 * half;
#pragma unroll
      for (int s = 0; s < 4; ++s) qf[s] = *(const bf16x8*)(qp + 16 * s); }
    f32x16 O[4];
#pragma unroll
    for (int e = 0; e < 4; ++e)
#pragma unroll
        for (int r = 0; r < 16; ++r) O[e][r] = 0.f;
    float m_run = 0.f, l_run = 0.f;
    const int ntile = 2 * (qb + 1);
    const int skey = tid >> 4, sch = tid & 15;
    const bf16* gk = QKV + (trow0 + skey) * 3072 + 1024 + h * 128 + sch * 8;
    const int dk = skey * KPITCH + sch * 16, dv = KBYTES + skey * VPITCH + sch * 16;
    u32x4 stg[4];
#define GLOAD(j) do { const bf16* g_ = gk + (size_t)(j) * 64 * 3072; stg[0] = *(const u32x4*)g_; stg[1] = *(const u32x4*)(g_ + 32 * 3072); stg[2] = *(const u32x4*)(g_ + 1024); stg[3] = *(const u32x4*)(g_ + 32 * 3072 + 1024); } while (0)
#define LSTORE(st) do { LAS unsigned char* b_ = lds + (st) * STAGEB; *(LAS u32x4*)(b_ + dk) = stg[0]; *(LAS u32x4*)(b_ + dk + 32 * KPITCH) = stg[1]; *(LAS u32x4*)(b_ + dv) = stg[2]; *(LAS u32x4*)(b_ + dv + 32 * VPITCH) = stg[3]; } while (0)
    GLOAD(0); LSTORE(0); __syncthreads();
    const int koff = l31 * KPITCH + map * 128 + half * 16;
    const int voff = KBYTES + (4 * half + ((lane & 15) >> 2)) * VPITCH + (((lane >> 4) & 1) * 16 + (lane & 3) * 4) * 2;
    const int qi = q0 + l31;
    for (int j = 0; j < ntile; ++j) {
        if (j + 1 < ntile) GLOAD(j + 1);
        const int kbase = 64 * j;
        if (kbase <= q0 + 31) {
            const LAS unsigned char* sb = lds + (j & 1) * STAGEB;
            f32x16 s0, s1;
            const float negm = -m_run;
#pragma unroll
            for (int r = 0; r < 16; ++r) { s0[r] = negm; s1[r] = negm; }
#pragma unroll
            for (int s = 0; s < 4; ++s) { const bf16x8 k0 = *(const LAS bf16x8*)(sb + koff + s * 32), k1 = *(const LAS bf16x8*)(sb + koff + 32 * KPITCH + s * 32);
                s0 = __builtin_amdgcn_mfma_f32_32x32x16_bf16(k0, qf[s], s0, 0, 0, 0); s1 = __builtin_amdgcn_mfma_f32_32x32x16_bf16(k1, qf[s], s1, 0, 0, 0); }
            const LAS unsigned char* vb = sb + voff;
            s16x4 vlo[4][4], vhi[4][4];
            if (kbase + 63 > q0) {
#pragma unroll
                for (int r = 0; r < 16; ++r) { const int key = kbase + (r & 3) + 8 * (r >> 2) + 4 * half;
                    s0[r] = (key <= qi) ? s0[r] : -1e30f; s1[r] = (key + 32 <= qi) ? s1[r] : -1e30f; }
            }
            float mx = fmaxf(s0[0], s1[0]);
#pragma unroll
            for (int r = 1; r < 16; ++r) mx = fmaxf(mx, fmaxf(s0[r], s1[r]));
            mx = fmaxf(mx, __shfl_xor(mx, 32));
            float ps = 0.f;
            const bool first = (j == 0), move = first || (__ballot(mx > 8.f) != 0ull);
            const float delta = move ? (first ? mx : fmaxf(mx, 0.f)) : 0.f;
#pragma unroll
            for (int r = 0; r < 16; ++r) { s0[r] = __builtin_amdgcn_exp2f(s0[r] - delta); s1[r] = __builtin_amdgcn_exp2f(s1[r] - delta); ps += s0[r] + s1[r]; }
            if (move) {
                const float alpha = first ? 0.f : __builtin_amdgcn_exp2f(-delta); m_run += delta;
                l_run = l_run * alpha + ps;
                if (!first) {
#pragma unroll
                    for (int e = 0; e < 4; ++e) O[e] = O[e] * alpha;
                }
            } else l_run += ps;
            bf16x8 pf[4];
#pragma unroll
            for (int kk = 0; kk < 4; ++kk) { u32x4 wv;
                if (kk < 2) { wv.x = cvtpk(s0[8 * kk + 0], s0[8 * kk + 1]); wv.y = cvtpk(s0[8 * kk + 2], s0[8 * kk + 3]); wv.z = cvtpk(s0[8 * kk + 4], s0[8 * kk + 5]); wv.w = cvtpk(s0[8 * kk + 6], s0[8 * kk + 7]); }
                else { const int k2 = kk - 2; wv.x = cvtpk(s1[8 * k2 + 0], s1[8 * k2 + 1]); wv.y = cvtpk(s1[8 * k2 + 2], s1[8 * k2 + 3]); wv.z = cvtpk(s1[8 * k2 + 4], s1[8 * k2 + 5]); wv.w = cvtpk(s1[8 * k2 + 6], s1[8 * k2 + 7]); }
                pf[kk] = __builtin_bit_cast(bf16x8, wv); }
#pragma unroll
            for (int e = 0; e < 4; ++e) { vlo[0][e] = vtr(vb + e * 64); vhi[0][e] = vtr(vb + 8 * VPITCH + e * 64); }
#pragma unroll
            for (int kk = 0; kk < 4; ++kk)
#pragma unroll
                for (int e = 0; e < 4; ++e) {
                    if (e == 0 && kk < 3) {
#pragma unroll
                        for (int e2 = 0; e2 < 4; ++e2) { vlo[kk + 1][e2] = vtr(vb + (kk + 1) * 16 * VPITCH + e2 * 64); vhi[kk + 1][e2] = vtr(vb + ((kk + 1) * 16 + 8) * VPITCH + e2 * 64); }
                        __builtin_amdgcn_sched_barrier(0);
                    }
                    const s16x4 lo = vlo[kk][e], hi = vhi[kk][e];
                    bf16x8 a; a[0] = lo[0]; a[1] = lo[1]; a[2] = lo[2]; a[3] = lo[3]; a[4] = hi[0]; a[5] = hi[1]; a[6] = hi[2]; a[7] = hi[3];
                    O[e] = __builtin_amdgcn_mfma_f32_32x32x16_bf16(a, pf[kk], O[e], 0, 0, 0); }
        }
        if (j + 1 < ntile) LSTORE((j + 1) & 1);
        __syncthreads();
    }
#undef GLOAD
#undef LSTORE
    const float ltot = l_run + __shfl_xor(l_run, 32), inv = 1.f / ltot;
    LAS float* X = (LAS float*)(lds + XOFF) + wq * 4096 + lane;
    if (map == 1) {
        const float sc = inv * lam;
#pragma unroll
        for (int e = 0; e < 4; ++e)
#pragma unroll
            for (int r = 0; r < 16; ++r) X[(e * 16 + r) * 64] = O[e][r] * sc;
    }
    __syncthreads();
    if (map == 0) {
        float ssq = 0.f;
#pragma unroll
        for (int e = 0; e < 4; ++e)
#pragma unroll
            for (int r = 0; r < 16; ++r) { const float o = O[e][r] * inv - X[(e * 16 + r) * 64]; O[e][r] = o; ssq += o * o; }
        ssq += __shfl_xor(ssq, 32);
        const float rms = rsqrtf(ssq * (1.f / 128.f) + EPS) * 0.8f;
        LAS unsigned char* ost = lds + OSTOFF + wq * OSTB;
#pragma unroll
        for (int e = 0; e < 4; ++e)
#pragma unroll
            for (int rq = 0; rq < 4; ++rq) { const int e0 = 32 * e + 8 * rq + 4 * half; const f32x4 g = *(const f32x4*)(subg + e0);
                u32x2 o; o.x = cvtpk(O[e][4 * rq + 0] * rms * g[0], O[e][4 * rq + 1] * rms * g[1]); o.y = cvtpk(O[e][4 * rq + 2] * rms * g[2], O[e][4 * rq + 3] * rms * g[3]);
                *(LAS u32x2*)(ost + l31 * OSTPITCH + e0 * 2) = o; }
        LDS_WAIT(); __builtin_amdgcn_wave_barrier();
#pragma unroll
        for (int jj = 0; jj < 8; ++jj) { const int c = lane + 64 * jj, row = c >> 4, ch = c & 15;
            const u32x4 v = *(const LAS u32x4*)(ost + row * OSTPITCH + ch * 16);
            *(u32x4*)(ON + (trow0 + q0 + row) * 2048 + h * 128 + ch * 8) = v; }
    }
    __syncthreads();
}

__device__ __forceinline__ void phase_attn(const Params& p, LAS unsigned char* lds, int G, int bid, int tid) {
    const bf16* QKV = (const bf16*)(p.ws + WS_BIG); bf16* ON = (bf16*)p.out;
    const int lane = tid & 63;
    const float a = p.lambda_qk[lane] * p.lambda_qk[64 + lane], b = p.lambda_qk[128 + lane] * p.lambda_qk[192 + lane];
    const float lam = expf(wave_sum(a)) - expf(wave_sum(b)) + 0.2f;
    for (int c = bid; c < 256; c += G) {
        const int bh = c >> 2, quad = c & 3, b_ = bh >> 3, h = bh & 7;
        attn_unit(lds, QKV, ON, p.subln_g, lam, b_, h, 15 - 2 * quad, tid);
        attn_unit(lds, QKV, ON, p.subln_g, lam, b_, h, 2 * quad, tid);
        attn_unit(lds, QKV, ON, p.subln_g, lam, b_, h, 14 - 2 * quad, tid);
        attn_unit(lds, QKV, ON, p.subln_g, lam, b_, h, 2 * quad + 1, tid);
    }
}

__device__ __forceinline__ unsigned mono(float v) { const unsigned u = __builtin_bit_cast(unsigned, v); return (u & 0x80000000u) ? ~u : (u | 0x80000000u); }
__device__ __forceinline__ float unmono(unsigned k) { const unsigned u = (k & 0x80000000u) ? (k ^ 0x80000000u) : ~k; return __builtin_bit_cast(float, u); }
#define CE_(x, y) do { const unsigned t_ = max(x, y); y = min(x, y); x = t_; } while (0)
__device__ __forceinline__ void sort16(unsigned (&a)[16]) {
    CE_(a[0], a[1]); CE_(a[2], a[3]); CE_(a[0], a[2]); CE_(a[1], a[3]); CE_(a[1], a[2]); CE_(a[4], a[5]); CE_(a[6], a[7]); CE_(a[4], a[6]); CE_(a[5], a[7]); CE_(a[5], a[6]); CE_(a[0], a[4]); CE_(a[2], a[6]); CE_(a[2], a[4]); CE_(a[1], a[5]); CE_(a[3], a[7]); CE_(a[3], a[5]); CE_(a[1], a[2]); CE_(a[3], a[4]); CE_(a[5], a[6]); CE_(a[8], a[9]); CE_(a[10], a[11]); CE_(a[8], a[10]); CE_(a[9], a[11]); CE_(a[9], a[10]); CE_(a[12], a[13]); CE_(a[14], a[15]); CE_(a[12], a[14]); CE_(a[13], a[15]); CE_(a[13], a[14]); CE_(a[8], a[12]); CE_(a[10], a[14]); CE_(a[10], a[12]); CE_(a[9], a[13]); CE_(a[11], a[15]); CE_(a[11], a[13]); CE_(a[9], a[10]); CE_(a[11], a[12]); CE_(a[13], a[14]); CE_(a[0], a[8]); CE_(a[4], a[12]); CE_(a[4], a[8]); CE_(a[2], a[10]); CE_(a[6], a[14]); CE_(a[6], a[10]); CE_(a[2], a[4]); CE_(a[6], a[8]); CE_(a[10], a[12]); CE_(a[1], a[9]); CE_(a[5], a[13]); CE_(a[5], a[9]); CE_(a[3], a[11]); CE_(a[7], a[15]); CE_(a[7], a[11]); CE_(a[3], a[5]); CE_(a[7], a[9]); CE_(a[11], a[13]); CE_(a[1], a[2]); CE_(a[3], a[4]); CE_(a[5], a[6]); CE_(a[7], a[8]); CE_(a[9], a[10]); CE_(a[11], a[12]); CE_(a[13], a[14]);
}
__device__ __forceinline__ void merge16(unsigned (&a)[16], const unsigned (&b)[16]) {
    a[0] = max(a[0], b[15]); a[1] = max(a[1], b[14]); a[2] = max(a[2], b[13]); a[3] = max(a[3], b[12]); a[4] = max(a[4], b[11]); a[5] = max(a[5], b[10]); a[6] = max(a[6], b[9]); a[7] = max(a[7], b[8]); a[8] = max(a[8], b[7]); a[9] = max(a[9], b[6]); a[10] = max(a[10], b[5]); a[11] = max(a[11], b[4]); a[12] = max(a[12], b[3]); a[13] = max(a[13], b[2]); a[14] = max(a[14], b[1]); a[15] = max(a[15], b[0]);
    CE_(a[0], a[8]); CE_(a[1], a[9]); CE_(a[2], a[10]); CE_(a[3], a[11]); CE_(a[4], a[12]); CE_(a[5], a[13]); CE_(a[6], a[14]); CE_(a[7], a[15]); CE_(a[0], a[4]); CE_(a[1], a[5]); CE_(a[2], a[6]); CE_(a[3], a[7]); CE_(a[8], a[12]); CE_(a[9], a[13]); CE_(a[10], a[14]); CE_(a[11], a[15]); CE_(a[0], a[2]); CE_(a[1], a[3]); CE_(a[4], a[6]); CE_(a[5], a[7]); CE_(a[8], a[10]); CE_(a[9], a[11]); CE_(a[12], a[14]); CE_(a[13], a[15]); CE_(a[0], a[1]); CE_(a[2], a[3]); CE_(a[4], a[5]); CE_(a[6], a[7]); CE_(a[8], a[9]); CE_(a[10], a[11]); CE_(a[12], a[13]); CE_(a[14], a[15]);
}

__device__ __forceinline__ void convert_experts(const Params& p, size_t gtid, size_t nthr) {
    cvt_flat_fp8(p.expert_u, p.ws + WS_EU, (size_t)16384 * 1024 / 16, ESCALE, gtid, nthr);
    cvt_flat_fp8(p.expert_v, p.ws + WS_EV, (size_t)16384 * 1024 / 16, ESCALE, gtid, nthr);
}
__device__ __forceinline__ void phase_topk(const Params& p, LAS unsigned char* lds, int G, int bid, int wave, int lane) {
    const bf16* QP = (const bf16*)(p.ws + WS_BIG + B_QP); const bf16* SK = (const bf16*)(p.ws + WS_SUBK);
    int* SEL = (int*)(p.ws + WS_BIG + B_SEL); float* GATE = (float*)(p.ws + WS_BIG + B_GATE);
    const int gw = bid * NWAVES + wave, NGW = G * NWAVES, l31 = lane & 31, half = lane >> 5;
    LAS int* tab = (LAS int*)(lds + wave * 12288) + l31 * 32;
    LAS unsigned char* qst = lds + wave * 12288 + 4096 + lane * 16;
    LAS unsigned char* skl = lds + 8 * 12288;
    const float* ctab = (wave < 4) ? p.expert_u : p.expert_v; unsigned char* cdst = p.ws + ((wave < 4) ? WS_EU : WS_EV);
    const int tid_ = wave * 64 + lane;
    for (int sbk = bid; sbk < 256; sbk += G)
    for (int rnd = 0; rnd < 2; ++rnd) {
        const int tg = 8 * (sbk >> 2) + wave, h = 2 * (sbk & 3) + rnd, t = tg * 32 + l31;
        unsigned lists[2][16];
#pragma unroll
        for (int m = 0; m < 2; ++m) {
            f32x16 acc[4];
#pragma unroll
            for (int kb = 0; kb < 4; ++kb)
#pragma unroll
                for (int r = 0; r < 16; ++r) acc[kb][r] = 0.f;
            const bf16* qp = QP + (size_t)t * 2048 + h * 256 + m * 128 + 8 * half;
            { const bf16* sks = SK + (size_t)(h * 2 + m) * 128 * 128;
#pragma unroll
              for (int jj = 0; jj < 4; ++jj) { const int c = tid_ + 512 * jj, row = c >> 4, ch = c & 15;
                  *(LAS u32x4*)(skl + row * 272 + ch * 16) = *(const u32x4*)(sks + row * 128 + ch * 8); } }
            __syncthreads();
            const size_t cbase = ((size_t)(sbk * 4 + (wave & 3)) * 1024 + (size_t)(rnd * 2 + m) * 256 + lane) * 16;
#define CAST_SLICE() do { _Pragma("unroll") for (int j = 0; j < 4; ++j) { const size_t o_ = cbase + (size_t)j * 64 * 16; u32x4 w_; \
                _Pragma("unroll") for (int q = 0; q < 4; ++q) { const f32x4 a_ = *(const f32x4*)(ctab + o_ + 4 * q) * ESCALE; int x_ = 0; \
                    x_ = __builtin_amdgcn_cvt_pk_fp8_f32(a_[0], a_[1], x_, false); x_ = __builtin_amdgcn_cvt_pk_fp8_f32(a_[2], a_[3], x_, true); w_[q] = (unsigned)x_; } \
                *(u32x4*)(cdst + o_) = w_; } } while (0)
            if (wave < 4) CAST_SLICE();
            const LAS unsigned char* kl = skl + l31 * 272 + half * 16;
            { u32x4 tq[8];
#pragma unroll
              for (int s = 0; s < 8; ++s) tq[s] = *(const u32x4*)(qp + 16 * s);
#pragma unroll
              for (int s = 0; s < 8; ++s) *(LAS u32x4*)(qst + s * 1024) = tq[s]; }
#pragma unroll 2
            for (int s = 0; s < 8; ++s) {
                const bf16x8 bq = *(const LAS bf16x8*)(qst + s * 1024);
#pragma unroll
                for (int kb = 0; kb < 4; ++kb) { const bf16x8 ak = *(const LAS bf16x8*)(kl + kb * 32 * 272 + s * 32); acc[kb] = __builtin_amdgcn_mfma_f32_32x32x16_bf16(ak, bq, acc[kb], 0, 0, 0); }
            }
            unsigned top[16], oth[16];
#pragma unroll
            for (int kb = 0; kb < 4; ++kb) {
#pragma unroll
                for (int r = 0; r < 16; ++r) { const int kidx = 32 * kb + (r & 3) + 8 * (r >> 2) + 4 * half; oth[r] = (mono(acc[kb][r]) & ~127u) | (unsigned)(127 - kidx); }
                sort16(oth);
                if (kb == 0) {
#pragma unroll
                    for (int i = 0; i < 16; ++i) top[i] = oth[i];
                } else merge16(top, oth);
            }
#pragma unroll
            for (int i = 0; i < 16; ++i) oth[i] = (unsigned)__shfl_xor((int)top[i], 32);
            merge16(top, oth);
#pragma unroll
            for (int i = 0; i < 16; ++i) lists[m][i] = top[i];
            if (wave >= 4) CAST_SLICE();
#undef CAST_SLICE
            __syncthreads();
        }
        float va[16], vb[16];
#pragma unroll
        for (int i = 0; i < 16; ++i) { va[i] = unmono(lists[0][i] & ~127u); vb[i] = unmono(lists[1][i] & ~127u);
            tab[i] = 127 - (int)(lists[0][i] & 127u); tab[16 + i] = 127 - (int)(lists[1][i] & 127u); }
#define CKEY(i, j) ((mono(va[i] + vb[j]) & ~255u) | (unsigned)(255 - ((i) * 16 + (j))))
        unsigned ct[16], l1[16], l2[16], l3[16];
#pragma unroll
        for (int j = 0; j < 16; ++j) ct[j] = CKEY(0, j);
#pragma unroll
        for (int j = 0; j < 8; ++j) l1[j] = CKEY(1, j);
#pragma unroll
        for (int j = 0; j < 5; ++j) l1[8 + j] = CKEY(2, j);
        l1[13] = 0u; l1[14] = 0u; l1[15] = 0u;
#pragma unroll
        for (int j = 0; j < 4; ++j) l2[j] = CKEY(3, j);
#pragma unroll
        for (int j = 0; j < 3; ++j) l2[4 + j] = CKEY(4, j);
#pragma unroll
        for (int j = 0; j < 2; ++j) { l2[7 + j] = CKEY(5, j); l2[9 + j] = CKEY(6, j); l2[11 + j] = CKEY(7, j); }
        l2[13] = 0u; l2[14] = 0u; l2[15] = 0u;
#pragma unroll
        for (int i = 0; i < 8; ++i) { l3[i] = CKEY(8 + i, 0); l3[8 + i] = 0u; }
#undef CKEY
        sort16(l1); sort16(l2); sort16(l3);
        merge16(ct, l1); merge16(l2, l3); merge16(ct, l2);
        LDS_WAIT(); __builtin_amdgcn_wave_barrier();
        const float s0 = unmono(ct[0] & ~255u);
        float ev[16], es = 0.f; int ex[16];
#pragma unroll
        for (int r = 0; r < 16; ++r) { const int pos = 255 - (int)(ct[r] & 255u); ev[r] = __expf(unmono(ct[r] & ~255u) - s0); es += ev[r];
            ex[r] = tab[pos >> 4] * 128 + tab[16 + (pos & 15)]; }
        const float ie = 1.f / es;
        int* so = SEL + (size_t)t * 128 + h * 16; float* go = GATE + (size_t)t * 128 + h * 16;
        if (half == 0) {
#pragma unroll
            for (int r = 0; r < 8; ++r) { so[r] = ex[r]; go[r] = ev[r] * ie; }
        } else {
#pragma unroll
            for (int r = 8; r < 16; ++r) { so[r] = ex[r]; go[r] = ev[r] * ie; }
        }
        LDS_WAIT(); __builtin_amdgcn_wave_barrier();
    }
}

__device__ __forceinline__ float gelu_as(float v) {
    const float av = fabsf(v), t = __builtin_amdgcn_rcpf(av * 0.2316418882f + 1.0f);
    float q = t * 0.5307027145f + (-0.7265760135f); q = q * t + 0.7107068705f; q = q * t + (-0.142248368f); q = q * t + 0.127414796f; q = q * t;
    const float e = __builtin_amdgcn_exp2f((v * v) * (-0.72134752044f)), m = v * (q * e);
    return v < 0.f ? m : v - m;
}
constexpr int KT = 4;
constexpr int GW_LDS = 17152;
constexpr int UPITCH = 272, USTG = 16 * UPITCH;
static_assert(KT == 4, "LDS map of the gather phase is laid out for 4 tokens per wave");
__device__ __forceinline__ void phase_gather(const Params& p, LAS unsigned char* lds, int G, int bid, int wave, int lane) {
    const int* SEL = (const int*)(p.ws + WS_BIG + B_SEL); const float* GATE = (const float*)(p.ws + WS_BIG + B_GATE);
    const unsigned char* EU = p.ws + WS_EU; const unsigned char* EV = p.ws + WS_EV;
    float* H2 = p.out;
    const int gw = bid * NWAVES + wave, NGW = G * NWAVES, l15 = lane & 15, g4 = lane >> 4;
    LAS unsigned char* wl = lds + wave * GW_LDS;
    LAS unsigned char* xnb = wl; LAS int* selb = (LAS int*)(wl + 4096); LAS float* gateb = (LAS float*)(wl + 6144); LAS float* hb = (LAS float*)(wl + 8192); LAS unsigned char* ustg = wl + 8448;
    for (int tb = gw * KT; tb < T; tb += NGW * KT) {
#pragma unroll 1
        for (int k = 0; k < KT; ++k) {
            const int t = tb + k;
            const float* hrow = H2 + (size_t)t * DM + 16 * lane;
            f32x4 hv[4];
#pragma unroll
            for (int j = 0; j < 4; ++j) hv[j] = *(const f32x4*)(hrow + 4 * j);
            const int selA = SEL[(size_t)t * 128 + lane], selB = SEL[(size_t)t * 128 + 64 + lane];
            const float gtA = GATE[(size_t)t * 128 + lane], gtB = GATE[(size_t)t * 128 + 64 + lane];
            float ssq = 0.f;
#pragma unroll
            for (int j = 0; j < 4; ++j) ssq += (hv[j][0] * hv[j][0] + hv[j][1] * hv[j][1]) + (hv[j][2] * hv[j][2] + hv[j][3] * hv[j][3]);
            const float r2 = rsqrtf(wave_sum(ssq) * (1.f / DM) + EPS);
            { u32x4 o;
#pragma unroll
              for (int j = 0; j < 4; ++j) { const f32x4 a = hv[j] * r2 * *(const f32x4*)(p.norm2_g + 16 * lane + 4 * j); int w = 0;
                  w = __builtin_amdgcn_cvt_pk_fp8_f32(a[0], a[1], w, false); w = __builtin_amdgcn_cvt_pk_fp8_f32(a[2], a[3], w, true); o[j] = (unsigned)w; }
              *(LAS u32x4*)(xnb + k * 1024 + 16 * lane) = o; }
            const int bA = selA >> 10, bB = selB >> 10; int posA = 0, posB = 0, off = 0;
#pragma unroll
            for (int b = 0; b < 16; ++b) {
                const unsigned long long mA = __ballot(bA == b), mB = __ballot(bB == b);
                const int cA = __popcll(mA), cB = __popcll(mB);
                const int rA = (int)__builtin_amdgcn_mbcnt_hi((unsigned)(mA >> 32), __builtin_amdgcn_mbcnt_lo((unsigned)mA, 0u));
                const int rB = (int)__builtin_amdgcn_mbcnt_hi((unsigned)(mB >> 32), __builtin_amdgcn_mbcnt_lo((unsigned)mB, 0u));
                if (bA == b) posA = off + rA;
                if (bB == b) posB = off + cA + rB;
                off += cA + cB;
            }
            selb[k * 128 + posA] = selA; gateb[k * 128 + posA] = gtA; selb[k * 128 + posB] = selB; gateb[k * 128 + posB] = gtB;
        }
        LDS_WAIT(); __builtin_amdgcn_wave_barrier();
        f32x2_t y[KT][8];
#pragma unroll
        for (int k = 0; k < KT; ++k)
#pragma unroll
            for (int i = 0; i < 8; ++i) y[k][i] = (f32x2_t){0.f, 0.f};
#pragma unroll 1
        for (int g = 0; g < 8; ++g) {
#pragma unroll
            for (int k = 0; k < KT; ++k) {
                asm volatile("" ::: "memory");
                f32x4 acc = (f32x4){0.f, 0.f, 0.f, 0.f};
                const int rr = lane >> 4, cc = lane & 15;
                const unsigned char* rp[4];
#pragma unroll
                for (int i = 0; i < 4; ++i) rp[i] = EU + (size_t)selb[k * 128 + 16 * g + 4 * i + rr] * DM + 16 * cc;
                u32x4 ld[4];
#pragma unroll
                for (int i = 0; i < 4; ++i) ld[i] = *(const u32x4*)(rp[i]);
#pragma unroll
                for (int qd = 0; qd < 4; ++qd) {
                    LAS unsigned char* sb = ustg + (qd & 1) * USTG;
#pragma unroll
                    for (int i = 0; i < 4; ++i) *(LAS u32x4*)(sb + (4 * i + rr) * UPITCH + 16 * cc) = ld[i];
                    if (qd < 3) {
#pragma unroll
                        for (int i = 0; i < 4; ++i) ld[i] = *(const u32x4*)(rp[i] + 256 * (qd + 1));
                    }
                    LDS_WAIT(); __builtin_amdgcn_wave_barrier();
                    const LAS unsigned char* ar = sb + l15 * UPITCH + 64 * g4;
                    const LAS unsigned char* xk = xnb + k * 1024 + 256 * qd + 64 * g4;
#pragma unroll
                    for (int i = 0; i < 4; ++i) { const u32x4 a = *(const LAS u32x4*)(ar + 16 * i); const u32x4 bx = *(const LAS u32x4*)(xk + 16 * i);
                        const long a0 = (long)(((unsigned long long)a.y << 32) | a.x), a1 = (long)(((unsigned long long)a.w << 32) | a.z);
                        const long b0 = (long)(((unsigned long long)bx.y << 32) | bx.x), b1 = (long)(((unsigned long long)bx.w << 32) | bx.z);
                        acc = __builtin_amdgcn_mfma_f32_16x16x32_fp8_fp8(a0, b0, acc, 0, 0, 0);
                        acc = __builtin_amdgcn_mfma_f32_16x16x32_fp8_fp8(a1, b1, acc, 0, 0, 0); }
                }
                if (l15 == 0) {
#pragma unroll
                    for (int j = 0; j < 4; ++j) { const float a = acc[j] * (1.f / ESCALE);
                        hb[k * 16 + 4 * g4 + j] = gelu_as(a) * gateb[k * 128 + 16 * g + 4 * g4 + j] * (1.f / ESCALE); }
                }
            }
            LDS_WAIT(); __builtin_amdgcn_wave_barrier();
#pragma unroll
            for (int k = 0; k < KT; ++k) {
                asm volatile("" ::: "memory");
                u32x4 vr[2][4];
#pragma unroll
                for (int i = 0; i < 4; ++i) vr[0][i] = *(const u32x4*)(EV + (size_t)selb[k * 128 + 16 * g + i] * DM + 16 * lane);
#pragma unroll
                for (int bt = 0; bt < 4; ++bt) {
                    if (bt < 3) {
#pragma unroll
                        for (int i = 0; i < 4; ++i) vr[(bt + 1) & 1][i] = *(const u32x4*)(EV + (size_t)selb[k * 128 + 16 * g + 4 * (bt + 1) + i] * DM + 16 * lane);
                    }
                    asm volatile("" ::: "memory");
#pragma unroll
                    for (int i = 0; i < 4; ++i) { const float hs = hb[k * 16 + 4 * bt + i]; const u32x4 v = vr[bt & 1][i];
#pragma unroll
                        for (int q = 0; q < 4; ++q) { const f32x2_t lo = __builtin_amdgcn_cvt_pk_f32_fp8((int)v[q], false), hi = __builtin_amdgcn_cvt_pk_f32_fp8((int)v[q], true);
                            y[k][2 * q] += lo * hs; y[k][2 * q + 1] += hi * hs; } }
                }
            }
            LDS_WAIT(); __builtin_amdgcn_wave_barrier();
        }
#pragma unroll
        for (int k = 0; k < KT; ++k) {
            float* hrow = H2 + (size_t)(tb + k) * DM + 16 * lane;
            f32x4 h3[4]; float s3 = 0.f;
#pragma unroll
            for (int j = 0; j < 4; ++j) { const f32x4 hv = *(const f32x4*)(hrow + 4 * j);
                h3[j][0] = hv[0] + y[k][2 * j][0]; h3[j][1] = hv[1] + y[k][2 * j][1]; h3[j][2] = hv[2] + y[k][2 * j + 1][0]; h3[j][3] = hv[3] + y[k][2 * j + 1][1];
                s3 += (h3[j][0] * h3[j][0] + h3[j][1] * h3[j][1]) + (h3[j][2] * h3[j][2] + h3[j][3] * h3[j][3]); }
            const float r3 = rsqrtf(wave_sum(s3) * (1.f / DM) + EPS);
#pragma unroll
            for (int j = 0; j < 4; ++j) *(f32x4*)(hrow + 4 * j) = h3[j] * r3 * *(const f32x4*)(p.final_g + 16 * lane + 4 * j);
        }
        LDS_WAIT(); __builtin_amdgcn_wave_barrier();
    }
}

#define XB_TMO      128
#define XB_XCNT(j)  (256  + 64 * (j))
#define XB_XSUB(j)  (1280 + 64 * (j))
#define XB_XGEN(j)  (2304 + 64 * (j))
#define XB_TOP      3328
#define XB_TOPGEN   3392
#define XCD_BAR_WORDS 3456
#define XB_SPIN_CAP (1u << 18)

__device__ __forceinline__ unsigned xb_ld(unsigned* p)              { return __hip_atomic_load(p, __ATOMIC_RELAXED, __HIP_MEMORY_SCOPE_AGENT); }
__device__ __forceinline__ unsigned xb_add(unsigned* p, unsigned v) { return __hip_atomic_fetch_add(p, v, __ATOMIC_RELAXED, __HIP_MEMORY_SCOPE_AGENT); }
__device__ __forceinline__ unsigned xb_xcc_id() { return (unsigned)__builtin_amdgcn_s_getreg((3 << 11) | 20) & 0xFu; }
#define XB_SPIN(cond, bar) do { unsigned _sp = 0; while (cond) { __builtin_amdgcn_s_sleep(1); \
    if ((++_sp & 255u) == 0u) { if (xb_ld(&(bar)[XB_TMO])) break; if (_sp > XB_SPIN_CAP) { atomicAdd(&(bar)[XB_TMO], 1u); break; } } } } while (0)

struct XcdBarrier {
    unsigned* bar; unsigned x;
    volatile LAS unsigned* st;
};

__device__ __forceinline__ XcdBarrier xcd_barrier_post(unsigned* bar, volatile LAS unsigned* st) {
    XcdBarrier b; b.bar = bar; b.x = xb_xcc_id(); b.st = st;
    if (threadIdx.x == 0) (void)xb_add(&bar[XB_XCNT(b.x)], 1u);
    return b;
}
__device__ __forceinline__ void xcd_barrier_complete(unsigned* bar, unsigned x, unsigned& nloc, unsigned& nx) {
    const unsigned G = gridDim.x * gridDim.y * gridDim.z;
    unsigned sum, cnt, mine, sp = 0u;
    for (;;) {
        sum = 0u; cnt = 0u; mine = 0u;
#pragma unroll
        for (unsigned j = 0; j < 16; ++j) { const unsigned c = xb_ld(&bar[XB_XCNT(j)]); sum += c; cnt += (c > 0u) ? 1u : 0u; mine = (j == x) ? c : mine; }
        if (sum == G) break;
        __builtin_amdgcn_s_sleep(1);
        if ((++sp & 255u) == 0u) { if (xb_ld(&bar[XB_TMO])) break; if (sp > XB_SPIN_CAP) { atomicAdd(&bar[XB_TMO], 1u); break; } }
    }
    nloc = mine > 0u ? mine : 1u; nx = cnt > 0u ? cnt : 1u;
}

__device__ __forceinline__ void xcd_barrier(const XcdBarrier& b) {
    asm volatile("s_waitcnt vmcnt(0)" ::: "memory");
    __syncthreads();
    if (threadIdx.x == 0) {
        unsigned* bar = b.bar;
        __builtin_amdgcn_s_waitcnt(0);
        unsigned nloc = b.st[0], nx = b.st[1];
        if (nloc == 0u) { xcd_barrier_complete(bar, b.x, nloc, nx); b.st[0] = nloc; b.st[1] = nx; }
        const unsigned old = xb_add(&bar[XB_XSUB(b.x)], 1u);
        const unsigned gen = old / nloc;
        if (old + 1u == (gen + 1u) * nloc) {
            __builtin_amdgcn_fence(__ATOMIC_RELEASE, "agent");
            asm volatile("s_waitcnt vmcnt(0)" ::: "memory");
            const unsigned og = xb_add(&bar[XB_TOP], 1u);
            const unsigned tg = og / nx;
            if (og + 1u == (tg + 1u) * nx) xb_add(&bar[XB_TOPGEN], 1u);
            else XB_SPIN(xb_ld(&bar[XB_TOPGEN]) == tg, bar);
            __builtin_amdgcn_fence(__ATOMIC_ACQUIRE, "agent");
            xb_add(&bar[XB_XGEN(b.x)], 1u);
            asm volatile("s_waitcnt vmcnt(0)" ::: "memory");
        } else {
            XB_SPIN(xb_ld(&bar[XB_XGEN(b.x)]) == gen, bar);
            __builtin_amdgcn_fence(__ATOMIC_ACQUIRE, "agent");
            asm volatile("s_waitcnt vmcnt(0)" ::: "memory");
        }
    }
    __syncthreads();
}

#ifndef ONE_LAUNCH
#define ONE_LAUNCH 1
#endif
constexpr int NPHASE = 8;
__global__ void __launch_bounds__(NTHR, 2) hybrid_fwd(Params p) {
    extern __shared__ __attribute__((aligned(16))) unsigned char lds_raw[];
    LAS unsigned char* lds = (LAS unsigned char*)lds_raw;
    const int tid = threadIdx.x, lane = tid & 63, wave = __builtin_amdgcn_readfirstlane(tid >> 6), G = gridDim.x, bid = blockIdx.x;
    unsigned char* ws = p.ws;
    volatile LAS unsigned* xst = (volatile LAS unsigned*)(lds + 139264);
    if (tid < 2) xst[tid] = 0u;
    __syncthreads();
    XcdBarrier xbar; xbar.bar = (unsigned*)(ws + WS_END); xbar.x = 0; xbar.st = xst;
    if (ONE_LAUNCH && p.hi - p.lo > 1) {
        if (bid == 0) { for (int i = tid; i < XCD_BAR_WORDS; i += NTHR) __hip_atomic_store((unsigned*)(ws + WS_END) + i, 0u, __ATOMIC_RELAXED, __HIP_MEMORY_SCOPE_AGENT); }
        cg::this_grid().sync();
        xbar = xcd_barrier_post((unsigned*)(ws + WS_END), xst);
    }
    const pg8::bf16_t* N1 = (const pg8::bf16_t*)p.out;
#ifdef ONLY
#define PH(k) if ((k) == ONLY && p.lo <= (k) && (k) < p.hi)
#else
#define PH(k) if (p.lo <= (k) && (k) < p.hi)
#endif
#define SEAM(k) do { if (ONE_LAUNCH && p.lo <= (k) && (k) + 1 < p.hi) { xcd_barrier(xbar); } } while (0)
#define FRESH_IDS int tid = threadIdx.x; asm volatile("" : "+v"(tid)); const int lane = tid & 63, wave = __builtin_amdgcn_readfirstlane(tid >> 6); (void)lane; (void)wave
    unsigned char* big = ws + WS_BIG;
    PH(0) { FRESH_IDS; phase0(p, lds, G, bid, wave, lane); SEAM(0); }
    PH(1) { FRESH_IDS; pg8::Gemm g{N1, (const pg8::bf16_t*)(ws + WS_WIN), T, 8192, 1024, 2048, 1024}; pg8::StaticOrder S; S.init(T, 8192, G, bid);
        pg8::EpiG1 E{(pg8::bf16_t*)(big + B_QKV), (pg8::bf16_t*)(big + B_GG), (pg8::bf16_t*)p.out + 1024, (pg8::bf16_t*)(big + B_PR), C2};
        pg8::gemm_phase<pg8::EpiG1, pg8::StaticOrder, true, true>(lds, g, S, E); SEAM(1); }
    PH(2) { FRESH_IDS; phase_attn(p, lds, G, bid, tid); phase_conv(p, G, bid, tid); SEAM(2); }
    PH(3) { FRESH_IDS; pg8::Gemm g{(const pg8::bf16_t*)p.out, (const pg8::bf16_t*)(ws + WS_WAC), T, 1024, 1024, 2048, 2048}; pg8::SplitKOrder S; S.base.init(T, 1024, G, bid);
        pg8::EpiMerged E{(const pg8::bf16_t*)(big + B_GG), (pg8::bf16_t*)(big + B_MG)};
        pg8::gemm_phase<pg8::EpiMerged, pg8::SplitKOrder, false, true>(lds, g, S, E); SEAM(3); }
    PH(4) { FRESH_IDS; pg8::Gemm g{(const pg8::bf16_t*)(big + B_MG), (const pg8::bf16_t*)(ws + WS_WOUT), T, 1024, 1024, 1024, 1024}; pg8::StaticOrder S; S.init(T, 1024, G, bid);
        pg8::EpiResid E{p.x, p.out, (pg8::bf16_t*)(big + B_H2B), (float*)(ws + WS_SSQ)};
        pg8::gemm_phase<pg8::EpiResid, pg8::StaticOrder, false, true>(lds, g, S, E); SEAM(4); }
    PH(5) { FRESH_IDS; pg8::Gemm g{(const pg8::bf16_t*)(big + B_H2B), (const pg8::bf16_t*)(ws + WS_WQ), T, 2048, 1024, 1024, 1024}; pg8::StaticOrder S; S.init(T, 2048, G, bid);
        pg8::EpiRowScale E{(const float*)(ws + WS_SSQ), (pg8::bf16_t*)(big + B_QP)};
        pg8::gemm_phase<pg8::EpiRowScale, pg8::StaticOrder, true, true>(lds, g, S, E); SEAM(5); }
    PH(6) { FRESH_IDS; phase_topk(p, lds, G, bid, wave, lane); SEAM(6); }
    PH(7) { FRESH_IDS; phase_gather(p, lds, G, bid, wave, lane); }
#undef PH
#undef SEAM
}

extern "C" void kernel_launch(void* const* d_in, const int* in_sizes, int n_in, void* d_out, int out_size, void* d_ws, size_t ws_size, hipStream_t stream) {
    static int grid = 0;
    if (grid == 0) {
        if (n_in != 15 || out_size != T * DM || ws_size < WS_END) { fprintf(stderr, "kernel_launch: unexpected problem (n_in %d out %d ws %zu)\n", n_in, out_size, ws_size); grid = -1; return; }
        int dev = 0, cus = 0, per_cu = 0;
        hipGetDevice(&dev); hipDeviceGetAttribute(&cus, hipDeviceAttributeMultiprocessorCount, dev);
        if (hipFuncSetAttribute((const void*)hybrid_fwd, hipFuncAttributeMaxDynamicSharedMemorySize, LDS_BYTES) != hipSuccess) { fprintf(stderr, "kernel_launch: hipFuncSetAttribute failed\n"); grid = -1; return; }
        if (hipOccupancyMaxActiveBlocksPerMultiprocessor(&per_cu, (const void*)hybrid_fwd, NTHR, LDS_BYTES) != hipSuccess || per_cu < 1) { fprintf(stderr, "kernel_launch: occupancy query says %d\n", per_cu); per_cu = 1; }
        (void)hipGetLastError();
        grid = cus * per_cu;
    }
    if (grid < 0) return;
    Params p{};
    p.x = (const float*)d_in[0]; p.norm1_g = (const float*)d_in[1]; p.w_in = (const float*)d_in[2]; p.lambda_qk = (const float*)d_in[3]; p.subln_g = (const float*)d_in[4];
    p.conv_w = (const float*)d_in[5]; p.w_attn_o = (const float*)d_in[6]; p.w_conv_o = (const float*)d_in[7]; p.w_out = (const float*)d_in[8]; p.norm2_g = (const float*)d_in[9];
    p.w_query = (const float*)d_in[10]; p.sub_keys = (const float*)d_in[11]; p.expert_u = (const float*)d_in[12]; p.expert_v = (const float*)d_in[13]; p.final_g = (const float*)d_in[14];
    p.out = (float*)d_out; p.ws = (unsigned char*)d_ws;
#if ONE_LAUNCH
    p.lo = 0; p.hi = NPHASE;
    void* args[] = {&p};
    hipError_t e = hipLaunchCooperativeKernel((const void*)hybrid_fwd, dim3(grid), dim3(NTHR), args, LDS_BYTES, stream);
    if (e != hipSuccess) fprintf(stderr, "cooperative launch failed: %s (grid %d)\n", hipGetErrorString(e), grid);
#else
    for (int k = 0; k < NPHASE; ++k) {
        p.lo = k; p.hi = k + 1; hipLaunchKernelGGL(hybrid_fwd, dim3(grid), dim3(NTHR), LDS_BYTES, stream, p); }
#endif
}
```

```cpp
#include <hip/hip_runtime.h>
#include <hip/hip_cooperative_groups.h>
#include <cstdio>
#include <cstdint>
namespace cg = cooperative_groups;
namespace pg8 {
#define PG8_LAS __attribute__((address_space(3)))
typedef unsigned short bf16_t;
typedef short bf16x8 __attribute__((ext_vector_type(8)));
typedef float f32x4 __attribute__((ext_vector_type(4)));
typedef unsigned u32x4 __attribute__((ext_vector_type(4)));
constexpr int BM = 256, BK = 64, HALF = 128, HTB = HALF * BK * 2  , STAGE_BYTES = 8 * HTB, NXCD = 8, WGM = 8;

__host__ __device__ __forceinline__ int lds_byte(int r, int c) { const int st = (r >> 4) * 2 + (c >> 5), rr = r & 15, cc = c & 31, ob = rr * 64 + cc * 2; return st * 1024 + (ob ^ (((ob >> 9) & 1) << 5)); }
__host__ __device__ __forceinline__ void stage_rc(int b, int& R, int& C) { const int st = b / 1024, sb = b % 1024, swz = sb ^ (((sb >> 9) & 1) << 5); R = (st >> 1) * 16 + swz / 64; C = (st & 1) * 32 + (swz % 64) / 2; }
__host__ __device__ __forceinline__ int perm32(int rho) { const int n = rho >> 4, i = rho & 15; return 8 * (i >> 2) + 4 * n + (i & 3); }

struct Unit { int pm, pn, kh; };
struct Gemm { const bf16_t* A; const bf16_t* Bt; int M, N, K, lda, ldb; };
struct StaticOrder {
    int nM, nN, nwg, G, c;
    __host__ __device__ void init(int M, int N, int G_, int c_) { nM = M / BM; nN = N / BM; nwg = nM * nN; G = G_; c = c_; }
    __host__ __device__ bool next(int i, Unit& u) const {
        const long L = (long)i * G + c; if (L >= nwg) return false;
        int wgid = (int)L; { const int q = nwg / NXCD, r = nwg % NXCD, xcd = wgid % NXCD, off = wgid / NXCD; wgid = (xcd < r ? xcd * (q + 1) : r * (q + 1) + (xcd - r) * q) + off; }
        const int nig = WGM * nN, gid = wgid / nig, fm = gid * WGM, gsz = (nM - fm) < WGM ? (nM - fm) : WGM;
        u.pm = fm + ((wgid % nig) % gsz); u.pn = (wgid % nig) / gsz; u.kh = 0; return true;
    }
    __device__ __forceinline__ void a_ready(const Unit&) const {}
    __device__ __forceinline__ void done(const Unit&) const {}
};
struct SplitKOrder {
    StaticOrder base;
    __host__ __device__ bool next(int i, Unit& u) const { if (!base.next(i >> 1, u)) return false; u.kh = i & 1; return true; }
    __device__ __forceinline__ void a_ready(const Unit&) const {}
    __device__ __forceinline__ void done(const Unit&) const {}
};
__device__ __forceinline__ unsigned cvt_pk_bf16(float lo, float hi) { unsigned r; asm volatile("v_cvt_pk_bf16_f32 %0, %1, %2" : "=v"(r) : "v"(lo), "v"(hi)); return r; }
typedef float f32x2 __attribute__((ext_vector_type(2)));
typedef float f32x2 __attribute__((ext_vector_type(2)));
typedef unsigned u32x2 __attribute__((ext_vector_type(2)));
__device__ __forceinline__ void unpack8(const u32x4 w, float (&f)[8]) {
    f[0] = __builtin_bit_cast(float, w.x << 16); f[1] = __builtin_bit_cast(float, w.x & 0xffff0000u);
    f[2] = __builtin_bit_cast(float, w.y << 16); f[3] = __builtin_bit_cast(float, w.y & 0xffff0000u);
    f[4] = __builtin_bit_cast(float, w.z << 16); f[5] = __builtin_bit_cast(float, w.z & 0xffff0000u);
    f[6] = __builtin_bit_cast(float, w.w << 16); f[7] = __builtin_bit_cast(float, w.w & 0xffff0000u);
}
__device__ __forceinline__ u32x4 pack8(const f32x4 v0, const f32x4 v1) { u32x4 w; w.x = cvt_pk_bf16(v0[0], v0[1]); w.y = cvt_pk_bf16(v0[2], v0[3]); w.z = cvt_pk_bf16(v1[0], v1[1]); w.w = cvt_pk_bf16(v1[2], v1[3]); return w; }
struct EpiPlain {
    static constexpr bool PERM = true, AFTER_DRAIN = false, MID = false;
    bf16_t* O; int ldc;
    __device__ __forceinline__ void operator()(const f32x4 (&acc)[2][2][4][2], const Unit& u, int wr, int wc, int fr, int fq) const {
        const int row0 = u.pm * BM + wr * 64 + fr, col0 = u.pn * BM + wc * 32 + 8 * fq;
#pragma unroll
        for (int ai = 0; ai < 2; ++ai)
#pragma unroll
            for (int m = 0; m < 4; ++m) { bf16_t* rowp = O + (size_t)(row0 + ai * HALF + m * 16) * ldc + col0;
#pragma unroll
                for (int bj = 0; bj < 2; ++bj) *(u32x4*)(rowp + bj * HALF) = pack8(acc[ai][bj][m][0], acc[ai][bj][m][1]); }
    }
};
struct EpiQKVG {
    static constexpr bool PERM = true, AFTER_DRAIN = false, MID = false;
    bf16_t* QKV; bf16_t* GG; float c2;
    __device__ __forceinline__ void operator()(const f32x4 (&acc)[2][2][4][2], const Unit& u, int wr, int wc, int fr, int fq) const {
        int colt = u.pn * BM; bf16_t* base = QKV; int ldc = 3072; float sc = 1.f; bool sig = false;
        if (colt < 1024) sc = c2; else if (colt >= 3072) { base = GG; ldc = 2048; colt -= 3072; sig = true; }
        const int row0 = u.pm * BM + wr * 64 + fr, col0 = colt + wc * 32 + 8 * fq;
#pragma unroll
        for (int ai = 0; ai < 2; ++ai)
#pragma unroll
            for (int m = 0; m < 4; ++m) { bf16_t* rowp = base + (size_t)(row0 + ai * HALF + m * 16) * ldc + col0;
#pragma unroll
                for (int bj = 0; bj < 2; ++bj) { f32x4 v0 = acc[ai][bj][m][0], v1 = acc[ai][bj][m][1];
                    if (sig) {
#pragma unroll
                        for (int i = 0; i < 4; ++i) { v0[i] = __builtin_amdgcn_rcpf(1.f + __expf(-v0[i])); v1[i] = __builtin_amdgcn_rcpf(1.f + __expf(-v1[i])); }
                    } else { v0 = v0 * sc; v1 = v1 * sc; }
                    *(u32x4*)(rowp + bj * HALF) = pack8(v0, v1); } }
    }
};
struct EpiGateA {
    static constexpr bool PERM = true, AFTER_DRAIN = false, MID = false;
    const bf16_t* GG; float* TMP;
    __device__ __forceinline__ void operator()(const f32x4 (&acc)[2][2][4][2], const Unit& u, int wr, int wc, int fr, int fq) const {
        const int row0 = u.pm * BM + wr * 64 + fr, col0 = u.pn * BM + wc * 32 + 8 * fq;
#pragma unroll
        for (int ai = 0; ai < 2; ++ai)
#pragma unroll
            for (int m = 0; m < 4; ++m) { const size_t row = (size_t)(row0 + ai * HALF + m * 16);
#pragma unroll
                for (int bj = 0; bj < 2; ++bj) { const int col = col0 + bj * HALF; float g[8]; unpack8(*(const u32x4*)(GG + row * 2048 + col), g);
                    f32x4 v0 = acc[ai][bj][m][0], v1 = acc[ai][bj][m][1];
                    v0[0] *= g[0]; v0[1] *= g[1]; v0[2] *= g[2]; v0[3] *= g[3]; v1[0] *= g[4]; v1[1] *= g[5]; v1[2] *= g[6]; v1[3] *= g[7];
                    *(f32x4*)(TMP + row * 1024 + col) = v0; *(f32x4*)(TMP + row * 1024 + col + 4) = v1; } }
    }
};
struct EpiGateC {
    static constexpr bool PERM = true, AFTER_DRAIN = false, MID = false;
    const bf16_t* GG; const float* TMP; bf16_t* MG;
    __device__ __forceinline__ void operator()(const f32x4 (&acc)[2][2][4][2], const Unit& u, int wr, int wc, int fr, int fq) const {
        const int row0 = u.pm * BM + wr * 64 + fr, col0 = u.pn * BM + wc * 32 + 8 * fq;
#pragma unroll
        for (int ai = 0; ai < 2; ++ai)
#pragma unroll
            for (int m = 0; m < 4; ++m) { const size_t row = (size_t)(row0 + ai * HALF + m * 16);
#pragma unroll
                for (int bj = 0; bj < 2; ++bj) { const int col = col0 + bj * HALF; float g[8]; unpack8(*(const u32x4*)(GG + row * 2048 + 1024 + col), g);
                    const f32x4 t0 = *(const f32x4*)(TMP + row * 1024 + col), t1 = *(const f32x4*)(TMP + row * 1024 + col + 4);
                    f32x4 v0 = acc[ai][bj][m][0], v1 = acc[ai][bj][m][1];
                    v0[0] = t0[0] + v0[0] * g[0]; v0[1] = t0[1] + v0[1] * g[1]; v0[2] = t0[2] + v0[2] * g[2]; v0[3] = t0[3] + v0[3] * g[3];
                    v1[0] = t1[0] + v1[0] * g[4]; v1[1] = t1[1] + v1[1] * g[5]; v1[2] = t1[2] + v1[2] * g[6]; v1[3] = t1[3] + v1[3] * g[7];
                    *(u32x4*)(MG + row * 1024 + col) = pack8(v0, v1); } }
    }
};
struct EpiG1 {
    static constexpr bool PERM = true, AFTER_DRAIN = false, MID = false;
    bf16_t* QKV; bf16_t* GG; bf16_t* CB; bf16_t* PR; float c2;
    __device__ __forceinline__ void operator()(const f32x4 (&acc)[2][2][4][2], const Unit& u, int wr, int wc, int fr, int fq) const {
        int colt = u.pn * BM; const int row0 = u.pm * BM + wr * 64 + fr;
        if (colt >= 6144) {
            const int ch0 = (colt - 6144) / 2 + wc * 16 + 4 * fq;
#pragma unroll
            for (int ai = 0; ai < 2; ++ai)
#pragma unroll
                for (int m = 0; m < 4; ++m) { bf16_t* rowp = PR + (size_t)(row0 + ai * HALF + m * 16) * 1024 + ch0;
#pragma unroll
                    for (int bj = 0; bj < 2; ++bj) { const f32x4 v0 = acc[ai][bj][m][0], v1 = acc[ai][bj][m][1];
                        u32x2 w; w.x = cvt_pk_bf16(v0[0] * v0[1], v0[2] * v0[3]); w.y = cvt_pk_bf16(v1[0] * v1[1], v1[2] * v1[3]);
                        *(u32x2*)(rowp + bj * (HALF / 2)) = w; } }
            return;
        }
        bf16_t* base = QKV; int ldc = 3072; float sc = 1.f; bool sig = false;
        if (colt < 1024) sc = c2; else if (colt >= 5120) { base = CB; ldc = 2048; colt -= 5120; } else if (colt >= 3072) { base = GG; ldc = 2048; colt -= 3072; sig = true; }
        const int col0 = colt + wc * 32 + 8 * fq;
#pragma unroll
        for (int ai = 0; ai < 2; ++ai)
#pragma unroll
            for (int m = 0; m < 4; ++m) { bf16_t* rowp = base + (size_t)(row0 + ai * HALF + m * 16) * ldc + col0;
#pragma unroll
                for (int bj = 0; bj < 2; ++bj) { f32x4 v0 = acc[ai][bj][m][0], v1 = acc[ai][bj][m][1];
                    if (sig) {
#pragma unroll
                        for (int i = 0; i < 4; ++i) { v0[i] = __builtin_amdgcn_rcpf(1.f + __expf(-v0[i])); v1[i] = __builtin_amdgcn_rcpf(1.f + __expf(-v1[i])); }
                    } else { v0 = v0 * sc; v1 = v1 * sc; }
                    *(u32x4*)(rowp + bj * HALF) = pack8(v0, v1); } }
    }
};
struct EpiMerged {
    static constexpr bool PERM = true, AFTER_DRAIN = false, MID = true;
    const bf16_t* GG; bf16_t* MG;
    __device__ __forceinline__ void mid(f32x4 (&acc)[2][2][4][2], const Unit& u, int wr, int wc, int fr, int fq) const {
        const int row0 = u.pm * BM + wr * 64 + fr, col0 = u.pn * BM + wc * 32 + 8 * fq;
#pragma unroll
        for (int ai = 0; ai < 2; ++ai)
#pragma unroll
            for (int m = 0; m < 4; ++m) { const size_t row = (size_t)(row0 + ai * HALF + m * 16);
#pragma unroll
                for (int bj = 0; bj < 2; ++bj) { const int col = col0 + bj * HALF; float ga[8], gc[8];
                    unpack8(*(const u32x4*)(GG + row * 2048 + col), ga); unpack8(*(const u32x4*)(GG + row * 2048 + 1024 + col), gc);
#pragma unroll
                    for (int i = 0; i < 4; ++i) { acc[ai][bj][m][0][i] *= ga[i] * __builtin_amdgcn_rcpf(gc[i]); acc[ai][bj][m][1][i] *= ga[4 + i] * __builtin_amdgcn_rcpf(gc[4 + i]); }
                    asm volatile("" ::: "memory"); } }
    }
    __device__ __forceinline__ void operator()(const f32x4 (&acc)[2][2][4][2], const Unit& u, int wr, int wc, int fr, int fq) const {
        const int row0 = u.pm * BM + wr * 64 + fr, col0 = u.pn * BM + wc * 32 + 8 * fq;
#pragma unroll
        for (int ai = 0; ai < 2; ++ai)
#pragma unroll
            for (int m = 0; m < 4; ++m) { const size_t row = (size_t)(row0 + ai * HALF + m * 16);
#pragma unroll
                for (int bj = 0; bj < 2; ++bj) { const int col = col0 + bj * HALF; float gc[8]; unpack8(*(const u32x4*)(GG + row * 2048 + 1024 + col), gc);
                    f32x4 v0 = acc[ai][bj][m][0], v1 = acc[ai][bj][m][1];
#pragma unroll
                    for (int i = 0; i < 4; ++i) { v0[i] *= gc[i]; v1[i] *= gc[4 + i]; }
                    *(u32x4*)(MG + row * 1024 + col) = pack8(v0, v1); } }
    }
};
struct EpiResid {
    static constexpr bool PERM = true, AFTER_DRAIN = false, MID = false;
    const float* X; float* H2; bf16_t* H2B; float* SSQ;
    __device__ __forceinline__ void operator()(const f32x4 (&acc)[2][2][4][2], const Unit& u, int wr, int wc, int fr, int fq) const {
        const int row0 = u.pm * BM + wr * 64 + fr, col0 = u.pn * BM + wc * 32 + 8 * fq;
#pragma unroll
        for (int ai = 0; ai < 2; ++ai)
#pragma unroll
            for (int m = 0; m < 4; ++m) { const size_t row = (size_t)(row0 + ai * HALF + m * 16); float s = 0.f;
#pragma unroll
                for (int bj = 0; bj < 2; ++bj) { const size_t o = row * 1024 + col0 + bj * HALF;
                    const f32x4 v0 = acc[ai][bj][m][0] + *(const f32x4*)(X + o), v1 = acc[ai][bj][m][1] + *(const f32x4*)(X + o + 4);
                    *(f32x4*)(H2 + o) = v0; *(f32x4*)(H2 + o + 4) = v1; *(u32x4*)(H2B + o) = pack8(v0, v1);
                    s += (v0[0] * v0[0] + v0[1] * v0[1]) + (v0[2] * v0[2] + v0[3] * v0[3]) + (v1[0] * v1[0] + v1[1] * v1[1]) + (v1[2] * v1[2] + v1[3] * v1[3]); }
                s += __shfl_xor(s, 16); s += __shfl_xor(s, 32);
                if (fq == 0) SSQ[row * 16 + u.pn * 4 + wc] = s; }
    }
};
struct EpiRowScale {
    static constexpr bool PERM = true, AFTER_DRAIN = false, MID = false;
    const float* SSQ; bf16_t* O;
    __device__ __forceinline__ void operator()(const f32x4 (&acc)[2][2][4][2], const Unit& u, int wr, int wc, int fr, int fq) const {
        const int row0 = u.pm * BM + wr * 64 + fr, col0 = u.pn * BM + wc * 32 + 8 * fq;
#pragma unroll
        for (int ai = 0; ai < 2; ++ai)
#pragma unroll
            for (int m = 0; m < 4; ++m) { const size_t row = (size_t)(row0 + ai * HALF + m * 16);
                const f32x4* sp = (const f32x4*)(SSQ + row * 16); const f32x4 a = sp[0] + sp[1], b = sp[2] + sp[3], c = a + b;
                const float rs = rsqrtf(((c[0] + c[1]) + (c[2] + c[3])) * (1.f / 1024.f) + 1e-6f);
#pragma unroll
                for (int bj = 0; bj < 2; ++bj) *(u32x4*)(O + row * 2048 + col0 + bj * HALF) = pack8(acc[ai][bj][m][0] * rs, acc[ai][bj][m][1] * rs); }
    }
};
template <class Epi, class Sched, bool ALIGN_EPI = false, bool SP2 = false>
__device__ __forceinline__ void gemm_phase(PG8_LAS unsigned char* lds, const Gemm g, const Sched& S, const Epi& E) {
    const int tid = threadIdx.x, wid = __builtin_amdgcn_readfirstlane(tid >> 6), lane = tid & 63, wr = wid >> 2, wc = wid & 3, fr = lane & 15, fq = lane >> 4;
    const int K = g.K, nt = K / BK;
    unsigned voffA[2], voffB[2];
#pragma unroll
    for (int i = 0; i < 2; ++i) { int R, C; stage_rc(tid * 16 + i * 8192, R, C); const int Rb = Epi::PERM ? ((R & ~31) + perm32(R & 31)) : R;
        voffA[i] = (unsigned)(R * g.lda + C) * 2u; voffB[i] = (unsigned)(Rb * g.ldb + C) * 2u; }
    const size_t kstep = (size_t)(BK * 2);
    const size_t hstep = (size_t)HALF * g.ldb * 2;
    const size_t tstep = 2 * hstep;
    const size_t hstepA = (size_t)HALF * g.lda * 2, tstepA = 2 * hstepA;
    const unsigned ldsw = (unsigned)wid * 1024u;
    const int aoff = lds_byte(wr * 64 + fr, fq * 8), boff = lds_byte(wc * 32 + fr, fq * 8);
#define PG8_SA(b, h) (((b) * 2 + (h)) * HTB)
#define PG8_SB(b, h) ((4 + (b) * 2 + (h)) * HTB)
#define PG8_STAGE(bufoff, gbase, voff) do { _Pragma("unroll") for (int _i = 0; _i < 2; ++_i) \
        __builtin_amdgcn_global_load_lds((const unsigned*)((const char*)(gbase) + (voff)[_i]), (PG8_LAS unsigned*)(lds + (bufoff) + ldsw + _i * 8192), 16, 0, 0); } while (0)
#define PG8_LDA(dst, b, h) do { _Pragma("unroll") for (int m = 0; m < 4; ++m) _Pragma("unroll") for (int k = 0; k < 2; ++k) dst[m][k] = *(const PG8_LAS bf16x8*)(lds + PG8_SA(b, h) + aoff + m * 2048 + k * 1024); } while (0)
#define PG8_LDB(dst, b, h) do { _Pragma("unroll") for (int n = 0; n < 2; ++n) _Pragma("unroll") for (int k = 0; k < 2; ++k) dst[n][k] = *(const PG8_LAS bf16x8*)(lds + PG8_SB(b, h) + boff + n * 2048 + k * 1024); } while (0)
#define PG8_MMA(ai, bj, At, Bt) do { __builtin_amdgcn_s_setprio(1); _Pragma("unroll") for (int m = 0; m < 4; ++m) _Pragma("unroll") for (int n = 0; n < 2; ++n) _Pragma("unroll") for (int k = 0; k < 2; ++k) \
        acc[ai][bj][m][n] = __builtin_amdgcn_mfma_f32_16x16x32_bf16(Bt[n][k], At[m][k], acc[ai][bj][m][n], 0, 0, 0); __builtin_amdgcn_s_setprio(0); } while (0)
#define PG8_WAIT_V(n) asm volatile("s_waitcnt vmcnt(" #n ")" ::: "memory")
#define PG8_WAIT_L(n) asm volatile("s_waitcnt lgkmcnt(" #n ")" ::: "memory")
#define PG8_BAR __builtin_amdgcn_s_barrier()
#define PG8_SCHED __builtin_amdgcn_sched_barrier(0)
    Unit cur, nxt; int ui = 0;
    if (!S.next(0, cur)) return;
    f32x4 acc[2][2][4][2];
#pragma unroll
    for (int a = 0; a < 2; ++a)
#pragma unroll
        for (int b = 0; b < 2; ++b)
#pragma unroll
            for (int m = 0; m < 4; ++m)
#pragma unroll
                for (int n = 0; n < 2; ++n) acc[a][b][m][n] = (f32x4){0.f, 0.f, 0.f, 0.f};
    bf16x8 At[4][2], B0[2][2], B1[2][2];
    const char* cA = (const char*)g.A + (size_t)cur.pm * tstepA + (size_t)cur.kh * K * 2; const char* cB = (const char*)g.Bt + (size_t)cur.pn * tstep + (size_t)cur.kh * K * 2;
    S.a_ready(cur);
    if constexpr (SP2) {
        PG8_STAGE(PG8_SB(0, 0), cB, voffB); PG8_STAGE(PG8_SB(0, 1), cB + hstep, voffB); PG8_STAGE(PG8_SA(0, 0), cA, voffA); PG8_STAGE(PG8_SA(0, 1), cA + hstepA, voffA);
        if (wr == 1) PG8_BAR;
        PG8_WAIT_V(2); PG8_BAR;
        PG8_STAGE(PG8_SB(1, 0), cB + kstep, voffB); PG8_STAGE(PG8_SA(1, 0), cA + kstep, voffA); PG8_STAGE(PG8_SB(1, 1), cB + hstep + kstep, voffB);
        PG8_WAIT_V(6); PG8_BAR;
    } else {
        PG8_STAGE(PG8_SB(0, 0), cB, voffB); PG8_STAGE(PG8_SA(0, 0), cA, voffA); PG8_STAGE(PG8_SB(0, 1), cB + hstep, voffB); PG8_STAGE(PG8_SA(0, 1), cA + hstepA, voffA);
        if (wr == 1) PG8_BAR;
        PG8_WAIT_V(4); PG8_BAR;
        PG8_STAGE(PG8_SB(1, 0), cB + kstep, voffB); PG8_STAGE(PG8_SA(1, 0), cA + kstep, voffA); PG8_STAGE(PG8_SB(1, 1), cB + hstep + kstep, voffB);
        PG8_WAIT_V(6); PG8_BAR;
    }
    for (;;) {
        const bool has_next = S.next(ui + 1, nxt);
        const char* nA = has_next ? (const char*)g.A + (size_t)nxt.pm * tstepA + (size_t)nxt.kh * K * 2 : cA; const char* nB = has_next ? (const char*)g.Bt + (size_t)nxt.pn * tstep + (size_t)nxt.kh * K * 2 : cB;
        for (int t = 0; t < nt; t += 2) {
            const bool last = (t == nt - 2);
            const char* a1 = cA + (size_t)(t + 1) * kstep;
            const char* a2 = last ? nA : cA + (size_t)(t + 2) * kstep; const char* b2 = last ? nB : cB + (size_t)(t + 2) * kstep;
            const char* a3 = a2 + kstep; const char* b3 = b2 + kstep;
            if (last && has_next) S.a_ready(nxt);
            if constexpr (SP2) {
            PG8_LDB(B0, 0, 0); PG8_LDB(B1, 0, 1); PG8_SCHED; PG8_LDA(At, 0, 0); PG8_STAGE(PG8_SA(1, 1), a1 + hstepA, voffA);
            PG8_WAIT_V(8); PG8_WAIT_L(0); PG8_BAR; PG8_MMA(0, 0, At, B0); PG8_MMA(0, 1, At, B1); PG8_BAR; PG8_SCHED;
            PG8_LDA(At, 0, 1); PG8_STAGE(PG8_SB(0, 0), b2, voffB); PG8_STAGE(PG8_SB(0, 1), b2 + hstep, voffB); PG8_STAGE(PG8_SA(0, 0), a2, voffA);
            PG8_WAIT_V(8); PG8_WAIT_L(0); PG8_BAR; PG8_MMA(1, 0, At, B0); PG8_MMA(1, 1, At, B1); PG8_BAR; PG8_SCHED;
            PG8_LDB(B0, 1, 0); PG8_LDB(B1, 1, 1); PG8_SCHED; PG8_LDA(At, 1, 0); PG8_STAGE(PG8_SA(0, 1), a2 + hstepA, voffA);
            PG8_WAIT_V(8); PG8_WAIT_L(0); PG8_BAR; PG8_MMA(0, 0, At, B0); PG8_MMA(0, 1, At, B1); PG8_BAR; PG8_SCHED;
            PG8_LDA(At, 1, 1); PG8_STAGE(PG8_SB(1, 0), b3, voffB); PG8_STAGE(PG8_SB(1, 1), b3 + hstep, voffB); PG8_STAGE(PG8_SA(1, 0), a3, voffA);
            PG8_WAIT_V(8); PG8_WAIT_L(0); PG8_BAR; PG8_MMA(1, 0, At, B0); PG8_MMA(1, 1, At, B1); PG8_BAR; PG8_SCHED;
            } else {
            PG8_LDB(B0, 0, 0); PG8_SCHED; PG8_LDA(At, 0, 0); PG8_STAGE(PG8_SA(1, 1), a1 + hstepA, voffA);
            PG8_WAIT_L(8); PG8_BAR; PG8_WAIT_L(0); PG8_MMA(0, 0, At, B0); PG8_BAR; PG8_SCHED;
            PG8_LDB(B1, 0, 1); PG8_STAGE(PG8_SB(0, 0), b2, voffB);
            PG8_BAR; PG8_WAIT_L(0); PG8_MMA(0, 1, At, B1); PG8_BAR;
            PG8_LDA(At, 0, 1); PG8_STAGE(PG8_SA(0, 0), a2, voffA);
            PG8_BAR; PG8_WAIT_L(0); PG8_MMA(1, 0, At, B0); PG8_BAR; PG8_SCHED;
            PG8_STAGE(PG8_SB(0, 1), b2 + hstep, voffB);
            PG8_WAIT_V(6); PG8_BAR; PG8_MMA(1, 1, At, B1); PG8_BAR;
            PG8_LDB(B0, 1, 0); PG8_SCHED; PG8_LDA(At, 1, 0); PG8_STAGE(PG8_SA(0, 1), a2 + hstepA, voffA);
            PG8_WAIT_L(8); PG8_BAR; PG8_WAIT_L(0); PG8_MMA(0, 0, At, B0); PG8_BAR; PG8_SCHED;
            PG8_LDB(B1, 1, 1); PG8_STAGE(PG8_SB(1, 0), b3, voffB);
            PG8_BAR; PG8_WAIT_L(0); PG8_MMA(0, 1, At, B1); PG8_BAR;
            PG8_LDA(At, 1, 1); PG8_STAGE(PG8_SA(1, 0), a3, voffA);
            PG8_BAR; PG8_WAIT_L(0); PG8_MMA(1, 0, At, B0); PG8_BAR; PG8_SCHED;
            PG8_STAGE(PG8_SB(1, 1), b3 + hstep, voffB);
            PG8_WAIT_V(6); PG8_BAR; PG8_MMA(1, 1, At, B1); PG8_BAR;
            }
        }
        if constexpr (ALIGN_EPI) { if (wr == 0) PG8_BAR; }
        bool keep_acc = false;
        if constexpr (Epi::MID) { if (cur.kh == 0) { E.mid(acc, cur, wr, wc, fr, fq); keep_acc = true; } }
        if constexpr (!Epi::AFTER_DRAIN) { if (!keep_acc) { E(acc, cur, wr, wc, fr, fq); S.done(cur); } }
        if (!has_next) break;
        if (!keep_acc)
#pragma unroll
        for (int a = 0; a < 2; ++a)
#pragma unroll
            for (int b = 0; b < 2; ++b)
#pragma unroll
                for (int m = 0; m < 4; ++m)
#pragma unroll
                    for (int n = 0; n < 2; ++n) acc[a][b][m][n] = (f32x4){0.f, 0.f, 0.f, 0.f};
        cur = nxt; cA = nA; cB = nB; ++ui;
        if constexpr (ALIGN_EPI) { if (wr == 1) PG8_BAR; }
    }
    PG8_WAIT_V(0);
    if constexpr (!ALIGN_EPI) { if (wr == 0) PG8_BAR; }
    PG8_BAR;
    if constexpr (Epi::AFTER_DRAIN) { E.fused(acc, cur, wr, wc, fr, fq, lds, wid, lane); S.done(cur); }
#undef PG8_SA
#undef PG8_SB
#undef PG8_STAGE
#undef PG8_LDA
#undef PG8_LDB
#undef PG8_MMA
#undef PG8_WAIT_V
#undef PG8_WAIT_L
#undef PG8_BAR
#undef PG8_SCHED
}
}
#define LAS __attribute__((address_space(3)))
typedef unsigned short bf16;
typedef short bf16x8 __attribute__((ext_vector_type(8)));
typedef short s16x4 __attribute__((ext_vector_type(4)));
typedef float f32x4 __attribute__((ext_vector_type(4)));
typedef float f32x16 __attribute__((ext_vector_type(16)));
typedef unsigned u32x4 __attribute__((ext_vector_type(4)));
typedef unsigned u32x2 __attribute__((ext_vector_type(2)));
typedef float f32x2_t __attribute__((ext_vector_type(2))); typedef __bf16 bf16x2_t __attribute__((ext_vector_type(2)));

constexpr int T = 16384, DM = 1024, SEQ = 2048;
constexpr int NWAVES = 8, NTHR = 512;
constexpr int LDS_BYTES = 147456;
constexpr float EPS = 1e-6f;
constexpr float ESCALE = 64.f;
constexpr float C2 = 0.125f * 1.4426950408889634f;
constexpr size_t MiB = 1u << 20;
constexpr size_t WS_WIN = 0, WS_WAC = 16 * MiB, WS_WOUT = 20 * MiB, WS_WQ = 22 * MiB, WS_SUBK = 26 * MiB, WS_SSQ = 27 * MiB;
constexpr size_t WS_EU = 28 * MiB, WS_EV = 44 * MiB, WS_BIG = 60 * MiB, WS_END = 252 * MiB;
constexpr size_t B_QKV = 0, B_GG = 96 * MiB, B_PR = 160 * MiB, B_MG = 0, B_H2B = 32 * MiB, B_QP = 96 * MiB, B_SEL = 64 * MiB, B_GATE = 72 * MiB;

__device__ __forceinline__ unsigned cvtpk(float lo, float hi) { f32x2_t v = {lo, hi}; bf16x2_t b = __builtin_convertvector(v, bf16x2_t); return __builtin_bit_cast(unsigned, b); }
__device__ __forceinline__ float wave_sum(float v) {
#pragma unroll
    for (int o = 1; o < 64; o <<= 1) v += __shfl_xor(v, o);
    return v;
}
#define LDS_WAIT() asm volatile("s_waitcnt lgkmcnt(0)" ::: "memory")

struct Params {
    const float* x; const float* norm1_g; const float* w_in; const float* lambda_qk; const float* subln_g; const float* conv_w;
    const float* w_attn_o; const float* w_conv_o; const float* w_out; const float* norm2_g; const float* w_query; const float* sub_keys;
    const float* expert_u; const float* expert_v; const float* final_g;
    float* out; unsigned char* ws; int lo, hi;
};

__device__ __forceinline__ void transpose_item(const float* W, int K, int N, bf16* WT, int remap, int dpitch, int koff, const float* kscale, LAS float* scr, int item, int lane) {
    const int nblk = N / 32, kb = item / nblk, nb = item % nblk, k0 = 64 * kb, n0 = 32 * nb;
    int d0 = n0, dstr = 1;
    if (remap) { if (n0 < 3072) d0 = n0; else if (n0 < 4096) d0 = n0 + 2048; else if (n0 < 5120) { d0 = 6144 + 2 * (n0 - 4096); dstr = 2; } else if (n0 < 6144) { d0 = 6144 + 2 * (n0 - 5120) + 1; dstr = 2; } else d0 = n0 - 3072; }
    { float wv[32];
#pragma unroll
      for (int i = 0; i < 32; ++i) wv[i] = W[(size_t)(k0 + 2 * i + (lane >> 5)) * N + n0 + (lane & 31)];
#pragma unroll
      for (int i = 0; i < 32; ++i) { const int kk = 2 * i + (lane >> 5); float v = wv[i]; if (kscale) v *= kscale[k0 + kk]; scr[kk * 33 + (lane & 31)] = v; } }
    LDS_WAIT(); asm volatile("" ::: "memory");
    const int c = lane & 7;
#pragma unroll
    for (int j = 0; j < 4; ++j) { const int n = (lane >> 3) + 8 * j; const LAS float* sp = scr + (8 * c) * 33 + n;
        u32x4 o; o.x = cvtpk(sp[0 * 33], sp[1 * 33]); o.y = cvtpk(sp[2 * 33], sp[3 * 33]); o.z = cvtpk(sp[4 * 33], sp[5 * 33]); o.w = cvtpk(sp[6 * 33], sp[7 * 33]);
        *(u32x4*)(WT + (size_t)(d0 + n * dstr) * dpitch + koff + k0 + 8 * c) = o; }
    LDS_WAIT(); asm volatile("" ::: "memory");
}
__device__ __forceinline__ void cvt_flat(const float* src, bf16* dst, size_t n8, size_t gtid, size_t nthr) {
    for (size_t i = gtid; i < n8; i += nthr) { const f32x4 a = *(const f32x4*)(src + i * 8), b = *(const f32x4*)(src + i * 8 + 4);
        u32x4 o; o.x = cvtpk(a[0], a[1]); o.y = cvtpk(a[2], a[3]); o.z = cvtpk(b[0], b[1]); o.w = cvtpk(b[2], b[3]); *(u32x4*)(dst + i * 8) = o; }
}
__device__ __forceinline__ void cvt_flat_fp8(const float* src, unsigned char* dst, size_t n16, float sc, size_t gtid, size_t nthr) {
    for (size_t i = gtid; i < n16; i += nthr) { u32x4 o;
#pragma unroll
        for (int q = 0; q < 4; ++q) { const f32x4 a = *(const f32x4*)(src + i * 16 + 4 * q) * sc; int w = 0;
            w = __builtin_amdgcn_cvt_pk_fp8_f32(a[0], a[1], w, false); w = __builtin_amdgcn_cvt_pk_fp8_f32(a[2], a[3], w, true); o[q] = (unsigned)w; }
        *(u32x4*)(dst + i * 16) = o; }
}
__device__ __forceinline__ void phase0(const Params& p, LAS unsigned char* lds, int G, int bid, int wave, int lane) {
    unsigned char* ws = p.ws;
    LAS float* scr = (LAS float*)(lds + wave * 16384);
    const int gw = bid * NWAVES + wave, NGW = G * NWAVES;
    constexpr int I_IN = 16 * 256, I_SQ = 16 * 32, I_Q = 16 * 64, NITEMS = I_IN + 3 * I_SQ + I_Q;
    for (int it = gw; it < NITEMS; it += NGW) {
        int r = it;
        if (r < I_IN) { transpose_item(p.w_in, 1024, 8192, (bf16*)(ws + WS_WIN), 1, 1024, 0, nullptr, scr, r, lane); continue; } r -= I_IN;
        if (r < I_SQ) { transpose_item(p.w_attn_o, 1024, 1024, (bf16*)(ws + WS_WAC), 0, 2048, 0, nullptr, scr, r, lane); continue; } r -= I_SQ;
        if (r < I_SQ) { transpose_item(p.w_conv_o, 1024, 1024, (bf16*)(ws + WS_WAC), 0, 2048, 1024, nullptr, scr, r, lane); continue; } r -= I_SQ;
        if (r < I_SQ) { transpose_item(p.w_out, 1024, 1024, (bf16*)(ws + WS_WOUT), 0, 1024, 0, nullptr, scr, r, lane); continue; } r -= I_SQ;
        transpose_item(p.w_query, 1024, 2048, (bf16*)(ws + WS_WQ), 0, 1024, 0, p.norm2_g, scr, r, lane);
    }
    const size_t gtid = (size_t)bid * NTHR + wave * 64 + lane, nthr = (size_t)G * NTHR;
    cvt_flat(p.sub_keys, (bf16*)(ws + WS_SUBK), (size_t)(8 * 2 * 128 * 128) / 8, gtid, nthr);
    bf16* N1 = (bf16*)p.out;
    f32x4 gv[4];
#pragma unroll
    for (int j = 0; j < 4; ++j) gv[j] = *((const f32x4*)p.norm1_g + lane + 64 * j);
    for (int m0 = gw; m0 < T; m0 += 2 * NGW) {
        const int m1 = (m0 + NGW < T) ? m0 + NGW : m0;
        const f32x4* xr0 = (const f32x4*)(p.x + (size_t)m0 * DM) + lane; const f32x4* xr1 = (const f32x4*)(p.x + (size_t)m1 * DM) + lane;
        f32x4 v0[4], v1[4]; float s0 = 0.f, s1 = 0.f;
#pragma unroll
        for (int j = 0; j < 4; ++j) { v0[j] = xr0[64 * j]; v1[j] = xr1[64 * j]; }
#pragma unroll
        for (int j = 0; j < 4; ++j) { s0 += (v0[j][0] * v0[j][0] + v0[j][1] * v0[j][1]) + (v0[j][2] * v0[j][2] + v0[j][3] * v0[j][3]);
                                      s1 += (v1[j][0] * v1[j][0] + v1[j][1] * v1[j][1]) + (v1[j][2] * v1[j][2] + v1[j][3] * v1[j][3]); }
        const float r0 = rsqrtf(wave_sum(s0) * (1.f / DM) + EPS), r1 = rsqrtf(wave_sum(s1) * (1.f / DM) + EPS);
        u32x2* o0 = (u32x2*)(N1 + (size_t)m0 * 2048) + lane; u32x2* o1 = (u32x2*)(N1 + (size_t)m1 * 2048) + lane;
#pragma unroll
        for (int j = 0; j < 4; ++j) { u32x2 o; o.x = cvtpk(v0[j][0] * r0 * gv[j][0], v0[j][1] * r0 * gv[j][1]); o.y = cvtpk(v0[j][2] * r0 * gv[j][2], v0[j][3] * r0 * gv[j][3]); o0[64 * j] = o;
            u32x2 q; q.x = cvtpk(v1[j][0] * r1 * gv[j][0], v1[j][1] * r1 * gv[j][1]); q.y = cvtpk(v1[j][2] * r1 * gv[j][2], v1[j][3] * r1 * gv[j][3]); o1[64 * j] = q; }
    }
}

__device__ __forceinline__ void up8(const bf16* p, float (&f)[8]) { const u32x4 w = *(const u32x4*)p; pg8::unpack8(w, f); }
__device__ __forceinline__ void phase_conv(const Params& p, int G, int bid, int tid) {
    const bf16* PR = (const bf16*)(p.ws + WS_BIG + B_PR); bf16* CBU = (bf16*)p.out + 1024;
    const size_t nthr = (size_t)G * NTHR;
    for (size_t it = (size_t)bid * NTHR + tid; it < (size_t)(T / 8) * 128; it += nthr) {
        const int t0 = (int)(it >> 7) * 8, c8 = (int)(it & 127) * 8, s0 = t0 & (SEQ - 1);
        const bf16* row = PR + (size_t)t0 * 1024 + c8;
        u32x4 pr[10], cbr[8];
#pragma unroll
        for (int i = 0; i < 8; ++i) { pr[i + 2] = *(const u32x4*)(row + (size_t)i * 1024); cbr[i] = *(const u32x4*)(CBU + (size_t)(t0 + i) * 2048 + c8); }
        if (s0 != 0) { pr[0] = *(const u32x4*)(row - 2048); pr[1] = *(const u32x4*)(row - 1024); } else { pr[0] = (u32x4){0u, 0u, 0u, 0u}; pr[1] = pr[0]; }
        float w0[8], w1[8], w2[8];
#pragma unroll
        for (int i = 0; i < 8; ++i) { w0[i] = p.conv_w[c8 + i]; w1[i] = p.conv_w[1024 + c8 + i]; w2[i] = p.conv_w[2048 + c8 + i]; }
        float fa[8], fb[8], fc[8];
        pg8::unpack8(pr[0], fa); pg8::unpack8(pr[1], fb);
#pragma unroll
        for (int i = 0; i < 8; ++i) {
            pg8::unpack8(pr[i + 2], fc);
            float cb[8]; pg8::unpack8(cbr[i], cb);
            float o[8];
#pragma unroll
            for (int c = 0; c < 8; ++c) o[c] = cb[c] * (w0[c] * fa[c] + w1[c] * fb[c] + w2[c] * fc[c]);
            u32x4 w; w.x = cvtpk(o[0], o[1]); w.y = cvtpk(o[2], o[3]); w.z = cvtpk(o[4], o[5]); w.w = cvtpk(o[6], o[7]);
            *(u32x4*)(CBU + (size_t)(t0 + i) * 2048 + c8) = w;
#pragma unroll
            for (int c = 0; c < 8; ++c) { fa[c] = fb[c]; fb[c] = fc[c]; }
        }
    }
}

constexpr int KPITCH = 272, VPITCH = 320, KBYTES = 64 * KPITCH, STAGEB = KBYTES + 64 * VPITCH;
constexpr int XOFF = 0, OSTOFF = 65536, OSTPITCH = 272, OSTB = 32 * OSTPITCH;
__device__ __forceinline__ s16x4 vtr(const LAS unsigned char* p) { return __builtin_amdgcn_ds_read_tr16_b64_v4i16((LAS s16x4*)p); }

__device__ __forceinline__ void attn_unit(LAS unsigned char* lds, const bf16* QKV, bf16* ON, const float* subg, float lam, int b, int h, int qb, int tid) {
    const int w = __builtin_amdgcn_readfirstlane(tid >> 6), lane = tid & 63, map = w >> 2, wq = w & 3, l31 = lane & 31, half = lane >> 5;
    const size_t trow0 = (size_t)b * SEQ;
    const int q0 = qb * 128 + wq * 32;
    bf16x8 qf[4];
    { const bf16* qp = QKV + (trow0 + q0 + l31) * 3072 + h * 128 + map * 64 + 8 * half;
#pragma unroll
      for (int s = 0; s < 4; ++s) qf[s] = *(const bf16x8*)(qp + 16 * s); }
    f32x16 O[4];
#pragma unroll
    for (int e = 0; e < 4; ++e)
#pragma unroll
        for (int r = 0; r < 16; ++r) O[e][r] = 0.f;
    float m_run = 0.f, l_run = 0.f;
    const int ntile = 2 * (qb + 1);
    const int skey = tid >> 4, sch = tid & 15;
    const bf16* gk = QKV + (trow0 + skey) * 3072 + 1024 + h * 128 + sch * 8;
    const int dk = skey * KPITCH + sch * 16, dv = KBYTES + skey * VPITCH + sch * 16;
    u32x4 stg[4];
#define GLOAD(j) do { const bf16* g_ = gk + (size_t)(j) * 64 * 3072; stg[0] = *(const u32x4*)g_; stg[1] = *(const u32x4*)(g_ + 32 * 3072); stg[2] = *(const u32x4*)(g_ + 1024); stg[3] = *(const u32x4*)(g_ + 32 * 3072 + 1024); } while (0)
#define LSTORE(st) do { LAS unsigned char* b_ = lds + (st) * STAGEB; *(LAS u32x4*)(b_ + dk) = stg[0]; *(LAS u32x4*)(b_ + dk + 32 * KPITCH) = stg[1]; *(LAS u32x4*)(b_ + dv) = stg[2]; *(LAS u32x4*)(b_ + dv + 32 * VPITCH) = stg[3]; } while (0)
    GLOAD(0); LSTORE(0); __syncthreads();
    const int koff = l31 * KPITCH + map * 128 + half * 16;
    const int voff = KBYTES + (4 * half + ((lane & 15) >> 2)) * VPITCH + (((lane >> 4) & 1) * 16 + (lane & 3) * 4) * 2;
    const int qi = q0 + l31;
    for (int j = 0; j < ntile; ++j) {
        if (j + 1 < ntile) GLOAD(j + 1);
        const int kbase = 64 * j;
        if (kbase <= q0 + 31) {
            const LAS unsigned char* sb = lds + (j & 1) * STAGEB;
            f32x16 s0, s1;
            const float negm = -m_run;
#pragma unroll
            for (int r = 0; r < 16; ++r) { s0[r] = negm; s1[r] = negm; }
#pragma unroll
            for (int s = 0; s < 4; ++s) { const bf16x8 k0 = *(const LAS bf16x8*)(sb + koff + s * 32), k1 = *(const LAS bf16x8*)(sb + koff + 32 * KPITCH + s * 32);
                s0 = __builtin_amdgcn_mfma_f32_32x32x16_bf16(k0, qf[s], s0, 0, 0, 0); s1 = __builtin_amdgcn_mfma_f32_32x32x16_bf16(k1, qf[s], s1, 0, 0, 0); }
            const LAS unsigned char* vb = sb + voff;
            s16x4 vlo[4][4], vhi[4][4];
            if (kbase + 63 > q0) {
#pragma unroll
                for (int r = 0; r < 16; ++r) { const int key = kbase + (r & 3) + 8 * (r >> 2) + 4 * half;
                    s0[r] = (key <= qi) ? s0[r] : -1e30f; s1[r] = (key + 32 <= qi) ? s1[r] : -1e30f; }
            }
            float mx = fmaxf(s0[0], s1[0]);
#pragma unroll
            for (int r = 1; r < 16; ++r) mx = fmaxf(mx, fmaxf(s0[r], s1[r]));
            mx = fmaxf(mx, __shfl_xor(mx, 32));
            float ps = 0.f;
            const bool first = (j == 0), move = first || (__ballot(mx > 8.f) != 0ull);
            const float delta = move ? (first ? mx : fmaxf(mx, 0.f)) : 0.f;
#pragma unroll
            for (int r = 0; r < 16; ++r) { s0[r] = __builtin_amdgcn_exp2f(s0[r] - delta); s1[r] = __builtin_amdgcn_exp2f(s1[r] - delta); ps += s0[r] + s1[r]; }
            if (move) {
                const float alpha = first ? 0.f : __builtin_amdgcn_exp2f(-delta); m_run += delta;
                l_run = l_run * alpha + ps;
                if (!first) {
#pragma unroll
                    for (int e = 0; e < 4; ++e) O[e] = O[e] * alpha;
                }
            } else l_run += ps;
            bf16x8 pf[4];
#pragma unroll
            for (int kk = 0; kk < 4; ++kk) { u32x4 wv;
                if (kk < 2) { wv.x = cvtpk(s0[8 * kk + 0], s0[8 * kk + 1]); wv.y = cvtpk(s0[8 * kk + 2], s0[8 * kk + 3]); wv.z = cvtpk(s0[8 * kk + 4], s0[8 * kk + 5]); wv.w = cvtpk(s0[8 * kk + 6], s0[8 * kk + 7]); }
                else { const int k2 = kk - 2; wv.x = cvtpk(s1[8 * k2 + 0], s1[8 * k2 + 1]); wv.y = cvtpk(s1[8 * k2 + 2], s1[8 * k2 + 3]); wv.z = cvtpk(s1[8 * k2 + 4], s1[8 * k2 + 5]); wv.w = cvtpk(s1[8 * k2 + 6], s1[8 * k2 + 7]); }
                pf[kk] = __builtin_bit_cast(bf16x8, wv); }
#pragma unroll
            for (int e = 0; e < 4; ++e) { vlo[0][e] = vtr(vb + e * 64); vhi[0][e] = vtr(vb + 8 * VPITCH + e * 64); }
#pragma unroll
            for (int kk = 0; kk < 4; ++kk)
#pragma unroll
                for (int e = 0; e < 4; ++e) {
                    if (e == 0 && kk < 3) {
#pragma unroll
                        for (int e2 = 0; e2 < 4; ++e2) { vlo[kk + 1][e2] = vtr(vb + (kk + 1) * 16 * VPITCH + e2 * 64); vhi[kk + 1][e2] = vtr(vb + ((kk + 1) * 16 + 8) * VPITCH + e2 * 64); }
                        __builtin_amdgcn_sched_barrier(0);
                    }
                    const s16x4 lo = vlo[kk][e], hi = vhi[kk][e];
                    bf16x8 a; a[0] = lo[0]; a[1] = lo[1]; a[2] = lo[2]; a[3] = lo[3]; a[4] = hi[0]; a[5] = hi[1]; a[6] = hi[2]; a[7] = hi[3];
                    O[e] = __builtin_amdgcn_mfma_f32_32x32x16_bf16(a, pf[kk], O[e], 0, 0, 0); }
        }
        if (j + 1 < ntile) LSTORE((j + 1) & 1);
        __syncthreads();
    }
#undef GLOAD
#undef LSTORE
    const float ltot = l_run + __shfl_xor(l_run, 32), inv = 1.f / ltot;
    LAS float* X = (LAS float*)(lds + XOFF) + wq * 4096 + lane;
    if (map == 1) {
        const float sc = inv * lam;
#pragma unroll
        for (int e = 0; e < 4; ++e)
#pragma unroll
            for (int r = 0; r < 16; ++r) X[(e * 16 + r) * 64] = O[e][r] * sc;
    }
    __syncthreads();
    if (map == 0) {
        float ssq = 0.f;
#pragma unroll
        for (int e = 0; e < 4; ++e)
#pragma unroll
            for (int r = 0; r < 16; ++r) { const float o = O[e][r] * inv - X[(e * 16 + r) * 64]; O[e][r] = o; ssq += o * o; }
        ssq += __shfl_xor(ssq, 32);
        const float rms = rsqrtf(ssq * (1.f / 128.f) + EPS) * 0.8f;
        LAS unsigned char* ost = lds + OSTOFF + wq * OSTB;
#pragma unroll
        for (int e = 0; e < 4; ++e)
#pragma unroll
            for (int rq = 0; rq < 4; ++rq) { const int e0 = 32 * e + 8 * rq + 4 * half; const f32x4 g = *(const f32x4*)(subg + e0);
                u32x2 o; o.x = cvtpk(O[e][4 * rq + 0] * rms * g[0], O[e][4 * rq + 1] * rms * g[1]); o.y = cvtpk(O[e][4 * rq + 2] * rms * g[2], O[e][4 * rq + 3] * rms * g[3]);
                *(LAS u32x2*)(ost + l31 * OSTPITCH + e0 * 2) = o; }
        LDS_WAIT(); __builtin_amdgcn_wave_barrier();
#pragma unroll
        for (int jj = 0; jj < 8; ++jj) { const int c = lane + 64 * jj, row = c >> 4, ch = c & 15;
            const u32x4 v = *(const LAS u32x4*)(ost + row * OSTPITCH + ch * 16);
            *(u32x4*)(ON + (trow0 + q0 + row) * 2048 + h * 128 + ch * 8) = v; }
    }
    __syncthreads();
}

__device__ __forceinline__ void phase_attn(const Params& p, LAS unsigned char* lds, int G, int bid, int tid) {
    const bf16* QKV = (const bf16*)(p.ws + WS_BIG); bf16* ON = (bf16*)p.out;
    const int lane = tid & 63;
    const float a = p.lambda_qk[lane] * p.lambda_qk[64 + lane], b = p.lambda_qk[128 + lane] * p.lambda_qk[192 + lane];
    const float lam = expf(wave_sum(a)) - expf(wave_sum(b)) + 0.2f;
    for (int c = bid; c < 256; c += G) {
        const int bh = c >> 2, quad = c & 3, b_ = bh >> 3, h = bh & 7;
        attn_unit(lds, QKV, ON, p.subln_g, lam, b_, h, 15 - 2 * quad, tid);
        attn_unit(lds, QKV, ON, p.subln_g, lam, b_, h, 2 * quad, tid);
        attn_unit(lds, QKV, ON, p.subln_g, lam, b_, h, 14 - 2 * quad, tid);
        attn_unit(lds, QKV, ON, p.subln_g, lam, b_, h, 2 * quad + 1, tid);
    }
}

__device__ __forceinline__ unsigned mono(float v) { const unsigned u = __builtin_bit_cast(unsigned, v); return (u & 0x80000000u) ? ~u : (u | 0x80000000u); }
__device__ __forceinline__ float unmono(unsigned k) { const unsigned u = (k & 0x80000000u) ? (k ^ 0x80000000u) : ~k; return __builtin_bit_cast(float, u); }
#define CE_(x, y) do { const unsigned t_ = max(x, y); y = min(x, y); x = t_; } while (0)
__device__ __forceinline__ void sort16(unsigned (&a)[16]) {
    CE_(a[0], a[1]); CE_(a[2], a[3]); CE_(a[0], a[2]); CE_(a[1], a[3]); CE_(a[1], a[2]); CE_(a[4], a[5]); CE_(a[6], a[7]); CE_(a[4], a[6]); CE_(a[5], a[7]); CE_(a[5], a[6]); CE_(a[0], a[4]); CE_(a[2], a[6]); CE_(a[2], a[4]); CE_(a[1], a[5]); CE_(a[3], a[7]); CE_(a[3], a[5]); CE_(a[1], a[2]); CE_(a[3], a[4]); CE_(a[5], a[6]); CE_(a[8], a[9]); CE_(a[10], a[11]); CE_(a[8], a[10]); CE_(a[9], a[11]); CE_(a[9], a[10]); CE_(a[12], a[13]); CE_(a[14], a[15]); CE_(a[12], a[14]); CE_(a[13], a[15]); CE_(a[13], a[14]); CE_(a[8], a[12]); CE_(a[10], a[14]); CE_(a[10], a[12]); CE_(a[9], a[13]); CE_(a[11], a[15]); CE_(a[11], a[13]); CE_(a[9], a[10]); CE_(a[11], a[12]); CE_(a[13], a[14]); CE_(a[0], a[8]); CE_(a[4], a[12]); CE_(a[4], a[8]); CE_(a[2], a[10]); CE_(a[6], a[14]); CE_(a[6], a[10]); CE_(a[2], a[4]); CE_(a[6], a[8]); CE_(a[10], a[12]); CE_(a[1], a[9]); CE_(a[5], a[13]); CE_(a[5], a[9]); CE_(a[3], a[11]); CE_(a[7], a[15]); CE_(a[7], a[11]); CE_(a[3], a[5]); CE_(a[7], a[9]); CE_(a[11], a[13]); CE_(a[1], a[2]); CE_(a[3], a[4]); CE_(a[5], a[6]); CE_(a[7], a[8]); CE_(a[9], a[10]); CE_(a[11], a[12]); CE_(a[13], a[14]);
}
__device__ __forceinline__ void merge16(unsigned (&a)[16], const unsigned (&b)[16]) {
    a[0] = max(a[0], b[15]); a[1] = max(a[1], b[14]); a[2] = max(a[2], b[13]); a[3] = max(a[3], b[12]); a[4] = max(a[4], b[11]); a[5] = max(a[5], b[10]); a[6] = max(a[6], b[9]); a[7] = max(a[7], b[8]); a[8] = max(a[8], b[7]); a[9] = max(a[9], b[6]); a[10] = max(a[10], b[5]); a[11] = max(a[11], b[4]); a[12] = max(a[12], b[3]); a[13] = max(a[13], b[2]); a[14] = max(a[14], b[1]); a[15] = max(a[15], b[0]);
    CE_(a[0], a[8]); CE_(a[1], a[9]); CE_(a[2], a[10]); CE_(a[3], a[11]); CE_(a[4], a[12]); CE_(a[5], a[13]); CE_(a[6], a[14]); CE_(a[7], a[15]); CE_(a[0], a[4]); CE_(a[1], a[5]); CE_(a[2], a[6]); CE_(a[3], a[7]); CE_(a[8], a[12]); CE_(a[9], a[13]); CE_(a[10], a[14]); CE_(a[11], a[15]); CE_(a[0], a[2]); CE_(a[1], a[3]); CE_(a[4], a[6]); CE_(a[5], a[7]); CE_(a[8], a[10]); CE_(a[9], a[11]); CE_(a[12], a[14]); CE_(a[13], a[15]); CE_(a[0], a[1]); CE_(a[2], a[3]); CE_(a[4], a[5]); CE_(a[6], a[7]); CE_(a[8], a[9]); CE_(a[10], a[11]); CE_(a[12], a[13]); CE_(a[14], a[15]);
}

__device__ __forceinline__ void convert_experts(const Params& p, size_t gtid, size_t nthr) {
    cvt_flat_fp8(p.expert_u, p.ws + WS_EU, (size_t)16384 * 1024 / 16, ESCALE, gtid, nthr);
    cvt_flat_fp8(p.expert_v, p.ws + WS_EV, (size_t)16384 * 1024 / 16, ESCALE, gtid, nthr);
}
__device__ __forceinline__ void phase_topk(const Params& p, LAS unsigned char* lds, int G, int bid, int wave, int lane) {
    const bf16* QP = (const bf16*)(p.ws + WS_BIG + B_QP); const bf16* SK = (const bf16*)(p.ws + WS_SUBK);
    int* SEL = (int*)(p.ws + WS_BIG + B_SEL); float* GATE = (float*)(p.ws + WS_BIG + B_GATE);
    const int gw = bid * NWAVES + wave, NGW = G * NWAVES, l31 = lane & 31, half = lane >> 5;
    LAS int* tab = (LAS int*)(lds + wave * 12288) + l31 * 32;
    LAS unsigned char* qst = lds + wave * 12288 + 4096 + lane * 16;
    LAS unsigned char* skl = lds + 8 * 12288;
    const float* ctab = (wave < 4) ? p.expert_u : p.expert_v; unsigned char* cdst = p.ws + ((wave < 4) ? WS_EU : WS_EV);
    const int tid_ = wave * 64 + lane;
    for (int sbk = bid; sbk < 256; sbk += G)
    for (int rnd = 0; rnd < 2; ++rnd) {
        const int tg = 8 * (sbk >> 2) + wave, h = 2 * (sbk & 3) + rnd, t = tg * 32 + l31;
        unsigned lists[2][16];
#pragma unroll
        for (int m = 0; m < 2; ++m) {
            f32x16 acc[4];
#pragma unroll
            for (int kb = 0; kb < 4; ++kb)
#pragma unroll
                for (int r = 0; r < 16; ++r) acc[kb][r] = 0.f;
            const bf16* qp = QP + (size_t)t * 2048 + h * 256 + m * 128 + 8 * half;
            { const bf16* sks = SK + (size_t)(h * 2 + m) * 128 * 128;
#pragma unroll
              for (int jj = 0; jj < 4; ++jj) { const int c = tid_ + 512 * jj, row = c >> 4, ch = c & 15;
                  *(LAS u32x4*)(skl + row * 272 + ch * 16) = *(const u32x4*)(sks + row * 128 + ch * 8); } }
            __syncthreads();
            const size_t cbase = ((size_t)(sbk * 4 + (wave & 3)) * 1024 + (size_t)(rnd * 2 + m) * 256 + lane) * 16;
#define CAST_SLICE() do { _Pragma("unroll") for (int j = 0; j < 4; ++j) { const size_t o_ = cbase + (size_t)j * 64 * 16; u32x4 w_; \
                _Pragma("unroll") for (int q = 0; q < 4; ++q) { const f32x4 a_ = *(const f32x4*)(ctab + o_ + 4 * q) * ESCALE; int x_ = 0; \
                    x_ = __builtin_amdgcn_cvt_pk_fp8_f32(a_[0], a_[1], x_, false); x_ = __builtin_amdgcn_cvt_pk_fp8_f32(a_[2], a_[3], x_, true); w_[q] = (unsigned)x_; } \
                *(u32x4*)(cdst + o_) = w_; } } while (0)
            if (wave < 4) CAST_SLICE();
            const LAS unsigned char* kl = skl + l31 * 272 + half * 16;
            { u32x4 tq[8];
#pragma unroll
              for (int s = 0; s < 8; ++s) tq[s] = *(const u32x4*)(qp + 16 * s);
#pragma unroll
              for (int s = 0; s < 8; ++s) *(LAS u32x4*)(qst + s * 1024) = tq[s]; }
#pragma unroll 2
            for (int s = 0; s < 8; ++s) {
                const bf16x8 bq = *(const LAS bf16x8*)(qst + s * 1024);
#pragma unroll
                for (int kb = 0; kb < 4; ++kb) { const bf16x8 ak = *(const LAS bf16x8*)(kl + kb * 32 * 272 + s * 32); acc[kb] = __builtin_amdgcn_mfma_f32_32x32x16_bf16(ak, bq, acc[kb], 0, 0, 0); }
            }
            unsigned top[16], oth[16];
#pragma unroll
            for (int kb = 0; kb < 4; ++kb) {
#pragma unroll
                for (int r = 0; r < 16; ++r) { const int kidx = 32 * kb + (r & 3) + 8 * (r >> 2) + 4 * half; oth[r] = (mono(acc[kb][r]) & ~127u) | (unsigned)(127 - kidx); }
                sort16(oth);
                if (kb == 0) {
#pragma unroll
                    for (int i = 0; i < 16; ++i) top[i] = oth[i];
                } else merge16(top, oth);
            }
#pragma unroll
            for (int i = 0; i < 16; ++i) oth[i] = (unsigned)__shfl_xor((int)top[i], 32);
            merge16(top, oth);
#pragma unroll
            for (int i = 0; i < 16; ++i) lists[m][i] = top[i];
            if (wave >= 4) CAST_SLICE();
#undef CAST_SLICE
            __syncthreads();
        }
        float va[16], vb[16];
#pragma unroll
        for (int i = 0; i < 16; ++i) { va[i] = unmono(lists[0][i] & ~127u); vb[i] = unmono(lists[1][i] & ~127u);
            tab[i] = 127 - (int)(lists[0][i] & 127u); tab[16 + i] = 127 - (int)(lists[1][i] & 127u); }
#define CKEY(i, j) ((mono(va[i] + vb[j]) & ~255u) | (unsigned)(255 - ((i) * 16 + (j))))
        unsigned ct[16], l1[16], l2[16], l3[16];
#pragma unroll
        for (int j = 0; j < 16; ++j) ct[j] = CKEY(0, j);
#pragma unroll
        for (int j = 0; j < 8; ++j) l1[j] = CKEY(1, j);
#pragma unroll
        for (int j = 0; j < 5; ++j) l1[8 + j] = CKEY(2, j);
        l1[13] = 0u; l1[14] = 0u; l1[15] = 0u;
#pragma unroll
        for (int j = 0; j < 4; ++j) l2[j] = CKEY(3, j);
#pragma unroll
        for (int j = 0; j < 3; ++j) l2[4 + j] = CKEY(4, j);
#pragma unroll
        for (int j = 0; j < 2; ++j) { l2[7 + j] = CKEY(5, j); l2[9 + j] = CKEY(6, j); l2[11 + j] = CKEY(7, j); }
        l2[13] = 0u; l2[14] = 0u; l2[15] = 0u;
#pragma unroll
        for (int i = 0; i < 8; ++i) { l3[i] = CKEY(8 + i, 0); l3[8 + i] = 0u; }
#undef CKEY
        sort16(l1); sort16(l2); sort16(l3);
        merge16(ct, l1); merge16(l2, l3); merge16(ct, l2);
        LDS_WAIT(); __builtin_amdgcn_wave_barrier();
        const float s0 = unmono(ct[0] & ~255u);
        float ev[16], es = 0.f; int ex[16];
#pragma unroll
        for (int r = 0; r < 16; ++r) { const int pos = 255 - (int)(ct[r] & 255u); ev[r] = __expf(unmono(ct[r] & ~255u) - s0); es += ev[r];
            ex[r] = tab[pos >> 4] * 128 + tab[16 + (pos & 15)]; }
        const float ie = 1.f / es;
        int* so = SEL + (size_t)t * 128 + h * 16; float* go = GATE + (size_t)t * 128 + h * 16;
        if (half == 0) {
#pragma unroll
            for (int r = 0; r < 8; ++r) { so[r] = ex[r]; go[r] = ev[r] * ie; }
        } else {
#pragma unroll
            for (int r = 8; r < 16; ++r) { so[r] = ex[r]; go[r] = ev[r] * ie; }
        }
        LDS_WAIT(); __builtin_amdgcn_wave_barrier();
    }
}

__device__ __forceinline__ float gelu_as(float v) {
    const float av = fabsf(v), t = __builtin_amdgcn_rcpf(av * 0.2316418882f + 1.0f);
    float q = t * 0.5307027145f + (-0.7265760135f); q = q * t + 0.7107068705f; q = q * t + (-0.142248368f); q = q * t + 0.127414796f; q = q * t;
    const float e = __builtin_amdgcn_exp2f((v * v) * (-0.72134752044f)), m = v * (q * e);
    return v < 0.f ? m : v - m;
}
constexpr int KT = 4;
constexpr int GW_LDS = 17152;
constexpr int UPITCH = 272, USTG = 16 * UPITCH;
static_assert(KT == 4, "LDS map of the gather phase is laid out for 4 tokens per wave");
__device__ __forceinline__ void phase_gather(const Params& p, LAS unsigned char* lds, int G, int bid, int wave, int lane) {
    const int* SEL = (const int*)(p.ws + WS_BIG + B_SEL); const float* GATE = (const float*)(p.ws + WS_BIG + B_GATE);
    const unsigned char* EU = p.ws + WS_EU; const unsigned char* EV = p.ws + WS_EV;
    float* H2 = p.out;
    const int gw = bid * NWAVES + wave, NGW = G * NWAVES, l15 = lane & 15, g4 = lane >> 4;
    LAS unsigned char* wl = lds + wave * GW_LDS;
    LAS unsigned char* xnb = wl; LAS int* selb = (LAS int*)(wl + 4096); LAS float* gateb = (LAS float*)(wl + 6144); LAS float* hb = (LAS float*)(wl + 8192); LAS unsigned char* ustg = wl + 8448;
    for (int tb = gw * KT; tb < T; tb += NGW * KT) {
#pragma unroll 1
        for (int k = 0; k < KT; ++k) {
            const int t = tb + k;
            const float* hrow = H2 + (size_t)t * DM + 16 * lane;
            f32x4 hv[4];
#pragma unroll
            for (int j = 0; j < 4; ++j) hv[j] = *(const f32x4*)(hrow + 4 * j);
            const int selA = SEL[(size_t)t * 128 + lane], selB = SEL[(size_t)t * 128 + 64 + lane];
            const float gtA = GATE[(size_t)t * 128 + lane], gtB = GATE[(size_t)t * 128 + 64 + lane];
            float ssq = 0.f;
#pragma unroll
            for (int j = 0; j < 4; ++j) ssq += (hv[j][0] * hv[j][0] + hv[j][1] * hv[j][1]) + (hv[j][2] * hv[j][2] + hv[j][3] * hv[j][3]);
            const float r2 = rsqrtf(wave_sum(ssq) * (1.f / DM) + EPS);
            { u32x4 o;
#pragma unroll
              for (int j = 0; j < 4; ++j) { const f32x4 a = hv[j] * r2 * *(const f32x4*)(p.norm2_g + 16 * lane + 4 * j); int w = 0;
                  w = __builtin_amdgcn_cvt_pk_fp8_f32(a[0], a[1], w, false); w = __builtin_amdgcn_cvt_pk_fp8_f32(a[2], a[3], w, true); o[j] = (unsigned)w; }
              *(LAS u32x4*)(xnb + k * 1024 + 16 * lane) = o; }
            const int bA = selA >> 10, bB = selB >> 10; int posA = 0, posB = 0, off = 0;
#pragma unroll
            for (int b = 0; b < 16; ++b) {
                const unsigned long long mA = __ballot(bA == b), mB = __ballot(bB == b);
                const int cA = __popcll(mA), cB = __popcll(mB);
                const int rA = (int)__builtin_amdgcn_mbcnt_hi((unsigned)(mA >> 32), __builtin_amdgcn_mbcnt_lo((unsigned)mA, 0u));
                const int rB = (int)__builtin_amdgcn_mbcnt_hi((unsigned)(mB >> 32), __builtin_amdgcn_mbcnt_lo((unsigned)mB, 0u));
                if (bA == b) posA = off + rA;
                if (bB == b) posB = off + cA + rB;
                off += cA + cB;
            }
            selb[k * 128 + posA] = selA; gateb[k * 128 + posA] = gtA; selb[k * 128 + posB] = selB; gateb[k * 128 + posB] = gtB;
        }
        LDS_WAIT(); __builtin_amdgcn_wave_barrier();
        f32x2_t y[KT][8];
#pragma unroll
        for (int k = 0; k < KT; ++k)
#pragma unroll
            for (int i = 0; i < 8; ++i) y[k][i] = (f32x2_t){0.f, 0.f};
#pragma unroll 1
        for (int g = 0; g < 8; ++g) {
#pragma unroll
            for (int k = 0; k < KT; ++k) {
                asm volatile("" ::: "memory");
                f32x4 acc = (f32x4){0.f, 0.f, 0.f, 0.f};
                const int rr = lane >> 4, cc = lane & 15;
                const unsigned char* rp[4];
#pragma unroll
                for (int i = 0; i < 4; ++i) rp[i] = EU + (size_t)selb[k * 128 + 16 * g + 4 * i + rr] * DM + 16 * cc;
                u32x4 ld[4];
#pragma unroll
                for (int i = 0; i < 4; ++i) ld[i] = *(const u32x4*)(rp[i]);
#pragma unroll
                for (int qd = 0; qd < 4; ++qd) {
                    LAS unsigned char* sb = ustg + (qd & 1) * USTG;
#pragma unroll
                    for (int i = 0; i < 4; ++i) *(LAS u32x4*)(sb + (4 * i + rr) * UPITCH + 16 * cc) = ld[i];
                    if (qd < 3) {
#pragma unroll
                        for (int i = 0; i < 4; ++i) ld[i] = *(const u32x4*)(rp[i] + 256 * (qd + 1));
                    }
                    LDS_WAIT(); __builtin_amdgcn_wave_barrier();
                    const LAS unsigned char* ar = sb + l15 * UPITCH + 64 * g4;
                    const LAS unsigned char* xk = xnb + k * 1024 + 256 * qd + 64 * g4;
#pragma unroll
                    for (int i = 0; i < 4; ++i) { const u32x4 a = *(const LAS u32x4*)(ar + 16 * i); const u32x4 bx = *(const LAS u32x4*)(xk + 16 * i);
                        const long a0 = (long)(((unsigned long long)a.y << 32) | a.x), a1 = (long)(((unsigned long long)a.w << 32) | a.z);
                        const long b0 = (long)(((unsigned long long)bx.y << 32) | bx.x), b1 = (long)(((unsigned long long)bx.w << 32) | bx.z);
                        acc = __builtin_amdgcn_mfma_f32_16x16x32_fp8_fp8(a0, b0, acc, 0, 0, 0);
                        acc = __builtin_amdgcn_mfma_f32_16x16x32_fp8_fp8(a1, b1, acc, 0, 0, 0); }
                }
                if (l15 == 0) {
#pragma unroll
                    for (int j = 0; j < 4; ++j) { const float a = acc[j] * (1.f / ESCALE);
                        hb[k * 16 + 4 * g4 + j] = gelu_as(a) * gateb[k * 128 + 16 * g + 4 * g4 + j] * (1.f / ESCALE); }
                }
            }
            LDS_WAIT(); __builtin_amdgcn_wave_barrier();
#pragma unroll
            for (int k = 0; k < KT; ++k) {
                asm volatile("" ::: "memory");
                u32x4 vr[2][4];
#pragma unroll
                for (int i = 0; i < 4; ++i) vr[0][i] = *(const u32x4*)(EV + (size_t)selb[k * 128 + 16 * g + i] * DM + 16 * lane);
#pragma unroll
                for (int bt = 0; bt < 4; ++bt) {
                    if (bt < 3) {
#pragma unroll
                        for (int i = 0; i < 4; ++i) vr[(bt + 1) & 1][i] = *(const u32x4*)(EV + (size_t)selb[k * 128 + 16 * g + 4 * (bt + 1) + i] * DM + 16 * lane);
                    }
                    asm volatile("" ::: "memory");
#pragma unroll
                    for (int i = 0; i < 4; ++i) { const float hs = hb[k * 16 + 4 * bt + i]; const u32x4 v = vr[bt & 1][i];
#pragma unroll
                        for (int q = 0; q < 4; ++q) { const f32x2_t lo = __builtin_amdgcn_cvt_pk_f32_fp8((int)v[q], false), hi = __builtin_amdgcn_cvt_pk_f32_fp8((int)v[q], true);
                            y[k][2 * q] += lo * hs; y[k][2 * q + 1] += hi * hs; } }
                }
            }
            LDS_WAIT(); __builtin_amdgcn_wave_barrier();
        }
#pragma unroll
        for (int k = 0; k < KT; ++k) {
            float* hrow = H2 + (size_t)(tb + k) * DM + 16 * lane;
            f32x4 h3[4]; float s3 = 0.f;
#pragma unroll
            for (int j = 0; j < 4; ++j) { const f32x4 hv = *(const f32x4*)(hrow + 4 * j);
                h3[j][0] = hv[0] + y[k][2 * j][0]; h3[j][1] = hv[1] + y[k][2 * j][1]; h3[j][2] = hv[2] + y[k][2 * j + 1][0]; h3[j][3] = hv[3] + y[k][2 * j + 1][1];
                s3 += (h3[j][0] * h3[j][0] + h3[j][1] * h3[j][1]) + (h3[j][2] * h3[j][2] + h3[j][3] * h3[j][3]); }
            const float r3 = rsqrtf(wave_sum(s3) * (1.f / DM) + EPS);
#pragma unroll
            for (int j = 0; j < 4; ++j) *(f32x4*)(hrow + 4 * j) = h3[j] * r3 * *(const f32x4*)(p.final_g + 16 * lane + 4 * j);
        }
        LDS_WAIT(); __builtin_amdgcn_wave_barrier();
    }
}

#define XB_TMO      128
#define XB_XCNT(j)  (256  + 64 * (j))
#define XB_XSUB(j)  (1280 + 64 * (j))
#define XB_XGEN(j)  (2304 + 64 * (j))
#define XB_TOP      3328
#define XB_TOPGEN   3392
#define XCD_BAR_WORDS 3456
#define XB_SPIN_CAP (1u << 18)

__device__ __forceinline__ unsigned xb_ld(unsigned* p)              { return __hip_atomic_load(p, __ATOMIC_RELAXED, __HIP_MEMORY_SCOPE_AGENT); }
__device__ __forceinline__ unsigned xb_add(unsigned* p, unsigned v) { return __hip_atomic_fetch_add(p, v, __ATOMIC_RELAXED, __HIP_MEMORY_SCOPE_AGENT); }
__device__ __forceinline__ unsigned xb_xcc_id() { return (unsigned)__builtin_amdgcn_s_getreg((3 << 11) | 20) & 0xFu; }
#define XB_SPIN(cond, bar) do { unsigned _sp = 0; while (cond) { __builtin_amdgcn_s_sleep(1); \
    if ((++_sp & 255u) == 0u) { if (xb_ld(&(bar)[XB_TMO])) break; if (_sp > XB_SPIN_CAP) { atomicAdd(&(bar)[XB_TMO], 1u); break; } } } } while (0)

struct XcdBarrier {
    unsigned* bar; unsigned x;
    volatile LAS unsigned* st;
};

__device__ __forceinline__ XcdBarrier xcd_barrier_post(unsigned* bar, volatile LAS unsigned* st) {
    XcdBarrier b; b.bar = bar; b.x = xb_xcc_id(); b.st = st;
    if (threadIdx.x == 0) (void)xb_add(&bar[XB_XCNT(b.x)], 1u);
    return b;
}
__device__ __forceinline__ void xcd_barrier_complete(unsigned* bar, unsigned x, unsigned& nloc, unsigned& nx) {
    const unsigned G = gridDim.x * gridDim.y * gridDim.z;
    unsigned sum, cnt, mine, sp = 0u;
    for (;;) {
        sum = 0u; cnt = 0u; mine = 0u;
#pragma unroll
        for (unsigned j = 0; j < 16; ++j) { const unsigned c = xb_ld(&bar[XB_XCNT(j)]); sum += c; cnt += (c > 0u) ? 1u : 0u; mine = (j == x) ? c : mine; }
        if (sum == G) break;
        __builtin_amdgcn_s_sleep(1);
        if ((++sp & 255u) == 0u) { if (xb_ld(&bar[XB_TMO])) break; if (sp > XB_SPIN_CAP) { atomicAdd(&bar[XB_TMO], 1u); break; } }
    }
    nloc = mine > 0u ? mine : 1u; nx = cnt > 0u ? cnt : 1u;
}

__device__ __forceinline__ void xcd_barrier(const XcdBarrier& b) {
    asm volatile("s_waitcnt vmcnt(0)" ::: "memory");
    __syncthreads();
    if (threadIdx.x == 0) {
        unsigned* bar = b.bar;
        __builtin_amdgcn_s_waitcnt(0);
        unsigned nloc = b.st[0], nx = b.st[1];
        if (nloc == 0u) { xcd_barrier_complete(bar, b.x, nloc, nx); b.st[0] = nloc; b.st[1] = nx; }
        const unsigned old = xb_add(&bar[XB_XSUB(b.x)], 1u);
        const unsigned gen = old / nloc;
        if (old + 1u == (gen + 1u) * nloc) {
            __builtin_amdgcn_fence(__ATOMIC_RELEASE, "agent");
            asm volatile("s_waitcnt vmcnt(0)" ::: "memory");
            const unsigned og = xb_add(&bar[XB_TOP], 1u);
            const unsigned tg = og / nx;
            if (og + 1u == (tg + 1u) * nx) xb_add(&bar[XB_TOPGEN], 1u);
            else XB_SPIN(xb_ld(&bar[XB_TOPGEN]) == tg, bar);
            __builtin_amdgcn_fence(__ATOMIC_ACQUIRE, "agent");
            xb_add(&bar[XB_XGEN(b.x)], 1u);
            asm volatile("s_waitcnt vmcnt(0)" ::: "memory");
        } else {
            XB_SPIN(xb_ld(&bar[XB_XGEN(b.x)]) == gen, bar);
            __builtin_amdgcn_fence(__ATOMIC_ACQUIRE, "agent");
            asm volatile("s_waitcnt vmcnt(0)" ::: "memory");
        }
    }
    __syncthreads();
}

#ifndef ONE_LAUNCH
#define ONE_LAUNCH 1
#endif
constexpr int NPHASE = 8;
__global__ void __launch_bounds__(NTHR, 2) hybrid_fwd(Params p) {
    extern __shared__ __attribute__((aligned(16))) unsigned char lds_raw[];
    LAS unsigned char* lds = (LAS unsigned char*)lds_raw;
    const int tid = threadIdx.x, lane = tid & 63, wave = __builtin_amdgcn_readfirstlane(tid >> 6), G = gridDim.x, bid = blockIdx.x;
    unsigned char* ws = p.ws;
    volatile LAS unsigned* xst = (volatile LAS unsigned*)(lds + 139264);
    if (tid < 2) xst[tid] = 0u;
    __syncthreads();
    XcdBarrier xbar; xbar.bar = (unsigned*)(ws + WS_END); xbar.x = 0; xbar.st = xst;
    if (ONE_LAUNCH && p.hi - p.lo > 1) {
        if (bid == 0) { for (int i = tid; i < XCD_BAR_WORDS; i += NTHR) __hip_atomic_store((unsigned*)(ws + WS_END) + i, 0u, __ATOMIC_RELAXED, __HIP_MEMORY_SCOPE_AGENT); }
        cg::this_grid().sync();
        xbar = xcd_barrier_post((unsigned*)(ws + WS_END), xst);
    }
    const pg8::bf16_t* N1 = (const pg8::bf16_t*)p.out;
#ifdef ONLY
#define PH(k) if ((k) == ONLY && p.lo <= (k) && (k) < p.hi)
#else
#define PH(k) if (p.lo <= (k) && (k) < p.hi)
#endif
#define SEAM(k) do { if (ONE_LAUNCH && p.lo <= (k) && (k) + 1 < p.hi) { xcd_barrier(xbar); } } while (0)
#define FRESH_IDS int tid = threadIdx.x; asm volatile("" : "+v"(tid)); const int lane = tid & 63, wave = __builtin_amdgcn_readfirstlane(tid >> 6); (void)lane; (void)wave
    unsigned char* big = ws + WS_BIG;
    PH(0) { FRESH_IDS; phase0(p, lds, G, bid, wave, lane); SEAM(0); }
    PH(1) { FRESH_IDS; pg8::Gemm g{N1, (const pg8::bf16_t*)(ws + WS_WIN), T, 8192, 1024, 2048, 1024}; pg8::StaticOrder S; S.init(T, 8192, G, bid);
        pg8::EpiG1 E{(pg8::bf16_t*)(big + B_QKV), (pg8::bf16_t*)(big + B_GG), (pg8::bf16_t*)p.out + 1024, (pg8::bf16_t*)(big + B_PR), C2};
        pg8::gemm_phase<pg8::EpiG1, pg8::StaticOrder, true, true>(lds, g, S, E); SEAM(1); }
    PH(2) { FRESH_IDS; phase_attn(p, lds, G, bid, tid); phase_conv(p, G, bid, tid); SEAM(2); }
    PH(3) { FRESH_IDS; pg8::Gemm g{(const pg8::bf16_t*)p.out, (const pg8::bf16_t*)(ws + WS_WAC), T, 1024, 1024, 2048, 2048}; pg8::SplitKOrder S; S.base.init(T, 1024, G, bid);
        pg8::EpiMerged E{(const pg8::bf16_t*)(big + B_GG), (pg8::bf16_t*)(big + B_MG)};
        pg8::gemm_phase<pg8::EpiMerged, pg8::SplitKOrder, true, true>(lds, g, S, E); SEAM(3); }
    PH(4) { FRESH_IDS; pg8::Gemm g{(const pg8::bf16_t*)(big + B_MG), (const pg8::bf16_t*)(ws + WS_WOUT), T, 1024, 1024, 1024, 1024}; pg8::StaticOrder S; S.init(T, 1024, G, bid);
        pg8::EpiResid E{p.x, p.out, (pg8::bf16_t*)(big + B_H2B), (float*)(ws + WS_SSQ)};
        pg8::gemm_phase<pg8::EpiResid, pg8::StaticOrder, false, true>(lds, g, S, E); SEAM(4); }
    PH(5) { FRESH_IDS; pg8::Gemm g{(const pg8::bf16_t*)(big + B_H2B), (const pg8::bf16_t*)(ws + WS_WQ), T, 2048, 1024, 1024, 1024}; pg8::StaticOrder S; S.init(T, 2048, G, bid);
        pg8::EpiRowScale E{(const float*)(ws + WS_SSQ), (pg8::bf16_t*)(big + B_QP)};
        pg8::gemm_phase<pg8::EpiRowScale, pg8::StaticOrder, true, true>(lds, g, S, E); SEAM(5); }
    PH(6) { FRESH_IDS; phase_topk(p, lds, G, bid, wave, lane); SEAM(6); }
    PH(7) { FRESH_IDS; phase_gather(p, lds, G, bid, wave, lane); }
#undef PH
#undef SEAM
}

extern "C" void kernel_launch(void* const* d_in, const int* in_sizes, int n_in, void* d_out, int out_size, void* d_ws, size_t ws_size, hipStream_t stream) {
    static int grid = 0;
    if (grid == 0) {
        if (n_in != 15 || out_size != T * DM || ws_size < WS_END) { fprintf(stderr, "kernel_launch: unexpected problem (n_in %d out %d ws %zu)\n", n_in, out_size, ws_size); grid = -1; return; }
        int dev = 0, cus = 0, per_cu = 0;
        hipGetDevice(&dev); hipDeviceGetAttribute(&cus, hipDeviceAttributeMultiprocessorCount, dev);
        if (hipFuncSetAttribute((const void*)hybrid_fwd, hipFuncAttributeMaxDynamicSharedMemorySize, LDS_BYTES) != hipSuccess) { fprintf(stderr, "kernel_launch: hipFuncSetAttribute failed\n"); grid = -1; return; }
        if (hipOccupancyMaxActiveBlocksPerMultiprocessor(&per_cu, (const void*)hybrid_fwd, NTHR, LDS_BYTES) != hipSuccess || per_cu < 1) { fprintf(stderr, "kernel_launch: occupancy query says %d\n", per_cu); per_cu = 1; }
        (void)hipGetLastError();
        grid = cus * per_cu;
    }
    if (grid < 0) return;
    Params p{};
    p.x = (const float*)d_in[0]; p.norm1_g = (const float*)d_in[1]; p.w_in = (const float*)d_in[2]; p.lambda_qk = (const float*)d_in[3]; p.subln_g = (const float*)d_in[4];
    p.conv_w = (const float*)d_in[5]; p.w_attn_o = (const float*)d_in[6]; p.w_conv_o = (const float*)d_in[7]; p.w_out = (const float*)d_in[8]; p.norm2_g = (const float*)d_in[9];
    p.w_query = (const float*)d_in[10]; p.sub_keys = (const float*)d_in[11]; p.expert_u = (const float*)d_in[12]; p.expert_v = (const float*)d_in[13]; p.final_g = (const float*)d_in[14];
    p.out = (float*)d_out; p.ws = (unsigned char*)d_ws;
#if ONE_LAUNCH
    p.lo = 0; p.hi = NPHASE;
    void* args[] = {&p};
    hipError_t e = hipLaunchCooperativeKernel((const void*)hybrid_fwd, dim3(grid), dim3(NTHR), args, LDS_BYTES, stream);
    if (e != hipSuccess) fprintf(stderr, "cooperative launch failed: %s (grid %d)\n", hipGetErrorString(e), grid);
#else
    for (int k = 0; k < NPHASE; ++k) {
        p.lo = k; p.hi = k + 1; hipLaunchKernelGGL(hybrid_fwd, dim3(grid), dim3(NTHR), LDS_BYTES, stream, p); }
#endif
}
```

```cpp
#include <hip/hip_runtime.h>
#include <hip/hip_cooperative_groups.h>
#include <cstdio>
#include <cstdint>
namespace cg = cooperative_groups;
namespace pg8 {
#define PG8_LAS __attribute__((address_space(3)))
typedef unsigned short bf16_t;
typedef short bf16x8 __attribute__((ext_vector_type(8)));
typedef float f32x4 __attribute__((ext_vector_type(4)));
typedef unsigned u32x4 __attribute__((ext_vector_type(4)));
constexpr int BM = 256, BK = 64, HALF = 128, HTB = HALF * BK * 2  , STAGE_BYTES = 8 * HTB, NXCD = 8, WGM = 8;

__host__ __device__ __forceinline__ int lds_byte(int r, int c) { const int st = (r >> 4) * 2 + (c >> 5), rr = r & 15, cc = c & 31, ob = rr * 64 + cc * 2; return st * 1024 + (ob ^ (((ob >> 9) & 1) << 5)); }
__host__ __device__ __forceinline__ void stage_rc(int b, int& R, int& C) { const int st = b / 1024, sb = b % 1024, swz = sb ^ (((sb >> 9) & 1) << 5); R = (st >> 1) * 16 + swz / 64; C = (st & 1) * 32 + (swz % 64) / 2; }
__host__ __device__ __forceinline__ int perm32(int rho) { const int n = rho >> 4, i = rho & 15; return 8 * (i >> 2) + 4 * n + (i & 3); }

struct Unit { int pm, pn, kh; };
struct Gemm { const bf16_t* A; const bf16_t* Bt; int M, N, K, lda, ldb; };
struct StaticOrder {
    int nM, nN, nwg, G, c;
    __host__ __device__ void init(int M, int N, int G_, int c_) { nM = M / BM; nN = N / BM; nwg = nM * nN; G = G_; c = c_; }
    __host__ __device__ bool next(int i, Unit& u) const {
        const long L = (long)i * G + c; if (L >= nwg) return false;
        int wgid = (int)L; { const int q = nwg / NXCD, r = nwg % NXCD, xcd = wgid % NXCD, off = wgid / NXCD; wgid = (xcd < r ? xcd * (q + 1) : r * (q + 1) + (xcd - r) * q) + off; }
        const int nig = WGM * nN, gid = wgid / nig, fm = gid * WGM, gsz = (nM - fm) < WGM ? (nM - fm) : WGM;
        u.pm = fm + ((wgid % nig) % gsz); u.pn = (wgid % nig) / gsz; u.kh = 0; return true;
    }
    __device__ __forceinline__ void a_ready(const Unit&) const {}
    __device__ __forceinline__ void done(const Unit&) const {}
};
struct SplitKOrder {
    StaticOrder base;
    __host__ __device__ bool next(int i, Unit& u) const { if (!base.next(i >> 1, u)) return false; u.kh = i & 1; return true; }
    __device__ __forceinline__ void a_ready(const Unit&) const {}
    __device__ __forceinline__ void done(const Unit&) const {}
};
__device__ __forceinline__ unsigned cvt_pk_bf16(float lo, float hi) { unsigned r; asm volatile("v_cvt_pk_bf16_f32 %0, %1, %2" : "=v"(r) : "v"(lo), "v"(hi)); return r; }
typedef float f32x2 __attribute__((ext_vector_type(2)));
typedef float f32x2 __attribute__((ext_vector_type(2)));
typedef unsigned u32x2 __attribute__((ext_vector_type(2)));
__device__ __forceinline__ void unpack8(const u32x4 w, float (&f)[8]) {
    f[0] = __builtin_bit_cast(float, w.x << 16); f[1] = __builtin_bit_cast(float, w.x & 0xffff0000u);
    f[2] = __builtin_bit_cast(float, w.y << 16); f[3] = __builtin_bit_cast(float, w.y & 0xffff0000u);
    f[4] = __builtin_bit_cast(float, w.z << 16); f[5] = __builtin_bit_cast(float, w.z & 0xffff0000u);
    f[6] = __builtin_bit_cast(float, w.w << 16); f[7] = __builtin_bit_cast(float, w.w & 0xffff0000u);
}
__device__ __forceinline__ u32x4 pack8(const f32x4 v0, const f32x4 v1) { u32x4 w; w.x = cvt_pk_bf16(v0[0], v0[1]); w.y = cvt_pk_bf16(v0[2], v0[3]); w.z = cvt_pk_bf16(v1[0], v1[1]); w.w = cvt_pk_bf16(v1[2], v1[3]); return w; }
struct EpiPlain {
    static constexpr bool PERM = true, AFTER_DRAIN = false, MID = false;
    bf16_t* O; int ldc;
    __device__ __forceinline__ void operator()(const f32x4 (&acc)[2][2][4][2], const Unit& u, int wr, int wc, int fr, int fq) const {
        const int row0 = u.pm * BM + wr * 64 + fr, col0 = u.pn * BM + wc * 32 + 8 * fq;
#pragma unroll
        for (int ai = 0; ai < 2; ++ai)
#pragma unroll
            for (int m = 0; m < 4; ++m) { bf16_t* rowp = O + (size_t)(row0 + ai * HALF + m * 16) * ldc + col0;
#pragma unroll
                for (int bj = 0; bj < 2; ++bj) *(u32x4*)(rowp + bj * HALF) = pack8(acc[ai][bj][m][0], acc[ai][bj][m][1]); }
    }
};
struct EpiQKVG {
    static constexpr bool PERM = true, AFTER_DRAIN = false, MID = false;
    bf16_t* QKV; bf16_t* GG; float c2;
    __device__ __forceinline__ void operator()(const f32x4 (&acc)[2][2][4][2], const Unit& u, int wr, int wc, int fr, int fq) const {
        int colt = u.pn * BM; bf16_t* base = QKV; int ldc = 3072; float sc = 1.f; bool sig = false;
        if (colt < 1024) sc = c2; else if (colt >= 3072) { base = GG; ldc = 2048; colt -= 3072; sig = true; }
        const int row0 = u.pm * BM + wr * 64 + fr, col0 = colt + wc * 32 + 8 * fq;
#pragma unroll
        for (int ai = 0; ai < 2; ++ai)
#pragma unroll
            for (int m = 0; m < 4; ++m) { bf16_t* rowp = base + (size_t)(row0 + ai * HALF + m * 16) * ldc + col0;
#pragma unroll
                for (int bj = 0; bj < 2; ++bj) { f32x4 v0 = acc[ai][bj][m][0], v1 = acc[ai][bj][m][1];
                    if (sig) {
#pragma unroll
                        for (int i = 0; i < 4; ++i) { v0[i] = __builtin_amdgcn_rcpf(1.f + __expf(-v0[i])); v1[i] = __builtin_amdgcn_rcpf(1.f + __expf(-v1[i])); }
                    } else { v0 = v0 * sc; v1 = v1 * sc; }
                    *(u32x4*)(rowp + bj * HALF) = pack8(v0, v1); } }
    }
};
struct EpiGateA {
    static constexpr bool PERM = true, AFTER_DRAIN = false, MID = false;
    const bf16_t* GG; float* TMP;
    __device__ __forceinline__ void operator()(const f32x4 (&acc)[2][2][4][2], const Unit& u, int wr, int wc, int fr, int fq) const {
        const int row0 = u.pm * BM + wr * 64 + fr, col0 = u.pn * BM + wc * 32 + 8 * fq;
#pragma unroll
        for (int ai = 0; ai < 2; ++ai)
#pragma unroll
            for (int m = 0; m < 4; ++m) { const size_t row = (size_t)(row0 + ai * HALF + m * 16);
#pragma unroll
                for (int bj = 0; bj < 2; ++bj) { const int col = col0 + bj * HALF; float g[8]; unpack8(*(const u32x4*)(GG + row * 2048 + col), g);
                    f32x4 v0 = acc[ai][bj][m][0], v1 = acc[ai][bj][m][1];
                    v0[0] *= g[0]; v0[1] *= g[1]; v0[2] *= g[2]; v0[3] *= g[3]; v1[0] *= g[4]; v1[1] *= g[5]; v1[2] *= g[6]; v1[3] *= g[7];
                    *(f32x4*)(TMP + row * 1024 + col) = v0; *(f32x4*)(TMP + row * 1024 + col + 4) = v1; } }
    }
};
struct EpiGateC {
    static constexpr bool PERM = true, AFTER_DRAIN = false, MID = false;
    const bf16_t* GG; const float* TMP; bf16_t* MG;
    __device__ __forceinline__ void operator()(const f32x4 (&acc)[2][2][4][2], const Unit& u, int wr, int wc, int fr, int fq) const {
        const int row0 = u.pm * BM + wr * 64 + fr, col0 = u.pn * BM + wc * 32 + 8 * fq;
#pragma unroll
        for (int ai = 0; ai < 2; ++ai)
#pragma unroll
            for (int m = 0; m < 4; ++m) { const size_t row = (size_t)(row0 + ai * HALF + m * 16);
#pragma unroll
                for (int bj = 0; bj < 2; ++bj) { const int col = col0 + bj * HALF; float g[8]; unpack8(*(const u32x4*)(GG + row * 2048 + 1024 + col), g);
                    const f32x4 t0 = *(const f32x4*)(TMP + row * 1024 + col), t1 = *(const f32x4*)(TMP + row * 1024 + col + 4);
                    f32x4 v0 = acc[ai][bj][m][0], v1 = acc[ai][bj][m][1];
                    v0[0] = t0[0] + v0[0] * g[0]; v0[1] = t0[1] + v0[1] * g[1]; v0[2] = t0[2] + v0[2] * g[2]; v0[3] = t0[3] + v0[3] * g[3];
                    v1[0] = t1[0] + v1[0] * g[4]; v1[1] = t1[1] + v1[1] * g[5]; v1[2] = t1[2] + v1[2] * g[6]; v1[3] = t1[3] + v1[3] * g[7];
                    *(u32x4*)(MG + row * 1024 + col) = pack8(v0, v1); } }
    }
};
struct EpiG1 {
    static constexpr bool PERM = true, AFTER_DRAIN = false, MID = false;
    bf16_t* QKV; bf16_t* GG; bf16_t* CB; bf16_t* PR; float c2;
    __device__ __forceinline__ void operator()(const f32x4 (&acc)[2][2][4][2], const Unit& u, int wr, int wc, int fr, int fq) const {
        int colt = u.pn * BM; const int row0 = u.pm * BM + wr * 64 + fr;
        if (colt >= 6144) {
            const int ch0 = (colt - 6144) / 2 + wc * 16 + 4 * fq;
#pragma unroll
            for (int ai = 0; ai < 2; ++ai)
#pragma unroll
                for (int m = 0; m < 4; ++m) { bf16_t* rowp = PR + (size_t)(row0 + ai * HALF + m * 16) * 1024 + ch0;
#pragma unroll
                    for (int bj = 0; bj < 2; ++bj) { const f32x4 v0 = acc[ai][bj][m][0], v1 = acc[ai][bj][m][1];
                        u32x2 w; w.x = cvt_pk_bf16(v0[0] * v0[1], v0[2] * v0[3]); w.y = cvt_pk_bf16(v1[0] * v1[1], v1[2] * v1[3]);
                        *(u32x2*)(rowp + bj * (HALF / 2)) = w; } }
            return;
        }
        bf16_t* base = QKV; int ldc = 3072; float sc = 1.f; bool sig = false;
        if (colt < 1024) sc = c2; else if (colt >= 5120) { base = CB; ldc = 2048; colt -= 5120; } else if (colt >= 3072) { base = GG; ldc = 2048; colt -= 3072; sig = true; }
        const int col0 = colt + wc * 32 + 8 * fq;
#pragma unroll
        for (int ai = 0; ai < 2; ++ai)
#pragma unroll
            for (int m = 0; m < 4; ++m) { bf16_t* rowp = base + (size_t)(row0 + ai * HALF + m * 16) * ldc + col0;
#pragma unroll
                for (int bj = 0; bj < 2; ++bj) { f32x4 v0 = acc[ai][bj][m][0], v1 = acc[ai][bj][m][1];
                    if (sig) {
#pragma unroll
                        for (int i = 0; i < 4; ++i) { v0[i] = __builtin_amdgcn_rcpf(1.f + __expf(-v0[i])); v1[i] = __builtin_amdgcn_rcpf(1.f + __expf(-v1[i])); }
                    } else { v0 = v0 * sc; v1 = v1 * sc; }
                    *(u32x4*)(rowp + bj * HALF) = pack8(v0, v1); } }
    }
};
struct EpiMerged {
    static constexpr bool PERM = true, AFTER_DRAIN = false, MID = true;
    const bf16_t* GG; bf16_t* MG;
    __device__ __forceinline__ void mid(f32x4 (&acc)[2][2][4][2], const Unit& u, int wr, int wc, int fr, int fq) const {
        const int row0 = u.pm * BM + wr * 64 + fr, col0 = u.pn * BM + wc * 32 + 8 * fq;
#pragma unroll
        for (int ai = 0; ai < 2; ++ai)
#pragma unroll
            for (int m = 0; m < 4; ++m) { const size_t row = (size_t)(row0 + ai * HALF + m * 16);
#pragma unroll
                for (int bj = 0; bj < 2; ++bj) { const int col = col0 + bj * HALF; float ga[8], gc[8];
                    unpack8(*(const u32x4*)(GG + row * 2048 + col), ga); unpack8(*(const u32x4*)(GG + row * 2048 + 1024 + col), gc);
#pragma unroll
                    for (int i = 0; i < 4; ++i) { acc[ai][bj][m][0][i] *= ga[i] * __builtin_amdgcn_rcpf(gc[i]); acc[ai][bj][m][1][i] *= ga[4 + i] * __builtin_amdgcn_rcpf(gc[4 + i]); }
                    asm volatile("" ::: "memory"); } }
    }
    __device__ __forceinline__ void operator()(const f32x4 (&acc)[2][2][4][2], const Unit& u, int wr, int wc, int fr, int fq) const {
        const int row0 = u.pm * BM + wr * 64 + fr, col0 = u.pn * BM + wc * 32 + 8 * fq;
#pragma unroll
        for (int ai = 0; ai < 2; ++ai)
#pragma unroll
            for (int m = 0; m < 4; ++m) { const size_t row = (size_t)(row0 + ai * HALF + m * 16);
#pragma unroll
                for (int bj = 0; bj < 2; ++bj) { const int col = col0 + bj * HALF; float gc[8]; unpack8(*(const u32x4*)(GG + row * 2048 + 1024 + col), gc);
                    f32x4 v0 = acc[ai][bj][m][0], v1 = acc[ai][bj][m][1];
#pragma unroll
                    for (int i = 0; i < 4; ++i) { v0[i] *= gc[i]; v1[i] *= gc[4 + i]; }
                    *(u32x4*)(MG + row * 1024 + col) = pack8(v0, v1); } }
    }
};
struct EpiResid {
    static constexpr bool PERM = true, AFTER_DRAIN = false, MID = false;
    const float* X; float* H2; bf16_t* H2B; float* SSQ;
    __device__ __forceinline__ void operator()(const f32x4 (&acc)[2][2][4][2], const Unit& u, int wr, int wc, int fr, int fq) const {
        const int row0 = u.pm * BM + wr * 64 + fr, col0 = u.pn * BM + wc * 32 + 8 * fq;
#pragma unroll
        for (int ai = 0; ai < 2; ++ai)
#pragma unroll
            for (int m = 0; m < 4; ++m) { const size_t row = (size_t)(row0 + ai * HALF + m * 16); float s = 0.f;
#pragma unroll
                for (int bj = 0; bj < 2; ++bj) { const size_t o = row * 1024 + col0 + bj * HALF;
                    const f32x4 v0 = acc[ai][bj][m][0] + *(const f32x4*)(X + o), v1 = acc[ai][bj][m][1] + *(const f32x4*)(X + o + 4);
                    *(f32x4*)(H2 + o) = v0; *(f32x4*)(H2 + o + 4) = v1; *(u32x4*)(H2B + o) = pack8(v0, v1);
                    s += (v0[0] * v0[0] + v0[1] * v0[1]) + (v0[2] * v0[2] + v0[3] * v0[3]) + (v1[0] * v1[0] + v1[1] * v1[1]) + (v1[2] * v1[2] + v1[3] * v1[3]); }
                s += __shfl_xor(s, 16); s += __shfl_xor(s, 32);
                if (fq == 0) SSQ[row * 16 + u.pn * 4 + wc] = s; }
    }
};
struct EpiRowScale {
    static constexpr bool PERM = true, AFTER_DRAIN = false, MID = false;
    const float* SSQ; bf16_t* O;
    __device__ __forceinline__ void operator()(const f32x4 (&acc)[2][2][4][2], const Unit& u, int wr, int wc, int fr, int fq) const {
        const int row0 = u.pm * BM + wr * 64 + fr, col0 = u.pn * BM + wc * 32 + 8 * fq;
#pragma unroll
        for (int ai = 0; ai < 2; ++ai)
#pragma unroll
            for (int m = 0; m < 4; ++m) { const size_t row = (size_t)(row0 + ai * HALF + m * 16);
                const f32x4* sp = (const f32x4*)(SSQ + row * 16); const f32x4 a = sp[0] + sp[1], b = sp[2] + sp[3], c = a + b;
                const float rs = rsqrtf(((c[0] + c[1]) + (c[2] + c[3])) * (1.f / 1024.f) + 1e-6f);
#pragma unroll
                for (int bj = 0; bj < 2; ++bj) *(u32x4*)(O + row * 2048 + col0 + bj * HALF) = pack8(acc[ai][bj][m][0] * rs, acc[ai][bj][m][1] * rs); }
    }
};
template <class Epi, class Sched, bool ALIGN_EPI = false, bool SP2 = false>
__device__ __forceinline__ void gemm_phase(PG8_LAS unsigned char* lds, const Gemm g, const Sched& S, const Epi& E) {
    const int tid = threadIdx.x, wid = __builtin_amdgcn_readfirstlane(tid >> 6), lane = tid & 63, wr = wid >> 2, wc = wid & 3, fr = lane & 15, fq = lane >> 4;
    const int K = g.K, nt = K / BK;
    unsigned voffA[2], voffB[2];
#pragma unroll
    for (int i = 0; i < 2; ++i) { int R, C; stage_rc(tid * 16 + i * 8192, R, C); const int Rb = Epi::PERM ? ((R & ~31) + perm32(R & 31)) : R;
        voffA[i] = (unsigned)(R * g.lda + C) * 2u; voffB[i] = (unsigned)(Rb * g.ldb + C) * 2u; }
    const size_t kstep = (size_t)(BK * 2);
    const size_t hstep = (size_t)HALF * g.ldb * 2;
    const size_t tstep = 2 * hstep;
    const size_t hstepA = (size_t)HALF * g.lda * 2, tstepA = 2 * hstepA;
    const unsigned ldsw = (unsigned)wid * 1024u;
    const int aoff = lds_byte(wr * 64 + fr, fq * 8), boff = lds_byte(wc * 32 + fr, fq * 8);
#define PG8_SA(b, h) (((b) * 2 + (h)) * HTB)
#define PG8_SB(b, h) ((4 + (b) * 2 + (h)) * HTB)
#define PG8_STAGE(bufoff, gbase, voff) do { _Pragma("unroll") for (int _i = 0; _i < 2; ++_i) \
        __builtin_amdgcn_global_load_lds((const unsigned*)((const char*)(gbase) + (voff)[_i]), (PG8_LAS unsigned*)(lds + (bufoff) + ldsw + _i * 8192), 16, 0, 0); } while (0)
#define PG8_LDA(dst, b, h) do { _Pragma("unroll") for (int m = 0; m < 4; ++m) _Pragma("unroll") for (int k = 0; k < 2; ++k) dst[m][k] = *(const PG8_LAS bf16x8*)(lds + PG8_SA(b, h) + aoff + m * 2048 + k * 1024); } while (0)
#define PG8_LDB(dst, b, h) do { _Pragma("unroll") for (int n = 0; n < 2; ++n) _Pragma("unroll") for (int k = 0; k < 2; ++k) dst[n][k] = *(const PG8_LAS bf16x8*)(lds + PG8_SB(b, h) + boff + n * 2048 + k * 1024); } while (0)
#define PG8_MMA(ai, bj, At, Bt) do { __builtin_amdgcn_s_setprio(1); _Pragma("unroll") for (int m = 0; m < 4; ++m) _Pragma("unroll") for (int n = 0; n < 2; ++n) _Pragma("unroll") for (int k = 0; k < 2; ++k) \
        acc[ai][bj][m][n] = __builtin_amdgcn_mfma_f32_16x16x32_bf16(Bt[n][k], At[m][k], acc[ai][bj][m][n], 0, 0, 0); __builtin_amdgcn_s_setprio(0); } while (0)
#define PG8_WAIT_V(n) asm volatile("s_waitcnt vmcnt(" #n ")" ::: "memory")
#define PG8_WAIT_L(n) asm volatile("s_waitcnt lgkmcnt(" #n ")" ::: "memory")
#define PG8_BAR __builtin_amdgcn_s_barrier()
#define PG8_SCHED __builtin_amdgcn_sched_barrier(0)
    Unit cur, nxt; int ui = 0;
    if (!S.next(0, cur)) return;
    f32x4 acc[2][2][4][2];
#pragma unroll
    for (int a = 0; a < 2; ++a)
#pragma unroll
        for (int b = 0; b < 2; ++b)
#pragma unroll
            for (int m = 0; m < 4; ++m)
#pragma unroll
                for (int n = 0; n < 2; ++n) acc[a][b][m][n] = (f32x4){0.f, 0.f, 0.f, 0.f};
    bf16x8 At[4][2], B0[2][2], B1[2][2];
    const char* cA = (const char*)g.A + (size_t)cur.pm * tstepA + (size_t)cur.kh * K * 2; const char* cB = (const char*)g.Bt + (size_t)cur.pn * tstep + (size_t)cur.kh * K * 2;
    S.a_ready(cur);
    if constexpr (SP2) {
        PG8_STAGE(PG8_SB(0, 0), cB, voffB); PG8_STAGE(PG8_SB(0, 1), cB + hstep, voffB); PG8_STAGE(PG8_SA(0, 0), cA, voffA); PG8_STAGE(PG8_SA(0, 1), cA + hstepA, voffA);
        if (wr == 1) PG8_BAR;
        PG8_WAIT_V(2); PG8_BAR;
        PG8_STAGE(PG8_SB(1, 0), cB + kstep, voffB); PG8_STAGE(PG8_SA(1, 0), cA + kstep, voffA); PG8_STAGE(PG8_SB(1, 1), cB + hstep + kstep, voffB);
        PG8_WAIT_V(6); PG8_BAR;
    } else {
        PG8_STAGE(PG8_SB(0, 0), cB, voffB); PG8_STAGE(PG8_SA(0, 0), cA, voffA); PG8_STAGE(PG8_SB(0, 1), cB + hstep, voffB); PG8_STAGE(PG8_SA(0, 1), cA + hstepA, voffA);
        if (wr == 1) PG8_BAR;
        PG8_WAIT_V(4); PG8_BAR;
        PG8_STAGE(PG8_SB(1, 0), cB + kstep, voffB); PG8_STAGE(PG8_SA(1, 0), cA + kstep, voffA); PG8_STAGE(PG8_SB(1, 1), cB + hstep + kstep, voffB);
        PG8_WAIT_V(6); PG8_BAR;
    }
    for (;;) {
        const bool has_next = S.next(ui + 1, nxt);
        const char* nA = has_next ? (const char*)g.A + (size_t)nxt.pm * tstepA + (size_t)nxt.kh * K * 2 : cA; const char* nB = has_next ? (const char*)g.Bt + (size_t)nxt.pn * tstep + (size_t)nxt.kh * K * 2 : cB;
        for (int t = 0; t < nt; t += 2) {
            const bool last = (t == nt - 2);
            const char* a1 = cA + (size_t)(t + 1) * kstep;
            const char* a2 = last ? nA : cA + (size_t)(t + 2) * kstep; const char* b2 = last ? nB : cB + (size_t)(t + 2) * kstep;
            const char* a3 = a2 + kstep; const char* b3 = b2 + kstep;
            if (last && has_next) S.a_ready(nxt);
            if constexpr (SP2) {
            PG8_LDB(B0, 0, 0); PG8_LDB(B1, 0, 1); PG8_SCHED; PG8_LDA(At, 0, 0); PG8_STAGE(PG8_SA(1, 1), a1 + hstepA, voffA);
            PG8_WAIT_V(8); PG8_WAIT_L(0); PG8_BAR; PG8_MMA(0, 0, At, B0); PG8_MMA(0, 1, At, B1); PG8_BAR; PG8_SCHED;
            PG8_LDA(At, 0, 1); PG8_STAGE(PG8_SB(0, 0), b2, voffB); PG8_STAGE(PG8_SB(0, 1), b2 + hstep, voffB); PG8_STAGE(PG8_SA(0, 0), a2, voffA);
            PG8_WAIT_V(8); PG8_WAIT_L(0); PG8_BAR; PG8_MMA(1, 0, At, B0); PG8_MMA(1, 1, At, B1); PG8_BAR; PG8_SCHED;
            PG8_LDB(B0, 1, 0); PG8_LDB(B1, 1, 1); PG8_SCHED; PG8_LDA(At, 1, 0); PG8_STAGE(PG8_SA(0, 1), a2 + hstepA, voffA);
            PG8_WAIT_V(8); PG8_WAIT_L(0); PG8_BAR; PG8_MMA(0, 0, At, B0); PG8_MMA(0, 1, At, B1); PG8_BAR; PG8_SCHED;
            PG8_LDA(At, 1, 1); PG8_STAGE(PG8_SB(1, 0), b3, voffB); PG8_STAGE(PG8_SB(1, 1), b3 + hstep, voffB); PG8_STAGE(PG8_SA(1, 0), a3, voffA);
            PG8_WAIT_V(8); PG8_WAIT_L(0); PG8_BAR; PG8_MMA(1, 0, At, B0); PG8_MMA(1, 1, At, B1); PG8_BAR; PG8_SCHED;
            } else {
            PG8_LDB(B0, 0, 0); PG8_SCHED; PG8_LDA(At, 0, 0); PG8_STAGE(PG8_SA(1, 1), a1 + hstepA, voffA);
            PG8_WAIT_L(8); PG8_BAR; PG8_WAIT_L(0); PG8_MMA(0, 0, At, B0); PG8_BAR; PG8_SCHED;
            PG8_LDB(B1, 0, 1); PG8_STAGE(PG8_SB(0, 0), b2, voffB);
            PG8_BAR; PG8_WAIT_L(0); PG8_MMA(0, 1, At, B1); PG8_BAR;
            PG8_LDA(At, 0, 1); PG8_STAGE(PG8_SA(0, 0), a2, voffA);
            PG8_BAR; PG8_WAIT_L(0); PG8_MMA(1, 0, At, B0); PG8_BAR; PG8_SCHED;
            PG8_STAGE(PG8_SB(0, 1), b2 + hstep, voffB);
            PG8_WAIT_V(6); PG8_BAR; PG8_MMA(1, 1, At, B1); PG8_BAR;
            PG8_LDB(B0, 1, 0); PG8_SCHED; PG8_LDA(At, 1, 0); PG8_STAGE(PG8_SA(0, 1), a2 + hstepA, voffA);
            PG8_WAIT_L(8); PG8_BAR; PG8_WAIT_L(0); PG8_MMA(0, 0, At, B0); PG8_BAR; PG8_SCHED;
            PG8_LDB(B1, 1, 1); PG8_STAGE(PG8_SB(1, 0), b3, voffB);
            PG8_BAR; PG8_WAIT_L(0); PG8_MMA(0, 1, At, B1); PG8_BAR;
            PG8_LDA(At, 1, 1); PG8_STAGE(PG8_SA(1, 0), a3, voffA);
            PG8_BAR; PG8_WAIT_L(0); PG8_MMA(1, 0, At, B0); PG8_BAR; PG8_SCHED;
            PG8_STAGE(PG8_SB(1, 1), b3 + hstep, voffB);
            PG8_WAIT_V(6); PG8_BAR; PG8_MMA(1, 1, At, B1); PG8_BAR;
            }
        }
        if constexpr (ALIGN_EPI) { if (wr == 0) PG8_BAR; }
        bool keep_acc = false;
        if constexpr (Epi::MID) { if (cur.kh == 0) { E.mid(acc, cur, wr, wc, fr, fq); keep_acc = true; } }
        if constexpr (!Epi::AFTER_DRAIN) { if (!keep_acc) { E(acc, cur, wr, wc, fr, fq); S.done(cur); } }
        if (!has_next) break;
        if (!keep_acc)
#pragma unroll
        for (int a = 0; a < 2; ++a)
#pragma unroll
            for (int b = 0; b < 2; ++b)
#pragma unroll
                for (int m = 0; m < 4; ++m)
#pragma unroll
                    for (int n = 0; n < 2; ++n) acc[a][b][m][n] = (f32x4){0.f, 0.f, 0.f, 0.f};
        cur = nxt; cA = nA; cB = nB; ++ui;
        if constexpr (ALIGN_EPI) { if (wr == 1) PG8_BAR; }
    }
    PG8_WAIT_V(0);
    if constexpr (!ALIGN_EPI) { if (wr == 0) PG8_BAR; }
    PG8_BAR;
    if constexpr (Epi::AFTER_DRAIN) { E.fused(acc, cur, wr, wc, fr, fq, lds, wid, lane); S.done(cur); }
#undef PG8_SA
#undef PG8_SB
#undef PG8_STAGE
#undef PG8_LDA
#undef PG8_LDB
#undef PG8_MMA
#undef PG8_WAIT_V
#undef PG8_WAIT_L
#undef PG8_BAR
#undef PG8_SCHED
}
}
#define LAS __attribute__((address_space(3)))
typedef unsigned short bf16;
typedef short bf16x8 __attribute__((ext_vector_type(8)));
typedef short s16x4 __attribute__((ext_vector_type(4)));
typedef float f32x4 __attribute__((ext_vector_type(4)));
typedef float f32x16 __attribute__((ext_vector_type(16)));
typedef unsigned u32x4 __attribute__((ext_vector_type(4)));
typedef unsigned u32x2 __attribute__((ext_vector_type(2)));
typedef float f32x2_t __attribute__((ext_vector_type(2))); typedef __bf16 bf16x2_t __attribute__((ext_vector_type(2)));

constexpr int T = 16384, DM = 1024, SEQ = 2048;
constexpr int NWAVES = 8, NTHR = 512;
constexpr int LDS_BYTES = 147456;
constexpr float EPS = 1e-6f;
constexpr float ESCALE = 64.f;
constexpr float C2 = 0.125f * 1.4426950408889634f;
constexpr size_t MiB = 1u << 20;
constexpr size_t WS_WIN = 0, WS_WAC = 16 * MiB, WS_WOUT = 20 * MiB, WS_WQ = 22 * MiB, WS_SUBK = 26 * MiB, WS_SSQ = 27 * MiB;
constexpr size_t WS_EU = 28 * MiB, WS_EV = 44 * MiB, WS_BIG = 60 * MiB, WS_END = 252 * MiB;
constexpr size_t B_QKV = 0, B_GG = 96 * MiB, B_PR = 160 * MiB, B_MG = 0, B_H2B = 32 * MiB, B_QP = 96 * MiB, B_SEL = 64 * MiB, B_GATE = 72 * MiB;

__device__ __forceinline__ unsigned cvtpk(float lo, float hi) { f32x2_t v = {lo, hi}; bf16x2_t b = __builtin_convertvector(v, bf16x2_t); return __builtin_bit_cast(unsigned, b); }
__device__ __forceinline__ float wave_sum(float v) {
#pragma unroll
    for (int o = 1; o < 64; o <<= 1) v += __shfl_xor(v, o);
    return v;
}
#define LDS_WAIT() asm volatile("s_waitcnt lgkmcnt(0)" ::: "memory")

struct Params {
    const float* x; const float* norm1_g; const float* w_in; const float* lambda_qk; const float* subln_g; const float* conv_w;
    const float* w_attn_o; const float* w_conv_o; const float* w_out; const float* norm2_g; const float* w_query; const float* sub_keys;
    const float* expert_u; const float* expert_v; const float* final_g;
    float* out; unsigned char* ws; int lo, hi;
};

__device__ __forceinline__ void transpose_item(const float* W, int K, int N, bf16* WT, int remap, int dpitch, int koff, const float* kscale, LAS float* scr, int item, int lane) {
    const int nblk = N / 32, kb = item / nblk, nb = item % nblk, k0 = 64 * kb, n0 = 32 * nb;
    int d0 = n0, dstr = 1;
    if (remap) { if (n0 < 3072) d0 = n0; else if (n0 < 4096) d0 = n0 + 2048; else if (n0 < 5120) { d0 = 6144 + 2 * (n0 - 4096); dstr = 2; } else if (n0 < 6144) { d0 = 6144 + 2 * (n0 - 5120) + 1; dstr = 2; } else d0 = n0 - 3072; }
    { float wv[32];
#pragma unroll
      for (int i = 0; i < 32; ++i) wv[i] = W[(size_t)(k0 + 2 * i + (lane >> 5)) * N + n0 + (lane & 31)];
#pragma unroll
      for (int i = 0; i < 32; ++i) { const int kk = 2 * i + (lane >> 5); float v = wv[i]; if (kscale) v *= kscale[k0 + kk]; scr[kk * 33 + (lane & 31)] = v; } }
    LDS_WAIT(); asm volatile("" ::: "memory");
    const int c = lane & 7;
#pragma unroll
    for (int j = 0; j < 4; ++j) { const int n = (lane >> 3) + 8 * j; const LAS float* sp = scr + (8 * c) * 33 + n;
        u32x4 o; o.x = cvtpk(sp[0 * 33], sp[1 * 33]); o.y = cvtpk(sp[2 * 33], sp[3 * 33]); o.z = cvtpk(sp[4 * 33], sp[5 * 33]); o.w = cvtpk(sp[6 * 33], sp[7 * 33]);
        *(u32x4*)(WT + (size_t)(d0 + n * dstr) * dpitch + koff + k0 + 8 * c) = o; }
    LDS_WAIT(); asm volatile("" ::: "memory");
}
__device__ __forceinline__ void cvt_flat(const float* src, bf16* dst, size_t n8, size_t gtid, size_t nthr) {
    for (size_t i = gtid; i < n8; i += nthr) { const f32x4 a = *(const f32x4*)(src + i * 8), b = *(const f32x4*)(src + i * 8 + 4);
        u32x4 o; o.x = cvtpk(a[0], a[1]); o.y = cvtpk(a[2], a[3]); o.z = cvtpk(b[0], b[1]); o.w = cvtpk(b[2], b[3]); *(u32x4*)(dst + i * 8) = o; }
}
__device__ __forceinline__ void cvt_flat_fp8(const float* src, unsigned char* dst, size_t n16, float sc, size_t gtid, size_t nthr) {
    for (size_t i = gtid; i < n16; i += nthr) { u32x4 o;
#pragma unroll
        for (int q = 0; q < 4; ++q) { const f32x4 a = *(const f32x4*)(src + i * 16 + 4 * q) * sc; int w = 0;
            w = __builtin_amdgcn_cvt_pk_fp8_f32(a[0], a[1], w, false); w = __builtin_amdgcn_cvt_pk_fp8_f32(a[2], a[3], w, true); o[q] = (unsigned)w; }
        *(u32x4*)(dst + i * 16) = o; }
}
__device__ __forceinline__ void phase0(const Params& p, LAS unsigned char* lds, int G, int bid, int wave, int lane) {
    unsigned char* ws = p.ws;
    LAS float* scr = (LAS float*)(lds + wave * 16384);
    const int gw = bid * NWAVES + wave, NGW = G * NWAVES;
    constexpr int I_IN = 16 * 256, I_SQ = 16 * 32, I_Q = 16 * 64, NITEMS = I_IN + 3 * I_SQ + I_Q;
    for (int it = gw; it < NITEMS; it += NGW) {
        int r = it;
        if (r < I_IN) { transpose_item(p.w_in, 1024, 8192, (bf16*)(ws + WS_WIN), 1, 1024, 0, nullptr, scr, r, lane); continue; } r -= I_IN;
        if (r < I_SQ) { transpose_item(p.w_attn_o, 1024, 1024, (bf16*)(ws + WS_WAC), 0, 2048, 0, nullptr, scr, r, lane); continue; } r -= I_SQ;
        if (r < I_SQ) { transpose_item(p.w_conv_o, 1024, 1024, (bf16*)(ws + WS_WAC), 0, 2048, 1024, nullptr, scr, r, lane); continue; } r -= I_SQ;
        if (r < I_SQ) { transpose_item(p.w_out, 1024, 1024, (bf16*)(ws + WS_WOUT), 0, 1024, 0, nullptr, scr, r, lane); continue; } r -= I_SQ;
        transpose_item(p.w_query, 1024, 2048, (bf16*)(ws + WS_WQ), 0, 1024, 0, p.norm2_g, scr, r, lane);
    }
    const size_t gtid = (size_t)bid * NTHR + wave * 64 + lane, nthr = (size_t)G * NTHR;
    cvt_flat(p.sub_keys, (bf16*)(ws + WS_SUBK), (size_t)(8 * 2 * 128 * 128) / 8, gtid, nthr);
    bf16* N1 = (bf16*)p.out;
    f32x4 gv[4];
#pragma unroll
    for (int j = 0; j < 4; ++j) gv[j] = *((const f32x4*)p.norm1_g + lane + 64 * j);
    for (int m0 = gw; m0 < T; m0 += 2 * NGW) {
        const int m1 = (m0 + NGW < T) ? m0 + NGW : m0;
        const f32x4* xr0 = (const f32x4*)(p.x + (size_t)m0 * DM) + lane; const f32x4* xr1 = (const f32x4*)(p.x + (size_t)m1 * DM) + lane;
        f32x4 v0[4], v1[4]; float s0 = 0.f, s1 = 0.f;
#pragma unroll
        for (int j = 0; j < 4; ++j) { v0[j] = xr0[64 * j]; v1[j] = xr1[64 * j]; }
#pragma unroll
        for (int j = 0; j < 4; ++j) { s0 += (v0[j][0] * v0[j][0] + v0[j][1] * v0[j][1]) + (v0[j][2] * v0[j][2] + v0[j][3] * v0[j][3]);
                                      s1 += (v1[j][0] * v1[j][0] + v1[j][1] * v1[j][1]) + (v1[j][2] * v1[j][2] + v1[j][3] * v1[j][3]); }
        const float r0 = rsqrtf(wave_sum(s0) * (1.f / DM) + EPS), r1 = rsqrtf(wave_sum(s1) * (1.f / DM) + EPS);
        u32x2* o0 = (u32x2*)(N1 + (size_t)m0 * 2048) + lane; u32x2* o1 = (u32x2*)(N1 + (size_t)m1 * 2048) + lane;
#pragma unroll
        for (int j = 0; j < 4; ++j) { u32x2 o; o.x = cvtpk(v0[j][0] * r0 * gv[j][0], v0[j][1] * r0 * gv[j][1]); o.y = cvtpk(v0[j][2] * r0 * gv[j][2], v0[j][3] * r0 * gv[j][3]); o0[64 * j] = o;
            u32x2 q; q.x = cvtpk(v1[j][0] * r1 * gv[j][0], v1[j][1] * r1 * gv[j][1]); q.y = cvtpk(v1[j][2] * r1 * gv[j][2], v1[j][3] * r1 * gv[j][3]); o1[64 * j] = q; }
    }
}

__device__ __forceinline__ void up8(const bf16* p, float (&f)[8]) { const u32x4 w = *(const u32x4*)p; pg8::unpack8(w, f); }
__device__ __forceinline__ void phase_conv(const Params& p, int G, int bid, int tid) {
    const bf16* PR = (const bf16*)(p.ws + WS_BIG + B_PR); bf16* CBU = (bf16*)p.out + 1024;
    const size_t nthr = (size_t)G * NTHR;
    for (size_t it = (size_t)bid * NTHR + tid; it < (size_t)(T / 16) * 128; it += nthr) {
        const int t0 = (int)(it >> 7) * 16, c8 = (int)(it & 127) * 8, s0 = t0 & (SEQ - 1);
        const bf16* row = PR + (size_t)t0 * 1024 + c8;
        u32x4 pr[18], cbr[16];
#pragma unroll
        for (int i = 0; i < 16; ++i) { pr[i + 2] = *(const u32x4*)(row + (size_t)i * 1024); cbr[i] = *(const u32x4*)(CBU + (size_t)(t0 + i) * 2048 + c8); }
        if (s0 != 0) { pr[0] = *(const u32x4*)(row - 2048); pr[1] = *(const u32x4*)(row - 1024); } else { pr[0] = (u32x4){0u, 0u, 0u, 0u}; pr[1] = pr[0]; }
        float w0[8], w1[8], w2[8];
#pragma unroll
        for (int i = 0; i < 8; ++i) { w0[i] = p.conv_w[c8 + i]; w1[i] = p.conv_w[1024 + c8 + i]; w2[i] = p.conv_w[2048 + c8 + i]; }
        float fa[8], fb[8], fc[8];
        pg8::unpack8(pr[0], fa); pg8::unpack8(pr[1], fb);
#pragma unroll
        for (int i = 0; i < 16; ++i) {
            pg8::unpack8(pr[i + 2], fc);
            float cb[8]; pg8::unpack8(cbr[i], cb);
            float o[8];
#pragma unroll
            for (int c = 0; c < 8; ++c) o[c] = cb[c] * (w0[c] * fa[c] + w1[c] * fb[c] + w2[c] * fc[c]);
            u32x4 w; w.x = cvtpk(o[0], o[1]); w.y = cvtpk(o[2], o[3]); w.z = cvtpk(o[4], o[5]); w.w = cvtpk(o[6], o[7]);
            *(u32x4*)(CBU + (size_t)(t0 + i) * 2048 + c8) = w;
#pragma unroll
            for (int c = 0; c < 8; ++c) { fa[c] = fb[c]; fb[c] = fc[c]; }
        }
    }
}

constexpr int KPITCH = 272, VPITCH = 320, KBYTES = 64 * KPITCH, STAGEB = KBYTES + 64 * VPITCH;
constexpr int XOFF = 0, OSTOFF = 65536, OSTPITCH = 272, OSTB = 32 * OSTPITCH;
__device__ __forceinline__ s16x4 vtr(const LAS unsigned char* p) { return __builtin_amdgcn_ds_read_tr16_b64_v4i16((LAS s16x4*)p); }

__device__ __forceinline__ void attn_unit(LAS unsigned char* lds, const bf16* QKV, bf16* ON, const float* subg, float lam, int b, int h, int qb, int tid) {
    const int w = __builtin_amdgcn_readfirstlane(tid >> 6), lane = tid & 63, map = w >> 2, wq = w & 3, l31 = lane & 31, half = lane >> 5;
    const size_t trow0 = (size_t)b * SEQ;
    const int q0 = qb * 128 + wq * 32;
    bf16x8 qf[4];
    { const bf16* qp = QKV + (trow0 + q0 + l31) * 3072 + h * 128 + map * 64 + 8 * half;
#pragma unroll
      for (int s = 0; s < 4; ++s) qf[s] = *(const bf16x8*)(qp + 16 * s); }
    f32x16 O[4];
#pragma unroll
    for (int e = 0; e < 4; ++e)
#pragma unroll
        for (int r = 0; r < 16; ++r) O[e][r] = 0.f;
    float m_run = 0.f, l_run = 0.f;
    const int ntile = 2 * (qb + 1);
    const int skey = tid >> 4, sch = tid & 15;
    const bf16* gk = QKV + (trow0 + skey) * 3072 + 1024 + h * 128 + sch * 8;
    const int dk = skey * KPITCH + sch * 16, dv = KBYTES + skey * VPITCH + sch * 16;
    u32x4 stg[4];
#define GLOAD(j) do { const bf16* g_ = gk + (size_t)(j) * 64 * 3072; stg[0] = *(const u32x4*)g_; stg[1] = *(const u32x4*)(g_ + 32 * 3072); stg[2] = *(const u32x4*)(g_ + 1024); stg[3] = *(const u32x4*)(g_ + 32 * 3072 + 1024); } while (0)
#define LSTORE(st) do { LAS unsigned char* b_ = lds + (st) * STAGEB; *(LAS u32x4*)(b_ + dk) = stg[0]; *(LAS u32x4*)(b_ + dk + 32 * KPITCH) = stg[1]; *(LAS u32x4*)(b_ + dv) = stg[2]; *(LAS u32x4*)(b_ + dv + 32 * VPITCH) = stg[3]; } while (0)
    GLOAD(0); LSTORE(0); __syncthreads();
    const int koff = l31 * KPITCH + map * 128 + half * 16;
    const int voff = KBYTES + (4 * half + ((lane & 15) >> 2)) * VPITCH + (((lane >> 4) & 1) * 16 + (lane & 3) * 4) * 2;
    const int qi = q0 + l31;
    for (int j = 0; j < ntile; ++j) {
        if (j + 1 < ntile) GLOAD(j + 1);
        const int kbase = 64 * j;
        if (kbase <= q0 + 31) {
            const LAS unsigned char* sb = lds + (j & 1) * STAGEB;
            f32x16 s0, s1;
            const float negm = -m_run;
#pragma unroll
            for (int r = 0; r < 16; ++r) { s0[r] = negm; s1[r] = negm; }
#pragma unroll
            for (int s = 0; s < 4; ++s) { const bf16x8 k0 = *(const LAS bf16x8*)(sb + koff + s * 32), k1 = *(const LAS bf16x8*)(sb + koff + 32 * KPITCH + s * 32);
                s0 = __builtin_amdgcn_mfma_f32_32x32x16_bf16(k0, qf[s], s0, 0, 0, 0); s1 = __builtin_amdgcn_mfma_f32_32x32x16_bf16(k1, qf[s], s1, 0, 0, 0); }
            const LAS unsigned char* vb = sb + voff;
            s16x4 vlo[4][4], vhi[4][4];
            if (kbase + 63 > q0) {
#pragma unroll
                for (int r = 0; r < 16; ++r) { const int key = kbase + (r & 3) + 8 * (r >> 2) + 4 * half;
                    s0[r] = (key <= qi) ? s0[r] : -1e30f; s1[r] = (key + 32 <= qi) ? s1[r] : -1e30f; }
            }
            float mx = fmaxf(s0[0], s1[0]);
#pragma unroll
            for (int r = 1; r < 16; ++r) mx = fmaxf(mx, fmaxf(s0[r], s1[r]));
            mx = fmaxf(mx, __shfl_xor(mx, 32));
            float ps = 0.f;
            const bool first = (j == 0), move = first || (__ballot(mx > 8.f) != 0ull);
            const float delta = move ? (first ? mx : fmaxf(mx, 0.f)) : 0.f;
#pragma unroll
            for (int r = 0; r < 16; ++r) { s0[r] = __builtin_amdgcn_exp2f(s0[r] - delta); s1[r] = __builtin_amdgcn_exp2f(s1[r] - delta); ps += s0[r] + s1[r]; }
            if (move) {
                const float alpha = first ? 0.f : __builtin_amdgcn_exp2f(-delta); m_run += delta;
                l_run = l_run * alpha + ps;
                if (!first) {
#pragma unroll
                    for (int e = 0; e < 4; ++e) O[e] = O[e] * alpha;
                }
            } else l_run += ps;
            bf16x8 pf[4];
#pragma unroll
            for (int kk = 0; kk < 4; ++kk) { u32x4 wv;
                if (kk < 2) { wv.x = cvtpk(s0[8 * kk + 0], s0[8 * kk + 1]); wv.y = cvtpk(s0[8 * kk + 2], s0[8 * kk + 3]); wv.z = cvtpk(s0[8 * kk + 4], s0[8 * kk + 5]); wv.w = cvtpk(s0[8 * kk + 6], s0[8 * kk + 7]); }
                else { const int k2 = kk - 2; wv.x = cvtpk(s1[8 * k2 + 0], s1[8 * k2 + 1]); wv.y = cvtpk(s1[8 * k2 + 2], s1[8 * k2 + 3]); wv.z = cvtpk(s1[8 * k2 + 4], s1[8 * k2 + 5]); wv.w = cvtpk(s1[8 * k2 + 6], s1[8 * k2 + 7]); }
                pf[kk] = __builtin_bit_cast(bf16x8, wv); }
#pragma unroll
            for (int e = 0; e < 4; ++e) { vlo[0][e] = vtr(vb + e * 64); vhi[0][e] = vtr(vb + 8 * VPITCH + e * 64); }
#pragma unroll
            for (int kk = 0; kk < 4; ++kk)
#pragma unroll
                for (int e = 0; e < 4; ++e) {
                    if (e == 0 && kk < 3) {
#pragma unroll
                        for (int e2 = 0; e2 < 4; ++e2) { vlo[kk + 1][e2] = vtr(vb + (kk + 1) * 16 * VPITCH + e2 * 64); vhi[kk + 1][e2] = vtr(vb + ((kk + 1) * 16 + 8) * VPITCH + e2 * 64); }
                        __builtin_amdgcn_sched_barrier(0);
                    }
                    const s16x4 lo = vlo[kk][e], hi = vhi[kk][e];
                    bf16x8 a; a[0] = lo[0]; a[1] = lo[1]; a[2] = lo[2]; a[3] = lo[3]; a[4] = hi[0]; a[5] = hi[1]; a[6] = hi[2]; a[7] = hi[3];
                    O[e] = __builtin_amdgcn_mfma_f32_32x32x16_bf16(a, pf[kk], O[e], 0, 0, 0); }
        }
        if (j + 1 < ntile) LSTORE((j + 1) & 1);
        __syncthreads();
    }
#undef GLOAD
#undef LSTORE
    const float ltot = l_run + __shfl_xor(l_run, 32), inv = 1.f / ltot;
    LAS float* X = (LAS float*)(lds + XOFF) + wq * 4096 + lane;
    if (map == 1) {
        const float sc = inv * lam;
#pragma unroll
        for (int e = 0; e < 4; ++e)
#pragma unroll
            for (int r = 0; r < 16; ++r) X[(e * 16 + r) * 64] = O[e][r] * sc;
    }
    __syncthreads();
    if (map == 0) {
        float ssq = 0.f;
#pragma unroll
        for (int e = 0; e < 4; ++e)
#pragma unroll
            for (int r = 0; r < 16; ++r) { const float o = O[e][r] * inv - X[(e * 16 + r) * 64]; O[e][r] = o; ssq += o * o; }
        ssq += __shfl_xor(ssq, 32);
        const float rms = rsqrtf(ssq * (1.f / 128.f) + EPS) * 0.8f;
        LAS unsigned char* ost = lds + OSTOFF + wq * OSTB;
#pragma unroll
        for (int e = 0; e < 4; ++e)
#pragma unroll
            for (int rq = 0; rq < 4; ++rq) { const int e0 = 32 * e + 8 * rq + 4 * half; const f32x4 g = *(const f32x4*)(subg + e0);
                u32x2 o; o.x = cvtpk(O[e][4 * rq + 0] * rms * g[0], O[e][4 * rq + 1] * rms * g[1]); o.y = cvtpk(O[e][4 * rq + 2] * rms * g[2], O[e][4 * rq + 3] * rms * g[3]);
                *(LAS u32x2*)(ost + l31 * OSTPITCH + e0 * 2) = o; }
        LDS_WAIT(); __builtin_amdgcn_wave_barrier();
#pragma unroll
        for (int jj = 0; jj < 8; ++jj) { const int c = lane + 64 * jj, row = c >> 4, ch = c & 15;
            const u32x4 v = *(const LAS u32x4*)(ost + row * OSTPITCH + ch * 16);
            *(u32x4*)(ON + (trow0 + q0 + row) * 2048 + h * 128 + ch * 8) = v; }
    }
    __syncthreads();
}

__device__ __forceinline__ void phase_attn(const Params& p, LAS unsigned char* lds, int G, int bid, int tid) {
    const bf16* QKV = (const bf16*)(p.ws + WS_BIG); bf16* ON = (bf16*)p.out;
    const int lane = tid & 63;
    const float a = p.lambda_qk[lane] * p.lambda_qk[64 + lane], b = p.lambda_qk[128 + lane] * p.lambda_qk[192 + lane];
    const float lam = expf(wave_sum(a)) - expf(wave_sum(b)) + 0.2f;
    for (int c = bid; c < 256; c += G) {
        const int bh = c >> 2, quad = c & 3, b_ = bh >> 3, h = bh & 7;
        attn_unit(lds, QKV, ON, p.subln_g, lam, b_, h, 15 - 2 * quad, tid);
        attn_unit(lds, QKV, ON, p.subln_g, lam, b_, h, 2 * quad, tid);
        attn_unit(lds, QKV, ON, p.subln_g, lam, b_, h, 14 - 2 * quad, tid);
        attn_unit(lds, QKV, ON, p.subln_g, lam, b_, h, 2 * quad + 1, tid);
    }
}

__device__ __forceinline__ unsigned mono(float v) { const unsigned u = __builtin_bit_cast(unsigned, v); return (u & 0x80000000u) ? ~u : (u | 0x80000000u); }
__device__ __forceinline__ float unmono(unsigned k) { const unsigned u = (k & 0x80000000u) ? (k ^ 0x80000000u) : ~k; return __builtin_bit_cast(float, u); }
#define CE_(x, y) do { const unsigned t_ = max(x, y); y = min(x, y); x = t_; } while (0)
__device__ __forceinline__ void sort16(unsigned (&a)[16]) {
    CE_(a[0], a[1]); CE_(a[2], a[3]); CE_(a[0], a[2]); CE_(a[1], a[3]); CE_(a[1], a[2]); CE_(a[4], a[5]); CE_(a[6], a[7]); CE_(a[4], a[6]); CE_(a[5], a[7]); CE_(a[5], a[6]); CE_(a[0], a[4]); CE_(a[2], a[6]); CE_(a[2], a[4]); CE_(a[1], a[5]); CE_(a[3], a[7]); CE_(a[3], a[5]); CE_(a[1], a[2]); CE_(a[3], a[4]); CE_(a[5], a[6]); CE_(a[8], a[9]); CE_(a[10], a[11]); CE_(a[8], a[10]); CE_(a[9], a[11]); CE_(a[9], a[10]); CE_(a[12], a[13]); CE_(a[14], a[15]); CE_(a[12], a[14]); CE_(a[13], a[15]); CE_(a[13], a[14]); CE_(a[8], a[12]); CE_(a[10], a[14]); CE_(a[10], a[12]); CE_(a[9], a[13]); CE_(a[11], a[15]); CE_(a[11], a[13]); CE_(a[9], a[10]); CE_(a[11], a[12]); CE_(a[13], a[14]); CE_(a[0], a[8]); CE_(a[4], a[12]); CE_(a[4], a[8]); CE_(a[2], a[10]); CE_(a[6], a[14]); CE_(a[6], a[10]); CE_(a[2], a[4]); CE_(a[6], a[8]); CE_(a[10], a[12]); CE_(a[1], a[9]); CE_(a[5], a[13]); CE_(a[5], a[9]); CE_(a[3], a[11]); CE_(a[7], a[15]); CE_(a[7], a[11]); CE_(a[3], a[5]); CE_(a[7], a[9]); CE_(a[11], a[13]); CE_(a[1], a[2]); CE_(a[3], a[4]); CE_(a[5], a[6]); CE_(a[7], a[8]); CE_(a[9], a[10]); CE_(a[11], a[12]); CE_(a[13], a[14]);
}
__device__ __forceinline__ void merge16(unsigned (&a)[16], const unsigned (&b)[16]) {
    a[0] = max(a[0], b[15]); a[1] = max(a[1], b[14]); a[2] = max(a[2], b[13]); a[3] = max(a[3], b[12]); a[4] = max(a[4], b[11]); a[5] = max(a[5], b[10]); a[6] = max(a[6], b[9]); a[7] = max(a[7], b[8]); a[8] = max(a[8], b[7]); a[9] = max(a[9], b[6]); a[10] = max(a[10], b[5]); a[11] = max(a[11], b[4]); a[12] = max(a[12], b[3]); a[13] = max(a[13], b[2]); a[14] = max(a[14], b[1]); a[15] = max(a[15], b[0]);
    CE_(a[0], a[8]); CE_(a[1], a[9]); CE_(a[2], a[10]); CE_(a[3], a[11]); CE_(a[4], a[12]); CE_(a[5], a[13]); CE_(a[6], a[14]); CE_(a[7], a[15]); CE_(a[0], a[4]); CE_(a[1], a[5]); CE_(a[2], a[6]); CE_(a[3], a[7]); CE_(a[8], a[12]); CE_(a[9], a[13]); CE_(a[10], a[14]); CE_(a[11], a[15]); CE_(a[0], a[2]); CE_(a[1], a[3]); CE_(a[4], a[6]); CE_(a[5], a[7]); CE_(a[8], a[10]); CE_(a[9], a[11]); CE_(a[12], a[14]); CE_(a[13], a[15]); CE_(a[0], a[1]); CE_(a[2], a[3]); CE_(a[4], a[5]); CE_(a[6], a[7]); CE_(a[8], a[9]); CE_(a[10], a[11]); CE_(a[12], a[13]); CE_(a[14], a[15]);
}

__device__ __forceinline__ void convert_experts(const Params& p, size_t gtid, size_t nthr) {
    cvt_flat_fp8(p.expert_u, p.ws + WS_EU, (size_t)16384 * 1024 / 16, ESCALE, gtid, nthr);
    cvt_flat_fp8(p.expert_v, p.ws + WS_EV, (size_t)16384 * 1024 / 16, ESCALE, gtid, nthr);
}
__device__ __forceinline__ void phase_topk(const Params& p, LAS unsigned char* lds, int G, int bid, int wave, int lane) {
    const bf16* QP = (const bf16*)(p.ws + WS_BIG + B_QP); const bf16* SK = (const bf16*)(p.ws + WS_SUBK);
    int* SEL = (int*)(p.ws + WS_BIG + B_SEL); float* GATE = (float*)(p.ws + WS_BIG + B_GATE);
    const int gw = bid * NWAVES + wave, NGW = G * NWAVES, l31 = lane & 31, half = lane >> 5;
    LAS int* tab = (LAS int*)(lds + wave * 12288) + l31 * 32;
    LAS unsigned char* qst = lds + wave * 12288 + 4096 + lane * 16;
    LAS unsigned char* skl = lds + 8 * 12288;
    const float* ctab = (wave < 4) ? p.expert_u : p.expert_v; unsigned char* cdst = p.ws + ((wave < 4) ? WS_EU : WS_EV);
    const int tid_ = wave * 64 + lane;
    for (int sbk = bid; sbk < 256; sbk += G)
    for (int rnd = 0; rnd < 2; ++rnd) {
        const int tg = 8 * (sbk >> 2) + wave, h = 2 * (sbk & 3) + rnd, t = tg * 32 + l31;
        unsigned lists[2][16];
#pragma unroll
        for (int m = 0; m < 2; ++m) {
            f32x16 acc[4];
#pragma unroll
            for (int kb = 0; kb < 4; ++kb)
#pragma unroll
                for (int r = 0; r < 16; ++r) acc[kb][r] = 0.f;
            const bf16* qp = QP + (size_t)t * 2048 + h * 256 + m * 128 + 8 * half;
            { const bf16* sks = SK + (size_t)(h * 2 + m) * 128 * 128;
#pragma unroll
              for (int jj = 0; jj < 4; ++jj) { const int c = tid_ + 512 * jj, row = c >> 4, ch = c & 15;
                  *(LAS u32x4*)(skl + row * 272 + ch * 16) = *(const u32x4*)(sks + row * 128 + ch * 8); } }
            __syncthreads();
            const size_t cbase = ((size_t)(sbk * 4 + (wave & 3)) * 1024 + (size_t)(rnd * 2 + m) * 256 + lane) * 16;
#define CAST_SLICE() do { _Pragma("unroll") for (int j = 0; j < 4; ++j) { const size_t o_ = cbase + (size_t)j * 64 * 16; u32x4 w_; \
                _Pragma("unroll") for (int q = 0; q < 4; ++q) { const f32x4 a_ = *(const f32x4*)(ctab + o_ + 4 * q) * ESCALE; int x_ = 0; \
                    x_ = __builtin_amdgcn_cvt_pk_fp8_f32(a_[0], a_[1], x_, false); x_ = __builtin_amdgcn_cvt_pk_fp8_f32(a_[2], a_[3], x_, true); w_[q] = (unsigned)x_; } \
                *(u32x4*)(cdst + o_) = w_; } } while (0)
            if (wave < 4) CAST_SLICE();
            const LAS unsigned char* kl = skl + l31 * 272 + half * 16;
            { u32x4 tq[8];
#pragma unroll
              for (int s = 0; s < 8; ++s) tq[s] = *(const u32x4*)(qp + 16 * s);
#pragma unroll
              for (int s = 0; s < 8; ++s) *(LAS u32x4*)(qst + s * 1024) = tq[s]; }
#pragma unroll 2
            for (int s = 0; s < 8; ++s) {
                const bf16x8 bq = *(const LAS bf16x8*)(qst + s * 1024);
#pragma unroll
                for (int kb = 0; kb < 4; ++kb) { const bf16x8 ak = *(const LAS bf16x8*)(kl + kb * 32 * 272 + s * 32); acc[kb] = __builtin_amdgcn_mfma_f32_32x32x16_bf16(ak, bq, acc[kb], 0, 0, 0); }
            }
            unsigned top[16], oth[16];
#pragma unroll
            for (int kb = 0; kb < 4; ++kb) {
#pragma unroll
                for (int r = 0; r < 16; ++r) { const int kidx = 32 * kb + (r & 3) + 8 * (r >> 2) + 4 * half; oth[r] = (mono(acc[kb][r]) & ~127u) | (unsigned)(127 - kidx); }
                sort16(oth);
                if (kb == 0) {
#pragma unroll
                    for (int i = 0; i < 16; ++i) top[i] = oth[i];
                } else merge16(top, oth);
            }
#pragma unroll
            for (int i = 0; i < 16; ++i) oth[i] = (unsigned)__shfl_xor((int)top[i], 32);
            merge16(top, oth);
#pragma unroll
            for (int i = 0; i < 16; ++i) lists[m][i] = top[i];
            if (wave >= 4) CAST_SLICE();
#undef CAST_SLICE
            __syncthreads();
        }
        float va[16], vb[16];
#pragma unroll
        for (int i = 0; i < 16; ++i) { va[i] = unmono(lists[0][i] & ~127u); vb[i] = unmono(lists[1][i] & ~127u);
            tab[i] = 127 - (int)(lists[0][i] & 127u); tab[16 + i] = 127 - (int)(lists[1][i] & 127u); }
#define CKEY(i, j) ((mono(va[i] + vb[j]) & ~255u) | (unsigned)(255 - ((i) * 16 + (j))))
        unsigned ct[16], l1[16], l2[16], l3[16];
#pragma unroll
        for (int j = 0; j < 16; ++j) ct[j] = CKEY(0, j);
#pragma unroll
        for (int j = 0; j < 8; ++j) l1[j] = CKEY(1, j);
#pragma unroll
        for (int j = 0; j < 5; ++j) l1[8 + j] = CKEY(2, j);
        l1[13] = 0u; l1[14] = 0u; l1[15] = 0u;
#pragma unroll
        for (int j = 0; j < 4; ++j) l2[j] = CKEY(3, j);
#pragma unroll
        for (int j = 0; j < 3; ++j) l2[4 + j] = CKEY(4, j);
#pragma unroll
        for (int j = 0; j < 2; ++j) { l2[7 + j] = CKEY(5, j); l2[9 + j] = CKEY(6, j); l2[11 + j] = CKEY(7, j); }
        l2[13] = 0u; l2[14] = 0u; l2[15] = 0u;
#pragma unroll
        for (int i = 0; i < 8; ++i) { l3[i] = CKEY(8 + i, 0); l3[8 + i] = 0u; }
#undef CKEY
        sort16(l1); sort16(l2); sort16(l3);
        merge16(ct, l1); merge16(l2, l3); merge16(ct, l2);
        LDS_WAIT(); __builtin_amdgcn_wave_barrier();
        const float s0 = unmono(ct[0] & ~255u);
        float ev[16], es = 0.f; int ex[16];
#pragma unroll
        for (int r = 0; r < 16; ++r) { const int pos = 255 - (int)(ct[r] & 255u); ev[r] = __expf(unmono(ct[r] & ~255u) - s0); es += ev[r];
            ex[r] = tab[pos >> 4] * 128 + tab[16 + (pos & 15)]; }
        const float ie = 1.f / es;
        int* so = SEL + (size_t)t * 128 + h * 16; float* go = GATE + (size_t)t * 128 + h * 16;
        if (half == 0) {
#pragma unroll
            for (int r = 0; r < 8; ++r) { so[r] = ex[r]; go[r] = ev[r] * ie; }
        } else {
#pragma unroll
            for (int r = 8; r < 16; ++r) { so[r] = ex[r]; go[r] = ev[r] * ie; }
        }
        LDS_WAIT(); __builtin_amdgcn_wave_barrier();
    }
}

__device__ __forceinline__ float gelu_as(float v) {
    const float av = fabsf(v), t = __builtin_amdgcn_rcpf(av * 0.2316418882f + 1.0f);
    float q = t * 0.5307027145f + (-0.7265760135f); q = q * t + 0.7107068705f; q = q * t + (-0.142248368f); q = q * t + 0.127414796f; q = q * t;
    const float e = __builtin_amdgcn_exp2f((v * v) * (-0.72134752044f)), m = v * (q * e);
    return v < 0.f ? m : v - m;
}
constexpr int KT = 4;
constexpr int GW_LDS = 17152;
constexpr int UPITCH = 272, USTG = 16 * UPITCH;
static_assert(KT == 4, "LDS map of the gather phase is laid out for 4 tokens per wave");
__device__ __forceinline__ void phase_gather(const Params& p, LAS unsigned char* lds, int G, int bid, int wave, int lane) {
    const int* SEL = (const int*)(p.ws + WS_BIG + B_SEL); const float* GATE = (const float*)(p.ws + WS_BIG + B_GATE);
    const unsigned char* EU = p.ws + WS_EU; const unsigned char* EV = p.ws + WS_EV;
    float* H2 = p.out;
    const int gw = bid * NWAVES + wave, NGW = G * NWAVES, l15 = lane & 15, g4 = lane >> 4;
    LAS unsigned char* wl = lds + wave * GW_LDS;
    LAS unsigned char* xnb = wl; LAS int* selb = (LAS int*)(wl + 4096); LAS float* gateb = (LAS float*)(wl + 6144); LAS float* hb = (LAS float*)(wl + 8192); LAS unsigned char* ustg = wl + 8448;
    for (int tb = gw * KT; tb < T; tb += NGW * KT) {
#pragma unroll 1
        for (int k = 0; k < KT; ++k) {
            const int t = tb + k;
            const float* hrow = H2 + (size_t)t * DM + 16 * lane;
            f32x4 hv[4];
#pragma unroll
            for (int j = 0; j < 4; ++j) hv[j] = *(const f32x4*)(hrow + 4 * j);
            const int selA = SEL[(size_t)t * 128 + lane], selB = SEL[(size_t)t * 128 + 64 + lane];
            const float gtA = GATE[(size_t)t * 128 + lane], gtB = GATE[(size_t)t * 128 + 64 + lane];
            float ssq = 0.f;
#pragma unroll
            for (int j = 0; j < 4; ++j) ssq += (hv[j][0] * hv[j][0] + hv[j][1] * hv[j][1]) + (hv[j][2] * hv[j][2] + hv[j][3] * hv[j][3]);
            const float r2 = rsqrtf(wave_sum(ssq) * (1.f / DM) + EPS);
            { u32x4 o;
#pragma unroll
              for (int j = 0; j < 4; ++j) { const f32x4 a = hv[j] * r2 * *(const f32x4*)(p.norm2_g + 16 * lane + 4 * j); int w = 0;
                  w = __builtin_amdgcn_cvt_pk_fp8_f32(a[0], a[1], w, false); w = __builtin_amdgcn_cvt_pk_fp8_f32(a[2], a[3], w, true); o[j] = (unsigned)w; }
              *(LAS u32x4*)(xnb + k * 1024 + 16 * lane) = o; }
            const int bA = selA >> 10, bB = selB >> 10; int posA = 0, posB = 0, off = 0;
#pragma unroll
            for (int b = 0; b < 16; ++b) {
                const unsigned long long mA = __ballot(bA == b), mB = __ballot(bB == b);
                const int cA = __popcll(mA), cB = __popcll(mB);
                const int rA = (int)__builtin_amdgcn_mbcnt_hi((unsigned)(mA >> 32), __builtin_amdgcn_mbcnt_lo((unsigned)mA, 0u));
                const int rB = (int)__builtin_amdgcn_mbcnt_hi((unsigned)(mB >> 32), __builtin_amdgcn_mbcnt_lo((unsigned)mB, 0u));
                if (bA == b) posA = off + rA;
                if (bB == b) posB = off + cA + rB;
                off += cA + cB;
            }
            selb[k * 128 + posA] = selA; gateb[k * 128 + posA] = gtA; selb[k * 128 + posB] = selB; gateb[k * 128 + posB] = gtB;
        }
        LDS_WAIT(); __builtin_amdgcn_wave_barrier();
        f32x2_t y[KT][8];
#pragma unroll
        for (int k = 0; k < KT; ++k)
#pragma unroll
            for (int i = 0; i < 8; ++i) y[k][i] = (f32x2_t){0.f, 0.f};
#pragma unroll 1
        for (int g = 0; g < 8; ++g) {
#pragma unroll
            for (int k = 0; k < KT; ++k) {
                asm volatile("" ::: "memory");
                f32x4 acc = (f32x4){0.f, 0.f, 0.f, 0.f};
                const int rr = lane >> 4, cc = lane & 15;
                const unsigned char* rp[4];
#pragma unroll
                for (int i = 0; i < 4; ++i) rp[i] = EU + (size_t)selb[k * 128 + 16 * g + 4 * i + rr] * DM + 16 * cc;
                u32x4 ld[4];
#pragma unroll
                for (int i = 0; i < 4; ++i) ld[i] = *(const u32x4*)(rp[i]);
#pragma unroll
                for (int qd = 0; qd < 4; ++qd) {
                    LAS unsigned char* sb = ustg + (qd & 1) * USTG;
#pragma unroll
                    for (int i = 0; i < 4; ++i) *(LAS u32x4*)(sb + (4 * i + rr) * UPITCH + 16 * cc) = ld[i];
                    if (qd < 3) {
#pragma unroll
                        for (int i = 0; i < 4; ++i) ld[i] = *(const u32x4*)(rp[i] + 256 * (qd + 1));
                    }
                    LDS_WAIT(); __builtin_amdgcn_wave_barrier();
                    const LAS unsigned char* ar = sb + l15 * UPITCH + 64 * g4;
                    const LAS unsigned char* xk = xnb + k * 1024 + 256 * qd + 64 * g4;
#pragma unroll
                    for (int i = 0; i < 4; ++i) { const u32x4 a = *(const LAS u32x4*)(ar + 16 * i); const u32x4 bx = *(const LAS u32x4*)(xk + 16 * i);
                        const long a0 = (long)(((unsigned long long)a.y << 32) | a.x), a1 = (long)(((unsigned long long)a.w << 32) | a.z);
                        const long b0 = (long)(((unsigned long long)bx.y << 32) | bx.x), b1 = (long)(((unsigned long long)bx.w << 32) | bx.z);
                        acc = __builtin_amdgcn_mfma_f32_16x16x32_fp8_fp8(a0, b0, acc, 0, 0, 0);
                        acc = __builtin_amdgcn_mfma_f32_16x16x32_fp8_fp8(a1, b1, acc, 0, 0, 0); }
                }
                if (l15 == 0) {
#pragma unroll
                    for (int j = 0; j < 4; ++j) { const float a = acc[j] * (1.f / ESCALE);
                        hb[k * 16 + 4 * g4 + j] = gelu_as(a) * gateb[k * 128 + 16 * g + 4 * g4 + j] * (1.f / ESCALE); }
                }
            }
            LDS_WAIT(); __builtin_amdgcn_wave_barrier();
#pragma unroll
            for (int k = 0; k < KT; ++k) {
                asm volatile("" ::: "memory");
                u32x4 vr[2][4];
#pragma unroll
                for (int i = 0; i < 4; ++i) vr[0][i] = *(const u32x4*)(EV + (size_t)selb[k * 128 + 16 * g + i] * DM + 16 * lane);
#pragma unroll
                for (int bt = 0; bt < 4; ++bt) {
                    if (bt < 3) {
#pragma unroll
                        for (int i = 0; i < 4; ++i) vr[(bt + 1) & 1][i] = *(const u32x4*)(EV + (size_t)selb[k * 128 + 16 * g + 4 * (bt + 1) + i] * DM + 16 * lane);
                    }
                    asm volatile("" ::: "memory");
#pragma unroll
                    for (int i = 0; i < 4; ++i) { const float hs = hb[k * 16 + 4 * bt + i]; const u32x4 v = vr[bt & 1][i];
#pragma unroll
                        for (int q = 0; q < 4; ++q) { const f32x2_t lo = __builtin_amdgcn_cvt_pk_f32_fp8((int)v[q], false), hi = __builtin_amdgcn_cvt_pk_f32_fp8((int)v[q], true);
                            y[k][2 * q] += lo * hs; y[k][2 * q + 1] += hi * hs; } }
                }
            }
            LDS_WAIT(); __builtin_amdgcn_wave_barrier();
        }
#pragma unroll
        for (int k = 0; k < KT; ++k) {
            float* hrow = H2 + (size_t)(tb + k) * DM + 16 * lane;
            f32x4 h3[4]; float s3 = 0.f;
#pragma unroll
            for (int j = 0; j < 4; ++j) { const f32x4 hv = *(const f32x4*)(hrow + 4 * j);
                h3[j][0] = hv[0] + y[k][2 * j][0]; h3[j][1] = hv[1] + y[k][2 * j][1]; h3[j][2] = hv[2] + y[k][2 * j + 1][0]; h3[j][3] = hv[3] + y[k][2 * j + 1][1];
                s3 += (h3[j][0] * h3[j][0] + h3[j][1] * h3[j][1]) + (h3[j][2] * h3[j][2] + h3[j][3] * h3[j][3]); }
            const float r3 = rsqrtf(wave_sum(s3) * (1.f / DM) + EPS);
#pragma unroll
            for (int j = 0; j < 4; ++j) *(f32x4*)(hrow + 4 * j) = h3[j] * r3 * *(const f32x4*)(p.final_g + 16 * lane + 4 * j);
        }
        LDS_WAIT(); __builtin_amdgcn_wave_barrier();
    }
}

#define XB_TMO      128
#define XB_XCNT(j)  (256  + 64 * (j))
#define XB_XSUB(j)  (1280 + 64 * (j))
#define XB_XGEN(j)  (2304 + 64 * (j))
#define XB_TOP      3328
#define XB_TOPGEN   3392
#define XCD_BAR_WORDS 3456
#define XB_SPIN_CAP (1u << 18)

__device__ __forceinline__ unsigned xb_ld(unsigned* p)              { return __hip_atomic_load(p, __ATOMIC_RELAXED, __HIP_MEMORY_SCOPE_AGENT); }
__device__ __forceinline__ unsigned xb_add(unsigned* p, unsigned v) { return __hip_atomic_fetch_add(p, v, __ATOMIC_RELAXED, __HIP_MEMORY_SCOPE_AGENT); }
__device__ __forceinline__ unsigned xb_xcc_id() { return (unsigned)__builtin_amdgcn_s_getreg((3 << 11) | 20) & 0xFu; }
#define XB_SPIN(cond, bar) do { unsigned _sp = 0; while (cond) { __builtin_amdgcn_s_sleep(1); \
    if ((++_sp & 255u) == 0u) { if (xb_ld(&(bar)[XB_TMO])) break; if (_sp > XB_SPIN_CAP) { atomicAdd(&(bar)[XB_TMO], 1u); break; } } } } while (0)

struct XcdBarrier {
    unsigned* bar; unsigned x;
    volatile LAS unsigned* st;
};

__device__ __forceinline__ XcdBarrier xcd_barrier_post(unsigned* bar, volatile LAS unsigned* st) {
    XcdBarrier b; b.bar = bar; b.x = xb_xcc_id(); b.st = st;
    if (threadIdx.x == 0) (void)xb_add(&bar[XB_XCNT(b.x)], 1u);
    return b;
}
__device__ __forceinline__ void xcd_barrier_complete(unsigned* bar, unsigned x, unsigned& nloc, unsigned& nx) {
    const unsigned G = gridDim.x * gridDim.y * gridDim.z;
    unsigned sum, cnt, mine, sp = 0u;
    for (;;) {
        sum = 0u; cnt = 0u; mine = 0u;
#pragma unroll
        for (unsigned j = 0; j < 16; ++j) { const unsigned c = xb_ld(&bar[XB_XCNT(j)]); sum += c; cnt += (c > 0u) ? 1u : 0u; mine = (j == x) ? c : mine; }
        if (sum == G) break;
        __builtin_amdgcn_s_sleep(1);
        if ((++sp & 255u) == 0u) { if (xb_ld(&bar[XB_TMO])) break; if (sp > XB_SPIN_CAP) { atomicAdd(&bar[XB_TMO], 1u); break; } }
    }
    nloc = mine > 0u ? mine : 1u; nx = cnt > 0u ? cnt : 1u;
}

__device__ __forceinline__ void xcd_barrier(const XcdBarrier& b) {
    asm volatile("s_waitcnt vmcnt(0)" ::: "memory");
    __syncthreads();
    if (threadIdx.x == 0) {
        unsigned* bar = b.bar;
        __builtin_amdgcn_s_waitcnt(0);
        unsigned nloc = b.st[0], nx = b.st[1];
        if (nloc == 0u) { xcd_barrier_complete(bar, b.x, nloc, nx); b.st[0] = nloc; b.st[1] = nx; }
        const unsigned old = xb_add(&bar[XB_XSUB(b.x)], 1u);
        const unsigned gen = old / nloc;
        if (old + 1u == (gen + 1u) * nloc) {
            __builtin_amdgcn_fence(__ATOMIC_RELEASE, "agent");
            asm volatile("s_waitcnt vmcnt(0)" ::: "memory");
            const unsigned og = xb_add(&bar[XB_TOP], 1u);
            const unsigned tg = og / nx;
            if (og + 1u == (tg + 1u) * nx) xb_add(&bar[XB_TOPGEN], 1u);
            else XB_SPIN(xb_ld(&bar[XB_TOPGEN]) == tg, bar);
            __builtin_amdgcn_fence(__ATOMIC_ACQUIRE, "agent");
            xb_add(&bar[XB_XGEN(b.x)], 1u);
            asm volatile("s_waitcnt vmcnt(0)" ::: "memory");
        } else {
            XB_SPIN(xb_ld(&bar[XB_XGEN(b.x)]) == gen, bar);
            __builtin_amdgcn_fence(__ATOMIC_ACQUIRE, "agent");
            asm volatile("s_waitcnt vmcnt(0)" ::: "memory");
        }
    }
    __syncthreads();
}

#ifndef ONE_LAUNCH
#define ONE_LAUNCH 1
#endif
constexpr int NPHASE = 8;
__global__ void __launch_bounds__(NTHR, 2) hybrid_fwd(Params p) {
    extern __shared__ __attribute__((aligned(16))) unsigned char lds_raw[];
    LAS unsigned char* lds = (LAS unsigned char*)lds_raw;
    const int tid = threadIdx.x, lane = tid & 63, wave = __builtin_amdgcn_readfirstlane(tid >> 6), G = gridDim.x, bid = blockIdx.x;
    unsigned char* ws = p.ws;
    volatile LAS unsigned* xst = (volatile LAS unsigned*)(lds + 139264);
    if (tid < 2) xst[tid] = 0u;
    __syncthreads();
    XcdBarrier xbar; xbar.bar = (unsigned*)(ws + WS_END); xbar.x = 0; xbar.st = xst;
    if (ONE_LAUNCH && p.hi - p.lo > 1) {
        if (bid == 0) { for (int i = tid; i < XCD_BAR_WORDS; i += NTHR) __hip_atomic_store((unsigned*)(ws + WS_END) + i, 0u, __ATOMIC_RELAXED, __HIP_MEMORY_SCOPE_AGENT); }
        cg::this_grid().sync();
        xbar = xcd_barrier_post((unsigned*)(ws + WS_END), xst);
    }
    const pg8::bf16_t* N1 = (const pg8::bf16_t*)p.out;
#ifdef ONLY
#define PH(k) if ((k) == ONLY && p.lo <= (k) && (k) < p.hi)
#else
#define PH(k) if (p.lo <= (k) && (k) < p.hi)
#endif
#define SEAM(k) do { if (ONE_LAUNCH && p.lo <= (k) && (k) + 1 < p.hi) { xcd_barrier(xbar); } } while (0)
#define FRESH_IDS int tid = threadIdx.x; asm volatile("" : "+v"(tid)); const int lane = tid & 63, wave = __builtin_amdgcn_readfirstlane(tid >> 6); (void)lane; (void)wave
    unsigned char* big = ws + WS_BIG;
    PH(0) { FRESH_IDS; phase0(p, lds, G, bid, wave, lane); SEAM(0); }
    PH(1) { FRESH_IDS; pg8::Gemm g{N1, (const pg8::bf16_t*)(ws + WS_WIN), T, 8192, 1024, 2048, 1024}; pg8::StaticOrder S; S.init(T, 8192, G, bid);
        pg8::EpiG1 E{(pg8::bf16_t*)(big + B_QKV), (pg8::bf16_t*)(big + B_GG), (pg8::bf16_t*)p.out + 1024, (pg8::bf16_t*)(big + B_PR), C2};
        pg8::gemm_phase<pg8::EpiG1, pg8::StaticOrder, true, true>(lds, g, S, E); SEAM(1); }
    PH(2) { FRESH_IDS; phase_attn(p, lds, G, bid, tid); phase_conv(p, G, bid, tid); SEAM(2); }
    PH(3) { FRESH_IDS; pg8::Gemm g{(const pg8::bf16_t*)p.out, (const pg8::bf16_t*)(ws + WS_WAC), T, 1024, 1024, 2048, 2048}; pg8::SplitKOrder S; S.base.init(T, 1024, G, bid);
        pg8::EpiMerged E{(const pg8::bf16_t*)(big + B_GG), (pg8::bf16_t*)(big + B_MG)};
        pg8::gemm_phase<pg8::EpiMerged, pg8::SplitKOrder, true, true>(lds, g, S, E); SEAM(3); }
    PH(4) { FRESH_IDS; pg8::Gemm g{(const pg8::bf16_t*)(big + B_MG), (const pg8::bf16_t*)(ws + WS_WOUT), T, 1024, 1024, 1024, 1024}; pg8::StaticOrder S; S.init(T, 1024, G, bid);
        pg8::EpiResid E{p.x, p.out, (pg8::bf16_t*)(big + B_H2B), (float*)(ws + WS_SSQ)};
        pg8::gemm_phase<pg8::EpiResid, pg8::StaticOrder, false, true>(lds, g, S, E); SEAM(4); }
    PH(5) { FRESH_IDS; pg8::Gemm g{(const pg8::bf16_t*)(big + B_H2B), (const pg8::bf16_t*)(ws + WS_WQ), T, 2048, 1024, 1024, 1024}; pg8::StaticOrder S; S.init(T, 2048, G, bid);
        pg8::EpiRowScale E{(const float*)(ws + WS_SSQ), (pg8::bf16_t*)(big + B_QP)};
        pg8::gemm_phase<pg8::EpiRowScale, pg8::StaticOrder, true, true>(lds, g, S, E); SEAM(5); }
    PH(6) { FRESH_IDS; phase_topk(p, lds, G, bid, wave, lane); SEAM(6); }
    PH(7) { FRESH_IDS; phase_gather(p, lds, G, bid, wave, lane); }
#undef PH
#undef SEAM
}

extern "C" void kernel_launch(void* const* d_in, const int* in_sizes, int n_in, void* d_out, int out_size, void* d_ws, size_t ws_size, hipStream_t stream) {
    static int grid = 0;
    if (grid == 0) {
        if (n_in != 15 || out_size != T * DM || ws_size < WS_END) { fprintf(stderr, "kernel_launch: unexpected problem (n_in %d out %d ws %zu)\n", n_in, out_size, ws_size); grid = -1; return; }
        int dev = 0, cus = 0, per_cu = 0;
        hipGetDevice(&dev); hipDeviceGetAttribute(&cus, hipDeviceAttributeMultiprocessorCount, dev);
        if (hipFuncSetAttribute((const void*)hybrid_fwd, hipFuncAttributeMaxDynamicSharedMemorySize, LDS_BYTES) != hipSuccess) { fprintf(stderr, "kernel_launch: hipFuncSetAttribute failed\n"); grid = -1; return; }
        if (hipOccupancyMaxActiveBlocksPerMultiprocessor(&per_cu, (const void*)hybrid_fwd, NTHR, LDS_BYTES) != hipSuccess || per_cu < 1) { fprintf(stderr, "kernel_launch: occupancy query says %d\n", per_cu); per_cu = 1; }
        (void)hipGetLastError();
        grid = cus * per_cu;
    }
    if (grid < 0) return;
    Params p{};
    p.x = (const float*)d_in[0]; p.norm1_g = (const float*)d_in[1]; p.w_in = (const float*)d_in[2]; p.lambda_qk = (const float*)d_in[3]; p.subln_g = (const float*)d_in[4];
    p.conv_w = (const float*)d_in[5]; p.w_attn_o = (const float*)d_in[6]; p.w_conv_o = (const float*)d_in[7]; p.w_out = (const float*)d_in[8]; p.norm2_g = (const float*)d_in[9];
    p.w_query = (const float*)d_in[10]; p.sub_keys = (const float*)d_in[11]; p.expert_u = (const float*)d_in[12]; p.expert_v = (const float*)d_in[13]; p.final_g = (const float*)d_in[14];
    p.out = (float*)d_out; p.ws = (unsigned char*)d_ws;
#if ONE_LAUNCH
    p.lo = 0; p.hi = NPHASE;
    void* args[] = {&p};
    hipError_t e = hipLaunchCooperativeKernel((const void*)hybrid_fwd, dim3(grid), dim3(NTHR), args, LDS_BYTES, stream);
    if (e != hipSuccess) fprintf(stderr, "cooperative launch failed: %s (grid %d)\n", hipGetErrorString(e), grid);
#else
    for (int k = 0; k < NPHASE; ++k) {
        p.lo = k; p.hi = k + 1; hipLaunchKernelGGL(hybrid_fwd, dim3(grid), dim3(NTHR), LDS_BYTES, stream, p); }
#endif
}
```
